# Optimizing an MI355X kernel written in HIP

```python
import math
import jax
import jax.numpy as jnp
from jax import lax
import numpy as np

D_MODEL = 2048
BATCH = 1
SEQ = 16384
DEPTH = 2

D_MIX = D_MODEL
D_CONV = D_MIX // 4
D_ATT = D_MIX // 2
D_SSM = D_MIX - D_CONV - D_ATT
CONV_WIDTH = 31
HEAD_DIM = 128
N_HEADS = D_ATT // HEAD_DIM
N_KV_HEADS = 2
GQA = N_HEADS // N_KV_HEADS
KV_W = N_KV_HEADS * HEAD_DIM
ROT_DIM = HEAD_DIM // 4
ROPE_THETA = 500000.0
CMP_LEN = 32
CMP_STRIDE = 16
SLC_LEN = 64
N_SEL = 16
WINDOW = 512
Q_BLOCK = 128
FORCE_BONUS = 1000.0
SSM_GROUP = 16
N_SSM_GROUPS = D_SSM // SSM_GROUP
SSM_STATE = 64
DT_MIN = 1e-3
DT_MAX = 1e-1
D_FF = 5632
N_EXPERTS = 8
TOP_K = 2
D_FF_EXPERT = 7168
N_DENSE = (DEPTH + 1) // 2
N_MOE = DEPTH // 2
EPS = 1e-5

OFF_CONV = 0
OFF_Q = OFF_CONV + 2 * D_CONV
OFF_KV = OFF_Q + D_ATT
OFF_GATE = OFF_KV + 6 * KV_W
OFF_SSM = OFF_GATE + 3 * N_HEADS
D_IN = OFF_SSM + D_SSM

kernel_name = 'hybrid_conv_nsa_s5_moe_block'


def _rmsnorm(x, g):
    xf = x.astype(jnp.float32)
    y = xf * lax.rsqrt(jnp.mean(xf * xf, axis=-1, keepdims=True) + EPS)
    return (y * g.astype(jnp.float32)).astype(x.dtype)


def _layernorm(x, g, b):
    xf = x.astype(jnp.float32)
    mu = jnp.mean(xf, axis=-1, keepdims=True)
    var = jnp.mean(jnp.square(xf - mu), axis=-1, keepdims=True)
    y = (xf - mu) * lax.rsqrt(var + EPS) * g.astype(jnp.float32) + b.astype(jnp.float32)
    return y.astype(x.dtype)


def _masked_softmax(s, mask):
    s = jnp.where(mask, s.astype(jnp.float32), -jnp.inf)
    m = jnp.max(s, axis=-1, keepdims=True)
    m = jnp.where(jnp.isfinite(m), m, 0.0)
    p = jnp.exp(s - m)
    return p / jnp.maximum(jnp.sum(p, axis=-1, keepdims=True), 1e-30)


def _rope_tables(positions):
    inv = ROPE_THETA ** (-jnp.arange(0, ROT_DIM, 2, dtype=jnp.float32) / ROT_DIM)
    ang = positions.astype(jnp.float32)[..., None] * inv
    return jnp.cos(ang)[:, :, None, :], jnp.sin(ang)[:, :, None, :]


def _rope_partial(t, cos, sin):
    half = ROT_DIM // 2
    tf = t[..., :ROT_DIM].astype(jnp.float32)
    t1, t2 = tf[..., :half], tf[..., half:]
    rot = jnp.concatenate([t1 * cos - t2 * sin, t2 * cos + t1 * sin], axis=-1)
    return jnp.concatenate([rot.astype(t.dtype), t[..., ROT_DIM:]], axis=-1)


def _swiglu(x, wg, wu, wd):
    return (jax.nn.silu(x @ wg) * (x @ wu)) @ wd


def _conv_module(h, dw_w, dw_b, ln_g, ln_b, pw_w, pw_b):
    a, b = h[..., :D_CONV], h[..., D_CONV:]
    u = a * jax.nn.sigmoid(b)
    y = lax.conv_general_dilated(
        u, dw_w[:, None, :], window_strides=(1,), padding=[(CONV_WIDTH - 1, 0)],
        dimension_numbers=('NWC', 'WIO', 'NWC'), feature_group_count=D_CONV) + dw_b
    y = jax.nn.silu(_layernorm(y, ln_g, ln_b))
    return y @ pw_w + pw_b


def _nsa_compress(k, pe, w1, w2):
    B, S, G, hd = k.shape
    ch = k.reshape(B, S // CMP_STRIDE, CMP_STRIDE, G, hd)
    blk = jnp.concatenate([ch[:, :-1], ch[:, 1:]], axis=2)
    hid = jax.nn.silu(jnp.einsum('bnlgd,lde->bnge', blk + pe[None, None, :, None, :], w1))
    return jnp.einsum('bnge,ef->bngf', hid, w2)


def _nsa_mixer(q, kc_raw, vc_raw, ks, vs, kw, vw, gates, positions,
               pe_k, pe_v, w1k, w2k, w1v, w2v):
    B, S = q.shape[0], q.shape[1]
    G, R, hd = N_KV_HEADS, GQA, HEAD_DIM
    cos, sin = _rope_tables(positions)
    q_rope = _rope_partial(q, cos, sin)
    ks = _rope_partial(ks, cos, sin)
    kw = _rope_partial(kw, cos, sin)
    kc = _nsa_compress(kc_raw, pe_k, w1k, w2k)
    vc = _nsa_compress(vc_raw, pe_v, w1v, w2v)
    NC = kc.shape[1]
    NS = S // SLC_LEN
    n_sel = min(N_SEL, NS)
    ratio = SLC_LEN // CMP_STRIDE
    cmp_end = jnp.arange(NC) * CMP_STRIDE + CMP_LEN - 1
    ks_blk = ks.reshape(B, NS, SLC_LEN, G, hd).transpose(0, 3, 1, 2, 4)
    vs_blk = vs.reshape(B, NS, SLC_LEN, G, hd).transpose(0, 3, 1, 2, 4)
    kw_pad = jnp.pad(kw, ((0, 0), (WINDOW, 0), (0, 0), (0, 0)))
    vw_pad = jnp.pad(vw, ((0, 0), (WINDOW, 0), (0, 0), (0, 0)))
    qg_raw = q.reshape(B, S, G, R, hd)
    qg_rope = q_rope.reshape(B, S, G, R, hd)
    scale = HEAD_DIM ** -0.5
    bi = jnp.arange(B)[:, None, None, None]
    gi = jnp.arange(G)[None, :, None, None]
    blk_j = jnp.arange(NS)

    def block_fn(qb):
        q0 = qb * Q_BLOCK
        t = q0 + jnp.arange(Q_BLOCK)
        qr = lax.dynamic_slice_in_dim(qg_raw, q0, Q_BLOCK, axis=1)
        qp = lax.dynamic_slice_in_dim(qg_rope, q0, Q_BLOCK, axis=1)
        s_c = jnp.einsum('bqgrd,bngd->bgrqn', qr, kc) * scale
        p_c = _masked_softmax(s_c, cmp_end[None, :] <= t[:, None])
        o_c = jnp.einsum('bgrqn,bngd->bqgrd', p_c.astype(vc.dtype), vc)
        imp = jnp.pad(jnp.sum(p_c, axis=2), ((0, 0), (0, 0), (0, 0), (1, 0)))
        imp = imp.reshape(B, G, Q_BLOCK, NS, ratio)
        imp_slc = jnp.sum(imp, axis=-1) + jnp.pad(imp[..., 1:, 0], ((0, 0), (0, 0), (0, 0), (0, 1)))
        cur = t // SLC_LEN
        allowed = blk_j[None, :] <= cur[:, None]
        forced = (blk_j[None, :] == 0) | (blk_j[None, :] == cur[:, None]) | (blk_j[None, :] == cur[:, None] - 1)
        score = jnp.where(forced, imp_slc + FORCE_BONUS, imp_slc)
        score = jnp.where(allowed, score, -1.0)
        top_v, top_i = lax.top_k(score, n_sel)
        valid = top_v >= 0.0
        k_sel = ks_blk[bi, gi, top_i]
        v_sel = vs_blk[bi, gi, top_i]
        tok = top_i[..., None] * SLC_LEN + jnp.arange(SLC_LEN)
        m_s = valid[..., None] & (tok <= t[None, None, :, None, None])
        s_s = jnp.einsum('bqgrd,bgqnld->bgrqnl', qp, k_sel) * scale
        nl = n_sel * SLC_LEN
        p_s = _masked_softmax(s_s.reshape(B, G, R, Q_BLOCK, nl), m_s.reshape(B, G, 1, Q_BLOCK, nl))
        o_s = jnp.einsum('bgrqm,bgqmd->bqgrd', p_s.astype(v_sel.dtype), v_sel.reshape(B, G, Q_BLOCK, nl, hd))
        kwb = lax.dynamic_slice_in_dim(kw_pad, q0, Q_BLOCK + WINDOW, axis=1)
        vwb = lax.dynamic_slice_in_dim(vw_pad, q0, Q_BLOCK + WINDOW, axis=1)
        src = q0 - WINDOW + jnp.arange(Q_BLOCK + WINDOW)
        diff = t[:, None] - src[None, :]
        m_w = (diff >= 0) & (diff < WINDOW) & (src[None, :] >= 0)
        s_w = jnp.einsum('bqgrd,bkgd->bgrqk', qp, kwb) * scale
        p_w = _masked_softmax(s_w, m_w)
        o_w = jnp.einsum('bgrqk,bkgd->bqgrd', p_w.astype(vwb.dtype), vwb)
        g = lax.dynamic_slice_in_dim(gates, q0, Q_BLOCK, axis=1)
        return g[..., 0:1] * o_c + g[..., 1:2] * o_s + g[..., 2:3] * o_w

    out = lax.map(block_fn, jnp.arange(S // Q_BLOCK))
    return out.transpose(1, 0, 2, 3, 4, 5).reshape(B, S, D_ATT)


def _cplx_combine(e1, e2):
    a1r, a1i, b1r, b1i = e1
    a2r, a2i, b2r, b2i = e2
    return (a2r * a1r - a2i * a1i,
            a2r * a1i + a2i * a1r,
            a2r * b1r - a2i * b1i + b2r,
            a2r * b1i + a2i * b1r + b2i)


def _ssm_mixer(u, lam_re, lam_im, log_dt, b_re, b_im, c_re, c_im, d_skip, glu_w, glu_b):
    B, S = u.shape[0], u.shape[1]
    f32 = jnp.float32
    uf = u.astype(f32)
    ug = uf.reshape(B, S, N_SSM_GROUPS, SSM_GROUP)
    lr = jnp.minimum(lam_re.astype(f32), -1e-4)
    li = lam_im.astype(f32)
    dt = jnp.exp(log_dt.astype(f32))[:, None]
    mag = jnp.exp(lr * dt)
    ar = mag * jnp.cos(li * dt)
    ai = mag * jnp.sin(li * dt)
    den = lr * lr + li * li
    cr = ((ar - 1.0) * lr + ai * li) / den
    ci = (ai * lr - (ar - 1.0) * li) / den
    br, bim = b_re.astype(f32), b_im.astype(f32)
    bbr = cr[..., None] * br - ci[..., None] * bim
    bbi = cr[..., None] * bim + ci[..., None] * br
    xr = jnp.einsum('bsgc,gpc->bsgp', ug, bbr)
    xi = jnp.einsum('bsgc,gpc->bsgp', ug, bbi)
    a_r = jnp.broadcast_to(ar, xr.shape)
    a_i = jnp.broadcast_to(ai, xi.shape)
    _, _, hr, hi = lax.associative_scan(_cplx_combine, (a_r, a_i, xr, xi), axis=1)
    y = (jnp.einsum('bsgp,gcp->bsgc', hr, c_re.astype(f32))
         - jnp.einsum('bsgp,gcp->bsgc', hi, c_im.astype(f32)))
    y = y.reshape(B, S, D_SSM) + d_skip.astype(f32) * uf
    y = jax.nn.gelu(y) * jax.nn.sigmoid(y @ glu_w.astype(f32) + glu_b.astype(f32))
    return y.astype(u.dtype)


def _moe(x, router_w, wg, wu, wd):
    shp = x.shape
    xf = x.reshape(-1, shp[-1])
    logits = (xf @ router_w).astype(jnp.float32)
    top_v, top_i = lax.top_k(logits, TOP_K)
    w = jax.nn.softmax(top_v, axis=-1)
    combine = jnp.sum(jax.nn.one_hot(top_i, N_EXPERTS, dtype=jnp.float32) * w[..., None], axis=1)
    out = jnp.zeros_like(xf)
    for e in range(N_EXPERTS):
        out = out + combine[:, e:e + 1].astype(x.dtype) * _swiglu(xf, wg[e], wu[e], wd[e])
    return out.reshape(shp)


def setup_inputs(seed: int = 0) -> dict:
    key = jax.random.key(seed)
    ks = iter(jax.random.split(key, 64))
    f32 = jnp.float32

    def nrm(shape, scale):
        return jax.random.normal(next(ks), shape, f32) * scale

    def gain(shape):
        return 1.0 + nrm(shape, 0.02)

    P = SSM_STATE
    lam_im = jnp.pi * jnp.arange(P, dtype=f32)
    return {
        'x': nrm((BATCH, SEQ, D_MODEL), 1.0),
        'positions': jnp.broadcast_to(jnp.arange(SEQ, dtype=jnp.int32), (BATCH, SEQ)),
        'norm_mix_g': gain((DEPTH, D_MODEL)),
        'w_in': nrm((DEPTH, D_MODEL, D_IN), D_MODEL ** -0.5),
        'conv_dw_w': nrm((DEPTH, CONV_WIDTH, D_CONV), CONV_WIDTH ** -0.5),
        'conv_dw_b': nrm((DEPTH, D_CONV), 0.02),
        'conv_ln_g': gain((DEPTH, D_CONV)),
        'conv_ln_b': nrm((DEPTH, D_CONV), 0.02),
        'conv_pw_w': nrm((DEPTH, D_CONV, D_CONV), D_CONV ** -0.5),
        'conv_pw_b': nrm((DEPTH, D_CONV), 0.02),
        'nsa_gate_b': nrm((DEPTH, 3 * N_HEADS), 0.02),
        'nsa_pe_k': nrm((DEPTH, CMP_LEN, HEAD_DIM), 0.02),
        'nsa_pe_v': nrm((DEPTH, CMP_LEN, HEAD_DIM), 0.02),
        'nsa_w1k': nrm((DEPTH, CMP_LEN, HEAD_DIM, HEAD_DIM), (CMP_LEN * HEAD_DIM) ** -0.5),
        'nsa_w2k': nrm((DEPTH, HEAD_DIM, HEAD_DIM), HEAD_DIM ** -0.5),
        'nsa_w1v': nrm((DEPTH, CMP_LEN, HEAD_DIM, HEAD_DIM), (CMP_LEN * HEAD_DIM) ** -0.5),
        'nsa_w2v': nrm((DEPTH, HEAD_DIM, HEAD_DIM), HEAD_DIM ** -0.5),
        'ssm_lambda_re': -0.5 + nrm((DEPTH, N_SSM_GROUPS, P), 0.01),
        'ssm_lambda_im': lam_im + nrm((DEPTH, N_SSM_GROUPS, P), 0.01),
        'ssm_log_dt': jax.random.uniform(next(ks), (DEPTH, N_SSM_GROUPS), f32,
                                         math.log(DT_MIN), math.log(DT_MAX)),
        'ssm_b_re': nrm((DEPTH, N_SSM_GROUPS, P, SSM_GROUP), (2 * SSM_GROUP) ** -0.5),
        'ssm_b_im': nrm((DEPTH, N_SSM_GROUPS, P, SSM_GROUP), (2 * SSM_GROUP) ** -0.5),
        'ssm_c_re': nrm((DEPTH, N_SSM_GROUPS, SSM_GROUP, P), P ** -0.5),
        'ssm_c_im': nrm((DEPTH, N_SSM_GROUPS, SSM_GROUP, P), P ** -0.5),
        'ssm_d': nrm((DEPTH, D_SSM), 1.0),
        'ssm_glu_w': nrm((DEPTH, D_SSM, D_SSM), D_SSM ** -0.5),
        'ssm_glu_b': nrm((DEPTH, D_SSM), 0.02),
        'mix_out_g': gain((DEPTH, D_MIX)),
        'w_out': nrm((DEPTH, D_MIX, D_MODEL), D_MIX ** -0.5),
        'norm_ffn_g': gain((DEPTH, D_MODEL)),
        'ffn_w_gate': nrm((N_DENSE, D_MODEL, D_FF), D_MODEL ** -0.5),
        'ffn_w_up': nrm((N_DENSE, D_MODEL, D_FF), D_MODEL ** -0.5),
        'ffn_w_down': nrm((N_DENSE, D_FF, D_MODEL), D_FF ** -0.5),
        'router_w': nrm((N_MOE, D_MODEL, N_EXPERTS), D_MODEL ** -0.5),
        'moe_w_gate': nrm((N_MOE, N_EXPERTS, D_MODEL, D_FF_EXPERT), D_MODEL ** -0.5),
        'moe_w_up': nrm((N_MOE, N_EXPERTS, D_MODEL, D_FF_EXPERT), D_MODEL ** -0.5),
        'moe_w_down': nrm((N_MOE, N_EXPERTS, D_FF_EXPERT, D_MODEL), D_FF_EXPERT ** -0.5),
        'final_norm_g': gain((D_MODEL,)),
    }


def reference(x, positions, norm_mix_g, w_in, conv_dw_w, conv_dw_b, conv_ln_g, conv_ln_b,
              conv_pw_w, conv_pw_b, nsa_gate_b, nsa_pe_k, nsa_pe_v, nsa_w1k, nsa_w2k,
              nsa_w1v, nsa_w2v, ssm_lambda_re, ssm_lambda_im, ssm_log_dt, ssm_b_re, ssm_b_im,
              ssm_c_re, ssm_c_im, ssm_d, ssm_glu_w, ssm_glu_b, mix_out_g, w_out, norm_ffn_g,
              ffn_w_gate, ffn_w_up, ffn_w_down, router_w, moe_w_gate, moe_w_up, moe_w_down,
              final_norm_g):
    B, S = x.shape[0], x.shape[1]
    h = x
    for l in range(DEPTH):
        hn = _rmsnorm(h, norm_mix_g[l])
        proj = hn @ w_in[l]
        conv_o = _conv_module(proj[..., OFF_CONV:OFF_Q], conv_dw_w[l], conv_dw_b[l],
                              conv_ln_g[l], conv_ln_b[l], conv_pw_w[l], conv_pw_b[l])
        q = proj[..., OFF_Q:OFF_KV].reshape(B, S, N_HEADS, HEAD_DIM)
        kv = proj[..., OFF_KV:OFF_GATE].reshape(B, S, 6, N_KV_HEADS, HEAD_DIM)
        gates = jax.nn.sigmoid(proj[..., OFF_GATE:OFF_SSM] + nsa_gate_b[l]).reshape(
            B, S, N_KV_HEADS, GQA, 3)
        att_o = _nsa_mixer(q, kv[:, :, 0], kv[:, :, 1], kv[:, :, 2], kv[:, :, 3],
                           kv[:, :, 4], kv[:, :, 5], gates, positions,
                           nsa_pe_k[l], nsa_pe_v[l], nsa_w1k[l], nsa_w2k[l],
                           nsa_w1v[l], nsa_w2v[l])
        ssm_o = _ssm_mixer(proj[..., OFF_SSM:D_IN], ssm_lambda_re[l], ssm_lambda_im[l],
                           ssm_log_dt[l], ssm_b_re[l], ssm_b_im[l], ssm_c_re[l],
                           ssm_c_im[l], ssm_d[l], ssm_glu_w[l], ssm_glu_b[l])
        g = mix_out_g[l]
        mixed = jnp.concatenate([
            _rmsnorm(conv_o, g[:D_CONV]),
            _rmsnorm(att_o, g[D_CONV:D_CONV + D_ATT]),
            _rmsnorm(ssm_o, g[D_CONV + D_ATT:]),
        ], axis=-1)
        h = h + mixed @ w_out[l]
        hn = _rmsnorm(h, norm_ffn_g[l])
        if l % 2 == 0:
            i = l // 2
            h = h + _swiglu(hn, ffn_w_gate[i], ffn_w_up[i], ffn_w_down[i])
        else:
            i = l // 2
            h = h + _moe(hn, router_w[i], moe_w_gate[i], moe_w_up[i], moe_w_down[i])
    return _rmsnorm(h, final_norm_g)
```

```cpp
#include <hip/hip_runtime.h>
#include <cstdio>
#include <cstdint>

namespace pg8 {
#define PG8_LAS __attribute__((address_space(3)))
typedef unsigned short bf16_t;
typedef short bf16x8 __attribute__((ext_vector_type(8)));
typedef float f32x4 __attribute__((ext_vector_type(4)));
typedef unsigned u32x4 __attribute__((ext_vector_type(4)));
typedef unsigned u32x2 __attribute__((ext_vector_type(2)));
constexpr int BM = 256, BK = 64, HALF = 128, HTB = HALF * BK * 2, STAGE_BYTES = 8 * HTB, NXCD = 8, WGM = 8;

__host__ __device__ __forceinline__ int lds_byte(int r, int c) { const int st = (r >> 4) * 2 + (c >> 5), rr = r & 15, cc = c & 31, ob = rr * 64 + cc * 2; return st * 1024 + (ob ^ (((ob >> 9) & 1) << 5)); }
__host__ __device__ __forceinline__ void stage_rc(int b, int& R, int& C) { const int st = b / 1024, sb = b % 1024, swz = sb ^ (((sb >> 9) & 1) << 5); R = (st >> 1) * 16 + swz / 64; C = (st & 1) * 32 + (swz % 64) / 2; }
__host__ __device__ __forceinline__ int perm32(int rho) { const int n = rho >> 4, i = rho & 15; return 8 * (i >> 2) + 4 * n + (i & 3); }

struct Unit { int pm, pn; };
struct Gemm { const bf16_t* A; const bf16_t* Bt; int K, lda, ldb; };

struct StaticOrder {
    int nM, nN, nwg, G, c;
    __host__ __device__ void init(int M, int N, int G_, int c_) { nM = M / BM; nN = N / BM; nwg = nM * nN; G = G_; c = c_; }
    __host__ __device__ bool next(int i, Unit& u) const {
        const long L = (long)i * G + c; if (L >= nwg) return false;
        int wgid = (int)L; { const int q = nwg / NXCD, r = nwg % NXCD, xcd = wgid % NXCD, off = wgid / NXCD; wgid = (xcd < r ? xcd * (q + 1) : r * (q + 1) + (xcd - r) * q) + off; }
        const int nig = WGM * nN, gid = wgid / nig, fm = gid * WGM, gsz = (nM - fm) < WGM ? (nM - fm) : WGM;
        u.pm = fm + ((wgid % nig) % gsz); u.pn = (wgid % nig) / gsz; return true;
    }
};

__device__ __forceinline__ unsigned cvt_pk_bf16(float lo, float hi) { unsigned r; asm volatile("v_cvt_pk_bf16_f32 %0, %1, %2" : "=v"(r) : "v"(lo), "v"(hi)); return r; }

template <class Epi, class Sched, bool ALIGN_EPI = true, bool SP2 = true>
__device__ __forceinline__ void gemm_phase(PG8_LAS unsigned char* lds, const Gemm g, const Sched& S, const Epi& E) {
    int tid_ = threadIdx.x; asm volatile("" : "+v"(tid_));
    const int tid = tid_, wid = __builtin_amdgcn_readfirstlane(tid >> 6), lane = tid & 63, wr = wid >> 2, wc = wid & 3, fr = lane & 15, fq = lane >> 4;
    const int K = g.K, nt = K / BK;
    unsigned voffA[2], voffB[2];
#pragma unroll
    for (int i = 0; i < 2; ++i) { int R, C; stage_rc(tid * 16 + i * 8192, R, C); const int Rb = Epi::PERM ? ((R & ~31) + perm32(R & 31)) : R;
        voffA[i] = (unsigned)(R * g.lda + C) * 2u; voffB[i] = (unsigned)(Rb * g.ldb + C) * 2u; }
    const size_t kstep = (size_t)(BK * 2);
    const size_t hstepA = (size_t)HALF * g.lda * 2, hstepB = (size_t)HALF * g.ldb * 2;
    const size_t tstepA = 2 * hstepA, tstepB = 2 * hstepB;
    const unsigned ldsw = (unsigned)wid * 1024u;
    const int aoff = lds_byte(wr * 64 + fr, fq * 8), boff = lds_byte(wc * 32 + fr, fq * 8);
#define PG8_SA(b, h) (((b) * 2 + (h)) * HTB)
#define PG8_SB(b, h) ((4 + (b) * 2 + (h)) * HTB)
#define PG8_STAGE(bufoff, gbase, voff) do { _Pragma("unroll") for (int _i = 0; _i < 2; ++_i) \
        __builtin_amdgcn_global_load_lds((const unsigned*)((const char*)(gbase) + (voff)[_i]), (PG8_LAS unsigned*)(lds + (bufoff) + ldsw + _i * 8192), 16, 0, 0); } while (0)
#define PG8_LDA(dst, b, h) do { _Pragma("unroll") for (int m = 0; m < 4; ++m) _Pragma("unroll") for (int k = 0; k < 2; ++k) dst[m][k] = *(const PG8_LAS bf16x8*)(lds + PG8_SA(b, h) + aoff + m * 2048 + k * 1024); } while (0)
#define PG8_LDB(dst, b, h) do { _Pragma("unroll") for (int n = 0; n < 2; ++n) _Pragma("unroll") for (int k = 0; k < 2; ++k) dst[n][k] = *(const PG8_LAS bf16x8*)(lds + PG8_SB(b, h) + boff + n * 2048 + k * 1024); } while (0)
#define PG8_MMA(ai, bj, At, Bt) do { __builtin_amdgcn_s_setprio(1); _Pragma("unroll") for (int m = 0; m < 4; ++m) _Pragma("unroll") for (int n = 0; n < 2; ++n) _Pragma("unroll") for (int k = 0; k < 2; ++k) \
        acc[ai][bj][m][n] = __builtin_amdgcn_mfma_f32_16x16x32_bf16(Bt[n][k], At[m][k], acc[ai][bj][m][n], 0, 0, 0); __builtin_amdgcn_s_setprio(0); } while (0)
#define PG8_WAIT_V(n) asm volatile("s_waitcnt vmcnt(" #n ")" ::: "memory")
#define PG8_WAIT_L(n) asm volatile("s_waitcnt lgkmcnt(" #n ")" ::: "memory")
#define PG8_BAR __builtin_amdgcn_s_barrier()
#define PG8_SCHED __builtin_amdgcn_sched_barrier(0)
    Unit cur, nxt; int ui = 0;
    if (!S.next(0, cur)) return;
    f32x4 acc[2][2][4][2];
#pragma unroll
    for (int a = 0; a < 2; ++a)
#pragma unroll
        for (int b = 0; b < 2; ++b)
#pragma unroll
            for (int m = 0; m < 4; ++m)
#pragma unroll
                for (int n = 0; n < 2; ++n) acc[a][b][m][n] = (f32x4){0.f, 0.f, 0.f, 0.f};
    bf16x8 At[4][2], B0[2][2], B1[2][2];
    const char* cA = (const char*)g.A + (size_t)cur.pm * tstepA; const char* cB = (const char*)g.Bt + (size_t)cur.pn * tstepB;
    if constexpr (SP2) {
        PG8_STAGE(PG8_SB(0, 0), cB, voffB); PG8_STAGE(PG8_SB(0, 1), cB + hstepB, voffB); PG8_STAGE(PG8_SA(0, 0), cA, voffA); PG8_STAGE(PG8_SA(0, 1), cA + hstepA, voffA);
        if (wr == 1) PG8_BAR;
        PG8_WAIT_V(2); PG8_BAR;
        PG8_STAGE(PG8_SB(1, 0), cB + kstep, voffB); PG8_STAGE(PG8_SA(1, 0), cA + kstep, voffA); PG8_STAGE(PG8_SB(1, 1), cB + hstepB + kstep, voffB);
        PG8_WAIT_V(6); PG8_BAR;
    } else {
        PG8_STAGE(PG8_SB(0, 0), cB, voffB); PG8_STAGE(PG8_SA(0, 0), cA, voffA); PG8_STAGE(PG8_SB(0, 1), cB + hstepB, voffB); PG8_STAGE(PG8_SA(0, 1), cA + hstepA, voffA);
        if (wr == 1) PG8_BAR;
        PG8_WAIT_V(4); PG8_BAR;
        PG8_STAGE(PG8_SB(1, 0), cB + kstep, voffB); PG8_STAGE(PG8_SA(1, 0), cA + kstep, voffA); PG8_STAGE(PG8_SB(1, 1), cB + hstepB + kstep, voffB);
        PG8_WAIT_V(6); PG8_BAR;
    }
    for (;;) {
        const bool has_next = S.next(ui + 1, nxt);
        const char* nA = has_next ? (const char*)g.A + (size_t)nxt.pm * tstepA : cA; const char* nB = has_next ? (const char*)g.Bt + (size_t)nxt.pn * tstepB : cB;
#pragma unroll 1
        for (int t = 0; t < nt; t += 2) {
            const bool last = (t == nt - 2);
            const char* a1 = cA + (size_t)(t + 1) * kstep;
            const char* a2 = last ? nA : cA + (size_t)(t + 2) * kstep; const char* b2 = last ? nB : cB + (size_t)(t + 2) * kstep;
            const char* a3 = a2 + kstep; const char* b3 = b2 + kstep;
            if constexpr (SP2) {
            PG8_LDB(B0, 0, 0); PG8_LDB(B1, 0, 1); PG8_SCHED; PG8_LDA(At, 0, 0); PG8_STAGE(PG8_SA(1, 1), a1 + hstepA, voffA);
            PG8_WAIT_V(8); PG8_WAIT_L(0); PG8_BAR; PG8_MMA(0, 0, At, B0); PG8_MMA(0, 1, At, B1); PG8_BAR; PG8_SCHED;
            PG8_LDA(At, 0, 1); PG8_STAGE(PG8_SB(0, 0), b2, voffB); PG8_STAGE(PG8_SB(0, 1), b2 + hstepB, voffB); PG8_STAGE(PG8_SA(0, 0), a2, voffA);
            PG8_WAIT_V(8); PG8_WAIT_L(0); PG8_BAR; PG8_MMA(1, 0, At, B0); PG8_MMA(1, 1, At, B1); PG8_BAR; PG8_SCHED;
            PG8_LDB(B0, 1, 0); PG8_LDB(B1, 1, 1); PG8_SCHED; PG8_LDA(At, 1, 0); PG8_STAGE(PG8_SA(0, 1), a2 + hstepA, voffA);
            PG8_WAIT_V(8); PG8_WAIT_L(0); PG8_BAR; PG8_MMA(0, 0, At, B0); PG8_MMA(0, 1, At, B1); PG8_BAR; PG8_SCHED;
            PG8_LDA(At, 1, 1); PG8_STAGE(PG8_SB(1, 0), b3, voffB); PG8_STAGE(PG8_SB(1, 1), b3 + hstepB, voffB); PG8_STAGE(PG8_SA(1, 0), a3, voffA);
            PG8_WAIT_V(8); PG8_WAIT_L(0); PG8_BAR; PG8_MMA(1, 0, At, B0); PG8_MMA(1, 1, At, B1); PG8_BAR; PG8_SCHED;
            } else {
            PG8_LDB(B0, 0, 0); PG8_SCHED; PG8_LDA(At, 0, 0); PG8_STAGE(PG8_SA(1, 1), a1 + hstepA, voffA);
            PG8_WAIT_L(8); PG8_BAR; PG8_WAIT_L(0); PG8_MMA(0, 0, At, B0); PG8_BAR; PG8_SCHED;
            PG8_LDB(B1, 0, 1); PG8_STAGE(PG8_SB(0, 0), b2, voffB);
            PG8_BAR; PG8_WAIT_L(0); PG8_MMA(0, 1, At, B1); PG8_BAR;
            PG8_LDA(At, 0, 1); PG8_STAGE(PG8_SA(0, 0), a2, voffA);
            PG8_BAR; PG8_WAIT_L(0); PG8_MMA(1, 0, At, B0); PG8_BAR; PG8_SCHED;
            PG8_STAGE(PG8_SB(0, 1), b2 + hstepB, voffB);
            PG8_WAIT_V(6); PG8_BAR; PG8_MMA(1, 1, At, B1); PG8_BAR;
            PG8_LDB(B0, 1, 0); PG8_SCHED; PG8_LDA(At, 1, 0); PG8_STAGE(PG8_SA(0, 1), a2 + hstepA, voffA);
            PG8_WAIT_L(8); PG8_BAR; PG8_WAIT_L(0); PG8_MMA(0, 0, At, B0); PG8_BAR; PG8_SCHED;
            PG8_LDB(B1, 1, 1); PG8_STAGE(PG8_SB(1, 0), b3, voffB);
            PG8_BAR; PG8_WAIT_L(0); PG8_MMA(0, 1, At, B1); PG8_BAR;
            PG8_LDA(At, 1, 1); PG8_STAGE(PG8_SA(1, 0), a3, voffA);
            PG8_BAR; PG8_WAIT_L(0); PG8_MMA(1, 0, At, B0); PG8_BAR; PG8_SCHED;
            PG8_STAGE(PG8_SB(1, 1), b3 + hstepB, voffB);
            PG8_WAIT_V(6); PG8_BAR; PG8_MMA(1, 1, At, B1); PG8_BAR;
            }
        }
        if constexpr (ALIGN_EPI) { if (wr == 0) PG8_BAR; }
        E(acc, cur, wr, wc, fr, fq);
        if (!has_next) break;
#pragma unroll
        for (int a = 0; a < 2; ++a)
#pragma unroll
            for (int b = 0; b < 2; ++b)
#pragma unroll
                for (int m = 0; m < 4; ++m)
#pragma unroll
                    for (int n = 0; n < 2; ++n) acc[a][b][m][n] = (f32x4){0.f, 0.f, 0.f, 0.f};
        cur = nxt; cA = nA; cB = nB; ++ui;
        if constexpr (ALIGN_EPI) { if (wr == 1) PG8_BAR; }
    }
    PG8_WAIT_V(0);
    if constexpr (!ALIGN_EPI) { if (wr == 0) PG8_BAR; }
    PG8_BAR;
#undef PG8_SA
#undef PG8_SB
#undef PG8_STAGE
#undef PG8_LDA
#undef PG8_LDB
#undef PG8_MMA
#undef PG8_WAIT_V
#undef PG8_WAIT_L
#undef PG8_BAR
#undef PG8_SCHED
}
}

constexpr int S = 16384, D = 2048, DIN = 4120, DCONV = 512, DATT = 1024, DSSM = 512;
constexpr int NH = 8, NKV = 2, HD = 128, NCMP = 1023, NSB = 256, CONVW = 31;
constexpr int DFF = 5632, NE = 8, DFFE = 7168, NGRP = 32, PST = 64;
constexpr int NPAD = 2 * S + NE * 256;
constexpr float EPS = 1e-5f;
constexpr int NWAVES = 8, NTHR = 512;

constexpr size_t MiB = 1u << 20;
constexpr size_t WS_CTL = 0, CTL_ZERO_BYTES = 1 * MiB;
constexpr size_t WS_H = 1 * MiB;
constexpr size_t WS_HN = WS_H + 128 * MiB;
constexpr size_t WS_MOE_GU = WS_HN + 64 * MiB;
constexpr size_t WS_MOE_D = WS_MOE_GU + 448 * MiB;
constexpr size_t WS_TOK = WS_MOE_D + 224 * MiB;
constexpr size_t WS_R = WS_TOK + 1 * MiB;
constexpr size_t R_WIN = WS_R;
constexpr size_t R_WOUT = R_WIN + 32 * MiB;
constexpr size_t R_WG = R_WOUT + 16 * MiB;
constexpr size_t R_CPW = R_WG + 1 * MiB;
constexpr size_t R_GLU = R_CPW + 1 * MiB;
constexpr size_t R_W1K = R_GLU + 1 * MiB;
constexpr size_t R_W1V = R_W1K + 2 * MiB;
constexpr size_t R_W2 = R_W1V + 2 * MiB;
constexpr size_t R_CB = R_W2 + 1 * MiB;
constexpr size_t R_TW = R_CB + 1 * MiB;
constexpr size_t R_WO2 = R_TW + 16 * MiB;
constexpr size_t R_FGU = R_WO2 + 8 * MiB;
constexpr size_t R_FD = R_FGU + 44 * MiB;
constexpr size_t R_CONVU = R_FD + 22 * MiB;
constexpr size_t R_Q = R_CONVU + 16 * MiB;
constexpr size_t R_QR = R_Q + 32 * MiB;
constexpr size_t R_KV = R_QR + 32 * MiB;
constexpr size_t R_VST = R_KV + 48 * MiB;
constexpr size_t R_VWT = R_VST + 8 * MiB;
constexpr size_t R_KC = R_VWT + 8 * MiB;
constexpr size_t R_VCT = R_KC + 1 * MiB;
constexpr size_t R_U = R_VCT + 1 * MiB;
constexpr size_t R_GATES = R_U + 16 * MiB;
constexpr size_t R_CONVACT = R_GATES + 2 * MiB;
constexpr size_t R_IMP = R_CONVACT + 16 * MiB;
constexpr size_t R_OC = R_IMP + 32 * MiB;
constexpr size_t R_OW = R_OC + 32 * MiB;
constexpr size_t R_OS = R_OW + 32 * MiB;
constexpr size_t R_CONVO = R_OS + 32 * MiB;
constexpr size_t R_SSMO = R_CONVO + 16 * MiB;
constexpr size_t R_YINTRA = R_SSMO + 16 * MiB;
constexpr size_t R_SC = R_YINTRA + 32 * MiB;
constexpr size_t R_HPREV = R_SC + 16 * MiB;
constexpr size_t R_YSSM = R_HPREV + 16 * MiB;
constexpr size_t R_GY = R_YSSM + 16 * MiB;
constexpr size_t R_MIXED = R_GY + 16 * MiB;
constexpr size_t R_ACT = R_MIXED + 64 * MiB;
constexpr size_t R_END = R_ACT + 176 * MiB;
constexpr size_t M_ASORT = WS_R;
constexpr size_t M_ACTS = M_ASORT + 136 * MiB;
constexpr size_t M_YS = M_ACTS + 476 * MiB;
constexpr size_t M_END = M_YS + 136 * MiB;
constexpr size_t WS_END = R_END > M_END ? R_END : M_END;
static_assert((size_t)NPAD * D * 2 <= 136 * MiB && (size_t)NPAD * DFFE * 2 <= 476 * MiB, "moe buffers");
static_assert(WS_END <= 1792 * MiB, "workspace map must fit 4x the largest input tensor");
constexpr size_t TOK_E = 0;
constexpr size_t TOK_W = 128 * 1024;
constexpr size_t TOK_SLOT = 256 * 1024;
constexpr size_t TOK_POS = 384 * 1024;
constexpr size_t TOK_RW = 512 * 1024;
constexpr int CW_BAR = 4096;
constexpr int CW_ECNT = 131072;
constexpr int CW_DBG = 140000;

constexpr int RING_OFF = 0, RING_BYTES = 131072;
constexpr int LDSCTL_OFF = RING_BYTES, MISC_OFF = LDSCTL_OFF + 320;
constexpr int LDS_BYTES = 147456;

#define GAS __attribute__((address_space(1)))
#define LAS __attribute__((address_space(3)))
#define DEVI __device__ __forceinline__
typedef unsigned short bf16;
typedef unsigned v4u __attribute__((ext_vector_type(4)));
typedef unsigned v2u __attribute__((ext_vector_type(2)));
typedef float f32x4 __attribute__((ext_vector_type(4)));
typedef float f32x2 __attribute__((ext_vector_type(2)));
typedef short bf16x8 __attribute__((ext_vector_type(8)));
typedef short bf16x4 __attribute__((ext_vector_type(4)));
typedef GAS unsigned gu32;
#define RLX_AGENT __ATOMIC_RELAXED, __HIP_MEMORY_SCOPE_AGENT
#define LDS_WAIT() asm volatile("s_waitcnt lgkmcnt(0)" ::: "memory")
#define VM_WAIT() asm volatile("s_waitcnt vmcnt(0)" ::: "memory")
DEVI unsigned f2bf(float f) { unsigned u = __builtin_bit_cast(unsigned, f); return (u + 0x7fffu + ((u >> 16) & 1u)) >> 16; }
DEVI unsigned pk2(float lo, float hi) { return f2bf(lo) | (f2bf(hi) << 16); }
DEVI float bf2f(unsigned b) { return __builtin_bit_cast(float, b << 16); }
DEVI float bflo(unsigned w) { return __builtin_bit_cast(float, w << 16); }
DEVI float bfhi(unsigned w) { return __builtin_bit_cast(float, w & 0xffff0000u); }
DEVI float sigmoidf_(float x) { return 1.f / (1.f + __expf(-x)); }
DEVI float siluf_(float x) { return x / (1.f + __expf(-x)); }
DEVI float wave_sum(float v) {
#pragma unroll
    for (int o = 1; o < 64; o <<= 1) v += __shfl_xor(v, o);
    return v;
}

#define XB_TMO      128
#define XB_XCNT(j)  (256  + 64 * (j))
#define XB_XSUB(j)  (1280 + 64 * (j))
#define XB_XGEN(j)  (2304 + 64 * (j))
#define XB_TOP      3328
#define XB_TOPGEN   3392
#define XCD_BAR_WORDS 3456
#define XB_SPIN_CAP (1u << 20)

__device__ __forceinline__ unsigned xb_ld(unsigned* p)              { return __hip_atomic_load(p, __ATOMIC_RELAXED, __HIP_MEMORY_SCOPE_AGENT); }
__device__ __forceinline__ unsigned xb_add(unsigned* p, unsigned v) { return __hip_atomic_fetch_add(p, v, __ATOMIC_RELAXED, __HIP_MEMORY_SCOPE_AGENT); }
__device__ __forceinline__ unsigned xb_xcc_id() { return (unsigned)__builtin_amdgcn_s_getreg((3 << 11) | 20) & 0xFu; }
#define XB_SPIN(cond, bar) do { unsigned _sp = 0; while (cond) { __builtin_amdgcn_s_sleep(1); \
    if ((++_sp & 255u) == 0u) { if (xb_ld(&(bar)[XB_TMO])) break; if (_sp > XB_SPIN_CAP) { atomicAdd(&(bar)[XB_TMO], 1u); break; } } } } while (0)

struct XcdBarrier { unsigned* bar; unsigned x; volatile LAS unsigned* st; };

__device__ __forceinline__ XcdBarrier xcd_barrier_post(unsigned* bar, volatile LAS unsigned* st) {
    XcdBarrier b; b.bar = bar; b.x = xb_xcc_id(); b.st = st;
    if (threadIdx.x == 0) (void)xb_add(&bar[XB_XCNT(b.x)], 1u);
    return b;
}
__device__ __forceinline__ void xcd_barrier_complete(unsigned* bar, unsigned x, unsigned& nloc, unsigned& nx) {
    const unsigned G = gridDim.x * gridDim.y * gridDim.z;
    unsigned sum, cnt, mine, sp = 0u;
    for (;;) {
        sum = 0u; cnt = 0u; mine = 0u;
#pragma unroll
        for (unsigned j = 0; j < 16; ++j) { const unsigned c = xb_ld(&bar[XB_XCNT(j)]); sum += c; cnt += (c > 0u) ? 1u : 0u; mine = (j == x) ? c : mine; }
        if (sum == G) break;
        __builtin_amdgcn_s_sleep(1);
        if ((++sp & 255u) == 0u) { if (xb_ld(&bar[XB_TMO])) break; if (sp > XB_SPIN_CAP) { atomicAdd(&bar[XB_TMO], 1u); break; } }
    }
    nloc = mine > 0u ? mine : 1u; nx = cnt > 0u ? cnt : 1u;
}
__device__ __forceinline__ void xcd_barrier(const XcdBarrier& b) {
    asm volatile("s_waitcnt vmcnt(0)" ::: "memory");
    __syncthreads();
    if (threadIdx.x == 0) {
        unsigned* bar = b.bar;
        __builtin_amdgcn_s_waitcnt(0);
        unsigned nloc = b.st[0], nx = b.st[1];
        if (nloc == 0u) { xcd_barrier_complete(bar, b.x, nloc, nx); b.st[0] = nloc; b.st[1] = nx; }
        const unsigned old = xb_add(&bar[XB_XSUB(b.x)], 1u);
        const unsigned gen = old / nloc;
        if (old + 1u == (gen + 1u) * nloc) {
            __builtin_amdgcn_fence(__ATOMIC_RELEASE, "agent");
            asm volatile("s_waitcnt vmcnt(0)" ::: "memory");
            const unsigned og = xb_add(&bar[XB_TOP], 1u);
            const unsigned tg = og / nx;
            if (og + 1u == (tg + 1u) * nx) xb_add(&bar[XB_TOPGEN], 1u);
            else XB_SPIN(xb_ld(&bar[XB_TOPGEN]) == tg, bar);
            __builtin_amdgcn_fence(__ATOMIC_ACQUIRE, "agent");
            xb_add(&bar[XB_XGEN(b.x)], 1u);
            asm volatile("s_waitcnt vmcnt(0)" ::: "memory");
        } else {
            XB_SPIN(xb_ld(&bar[XB_XGEN(b.x)]) == gen, bar);
            __builtin_amdgcn_fence(__ATOMIC_ACQUIRE, "agent");
            asm volatile("s_waitcnt vmcnt(0)" ::: "memory");
        }
    }
    __syncthreads();
}

using pg8::Unit; using pg8::BM; using pg8::HALF;
typedef const f32x4 (&AccT)[2][2][4][2];

struct EpiInProj {
    static constexpr bool PERM = true;
    bf16 *convu, *q, *kv, *u;
    DEVI void operator()(AccT acc, const Unit& un, int wr, int wc, int fr, int fq) const {
        const int row0 = un.pm * BM + wr * 64 + fr, pn = un.pn, cw = wc * 32 + 8 * fq;
#pragma unroll
        for (int ai = 0; ai < 2; ++ai)
#pragma unroll
            for (int m = 0; m < 4; ++m) {
                const int row = row0 + ai * HALF + m * 16;
                if (pn < 4) {
                    float o[8];
#pragma unroll
                    for (int n = 0; n < 2; ++n)
#pragma unroll
                        for (int j = 0; j < 4; ++j) o[4 * n + j] = acc[ai][0][m][n][j] * sigmoidf_(acc[ai][1][m][n][j]);
                    v4u w; w.x = pg8::cvt_pk_bf16(o[0], o[1]); w.y = pg8::cvt_pk_bf16(o[2], o[3]); w.z = pg8::cvt_pk_bf16(o[4], o[5]); w.w = pg8::cvt_pk_bf16(o[6], o[7]);
                    *(v4u*)(convu + (size_t)row * DCONV + pn * 128 + cw) = w;
                } else {
#pragma unroll
                    for (int bj = 0; bj < 2; ++bj) {
                        const f32x4 v0 = acc[ai][bj][m][0], v1 = acc[ai][bj][m][1];
                        v4u w; w.x = pg8::cvt_pk_bf16(v0[0], v0[1]); w.y = pg8::cvt_pk_bf16(v0[2], v0[3]); w.z = pg8::cvt_pk_bf16(v1[0], v1[1]); w.w = pg8::cvt_pk_bf16(v1[2], v1[3]);
                        bf16* dst;
                        if (pn < 8) dst = q + (size_t)row * DATT + (pn - 4) * 256 + bj * 128 + cw;
                        else if (pn < 14) dst = kv + ((size_t)((pn - 8) * 2 + bj) * S + row) * HD + cw;
                        else { const int ch = (pn - 14) * 256 + bj * 128 + cw; dst = u + ((size_t)(ch >> 4) * S + row) * 16 + (ch & 15); }
                        *(v4u*)dst = w;
                    }
                }
            }
    }
};
struct EpiSsm1 {
    static constexpr bool PERM = false;
    float *yintra, *sc;
    DEVI void operator()(AccT acc, const Unit& un, int wr, int wc, int fr, int fq) const {
        const int row0 = un.pm * BM + wr * 64 + fr, cw = wc * 32 + 4 * fq;
        if ((un.pn & 1) == 0) {
#pragma unroll
            for (int ai = 0; ai < 2; ++ai)
#pragma unroll
                for (int m = 0; m < 4; ++m) { float* p = yintra + (size_t)(row0 + ai * HALF + m * 16) * 256 + cw;
#pragma unroll
                    for (int bj = 0; bj < 2; ++bj)
#pragma unroll
                        for (int n = 0; n < 2; ++n) *(f32x4*)(p + bj * 128 + 16 * n) = acc[ai][bj][m][n]; }
        } else {
#pragma unroll
            for (int ai = 0; ai < 2; ++ai)
#pragma unroll
                for (int m = 0; m < 4; ++m) { float* p = sc + (size_t)(row0 + ai * HALF + m * 16) * 128 + cw;
#pragma unroll
                    for (int n = 0; n < 2; ++n) *(f32x4*)(p + 16 * n) = acc[ai][0][m][n]; }
        }
    }
};
struct EpiBiasBf16 {
    static constexpr bool PERM = true;
    bf16* O; int ldc; const float* bias;
    DEVI void operator()(AccT acc, const Unit& un, int wr, int wc, int fr, int fq) const {
        const int row0 = un.pm * BM + wr * 64 + fr, col0 = un.pn * BM + wc * 32 + 8 * fq;
#pragma unroll
        for (int ai = 0; ai < 2; ++ai)
#pragma unroll
            for (int m = 0; m < 4; ++m)
#pragma unroll
                for (int bj = 0; bj < 2; ++bj) {
                    const int col = col0 + bj * HALF;
                    const f32x4 b0 = *(const f32x4*)(bias + col), b1 = *(const f32x4*)(bias + col + 4);
                    const f32x4 v0 = acc[ai][bj][m][0] + b0, v1 = acc[ai][bj][m][1] + b1;
                    v4u w; w.x = pg8::cvt_pk_bf16(v0[0], v0[1]); w.y = pg8::cvt_pk_bf16(v0[2], v0[3]); w.z = pg8::cvt_pk_bf16(v1[0], v1[1]); w.w = pg8::cvt_pk_bf16(v1[2], v1[3]);
                    *(v4u*)(O + (size_t)(row0 + ai * HALF + m * 16) * ldc + col) = w;
                }
    }
};
DEVI float gelu_tanh(float y) { const float z = 0.7978845608028654f * (y + 0.044715f * y * y * y); const float e = __expf(2.f * z); const float th = 1.f - 2.f / (e + 1.f); return 0.5f * y * (1.f + th); }
struct EpiSsm2 {
    static constexpr bool PERM = false;
    const float* yintra; const bf16* u; const float* dsk; bf16 *yssm, *gy;
    DEVI void operator()(AccT acc, const Unit& un, int wr, int wc, int fr, int fq) const {
        const int row0 = un.pm * BM + wr * 64 + fr, g = un.pn, cw = wc * 32 + 4 * fq;
#pragma unroll
        for (int ai = 0; ai < 2; ++ai)
#pragma unroll
            for (int m = 0; m < 4; ++m) {
                const int row = row0 + ai * HALF + m * 16, chunk = row & 1023;
#pragma unroll
                for (int bj = 0; bj < 2; ++bj)
#pragma unroll
                    for (int n = 0; n < 2; ++n) {
                        const int col = bj * 128 + cw + 16 * n, j = col >> 4, co = col & 15, t = chunk * 16 + j, ch = g * 16 + co;
                        const f32x4 yi = *(const f32x4*)(yintra + (size_t)row * 256 + col);
                        const v2u uu = *(const v2u*)(u + ((size_t)g * S + t) * 16 + co);
                        const f32x4 dd = *(const f32x4*)(dsk + ch);
                        f32x4 y = acc[ai][bj][m][n] + yi;
                        y[0] += dd[0] * bflo(uu.x); y[1] += dd[1] * bfhi(uu.x); y[2] += dd[2] * bflo(uu.y); y[3] += dd[3] * bfhi(uu.y);
                        v2u w; w.x = pg8::cvt_pk_bf16(y[0], y[1]); w.y = pg8::cvt_pk_bf16(y[2], y[3]);
                        *(v2u*)(yssm + (size_t)t * DSSM + ch) = w;
                        v2u w2; w2.x = pg8::cvt_pk_bf16(gelu_tanh(y[0]), gelu_tanh(y[1])); w2.y = pg8::cvt_pk_bf16(gelu_tanh(y[2]), gelu_tanh(y[3]));
                        *(v2u*)(gy + (size_t)t * DSSM + ch) = w2;
                    }
                asm volatile("" ::: "memory");
            }
    }
};
struct EpiGlu {
    static constexpr bool PERM = true;
    const bf16* gy; const float* bias; bf16* O;
    DEVI void operator()(AccT acc, const Unit& un, int wr, int wc, int fr, int fq) const {
        const int row0 = un.pm * BM + wr * 64 + fr, col0 = un.pn * BM + wc * 32 + 8 * fq;
#pragma unroll
        for (int ai = 0; ai < 2; ++ai)
#pragma unroll
            for (int m = 0; m < 4; ++m)
#pragma unroll
                for (int bj = 0; bj < 2; ++bj) {
                    const int col = col0 + bj * HALF; const size_t off = (size_t)(row0 + ai * HALF + m * 16) * DSSM + col;
                    const f32x4 b0 = *(const f32x4*)(bias + col), b1 = *(const f32x4*)(bias + col + 4);
                    const v4u g4 = *(const v4u*)(gy + off);
                    const f32x4 v0 = acc[ai][bj][m][0] + b0, v1 = acc[ai][bj][m][1] + b1;
                    v4u w;
                    w.x = pg8::cvt_pk_bf16(bflo(g4.x) * sigmoidf_(v0[0]), bfhi(g4.x) * sigmoidf_(v0[1]));
                    w.y = pg8::cvt_pk_bf16(bflo(g4.y) * sigmoidf_(v0[2]), bfhi(g4.y) * sigmoidf_(v0[3]));
                    w.z = pg8::cvt_pk_bf16(bflo(g4.z) * sigmoidf_(v1[0]), bfhi(g4.z) * sigmoidf_(v1[1]));
                    w.w = pg8::cvt_pk_bf16(bflo(g4.w) * sigmoidf_(v1[2]), bfhi(g4.w) * sigmoidf_(v1[3]));
                    *(v4u*)(O + off) = w;
                }
    }
};
struct EpiResid {
    static constexpr bool PERM = false;
    const float* base; float* out;
    DEVI void operator()(AccT acc, const Unit& un, int wr, int wc, int fr, int fq) const {
        const int row0 = un.pm * BM + wr * 64 + fr, col0 = un.pn * BM + wc * 32 + 4 * fq;
#pragma unroll
        for (int ai = 0; ai < 2; ++ai)
#pragma unroll
            for (int m = 0; m < 4; ++m) {
                const size_t off = (size_t)(row0 + ai * HALF + m * 16) * D + col0;
#pragma unroll
                for (int bj = 0; bj < 2; ++bj)
#pragma unroll
                    for (int n = 0; n < 2; ++n) { const f32x4 bs = *(const f32x4*)(base + off + bj * HALF + n * 16); *(f32x4*)(out + off + bj * HALF + n * 16) = bs + acc[ai][bj][m][n]; }
                asm volatile("" ::: "memory");
            }
    }
};
struct EpiSwiglu {
    static constexpr bool PERM = true;
    bf16* O; int ldc, nct;
    DEVI void operator()(AccT acc, const Unit& un, int wr, int wc, int fr, int fq) const {
        const int row0 = un.pm * BM + wr * 64 + fr, col0 = (un.pn % nct) * 128 + wc * 32 + 8 * fq;
#pragma unroll
        for (int ai = 0; ai < 2; ++ai)
#pragma unroll
            for (int m = 0; m < 4; ++m) {
                float o[8];
#pragma unroll
                for (int n = 0; n < 2; ++n)
#pragma unroll
                    for (int j = 0; j < 4; ++j) o[4 * n + j] = siluf_(acc[ai][0][m][n][j]) * acc[ai][1][m][n][j];
                v4u w; w.x = pg8::cvt_pk_bf16(o[0], o[1]); w.y = pg8::cvt_pk_bf16(o[2], o[3]); w.z = pg8::cvt_pk_bf16(o[4], o[5]); w.w = pg8::cvt_pk_bf16(o[6], o[7]);
                *(v4u*)(O + (size_t)(row0 + ai * HALF + m * 16) * ldc + col0) = w;
            }
    }
};
struct EpiMoeDown {
    static constexpr bool PERM = true;
    bf16* O; const float* rw;
    DEVI void operator()(AccT acc, const Unit& un, int wr, int wc, int fr, int fq) const {
        const int row0 = un.pm * BM + wr * 64 + fr, col0 = (un.pn & 7) * BM + wc * 32 + 8 * fq;
#pragma unroll
        for (int ai = 0; ai < 2; ++ai)
#pragma unroll
            for (int m = 0; m < 4; ++m) {
                const int row = row0 + ai * HALF + m * 16; const float s = rw[row];
#pragma unroll
                for (int bj = 0; bj < 2; ++bj) {
                    const f32x4 v0 = acc[ai][bj][m][0] * s, v1 = acc[ai][bj][m][1] * s;
                    v4u w; w.x = pg8::cvt_pk_bf16(v0[0], v0[1]); w.y = pg8::cvt_pk_bf16(v0[2], v0[3]); w.z = pg8::cvt_pk_bf16(v1[0], v1[1]); w.w = pg8::cvt_pk_bf16(v1[2], v1[3]);
                    *(v4u*)(O + (size_t)row * D + col0 + bj * HALF) = w;
                }
            }
    }
};

struct Ssm1Order { int G, c; DEVI bool next(int i, Unit& u) const { const int L = i * G + c; if (L >= 256) return false; u.pm = L >> 1; u.pn = (u.pm >> 2) * 2 + (L & 1); return true; } };
struct Ssm2Order { int G, c; DEVI bool next(int i, Unit& u) const { const int L = i * G + c; if (L >= 128) return false; u.pm = L; u.pn = L >> 2; return true; } };
struct MoeOrder {
    pg8::StaticOrder so; int nct; int pe[NE + 1];
    DEVI bool next(int i, Unit& u) const {
        if (!so.next(i, u)) return false;
        int e = 0;
#pragma unroll
        for (int k = 1; k < NE; ++k) e += (u.pm >= pe[k]) ? 1 : 0;
        u.pn += e * nct; return true;
    }
};

struct Args { const float* in[38]; float* out; unsigned char* ws; int ph_lo, ph_hi, li, dbg; };
constexpr size_t CTL_TBL = 600000;
struct Frame {
    LAS unsigned char* lds; volatile LAS unsigned* MISC; gu32* ctl;
    int tid, lane, wave, G, gw, NGW;
    unsigned char* ws;
    DEVI const float* in(int i) const { const unsigned long long v = __hip_atomic_load((const unsigned long long*)(ws + CTL_TBL + (size_t)blockIdx.x * 512) + i, __ATOMIC_RELAXED, __HIP_MEMORY_SCOPE_WORKGROUP);
        return (const float*)(const GAS float*)(((unsigned long long)(unsigned)__builtin_amdgcn_readfirstlane((int)(v >> 32)) << 32) | (unsigned)__builtin_amdgcn_readfirstlane((int)v)); }
};
DEVI unsigned char* launder(unsigned char* p) { GAS unsigned char* g = (GAS unsigned char*)p; asm volatile("" : "+s"(g)); return (unsigned char*)g; }
DEVI int vlaunder(int v) { asm volatile("" : "+v"(v)); return v; }
enum { IN_X = 0, IN_POS, IN_NMG, IN_WIN, IN_DWW, IN_DWB, IN_LNG, IN_LNB, IN_PWW, IN_PWB, IN_GB, IN_PEK, IN_PEV, IN_W1K, IN_W2K, IN_W1V, IN_W2V,
       IN_LRE, IN_LIM, IN_LDT, IN_BRE, IN_BIM, IN_CRE, IN_CIM, IN_SD, IN_GLW, IN_GLB, IN_MOG, IN_WOUT, IN_NFG, IN_FG, IN_FU, IN_FD, IN_RW, IN_MG, IN_MU, IN_MD, IN_FNG };

DEVI void tr_item(const float* W, int ldw, int c0, int nvalid, int k0, bf16* dst, size_t ldd, int r0, LAS float* scr, int lane) {
    const int cg = (lane & 7) * 4;
#pragma unroll
    for (int i = 0; i < 8; ++i) {
        const int kk = 8 * i + (lane >> 3);
        const float* p = W + (size_t)(k0 + kk) * ldw + c0 + cg;
        f32x4 v;
        if (nvalid >= 32) { v = *(const f32x4*)p; }
        else { v[0] = cg + 0 < nvalid ? p[0] : 0.f; v[1] = cg + 1 < nvalid ? p[1] : 0.f; v[2] = cg + 2 < nvalid ? p[2] : 0.f; v[3] = cg + 3 < nvalid ? p[3] : 0.f; }
        scr[kk * 33 + cg + 0] = v[0]; scr[kk * 33 + cg + 1] = v[1]; scr[kk * 33 + cg + 2] = v[2]; scr[kk * 33 + cg + 3] = v[3];
    }
    LDS_WAIT(); asm volatile("" ::: "memory");
    const int c = lane & 7;
#pragma unroll
    for (int j = 0; j < 4; ++j) { const int n = (lane >> 3) + 8 * j; const LAS float* s = scr + (8 * c) * 33 + n;
        v4u o; o.x = pk2(s[0 * 33], s[1 * 33]); o.y = pk2(s[2 * 33], s[3 * 33]); o.z = pk2(s[4 * 33], s[5 * 33]); o.w = pk2(s[6 * 33], s[7 * 33]);
        *(v4u*)(dst + (size_t)(r0 + n) * ldd + k0 + 8 * c) = o; }
    LDS_WAIT(); asm volatile("" ::: "memory");
}
DEVI void tr_matrix_item(int item, const float* W, const float* W2, int K, int ldw, int Ndst, int kind, int nvalid_total, bf16* dst, LAS float* scr, int lane) {
    const int nblk = Ndst / 32, kb = item / nblk, nb = item % nblk, d0 = nb * 32;
    const float* src = W; int c0 = d0, nv = 32;
    if (kind == 1) { const int un = d0 >> 8, within = d0 & 255; src = (within >= 128) ? W2 : W; c0 = un * 128 + (within & 127); }
    else if (kind == 2) {
        const int un = d0 >> 8, within = d0 & 255;
        if (un < 4) c0 = (within >> 7) * 512 + un * 128 + (within & 127);
        else if (un < 14) c0 = d0;
        else c0 = 3608 + (d0 - 3584);
    }
    if (nvalid_total < Ndst) { nv = nvalid_total - d0; nv = nv < 0 ? 0 : (nv > 32 ? 32 : nv); }
    tr_item(src, ldw, c0, nv, kb * 64, dst, (size_t)K, d0, scr, lane);
}

DEVI void rms_row_to_bf16(const float* xrow, const float* g, bf16* orow, int lane) {
    f32x4 v[8]; float s = 0.f;
#pragma unroll
    for (int j = 0; j < 8; ++j) { v[j] = *(const f32x4*)(xrow + 4 * lane + 256 * j); s += (v[j].x * v[j].x + v[j].y * v[j].y) + (v[j].z * v[j].z + v[j].w * v[j].w); }
    const float r = 1.f / sqrtf(wave_sum(s) * (1.f / D) + EPS);
#pragma unroll
    for (int j = 0; j < 8; ++j) { const f32x4 gg = *(const f32x4*)(g + 4 * lane + 256 * j);
        v2u w; w.x = pk2(v[j].x * r * gg.x, v[j].y * r * gg.y); w.y = pk2(v[j].z * r * gg.z, v[j].w * r * gg.w);
        *(v2u*)(orow + 4 * lane + 256 * j) = w; }
}

DEVI void ssm_tables_job(Frame& F, int l, int g) {

    LAS float* apr = (LAS float*)F.lds;
    LAS float* api = apr + 18 * 64;
    LAS float* bbr = api + 18 * 64;
    LAS float* bbi = bbr + 1024;
    LAS float* ccr = bbi + 1024;
    LAS float* cci = ccr + 1024;
    LAS float* kt = cci + 1024;
    const int tid = F.tid;
    const size_t gp = (size_t)(l * NGRP + g) * PST;
    if (tid < 64) {
        const int p = tid;
        const float lr = fminf(F.in(IN_LRE)[gp + p], -1e-4f), li = F.in(IN_LIM)[gp + p], dt = expf(F.in(IN_LDT)[l * NGRP + g]);
        const float mag = expf(lr * dt), ar = mag * cosf(li * dt), ai = mag * sinf(li * dt);
        const float den = lr * lr + li * li, cr = ((ar - 1.f) * lr + ai * li) / den, ci = (ai * lr - (ar - 1.f) * li) / den;
        float pr = 1.f, pi = 0.f;
        for (int tau = 0; tau < 18; ++tau) { apr[tau * 64 + p] = pr; api[tau * 64 + p] = pi; const float nr = pr * ar - pi * ai, ni = pr * ai + pi * ar; pr = nr; pi = ni; }
        for (int c = 0; c < 16; ++c) { const float br = F.in(IN_BRE)[(gp + p) * 16 + c], bi = F.in(IN_BIM)[(gp + p) * 16 + c];
            bbr[p * 16 + c] = cr * br - ci * bi; bbi[p * 16 + c] = cr * bi + ci * br; }
        float* a16 = (float*)(F.ws + R_CB + 4096) + (gp + p) * 2;
        a16[0] = apr[16 * 64 + p]; a16[1] = api[16 * 64 + p];
    }
    for (int i = tid; i < 1024; i += NTHR) { const int co = i >> 6, p = i & 63; const size_t o = ((size_t)(l * NGRP + g) * 16 + co) * PST + p; ccr[i] = F.in(IN_CRE)[o]; cci[i] = F.in(IN_CIM)[o]; }
    __syncthreads();
    for (int i = tid; i < 4096; i += NTHR) {
        const int tau = i >> 8, co = (i >> 4) & 15, ci = i & 15; float s = 0.f;
        for (int p = 0; p < 64; ++p) {
            const float xr = apr[tau * 64 + p] * bbr[p * 16 + ci] - api[tau * 64 + p] * bbi[p * 16 + ci];
            const float xi = apr[tau * 64 + p] * bbi[p * 16 + ci] + api[tau * 64 + p] * bbr[p * 16 + ci];
            s += ccr[co * 64 + p] * xr - cci[co * 64 + p] * xi;
        }
        kt[i] = s;
    }
    __syncthreads();
    bf16* tw = (bf16*)(F.ws + R_TW) + (size_t)(l * NGRP + g) * 512 * 256;
    bf16* wo2 = (bf16*)(F.ws + R_WO2) + (size_t)(l * NGRP + g) * 256 * 256;
    for (int i2 = tid; i2 < 256 * 128; i2 += NTHR) {
        const int n = i2 >> 7, k = (i2 & 127) * 2, j = n >> 4, co = n & 15, ii = k >> 4, ci = k & 15;
        float v0 = 0.f, v1 = 0.f;
        if (ii <= j) { v0 = kt[(j - ii) * 256 + co * 16 + ci]; v1 = kt[(j - ii) * 256 + co * 16 + ci + 1]; }
        *(unsigned*)(tw + (size_t)n * 256 + k) = pk2(v0, v1);
    }
    for (int i2 = tid; i2 < 256 * 128; i2 += NTHR) {
        const int n = i2 >> 7, k = (i2 & 127) * 2, ii = k >> 4, ci = k & 15;
        float v0 = 0.f, v1 = 0.f;
        if (n < 128) { const int ri = n >> 6, p = n & 63; const float pr = apr[(15 - ii) * 64 + p], pi = api[(15 - ii) * 64 + p];
            const float b0r = bbr[p * 16 + ci], b0i = bbi[p * 16 + ci], b1r = bbr[p * 16 + ci + 1], b1i = bbi[p * 16 + ci + 1];
            if (ri == 0) { v0 = pr * b0r - pi * b0i; v1 = pr * b1r - pi * b1i; } else { v0 = pr * b0i + pi * b0r; v1 = pr * b1i + pi * b1r; } }
        *(unsigned*)(tw + (size_t)(256 + n) * 256 + k) = pk2(v0, v1);
    }
    for (int i2 = tid; i2 < 256 * 128; i2 += NTHR) {
        const int n = i2 >> 7, k = (i2 & 127) * 2, j = n >> 4, co = n & 15;
        float v[2] = {0.f, 0.f};
#pragma unroll
        for (int e = 0; e < 2; ++e) { const int kk = k + e;
            if (kk < 128) { const int p = kk & 63; const float pr = apr[(j + 1) * 64 + p], pi = api[(j + 1) * 64 + p], cr = ccr[co * 64 + p], ci = cci[co * 64 + p];
                v[e] = (kk < 64) ? (cr * pr - ci * pi) : -(cr * pi + ci * pr); } }
        *(unsigned*)(wo2 + (size_t)n * 256 + k) = pk2(v[0], v[1]);
    }
    __syncthreads();
}
DEVI void cbias_job(Frame& F, int l, int kv) {
     LAS float* red = (LAS float*)F.lds;
    const float* pe = F.in(kv ? IN_PEV : IN_PEK) + (size_t)l * 4096; const float* w1 = F.in(kv ? IN_W1V : IN_W1K) + (size_t)l * 4096 * 128;
    const int e = F.tid & 127, kq = F.tid >> 7; float s = 0.f;
#pragma unroll 8
    for (int k = kq * 1024; k < kq * 1024 + 1024; ++k) s += pe[k] * w1[(size_t)k * 128 + e];
    red[F.tid] = s; __syncthreads();
    if (F.tid < 128) ((float*)(F.ws + R_CB))[(l * 2 + kv) * 128 + e] = (red[e] + red[128 + e]) + (red[256 + e] + red[384 + e]);
    __syncthreads();
}

DEVI void p0_prologue(Frame& F) {
     unsigned char* ws = F.ws;
    for (int j = blockIdx.x; j < 68; j += F.G) { if (j < 64) ssm_tables_job(F, j >> 5, j & 31); else cbias_job(F, (j - 64) >> 1, (j - 64) & 1); }
    __syncthreads();
    LAS float* scr = (LAS float*)(F.lds + RING_OFF + F.wave * 16384);
    for (int m = F.gw; m < S; m += F.NGW) rms_row_to_bf16(F.in(IN_X) + (size_t)m * D, F.in(IN_NMG), (bf16*)(ws + WS_HN) + (size_t)m * D, F.lane);
    constexpr int I_WIN = 32 * 128, I_WG = 32, I_WOUT = 32 * 64, I_SQ = 8 * 16, I_W1 = 64 * 4, I_W2 = 2 * 4;
    constexpr int I_LAYER = I_WIN + I_WG + I_WOUT + 2 * I_SQ + 2 * I_W1 + 2 * I_W2;
    constexpr int I_FGU = 32 * (2 * DFF / 32), I_FD = (DFF / 64) * 64, I_MGU = 32 * (2 * DFFE / 32), I_MD = (DFFE / 64) * 64;
    constexpr int NITEMS = 2 * I_LAYER + I_FGU + I_FD + NE * (I_MGU + I_MD);
    for (int it = F.gw; it < NITEMS; it += F.NGW) {
        int r = it;
        if (r < 2 * I_LAYER) {
            const int l = r / I_LAYER; r -= l * I_LAYER;
            if (r < I_WIN) { tr_matrix_item(r, F.in(IN_WIN) + (size_t)l * D * DIN, nullptr, D, DIN, 4096, 2, 4096, (bf16*)(ws + R_WIN) + (size_t)l * 4096 * D, scr, F.lane); continue; } r -= I_WIN;
            if (r < I_WG) { tr_item(F.in(IN_WIN) + (size_t)l * D * DIN, DIN, 3584, 24, r * 64, (bf16*)(ws + R_WG) + (size_t)l * 32 * D, (size_t)D, 0, scr, F.lane); continue; } r -= I_WG;
            if (r < I_WOUT) { tr_matrix_item(r, F.in(IN_WOUT) + (size_t)l * D * D, nullptr, D, D, D, 0, D, (bf16*)(ws + R_WOUT) + (size_t)l * D * D, scr, F.lane); continue; } r -= I_WOUT;
            if (r < I_SQ) { tr_matrix_item(r, F.in(IN_PWW) + (size_t)l * 512 * 512, nullptr, 512, 512, 512, 0, 512, (bf16*)(ws + R_CPW) + (size_t)l * 512 * 512, scr, F.lane); continue; } r -= I_SQ;
            if (r < I_SQ) { tr_matrix_item(r, F.in(IN_GLW) + (size_t)l * 512 * 512, nullptr, 512, 512, 512, 0, 512, (bf16*)(ws + R_GLU) + (size_t)l * 512 * 512, scr, F.lane); continue; } r -= I_SQ;
            if (r < I_W1) { tr_matrix_item(r, F.in(IN_W1K) + (size_t)l * 4096 * 128, nullptr, 4096, 128, 128, 0, 128, (bf16*)(ws + R_W1K) + (size_t)l * 128 * 4096, scr, F.lane); continue; } r -= I_W1;
            if (r < I_W1) { tr_matrix_item(r, F.in(IN_W1V) + (size_t)l * 4096 * 128, nullptr, 4096, 128, 128, 0, 128, (bf16*)(ws + R_W1V) + (size_t)l * 128 * 4096, scr, F.lane); continue; } r -= I_W1;
            if (r < I_W2) { tr_matrix_item(r, F.in(IN_W2K) + (size_t)l * 128 * 128, nullptr, 128, 128, 128, 0, 128, (bf16*)(ws + R_W2) + (size_t)(l * 2 + 0) * 128 * 128, scr, F.lane); continue; } r -= I_W2;
            tr_matrix_item(r, F.in(IN_W2V) + (size_t)l * 128 * 128, nullptr, 128, 128, 128, 0, 128, (bf16*)(ws + R_W2) + (size_t)(l * 2 + 1) * 128 * 128, scr, F.lane); continue;
        }
        r -= 2 * I_LAYER;
        if (r < I_FGU) { tr_matrix_item(r, F.in(IN_FG), F.in(IN_FU), D, DFF, 2 * DFF, 1, 2 * DFF, (bf16*)(ws + R_FGU), scr, F.lane); continue; } r -= I_FGU;
        if (r < I_FD) { tr_matrix_item(r, F.in(IN_FD), nullptr, DFF, D, D, 0, D, (bf16*)(ws + R_FD), scr, F.lane); continue; } r -= I_FD;
        const int e = r / (I_MGU + I_MD); r -= e * (I_MGU + I_MD);
        if (r < I_MGU) { tr_matrix_item(r, F.in(IN_MG) + (size_t)e * D * DFFE, F.in(IN_MU) + (size_t)e * D * DFFE, D, DFFE, 2 * DFFE, 1, 2 * DFFE, (bf16*)(ws + WS_MOE_GU) + (size_t)e * 2 * DFFE * D, scr, F.lane); continue; } r -= I_MGU;
        tr_matrix_item(r, F.in(IN_MD) + (size_t)e * DFFE * D, nullptr, DFFE, D, D, 0, D, (bf16*)(ws + WS_MOE_D) + (size_t)e * D * DFFE, scr, F.lane);
    }
}

#define MFMA16(a, b, c) __builtin_amdgcn_mfma_f32_16x16x32_bf16((a), (b), (c), 0, 0, 0)
DEVI bf16x8 ldg8(const bf16* p) { return *(const bf16x8*)p; }
DEVI bf16x8 zero8() { bf16x8 z = {0, 0, 0, 0, 0, 0, 0, 0}; return z; }
DEVI bf16x8 pack8(f32x4 a, f32x4 b) { v4u w; w.x = pg8::cvt_pk_bf16(a[0], a[1]); w.y = pg8::cvt_pk_bf16(a[2], a[3]); w.z = pg8::cvt_pk_bf16(b[0], b[1]); w.w = pg8::cvt_pk_bf16(b[2], b[3]); return __builtin_bit_cast(bf16x8, w); }

DEVI void gates_job(Frame& F, int l, int job) {
    const int lane = F.lane, r = lane & 15, q = lane >> 4, t0 = job * 16;
    const bf16* hn = (const bf16*)(F.ws + WS_HN) + (size_t)(t0 + r) * D + 8 * q;
    const bf16* wg = (const bf16*)(F.ws + R_WG) + (size_t)l * 32 * D + (size_t)r * D + 8 * q;
    f32x4 a0 = {0.f, 0.f, 0.f, 0.f}, a1 = a0;
#pragma unroll 4
    for (int ks = 0; ks < D / 32; ++ks) {
        const bf16x8 a = ldg8(hn + 32 * ks), b0 = ldg8(wg + 32 * ks), b1 = ldg8(wg + (size_t)16 * D + 32 * ks);
        a0 = MFMA16(a, b0, a0); a1 = MFMA16(a, b1, a1);
    }
    const float* gb = F.in(IN_GB) + l * 24; float* go = (float*)(F.ws + R_GATES);
#pragma unroll
    for (int j = 0; j < 4; ++j) { const int t = t0 + 4 * q + j;
        go[(size_t)t * 24 + r] = sigmoidf_(a0[j] + gb[r]);
        if (r < 8) go[(size_t)t * 24 + 16 + r] = sigmoidf_(a1[j] + gb[16 + r]); }
}

DEVI void rope_job(Frame& F, int t) {
    const int lane = F.lane;
    const float pos = (float)((const int*)F.in(IN_POS))[t];
    float cs = 0.f, sn = 0.f;
    { const int i = lane & 15; const float inv = powf(500000.f, -(float)(2 * i) / 32.f); const float ang = pos * inv; cs = cosf(ang); sn = sinf(ang); }
    float cv[16], sv[16];
#pragma unroll
    for (int i = 0; i < 16; ++i) { cv[i] = __shfl(cs, i); sv[i] = __shfl(sn, i); }
    const bf16* qrow = (const bf16*)(F.ws + R_Q) + (size_t)t * DATT + 16 * lane;
    v4u w0 = *(const v4u*)qrow, w1 = *(const v4u*)(qrow + 8);
    unsigned w[8] = {w0.x, w0.y, w0.z, w0.w, w1.x, w1.y, w1.z, w1.w};
    const int sub = lane & 7;
    float x[16], o[16];
#pragma unroll
    for (int i = 0; i < 8; ++i) { x[2 * i] = bflo(w[i]); x[2 * i + 1] = bfhi(w[i]); }
#pragma unroll
    for (int i = 0; i < 16; ++i) { const float other = __shfl_xor(x[i], 1);
        o[i] = (sub == 0) ? (x[i] * cv[i] - other * sv[i]) : ((sub == 1) ? (x[i] * cv[i] + other * sv[i]) : x[i]); }
    v4u o0, o1; o0.x = pk2(o[0], o[1]); o0.y = pk2(o[2], o[3]); o0.z = pk2(o[4], o[5]); o0.w = pk2(o[6], o[7]); o1.x = pk2(o[8], o[9]); o1.y = pk2(o[10], o[11]); o1.z = pk2(o[12], o[13]); o1.w = pk2(o[14], o[15]);
    bf16* qr = (bf16*)(F.ws + R_QR) + (size_t)t * DATT + 16 * lane;
    if (sub >= 2) { o0 = w0; o1 = w1; }
    *(v4u*)qr = o0; *(v4u*)(qr + 8) = o1;
    if (lane < 4) {
        const int tensor = (lane >> 1) ? 4 : 2, g = lane & 1;
        bf16* kp = (bf16*)(F.ws + R_KV) + ((size_t)(tensor * 2 + g) * S + t) * HD;
        v4u a = *(const v4u*)kp, b = *(const v4u*)(kp + 8), c = *(const v4u*)(kp + 16), d = *(const v4u*)(kp + 24);
        unsigned u1[8] = {a.x, a.y, a.z, a.w, b.x, b.y, b.z, b.w}, u2[8] = {c.x, c.y, c.z, c.w, d.x, d.y, d.z, d.w};
        float r1[16], r2[16];
#pragma unroll
        for (int i = 0; i < 8; ++i) { const float t1a = bflo(u1[i]), t1b = bfhi(u1[i]), t2a = bflo(u2[i]), t2b = bfhi(u2[i]);
            r1[2 * i] = t1a * cv[2 * i] - t2a * sv[2 * i]; r1[2 * i + 1] = t1b * cv[2 * i + 1] - t2b * sv[2 * i + 1];
            r2[2 * i] = t2a * cv[2 * i] + t1a * sv[2 * i]; r2[2 * i + 1] = t2b * cv[2 * i + 1] + t1b * sv[2 * i + 1]; }
        v4u oa, ob, oc, od;
        oa.x = pk2(r1[0], r1[1]); oa.y = pk2(r1[2], r1[3]); oa.z = pk2(r1[4], r1[5]); oa.w = pk2(r1[6], r1[7]); ob.x = pk2(r1[8], r1[9]); ob.y = pk2(r1[10], r1[11]); ob.z = pk2(r1[12], r1[13]); ob.w = pk2(r1[14], r1[15]);
        oc.x = pk2(r2[0], r2[1]); oc.y = pk2(r2[2], r2[3]); oc.z = pk2(r2[4], r2[5]); oc.w = pk2(r2[6], r2[7]); od.x = pk2(r2[8], r2[9]); od.y = pk2(r2[10], r2[11]); od.z = pk2(r2[12], r2[13]); od.w = pk2(r2[14], r2[15]);
        *(v4u*)kp = oa; *(v4u*)(kp + 8) = ob; *(v4u*)(kp + 16) = oc; *(v4u*)(kp + 24) = od;
    }
}

DEVI void dwconv_job(Frame& F, int l, int job) {
    const int lane = F.lane, c0 = 8 * lane, t0 = job * 4;
    const bf16* u = (const bf16*)(F.ws + R_CONVU);
    const float* dww = F.in(IN_DWW) + (size_t)l * CONVW * DCONV + c0;
    float acc[4][8], wk[4][8];
#pragma unroll
    for (int i = 0; i < 4; ++i)
#pragma unroll
        for (int c = 0; c < 8; ++c) { acc[i][c] = 0.f; wk[i][c] = 0.f; }
#pragma unroll 2
    for (int kr = 0; kr < 34; ++kr) {
#pragma unroll
        for (int c = 0; c < 8; ++c) { wk[3][c] = wk[2][c]; wk[2][c] = wk[1][c]; wk[1][c] = wk[0][c]; }
        const int kk = kr <= 30 ? kr : 30; const float wm = kr <= 30 ? 1.f : 0.f;
        const f32x4 a = *(const f32x4*)(dww + (size_t)kk * DCONV), b = *(const f32x4*)(dww + (size_t)kk * DCONV + 4);
        wk[0][0] = a[0] * wm; wk[0][1] = a[1] * wm; wk[0][2] = a[2] * wm; wk[0][3] = a[3] * wm; wk[0][4] = b[0] * wm; wk[0][5] = b[1] * wm; wk[0][6] = b[2] * wm; wk[0][7] = b[3] * wm;
        const int r = t0 - 30 + kr; const int rc = r < 0 ? 0 : r; const float xm = r < 0 ? 0.f : 1.f;
        const v4u w = *(const v4u*)(u + (size_t)rc * DCONV + c0);
        const float x[8] = {bflo(w.x) * xm, bfhi(w.x) * xm, bflo(w.y) * xm, bfhi(w.y) * xm, bflo(w.z) * xm, bfhi(w.z) * xm, bflo(w.w) * xm, bfhi(w.w) * xm};
#pragma unroll
        for (int i = 0; i < 4; ++i)
#pragma unroll
            for (int c = 0; c < 8; ++c) acc[i][c] += x[c] * wk[i][c];
    }
    const float* dwb = F.in(IN_DWB) + l * DCONV + c0; const float* lng = F.in(IN_LNG) + l * DCONV + c0; const float* lnb = F.in(IN_LNB) + l * DCONV + c0;
    float bb[8], gg[8], be[8];
#pragma unroll
    for (int c = 0; c < 8; ++c) { bb[c] = dwb[c]; gg[c] = lng[c]; be[c] = lnb[c]; }
    bf16* out = (bf16*)(F.ws + R_CONVACT);
#pragma unroll
    for (int i = 0; i < 4; ++i) {
        float s = 0.f;
#pragma unroll
        for (int c = 0; c < 8; ++c) { acc[i][c] += bb[c]; s += acc[i][c]; }
        const float mu = wave_sum(s) * (1.f / DCONV); float q = 0.f;
#pragma unroll
        for (int c = 0; c < 8; ++c) { const float d = acc[i][c] - mu; q += d * d; }
        const float rstd = 1.f / sqrtf(wave_sum(q) * (1.f / DCONV) + EPS);
        float y[8];
#pragma unroll
        for (int c = 0; c < 8; ++c) y[c] = siluf_((acc[i][c] - mu) * rstd * gg[c] + be[c]);
        v4u w; w.x = pk2(y[0], y[1]); w.y = pk2(y[2], y[3]); w.z = pk2(y[4], y[5]); w.w = pk2(y[6], y[7]);
        *(v4u*)(out + (size_t)(t0 + i) * DCONV + c0) = w;
    }
}

DEVI void vt_job(Frame& F, int job) {
    const int lane = F.lane;
    const int dh = job & 1, chunk = (job >> 1) & 255, g = (job >> 9) & 1, tz = job >> 10;
    LAS unsigned* scr = (LAS unsigned*)(F.lds + RING_OFF + F.wave * 16384);
    const bf16* v = (const bf16*)(F.ws + R_KV) + ((size_t)((tz ? 5 : 3) * 2 + g) * S + chunk * 64) * HD + dh * 64;
#pragma unroll
    for (int i = 0; i < 8; ++i) { const int row = 8 * i + (lane >> 3), cg = (lane & 7) * 4;
        const v4u w = *(const v4u*)(v + (size_t)row * HD + cg * 2);
        scr[row * 33 + cg + 0] = w.x; scr[row * 33 + cg + 1] = w.y; scr[row * 33 + cg + 2] = w.z; scr[row * 33 + cg + 3] = w.w; }
    LDS_WAIT(); asm volatile("" ::: "memory");
    bf16* vt = (bf16*)(F.ws + (tz ? R_VWT : R_VST)) + ((size_t)g * HD + dh * 64) * S + chunk * 64 + lane;
#pragma unroll 8
    for (int d2 = 0; d2 < 32; ++d2) { const unsigned w = scr[lane * 33 + d2];
        vt[(size_t)(2 * d2) * S] = (bf16)(w & 0xffffu); vt[(size_t)(2 * d2 + 1) * S] = (bf16)(w >> 16); }
    LDS_WAIT(); asm volatile("" ::: "memory");
}

DEVI void compress_job(Frame& F, int l, int job) {
    const int lane = F.lane, r = lane & 15, q = lane >> 4;
    const int nt = job & 63, g = (job >> 6) & 1, kv = job >> 7;
    const int n0 = nt * 16; int nn = n0 + r; nn = nn > NCMP - 1 ? NCMP - 1 : nn;
    const bf16* raw = (const bf16*)(F.ws + R_KV) + ((size_t)(kv * 2 + g) * S) * HD + (size_t)nn * 2048 + 8 * q;
    const bf16* w1t = (const bf16*)(F.ws + (kv ? R_W1V : R_W1K)) + (size_t)l * 128 * 4096 + (size_t)r * 4096 + 8 * q;
    f32x4 hid[8];
#pragma unroll
    for (int e = 0; e < 8; ++e) hid[e] = (f32x4){0.f, 0.f, 0.f, 0.f};
#pragma unroll 2
    for (int ks = 0; ks < 128; ++ks) {
        const bf16x8 b = ldg8(raw + 32 * ks);
#pragma unroll
        for (int e = 0; e < 8; ++e) { const bf16x8 a = ldg8(w1t + (size_t)(16 * e) * 4096 + 32 * ks); hid[e] = MFMA16(a, b, hid[e]); }
    }
    const float* cb = (const float*)(F.ws + R_CB) + (l * 2 + kv) * 128;
#pragma unroll
    for (int e = 0; e < 8; ++e) { const f32x4 bv = *(const f32x4*)(cb + 16 * e + 4 * q);
#pragma unroll
        for (int j = 0; j < 4; ++j) hid[e][j] = siluf_(hid[e][j] + bv[j]); }
    const bf16* w2t = (const bf16*)(F.ws + R_W2) + (size_t)(l * 2 + kv) * 128 * 128 + (size_t)r * 128 + 4 * q;
    f32x4 o[8];
#pragma unroll
    for (int f = 0; f < 8; ++f) o[f] = (f32x4){0.f, 0.f, 0.f, 0.f};
#pragma unroll
    for (int s = 0; s < 4; ++s) {
        const bf16x8 b = pack8(hid[2 * s], hid[2 * s + 1]);
#pragma unroll
        for (int f = 0; f < 8; ++f) {
            const v2u lo = *(const v2u*)(w2t + (size_t)(16 * f) * 128 + 32 * s), hi = *(const v2u*)(w2t + (size_t)(16 * f) * 128 + 32 * s + 16);
            v4u aw; aw.x = lo.x; aw.y = lo.y; aw.z = hi.x; aw.w = hi.y;
            o[f] = MFMA16(__builtin_bit_cast(bf16x8, aw), b, o[f]);
        }
    }
    if (kv == 0) { bf16* kc = (bf16*)(F.ws + R_KC) + ((size_t)g * 1024 + n0 + r) * HD + 4 * q;
#pragma unroll
        for (int f = 0; f < 8; ++f) { v2u w; w.x = pk2(o[f][0], o[f][1]); w.y = pk2(o[f][2], o[f][3]); *(v2u*)(kc + 16 * f) = w; } }
    else { bf16* vct = (bf16*)(F.ws + R_VCT) + ((size_t)g * HD + 4 * q) * 1024 + n0 + r;
#pragma unroll
        for (int f = 0; f < 8; ++f)
#pragma unroll
            for (int j = 0; j < 4; ++j) vct[(size_t)(16 * f + j) * 1024] = (bf16)f2bf(o[f][j]); }
}

DEVI void scan_job(Frame& F, int l, int g) {
    const int p = F.lane;
    const float* a16 = (const float*)(F.ws + R_CB + 4096) + ((size_t)(l * NGRP + g) * PST + p) * 2;
    const float ar = a16[0], ai = a16[1];
    const float* sc = (const float*)(F.ws + R_SC) + (size_t)g * 1024 * 128;
    bf16* hp = (bf16*)(F.ws + R_HPREV) + (size_t)g * 1024 * 256;
    float hr = 0.f, hi = 0.f;
    for (int c0 = 0; c0 < 1024; c0 += 8) {
        float sr[8], si[8];
#pragma unroll
        for (int k = 0; k < 8; ++k) { sr[k] = sc[(size_t)(c0 + k) * 128 + p]; si[k] = sc[(size_t)(c0 + k) * 128 + 64 + p]; }
#pragma unroll
        for (int k = 0; k < 8; ++k) {
            bf16* row = hp + (size_t)(c0 + k) * 256;
            row[p] = (bf16)f2bf(hr); row[64 + p] = (bf16)f2bf(hi); *(unsigned*)(row + 128 + 2 * p) = 0u;
            const float nr = ar * hr - ai * hi + sr[k], ni = ar * hi + ai * hr + si[k]; hr = nr; hi = ni;
        }
    }
}

constexpr float QK_SCALE = 0.08838834764831845f;
constexpr float C2 = 1.4426950408889634f * QK_SCALE;
constexpr float NEG_INF = -__builtin_inff();

DEVI int krow(int r, int T) { return 8 * (r >> 2) + 4 * T + (r & 3); }

DEVI void cmp_stats_job(Frame& F, int g, int tile) {
    const int lane = F.lane, r = lane & 15, q = lane >> 4, t0 = tile * 16, t = t0 + r;
    if (tile == 0) return;
    const int nmax = tile - 1;
    const int nsteps = (nmax >> 5) + 1;
    const bf16* qp = (const bf16*)(F.ws + R_Q) + (size_t)t * DATT + (size_t)(4 * g) * HD + 8 * q;
    bf16x8 qf[4][4];
#pragma unroll
    for (int h = 0; h < 4; ++h)
#pragma unroll
        for (int ks = 0; ks < 4; ++ks) qf[h][ks] = ldg8(qp + h * HD + 32 * ks);
    const bf16* kc = (const bf16*)(F.ws + R_KC) + (size_t)g * 1024 * HD + 8 * q;
    const int nvis = (t - 31) >> 4;
    float m[4], lsum[4];
#pragma unroll
    for (int h = 0; h < 4; ++h) { m[h] = -1e30f; lsum[h] = 0.f; }
    for (int pass = 0; pass < 2; ++pass) {
        float inv_l[4];
        if (pass == 1) {
#pragma unroll
            for (int h = 0; h < 4; ++h) {
                float mm = m[h], ll = lsum[h];
#pragma unroll
                for (int o = 16; o < 64; o <<= 1) { const float om = __shfl_xor(mm, o), ol = __shfl_xor(ll, o); const float nm = fmaxf(mm, om);
                    ll = ll * __builtin_amdgcn_exp2f(mm - nm) + ol * __builtin_amdgcn_exp2f(om - nm); mm = nm; }
                m[h] = mm; inv_l[h] = ll > 0.f ? 1.f / ll : 0.f;
            }
        }
        float carry = 0.f;
        for (int st = 0; st < nsteps; ++st) {
            const int key0 = st * 32;
            bf16x8 kf[2][4];
#pragma unroll
            for (int T = 0; T < 2; ++T)
#pragma unroll
                for (int ks = 0; ks < 4; ++ks) kf[T][ks] = ldg8(kc + (size_t)(key0 + krow(r, T)) * HD + 32 * ks);
            f32x4 imp0 = {0.f, 0.f, 0.f, 0.f}, imp1 = imp0;
#pragma unroll
            for (int h = 0; h < 4; ++h) {
                f32x4 s0 = {0.f, 0.f, 0.f, 0.f}, s1 = s0;
#pragma unroll
                for (int ks = 0; ks < 4; ++ks) { s0 = MFMA16(kf[0][ks], qf[h][ks], s0); s1 = MFMA16(kf[1][ks], qf[h][ks], s1); }
#pragma unroll
                for (int j = 0; j < 4; ++j) { s0[j] = (key0 + 8 * q + j <= nvis) ? s0[j] * C2 : NEG_INF; s1[j] = (key0 + 8 * q + 4 + j <= nvis) ? s1[j] * C2 : NEG_INF; }
                if (pass == 0) {
                    float mx = fmaxf(fmaxf(fmaxf(s0[0], s0[1]), fmaxf(s0[2], s0[3])), fmaxf(fmaxf(s1[0], s1[1]), fmaxf(s1[2], s1[3])));
                    const float nm = fmaxf(m[h], mx); float ps = 0.f;
#pragma unroll
                    for (int j = 0; j < 4; ++j) ps += __builtin_amdgcn_exp2f(s0[j] - nm) + __builtin_amdgcn_exp2f(s1[j] - nm);
                    lsum[h] = lsum[h] * __builtin_amdgcn_exp2f(m[h] - nm) + ps; m[h] = nm;
                } else {
#pragma unroll
                    for (int j = 0; j < 4; ++j) { imp0[j] += __builtin_amdgcn_exp2f(s0[j] - m[h]) * inv_l[h]; imp1[j] += __builtin_amdgcn_exp2f(s1[j] - m[h]) * inv_l[h]; }
                }
            }
            if (pass == 1) {
                const float prev_lane = __shfl_up(imp1[3], 16);
                const float pm1 = (q == 0) ? carry : prev_lane;
                const float b0 = pm1 + (imp0[0] + imp0[1]) + (imp0[2] + imp0[3]);
                const float b1 = imp0[3] + (imp1[0] + imp1[1]) + (imp1[2] + imp1[3]);
                carry = __shfl(imp1[3], 48 + r);
                float* dst = (float*)(F.ws + R_IMP) + ((size_t)t * 2 + g) * NSB + (key0 >> 2) + 2 * q;
                f32x2 w = {b0, b1}; *(f32x2*)dst = w;
            }
        }
        if (pass == 1 && q == 0 && 8 * nsteps < NSB) ((float*)(F.ws + R_IMP))[((size_t)t * 2 + g) * NSB + 8 * nsteps] = carry;
    }
}

struct AttnState { f32x4 o[8]; float m, l; };
template <int MODE>
DEVI void attn_step(AttnState& st, const bf16x8 (&qf)[4], const bf16* kbase  , const bf16* vtbase  , size_t vt_ld, int key0, int tq, int lane) {
    const int r = lane & 15, q = lane >> 4;
    bf16x8 kf[2][4];
#pragma unroll
    for (int T = 0; T < 2; ++T)
#pragma unroll
        for (int ks = 0; ks < 4; ++ks) kf[T][ks] = ldg8(kbase + (size_t)(key0 + krow(r, T)) * HD + 32 * ks);
    bf16x8 vf[8];
#pragma unroll
    for (int dt = 0; dt < 8; ++dt) vf[dt] = ldg8(vtbase + (size_t)(16 * dt) * vt_ld + key0);
    f32x4 s0 = {0.f, 0.f, 0.f, 0.f}, s1 = s0;
#pragma unroll
    for (int ks = 0; ks < 4; ++ks) { s0 = MFMA16(kf[0][ks], qf[ks], s0); s1 = MFMA16(kf[1][ks], qf[ks], s1); }
#pragma unroll
    for (int j = 0; j < 4; ++j) {
        const int ka = key0 + 8 * q + j, kb = ka + 4; bool va, vb;
        if (MODE == 0) { va = 16 * ka + 31 <= tq; vb = 16 * kb + 31 <= tq; }
        else if (MODE == 1) { va = (unsigned)(tq - ka) < 512u; vb = (unsigned)(tq - kb) < 512u; }
        else { va = ka <= tq; vb = kb <= tq; }
        s0[j] = va ? s0[j] * C2 : NEG_INF; s1[j] = vb ? s1[j] * C2 : NEG_INF;
    }
    float mx = fmaxf(fmaxf(fmaxf(s0[0], s0[1]), fmaxf(s0[2], s0[3])), fmaxf(fmaxf(s1[0], s1[1]), fmaxf(s1[2], s1[3])));
    mx = fmaxf(mx, __shfl_xor(mx, 16)); mx = fmaxf(mx, __shfl_xor(mx, 32));
    const float nm = fmaxf(st.m, mx), alpha = __builtin_amdgcn_exp2f(st.m - nm);
    st.m = nm;
    float ps = 0.f;
#pragma unroll
    for (int j = 0; j < 4; ++j) { s0[j] = __builtin_amdgcn_exp2f(s0[j] - nm); s1[j] = __builtin_amdgcn_exp2f(s1[j] - nm); ps += s0[j] + s1[j]; }
    st.l = st.l * alpha + ps;
    if (!__all(alpha == 1.f)) {
#pragma unroll
        for (int dt = 0; dt < 8; ++dt) st.o[dt] = st.o[dt] * alpha;
    }
    const bf16x8 pf = pack8(s0, s1);
#pragma unroll
    for (int dt = 0; dt < 8; ++dt) st.o[dt] = MFMA16(vf[dt], pf, st.o[dt]);
}
DEVI void attn_init(AttnState& st) {
#pragma unroll
    for (int dt = 0; dt < 8; ++dt) st.o[dt] = (f32x4){0.f, 0.f, 0.f, 0.f};
    st.m = -1e30f; st.l = 0.f;
}
DEVI void attn_store(AttnState& st, bf16* dst, bool active, int lane) {
    const int q = lane >> 4;
    float l = st.l; l += __shfl_xor(l, 16); l += __shfl_xor(l, 32);
    const float inv = l > 0.f ? 1.f / l : 0.f;
    if (active) {
#pragma unroll
        for (int dt = 0; dt < 8; ++dt) { v2u w; w.x = pk2(st.o[dt][0] * inv, st.o[dt][1] * inv); w.y = pk2(st.o[dt][2] * inv, st.o[dt][3] * inv); *(v2u*)(dst + 16 * dt + 4 * q) = w; }
    }
}
DEVI void cmp_att_job(Frame& F, int tile, int h) {
    const int lane = F.lane, r = lane & 15, q = lane >> 4, t = tile * 16 + r, g = h >> 2;
    AttnState st; attn_init(st);
    bf16x8 qf[4];
    const bf16* qp = (const bf16*)(F.ws + R_Q) + (size_t)t * DATT + (size_t)h * HD + 8 * q;
#pragma unroll
    for (int ks = 0; ks < 4; ++ks) qf[ks] = ldg8(qp + 32 * ks);
    if (tile > 0) {
        const int nsteps = ((tile - 1) >> 5) + 1;
        const bf16* kb = (const bf16*)(F.ws + R_KC) + (size_t)g * 1024 * HD + 8 * q;
        const bf16* vb = (const bf16*)(F.ws + R_VCT) + ((size_t)g * HD + r) * 1024 + 8 * q;
        for (int s = 0; s < nsteps; ++s) attn_step<0>(st, qf, kb, vb, 1024, s * 32, t, lane);
    }
    attn_store(st, (bf16*)(F.ws + R_OC) + (size_t)t * DATT + (size_t)h * HD, true, lane);
}
DEVI void win_att_job(Frame& F, int tile, int h) {
    const int lane = F.lane, r = lane & 15, q = lane >> 4, t0 = tile * 16, t = t0 + r, g = h >> 2;
    AttnState st; attn_init(st);
    bf16x8 qf[4];
    const bf16* qp = (const bf16*)(F.ws + R_QR) + (size_t)t * DATT + (size_t)h * HD + 8 * q;
#pragma unroll
    for (int ks = 0; ks < 4; ++ks) qf[ks] = ldg8(qp + 32 * ks);
    int k_lo = t0 - 511; k_lo = k_lo < 0 ? 0 : k_lo; k_lo &= ~31;
    const bf16* kb = (const bf16*)(F.ws + R_KV) + ((size_t)(4 * 2 + g) * S) * HD + 8 * q;
    const bf16* vb = (const bf16*)(F.ws + R_VWT) + ((size_t)g * HD + r) * S + 8 * q;
    for (int key0 = k_lo; key0 <= t0 + 15; key0 += 32) attn_step<1>(st, qf, kb, vb, (size_t)S, key0, t, lane);
    attn_store(st, (bf16*)(F.ws + R_OW) + (size_t)t * DATT + (size_t)h * HD, true, lane);
}
DEVI void sel_att_job(Frame& F, int t, int g) {
    const int lane = F.lane, r = lane & 15, q = lane >> 4;
    const int cur = t >> 6;
    const int nvis = (t - 31) >> 4, jlim = (t >= 31) ? ((nvis + 1) >> 2) : -1;
    const f32x4 iv = *(const f32x4*)((const float*)(F.ws + R_IMP) + ((size_t)t * 2 + g) * NSB + 4 * lane);
    float sc[4];
#pragma unroll
    for (int i = 0; i < 4; ++i) { const int j = 4 * lane + i; const float im = (j <= jlim) ? iv[i] : 0.f;
        const bool forced = (j == 0) || (j == cur) || (j == cur - 1);
        sc[i] = (j <= cur) ? (forced ? im + 1000.f : im) : -1.f; }
    int selv = -1;
    for (int s = 0; s < 16; ++s) {
        float bv = sc[0]; int bi = 4 * lane;
#pragma unroll
        for (int i = 1; i < 4; ++i) if (sc[i] > bv) { bv = sc[i]; bi = 4 * lane + i; }
#pragma unroll
        for (int o = 32; o >= 1; o >>= 1) { const float ov = __shfl_xor(bv, o); const int oi = __shfl_xor(bi, o); if (ov > bv || (ov == bv && oi < bi)) { bv = ov; bi = oi; } }
        if (bv < 0.f) break;
        if (lane == s) selv = bi;
#pragma unroll
        for (int i = 0; i < 4; ++i) if (4 * lane + i == bi) sc[i] = -2.f;
    }
    AttnState st; attn_init(st);
    bf16x8 qf[4];
    const bf16* qp = (const bf16*)(F.ws + R_QR) + (size_t)t * DATT + (size_t)(4 * g + (r & 3)) * HD + 8 * q;
#pragma unroll
    for (int ks = 0; ks < 4; ++ks) { qf[ks] = ldg8(qp + 32 * ks); if (r >= 4) qf[ks] = zero8(); }
    const bf16* kb = (const bf16*)(F.ws + R_KV) + ((size_t)(2 * 2 + g) * S) * HD + 8 * q;
    const bf16* vb = (const bf16*)(F.ws + R_VST) + ((size_t)g * HD + r) * S + 8 * q;
    for (int s = 0; s < 16; ++s) {
        const int blk = __builtin_amdgcn_readlane(selv, s);
        if (blk < 0) break;
        attn_step<2>(st, qf, kb, vb, (size_t)S, blk * 64, t, lane);
        attn_step<2>(st, qf, kb, vb, (size_t)S, blk * 64 + 32, t, lane);
    }
    attn_store(st, (bf16*)(F.ws + R_OS) + (size_t)t * DATT + (size_t)(4 * g + (r & 3)) * HD, r < 4, lane);
}

DEVI void mixnorm_job(Frame& F, int l, int t) {
    const int lane = F.lane;
    const float* mg = F.in(IN_MOG) + (size_t)l * D;
    bf16* mixed = (bf16*)(F.ws + R_MIXED) + (size_t)t * D;
#pragma unroll
    for (int part = 0; part < 2; ++part) {
        const bf16* src = (const bf16*)(F.ws + (part ? R_SSMO : R_CONVO)) + (size_t)t * 512 + 8 * lane;
        const int gofs = part ? (DCONV + DATT) : 0;
        const v4u w = *(const v4u*)src; float x[8] = {bflo(w.x), bfhi(w.x), bflo(w.y), bfhi(w.y), bflo(w.z), bfhi(w.z), bflo(w.w), bfhi(w.w)};
        float s = 0.f;
#pragma unroll
        for (int c = 0; c < 8; ++c) s += x[c] * x[c];
        const float rr = 1.f / sqrtf(wave_sum(s) * (1.f / 512.f) + EPS);
        const f32x4 g0 = *(const f32x4*)(mg + gofs + 8 * lane), g1 = *(const f32x4*)(mg + gofs + 8 * lane + 4);
        v4u o; o.x = pk2(x[0] * rr * g0[0], x[1] * rr * g0[1]); o.y = pk2(x[2] * rr * g0[2], x[3] * rr * g0[3]); o.z = pk2(x[4] * rr * g1[0], x[5] * rr * g1[1]); o.w = pk2(x[6] * rr * g1[2], x[7] * rr * g1[3]);
        *(v4u*)(mixed + gofs + 8 * lane) = o;
    }
    {
        const int h = lane >> 3; const float* gt = (const float*)(F.ws + R_GATES) + (size_t)t * 24 + 3 * h;
        const float gc = gt[0], gs = gt[1], gw = gt[2];
        const size_t off = (size_t)t * DATT + 16 * lane;
        const bf16* pc = (const bf16*)(F.ws + R_OC) + off; const bf16* ps = (const bf16*)(F.ws + R_OS) + off; const bf16* pw = (const bf16*)(F.ws + R_OW) + off;
        float x[16]; float s = 0.f;
#pragma unroll
        for (int hh = 0; hh < 2; ++hh) { const v4u a = *(const v4u*)(pc + 8 * hh), b = *(const v4u*)(ps + 8 * hh), c = *(const v4u*)(pw + 8 * hh);
            const unsigned aw[4] = {a.x, a.y, a.z, a.w}, bw[4] = {b.x, b.y, b.z, b.w}, cw[4] = {c.x, c.y, c.z, c.w};
#pragma unroll
            for (int i = 0; i < 4; ++i) { x[8 * hh + 2 * i] = gc * bflo(aw[i]) + gs * bflo(bw[i]) + gw * bflo(cw[i]); x[8 * hh + 2 * i + 1] = gc * bfhi(aw[i]) + gs * bfhi(bw[i]) + gw * bfhi(cw[i]); } }
#pragma unroll
        for (int c = 0; c < 16; ++c) s += x[c] * x[c];
        const float rr = 1.f / sqrtf(wave_sum(s) * (1.f / 1024.f) + EPS);
        const float* gp = mg + DCONV + 16 * lane;
        float gg[16];
#pragma unroll
        for (int c4 = 0; c4 < 4; ++c4) { const f32x4 v = *(const f32x4*)(gp + 4 * c4); gg[4 * c4] = v[0]; gg[4 * c4 + 1] = v[1]; gg[4 * c4 + 2] = v[2]; gg[4 * c4 + 3] = v[3]; }
        v4u o0, o1;
        o0.x = pk2(x[0] * rr * gg[0], x[1] * rr * gg[1]); o0.y = pk2(x[2] * rr * gg[2], x[3] * rr * gg[3]); o0.z = pk2(x[4] * rr * gg[4], x[5] * rr * gg[5]); o0.w = pk2(x[6] * rr * gg[6], x[7] * rr * gg[7]);
        o1.x = pk2(x[8] * rr * gg[8], x[9] * rr * gg[9]); o1.y = pk2(x[10] * rr * gg[10], x[11] * rr * gg[11]); o1.z = pk2(x[12] * rr * gg[12], x[13] * rr * gg[13]); o1.w = pk2(x[14] * rr * gg[14], x[15] * rr * gg[15]);
        *(v4u*)(mixed + DCONV + 16 * lane) = o0; *(v4u*)(mixed + DCONV + 16 * lane + 8) = o1;
    }
}

DEVI void norm_route_job(Frame& F, const float* g, int t, bool route) {
    const int lane = F.lane;
    const float* xrow = (const float*)(F.ws + WS_H) + (size_t)t * D;
    bf16* orow = (bf16*)(F.ws + WS_HN) + (size_t)t * D;
    f32x4 v[8]; float s = 0.f;
#pragma unroll
    for (int j = 0; j < 8; ++j) { v[j] = *(const f32x4*)(xrow + 4 * lane + 256 * j); s += (v[j].x * v[j].x + v[j].y * v[j].y) + (v[j].z * v[j].z + v[j].w * v[j].w); }
    const float rr = 1.f / sqrtf(wave_sum(s) * (1.f / D) + EPS);
#pragma unroll
    for (int j = 0; j < 8; ++j) { const f32x4 gg = *(const f32x4*)(g + 4 * lane + 256 * j); v[j] = v[j] * rr * gg;
        v2u w; w.x = pk2(v[j].x, v[j].y); w.y = pk2(v[j].z, v[j].w); *(v2u*)(orow + 4 * lane + 256 * j) = w; }
    if (!route) return;
    const float* rw = F.in(IN_RW);
    float lg[8];
#pragma unroll
    for (int e = 0; e < 8; ++e) lg[e] = 0.f;
#pragma unroll
    for (int j = 0; j < 8; ++j)
#pragma unroll
        for (int i = 0; i < 4; ++i) { const int k = 4 * lane + 256 * j + i; const f32x4 a = *(const f32x4*)(rw + (size_t)k * 8), b = *(const f32x4*)(rw + (size_t)k * 8 + 4); const float x = v[j][i];
            lg[0] += x * a[0]; lg[1] += x * a[1]; lg[2] += x * a[2]; lg[3] += x * a[3]; lg[4] += x * b[0]; lg[5] += x * b[1]; lg[6] += x * b[2]; lg[7] += x * b[3]; }
#pragma unroll
    for (int e = 0; e < 8; ++e) lg[e] = wave_sum(lg[e]);
    int e1 = 0; float v1 = lg[0];
#pragma unroll
    for (int e = 1; e < 8; ++e) if (lg[e] > v1) { v1 = lg[e]; e1 = e; }
    int e2 = -1; float v2 = -3.0e38f;
#pragma unroll
    for (int e = 0; e < 8; ++e) if (e != e1 && lg[e] > v2) { v2 = lg[e]; e2 = e; }
    const float p2 = __expf(v2 - v1), w1 = 1.f / (1.f + p2), w2 = p2 / (1.f + p2);
    if (lane < 2) {
        const int e = lane ? e2 : e1; const float w = lane ? w2 : w1;
        const unsigned slot = __hip_atomic_fetch_add((unsigned*)(F.ctl + CW_ECNT + 64 * e), 1u, RLX_AGENT);
        ((int*)(F.ws + WS_TOK + TOK_E))[2 * t + lane] = e; ((float*)(F.ws + WS_TOK + TOK_W))[2 * t + lane] = w; ((int*)(F.ws + WS_TOK + TOK_SLOT))[2 * t + lane] = (int)slot;
    }
}
DEVI void moe_prefix(Frame& F, int (&pe)[NE + 1]) {
    int acc = 0;
#pragma unroll
    for (int e = 0; e < NE; ++e) { pe[e] = acc; const unsigned c = __hip_atomic_load((unsigned*)(F.ctl + CW_ECNT + 64 * e), RLX_AGENT); acc += (int)((c + 255u) >> 8); }
    pe[NE] = acc;
}
DEVI void moe_gather_job(Frame& F, const int (&pe)[NE + 1], int job) {
    const int lane = F.lane, t = job >> 1;
    const int e = ((const int*)(F.ws + WS_TOK + TOK_E))[job], slot = ((const int*)(F.ws + WS_TOK + TOK_SLOT))[job];
    int p0 = 0;
#pragma unroll
    for (int k = 0; k < NE; ++k) p0 = (e == k) ? pe[k] : p0;
    const int row = p0 * 256 + slot;
    const v4u* src = (const v4u*)((const bf16*)(F.ws + WS_HN) + (size_t)t * D); v4u* dst = (v4u*)((bf16*)(F.ws + M_ASORT) + (size_t)row * D);
#pragma unroll
    for (int i = 0; i < 4; ++i) dst[lane + 64 * i] = src[lane + 64 * i];
    if (lane == 0) { ((int*)(F.ws + WS_TOK + TOK_POS))[job] = row; ((float*)(F.ws + WS_TOK + TOK_RW))[row] = ((const float*)(F.ws + WS_TOK + TOK_W))[job]; }
}
DEVI void moe_combine_job(Frame& F, float* outp, int t) {
    const int lane = F.lane;
    const float* xrow = (const float*)(F.ws + WS_H) + (size_t)t * D;
    const int r0 = ((const int*)(F.ws + WS_TOK + TOK_POS))[2 * t], r1 = ((const int*)(F.ws + WS_TOK + TOK_POS))[2 * t + 1];
    const bf16* y0 = (const bf16*)(F.ws + M_YS) + (size_t)r0 * D; const bf16* y1 = (const bf16*)(F.ws + M_YS) + (size_t)r1 * D;
    const float* g = F.in(IN_FNG); float* orow = outp + (size_t)t * D;
    f32x4 v[8]; float s = 0.f;
#pragma unroll
    for (int j = 0; j < 8; ++j) { const int c = 4 * lane + 256 * j; v[j] = *(const f32x4*)(xrow + c);
        const v2u a = *(const v2u*)(y0 + c), b = *(const v2u*)(y1 + c);
        v[j].x += bflo(a.x) + bflo(b.x); v[j].y += bfhi(a.x) + bfhi(b.x); v[j].z += bflo(a.y) + bflo(b.y); v[j].w += bfhi(a.y) + bfhi(b.y);
        s += (v[j].x * v[j].x + v[j].y * v[j].y) + (v[j].z * v[j].z + v[j].w * v[j].w); }
    const float rr = 1.f / sqrtf(wave_sum(s) * (1.f / D) + EPS);
#pragma unroll
    for (int j = 0; j < 8; ++j) { const int c = 4 * lane + 256 * j; const f32x4 gg = *(const f32x4*)(g + c); *(f32x4*)(orow + c) = v[j] * rr * gg; }
}

#ifndef MK_N_LAUNCHES
#define MK_N_LAUNCHES 1
#endif
constexpr int N_PHASES = 25;

__global__ void __launch_bounds__(NTHR, 2) fwd_kernel(Args args) {
    extern __shared__ __attribute__((aligned(16))) unsigned char lds[];
    Frame F;
    F.lds = (LAS unsigned char*)lds;
    F.MISC = (volatile LAS unsigned*)(F.lds + MISC_OFF);
    F.tid = threadIdx.x; F.lane = F.tid & 63; F.wave = __builtin_amdgcn_readfirstlane(F.tid >> 6);
    F.G = gridDim.x; F.gw = blockIdx.x * NWAVES + F.wave; F.NGW = F.G * NWAVES;
    F.ws = args.ws; F.ctl = (gu32*)(args.ws + WS_CTL);
    if (F.tid < 38) ((const float**)(args.ws + CTL_TBL + (size_t)blockIdx.x * 512))[F.tid] = args.in[F.tid];
    unsigned char* ws = args.ws;
    for (int u = F.tid; u < (LDS_BYTES - LDSCTL_OFF) / 4; u += NTHR) ((LAS unsigned*)(F.lds + LDSCTL_OFF))[u] = 0u;
    __syncthreads();
    XcdBarrier bar = xcd_barrier_post((unsigned*)(F.ctl + CW_BAR) + args.li * XCD_BAR_WORDS, F.MISC + 8);
    const int lo = args.ph_lo, hi = args.ph_hi;
#define IN(k) (lo <= (k) && (k) < hi)
#define SEAM(k) do { if (IN(k) && IN((k) + 1)) xcd_barrier(bar); } while (0)
    const int bx = blockIdx.x;

    if (IN(0)) { F.ws = launder(args.ws); F.tid = vlaunder(threadIdx.x); F.lane = F.tid & 63; p0_prologue(F); }
    SEAM(0);

#pragma unroll 1
    for (int l = 0; l < 2; ++l) {
        const int P = 1 + 12 * l;
#define PH(k) if (IN(k)) if ((F.ws = ws = launder(args.ws)) != nullptr && ((F.tid = vlaunder(threadIdx.x)), (F.lane = F.tid & 63), true))
        PH(P + 0) {
            pg8::Gemm g{(const bf16*)(ws + WS_HN), (const bf16*)(ws + R_WIN) + (size_t)l * 4096 * D, D, D, D};
            pg8::StaticOrder so; so.init(S, 4096, F.G, bx);
            EpiInProj E{(bf16*)(ws + R_CONVU), (bf16*)(ws + R_Q), (bf16*)(ws + R_KV), (bf16*)(ws + R_U)};
            pg8::gemm_phase(F.lds + RING_OFF, g, so, E);
        }
        SEAM(P + 0);
        PH(P + 1) {
            { pg8::Gemm g{(const bf16*)(ws + R_U), (const bf16*)(ws + R_TW) + (size_t)l * NGRP * 512 * 256, 256, 256, 256};
              Ssm1Order so{F.G, bx}; EpiSsm1 E{(float*)(ws + R_YINTRA), (float*)(ws + R_SC)};
              pg8::gemm_phase(F.lds + RING_OFF, g, so, E); }
            for (int j = F.gw; j < 256 + 2048 + 4096 + 1024 + S; j += F.NGW) {
                int r = j;
                if (r < 256) { compress_job(F, l, r); continue; } r -= 256;
                if (r < 2048) { vt_job(F, r); continue; } r -= 2048;
                if (r < 4096) { dwconv_job(F, l, r); continue; } r -= 4096;
                if (r < 1024) { gates_job(F, l, r); continue; } r -= 1024;
                rope_job(F, r);
            }
        }
        SEAM(P + 1);
        PH(P + 2) {
            { pg8::Gemm g{(const bf16*)(ws + R_CONVACT), (const bf16*)(ws + R_CPW) + (size_t)l * 512 * 512, 512, 512, 512};
              pg8::StaticOrder so; so.init(S, 512, F.G, bx); EpiBiasBf16 E{(bf16*)(ws + R_CONVO), DCONV, F.in(IN_PWB) + l * DCONV};
              pg8::gemm_phase(F.lds + RING_OFF, g, so, E); }
            for (int j = F.gw; j < 32 + 10240 + 8192; j += F.NGW) {
                int r = j;
                if (r < 32) { scan_job(F, l, r); continue; } r -= 32;
                if (r < 10240) { const int tile = 1023 - r / 10, k = r % 10; if (k < 2) cmp_stats_job(F, k, tile); else cmp_att_job(F, tile, k - 2); continue; } r -= 10240;
                win_att_job(F, r >> 3, r & 7);
            }
        }
        SEAM(P + 2);
        PH(P + 3) {
            { pg8::Gemm g{(const bf16*)(ws + R_HPREV), (const bf16*)(ws + R_WO2) + (size_t)l * NGRP * 256 * 256, 256, 256, 256};
              Ssm2Order so{F.G, bx}; EpiSsm2 E{(const float*)(ws + R_YINTRA), (const bf16*)(ws + R_U), F.in(IN_SD) + l * DSSM, (bf16*)(ws + R_YSSM), (bf16*)(ws + R_GY)};
              pg8::gemm_phase(F.lds + RING_OFF, g, so, E); }
            for (int j = F.gw; j < 2 * S; j += F.NGW) sel_att_job(F, S - 1 - (j >> 1), j & 1);
        }
        SEAM(P + 3);
        PH(P + 4) {
            pg8::Gemm g{(const bf16*)(ws + R_YSSM), (const bf16*)(ws + R_GLU) + (size_t)l * 512 * 512, 512, 512, 512};
            pg8::StaticOrder so; so.init(S, 512, F.G, bx); EpiGlu E{(const bf16*)(ws + R_GY), F.in(IN_GLB) + l * DSSM, (bf16*)(ws + R_SSMO)};
            pg8::gemm_phase(F.lds + RING_OFF, g, so, E);
        }
        SEAM(P + 4);
        PH(P + 5) { for (int t = F.gw; t < S; t += F.NGW) mixnorm_job(F, l, t); }
        SEAM(P + 5);
        PH(P + 6) {
            pg8::Gemm g{(const bf16*)(ws + R_MIXED), (const bf16*)(ws + R_WOUT) + (size_t)l * D * D, D, D, D};
            pg8::StaticOrder so; so.init(S, D, F.G, bx); EpiResid E{l == 0 ? F.in(IN_X) : (const float*)(ws + WS_H), (float*)(ws + WS_H)};
            pg8::gemm_phase(F.lds + RING_OFF, g, so, E);
        }
        SEAM(P + 6);
        PH(P + 7) { const float* gn = F.in(IN_NFG) + (size_t)l * D; for (int t = F.gw; t < S; t += F.NGW) norm_route_job(F, gn, t, l == 1); }
        SEAM(P + 7);
        if (l == 0) {
            PH(P + 8) {
                pg8::Gemm g{(const bf16*)(ws + WS_HN), (const bf16*)(ws + R_FGU), D, D, D};
                pg8::StaticOrder so; so.init(S, 2 * DFF, F.G, bx); EpiSwiglu E{(bf16*)(ws + R_ACT), DFF, 2 * DFF / 256};
                pg8::gemm_phase(F.lds + RING_OFF, g, so, E);
            }
            SEAM(P + 8);
            PH(P + 9) {
                pg8::Gemm g{(const bf16*)(ws + R_ACT), (const bf16*)(ws + R_FD), DFF, DFF, DFF};
                pg8::StaticOrder so; so.init(S, D, F.G, bx); EpiResid E{(const float*)(ws + WS_H), (float*)(ws + WS_H)};
                pg8::gemm_phase(F.lds + RING_OFF, g, so, E);
            }
            SEAM(P + 9);
            PH(P + 10) { const float* gn = F.in(IN_NMG) + D; for (int t = F.gw; t < S; t += F.NGW) rms_row_to_bf16((const float*)(ws + WS_H) + (size_t)t * D, gn, (bf16*)(ws + WS_HN) + (size_t)t * D, F.lane); }
            SEAM(P + 10);
            SEAM(P + 11);
        } else {
            PH(P + 8) { int pe[NE + 1]; moe_prefix(F, pe); for (int j = F.gw; j < 2 * S; j += F.NGW) moe_gather_job(F, pe, j); }
            SEAM(P + 8);
            PH(P + 9) {
                MoeOrder mo; moe_prefix(F, mo.pe); mo.nct = 2 * DFFE / 256; mo.so.init(mo.pe[NE] * 256, 2 * DFFE, F.G, bx);
                pg8::Gemm g{(const bf16*)(ws + M_ASORT), (const bf16*)(ws + WS_MOE_GU), D, D, D};
                EpiSwiglu E{(bf16*)(ws + M_ACTS), DFFE, 2 * DFFE / 256};
                pg8::gemm_phase(F.lds + RING_OFF, g, mo, E);
            }
            SEAM(P + 9);
            PH(P + 10) {
                MoeOrder mo; moe_prefix(F, mo.pe); mo.nct = D / 256; mo.so.init(mo.pe[NE] * 256, D, F.G, bx);
                pg8::Gemm g{(const bf16*)(ws + M_ACTS), (const bf16*)(ws + WS_MOE_D), DFFE, DFFE, DFFE};
                EpiMoeDown E{(bf16*)(ws + M_YS), (const float*)(ws + WS_TOK + TOK_RW)};
                pg8::gemm_phase(F.lds + RING_OFF, g, mo, E);
            }
            SEAM(P + 10);
            PH(P + 11) { for (int t = F.gw; t < S; t += F.NGW) moe_combine_job(F, args.out, t); }
        }
    }
#undef IN
#undef PH
#undef SEAM
}

extern "C" void kernel_launch(void* const* d_in, const int* in_sizes, int n_in, void* d_out, int out_size, void* d_ws, size_t ws_size, hipStream_t stream) {
    static int grid = 0;
    if (grid == 0) {
        if (n_in != 38 || out_size != S * D || ws_size < WS_END) { fprintf(stderr, "kernel_launch: unexpected problem shape (n_in %d, out %d, ws %zu < %zu)\n", n_in, out_size, ws_size, (size_t)WS_END); grid = -1; return; }
        int dev = 0, cus = 0, per_cu = 0;
        if (hipGetDevice(&dev) != hipSuccess || hipDeviceGetAttribute(&cus, hipDeviceAttributeMultiprocessorCount, dev) != hipSuccess) { grid = -1; return; }
        if (hipFuncSetAttribute((const void*)fwd_kernel, hipFuncAttributeMaxDynamicSharedMemorySize, LDS_BYTES) != hipSuccess) { fprintf(stderr, "kernel_launch: hipFuncSetAttribute failed\n"); grid = -1; return; }
        if (hipOccupancyMaxActiveBlocksPerMultiprocessor(&per_cu, (const void*)fwd_kernel, NTHR, LDS_BYTES) != hipSuccess || per_cu < 1)
            fprintf(stderr, "kernel_launch: note: occupancy query says %d\n", per_cu);
        (void)hipGetLastError();
        grid = cus;
    }
    if (grid < 0) return;
    if (hipMemsetAsync((char*)d_ws + WS_CTL, 0, CTL_ZERO_BYTES, stream) != hipSuccess) return;
    Args a{};
    for (int i = 0; i < 38; ++i) a.in[i] = (const float*)d_in[i];
    a.out = (float*)d_out; a.ws = (unsigned char*)d_ws; a.dbg = 0;
    constexpr int NL = MK_N_LAUNCHES;
    for (int li = 0; li < NL; ++li) {
        a.ph_lo = (NL == 1) ? 0 : li; a.ph_hi = (NL == 1) ? N_PHASES : li + 1; a.li = li;
        hipLaunchKernelGGL(fwd_kernel, dim3(grid), dim3(NTHR), LDS_BYTES, stream, a);
        const hipError_t le = hipPeekAtLastError();
        if (le != hipSuccess) { fprintf(stderr, "kernel_launch: launch %d failed: %s\n", li, hipGetErrorName(le)); break; }
    }
}
```

```cpp
#include <hip/hip_runtime.h>
#include <cstdio>
#include <cstdint>

namespace pg8 {
#define PG8_LAS __attribute__((address_space(3)))
typedef unsigned short bf16_t;
typedef short bf16x8 __attribute__((ext_vector_type(8)));
typedef float f32x4 __attribute__((ext_vector_type(4)));
typedef unsigned u32x4 __attribute__((ext_vector_type(4)));
typedef unsigned u32x2 __attribute__((ext_vector_type(2)));
constexpr int BM = 256, BK = 64, HALF = 128, HTB = HALF * BK * 2, STAGE_BYTES = 8 * HTB, NXCD = 8, WGM = 8;

__host__ __device__ __forceinline__ int lds_byte(int r, int c) { const int st = (r >> 4) * 2 + (c >> 5), rr = r & 15, cc = c & 31, ob = rr * 64 + cc * 2; return st * 1024 + (ob ^ (((ob >> 9) & 1) << 5)); }
__host__ __device__ __forceinline__ void stage_rc(int b, int& R, int& C) { const int st = b / 1024, sb = b % 1024, swz = sb ^ (((sb >> 9) & 1) << 5); R = (st >> 1) * 16 + swz / 64; C = (st & 1) * 32 + (swz % 64) / 2; }
__host__ __device__ __forceinline__ int g_swz(int r) { const int x = (r >> 1) & 7; return (((0x1320 >> (4 * (x >> 1))) & 3) << 1) | (x & 1); }
__host__ __device__ __forceinline__ int lds_off(int r, int c) { return (r >> 3) * 1024 + (r & 7) * 128 + ((c ^ g_swz(r & 15)) << 4); }
__host__ __device__ __forceinline__ void stage_rc2(int p16, int& R, int& CH) { const int s = p16 >> 6, L = p16 & 63; R = s * 8 + (L >> 3); CH = (L & 7) ^ g_swz(R & 15); }
__host__ __device__ __forceinline__ int perm32(int rho) { const int n = rho >> 4, i = rho & 15; return 8 * (i >> 2) + 4 * n + (i & 3); }

struct Unit { int pm, pn; };
struct Gemm { const bf16_t* A; const bf16_t* Bt; int K, nra, nrb; };

struct StaticOrder {
    int nM, nN, nwg, G, c;
    __host__ __device__ void init(int M, int N, int G_, int c_) { nM = M / BM; nN = N / BM; nwg = nM * nN; G = G_; c = c_; }
    __host__ __device__ bool next(int i, Unit& u) const { return at((long)i * G + c, u); }
    __host__ __device__ bool at(const long L, Unit& u) const {
        if (L >= nwg) return false;
        int wgid = (int)L; { const int q = nwg / NXCD, r = nwg % NXCD, xcd = wgid % NXCD, off = wgid / NXCD; wgid = (xcd < r ? xcd * (q + 1) : r * (q + 1) + (xcd - r) * q) + off; }
        const int nig = WGM * nN, gid = wgid / nig, fm = gid * WGM, gsz = (nM - fm) < WGM ? (nM - fm) : WGM;
        u.pm = fm + ((wgid % nig) % gsz); u.pn = (wgid % nig) / gsz; return true;
    }
};

__device__ __forceinline__ unsigned cvt_pk_bf16(float lo, float hi) { unsigned r; asm volatile("v_cvt_pk_bf16_f32 %0, %1, %2" : "=v"(r) : "v"(lo), "v"(hi)); return r; }

typedef int v8i_t __attribute__((ext_vector_type(8)));
typedef int v4i_t __attribute__((ext_vector_type(4)));
__device__ __forceinline__ v8i_t cat8(bf16x8 lo, bf16x8 hi) { const v4i_t a = __builtin_bit_cast(v4i_t, lo), b = __builtin_bit_cast(v4i_t, hi); return __builtin_shufflevector(a, b, 0, 1, 2, 3, 4, 5, 6, 7); }
template <class Epi, class Sched, bool ALIGN_EPI = true, bool SP2 = true, bool FP8 = false, int PROBE = 0, bool RECOMP = false>
__device__ __forceinline__ void gemm_phase(PG8_LAS unsigned char* lds, const Gemm g, const Sched& S, const Epi& E) {
    int tid_ = threadIdx.x; asm volatile("" : "+v"(tid_));
    const int tid = tid_, wid = __builtin_amdgcn_readfirstlane(tid >> 6), lane = tid & 63, wr = wid >> 2, wc = wid & 3, fr = lane & 15, fq = lane >> 4;
    const int K = g.K, nt = K / BK;
    unsigned voffA[2], voffB[2];
#pragma unroll
    for (int i = 0; i < 2; ++i) { int R, CH; stage_rc2(tid + i * 512, R, CH); const int Rb = Epi::PERM ? ((R & ~31) + perm32(R & 31)) : R;
        voffA[i] = (unsigned)(R * 128 + CH * 16); voffB[i] = (unsigned)(Rb * 128 + CH * 16); }
    const unsigned kstepA = (unsigned)g.nra * 128u, kstepB = (unsigned)g.nrb * 128u;
    const unsigned hstepA = HALF * 128u, hstepB = HALF * 128u;
    const unsigned tstepA = 2 * hstepA, tstepB = 2 * hstepB;
    const unsigned ldsw = (unsigned)wid * 1024u;
    const int aoffk0 = lds_off(wr * 64 + fr, FP8 ? 2 * fq : fq), aoffk1 = FP8 ? (aoffk0 ^ 16) : lds_off(wr * 64 + fr, fq + 4);
    const int boffk0 = lds_off(wc * 32 + fr, FP8 ? 2 * fq : fq), boffk1 = FP8 ? (boffk0 ^ 16) : lds_off(wc * 32 + fr, fq + 4);
#define PG8_SA(b, h) (((b) * 2 + (h)) * HTB)
#define PG8_SB(b, h) ((4 + (b) * 2 + (h)) * HTB)
#define PG8_STAGE(bufoff, goff, voff) do { const bool isB_ = (&(voff)[0] == &voffB[0]); \
        if constexpr (RECOMP) { int t2_ = tid; asm volatile("" : "+v"(t2_));     \
            _Pragma("unroll") for (int _i = 0; _i < 2; ++_i) { int R_, C_; stage_rc2(t2_ + _i * 512, R_, C_); const int Rr_ = (isB_ && Epi::PERM) ? ((R_ & ~31) + perm32(R_ & 31)) : R_; \
                __builtin_amdgcn_raw_ptr_buffer_load_lds(isB_ ? rsrcB : rsrcA, (PG8_LAS void*)(lds + (bufoff) + ldsw + _i * 8192), 16, Rr_ * 128 + C_ * 16, (int)(goff), 0, 0); } } \
        else { _Pragma("unroll") for (int _i = 0; _i < 2; ++_i) \
        __builtin_amdgcn_raw_ptr_buffer_load_lds(isB_ ? rsrcB : rsrcA, (PG8_LAS void*)(lds + (bufoff) + ldsw + _i * 8192), 16, (int)(voff)[_i], (int)(goff), 0, 0); } } while (0)
#define PG8_LDA(dst, b, h) do { if constexpr (PROBE == 2) break; _Pragma("unroll") for (int m = 0; m < 4; ++m) { if constexpr (FP8) dst##8[m] = cat8(*(const PG8_LAS bf16x8*)(lds + PG8_SA(b, h) + aoffk0 + m * 2048), *(const PG8_LAS bf16x8*)(lds + PG8_SA(b, h) + aoffk1 + m * 2048)); \
        else { dst[m][0] = *(const PG8_LAS bf16x8*)(lds + PG8_SA(b, h) + aoffk0 + m * 2048); dst[m][1] = *(const PG8_LAS bf16x8*)(lds + PG8_SA(b, h) + aoffk1 + m * 2048); } } } while (0)
#define PG8_LDB(dst, b, h) do { if constexpr (PROBE == 2) break; _Pragma("unroll") for (int n = 0; n < 2; ++n) { if constexpr (FP8) dst##8[n] = cat8(*(const PG8_LAS bf16x8*)(lds + PG8_SB(b, h) + boffk0 + n * 2048), *(const PG8_LAS bf16x8*)(lds + PG8_SB(b, h) + boffk1 + n * 2048)); \
        else { dst[n][0] = *(const PG8_LAS bf16x8*)(lds + PG8_SB(b, h) + boffk0 + n * 2048); dst[n][1] = *(const PG8_LAS bf16x8*)(lds + PG8_SB(b, h) + boffk1 + n * 2048); } } } while (0)
#define PG8_MMA(ai, bj, At, Bt) do { if constexpr (PROBE == 1) { _Pragma("unroll") for (int m = 0; m < 4; ++m) asm volatile("" :: "v"(At##8[m])); _Pragma("unroll") for (int n = 0; n < 2; ++n) asm volatile("" :: "v"(Bt##8[n])); break; } __builtin_amdgcn_s_setprio(1); _Pragma("unroll") for (int m = 0; m < 4; ++m) _Pragma("unroll") for (int n = 0; n < 2; ++n) { \
        if constexpr (FP8) acc[ai][bj][m][n] = __builtin_amdgcn_mfma_scale_f32_16x16x128_f8f6f4(Bt##8[n], At##8[m], acc[ai][bj][m][n], 0, 0, 0, 0x7F7F7F7F, 0, 0x7F7F7F7F); \
        else { _Pragma("unroll") for (int k = 0; k < 2; ++k) acc[ai][bj][m][n] = __builtin_amdgcn_mfma_f32_16x16x32_bf16(Bt[n][k], At[m][k], acc[ai][bj][m][n], 0, 0, 0); } } __builtin_amdgcn_s_setprio(0); } while (0)
#define PG8_WAIT_V(n) asm volatile("s_waitcnt vmcnt(" #n ")" ::: "memory")
#define PG8_WAIT_L(n) asm volatile("s_waitcnt lgkmcnt(" #n ")" ::: "memory")
#define PG8_BAR __builtin_amdgcn_s_barrier()
#define PG8_SCHED __builtin_amdgcn_sched_barrier(0)
    Unit cur, nxt; int ui = 0;
    if (!S.next(0, cur)) return;
    f32x4 acc[2][2][4][2];
#pragma unroll
    for (int a = 0; a < 2; ++a)
#pragma unroll
        for (int b = 0; b < 2; ++b)
#pragma unroll
            for (int m = 0; m < 4; ++m)
#pragma unroll
                for (int n = 0; n < 2; ++n) acc[a][b][m][n] = (f32x4){0.f, 0.f, 0.f, 0.f};
    bf16x8 At[4][2], B0[2][2], B1[2][2]; v8i_t At8[4], B08[2], B18[2];
    if constexpr (PROBE == 2) { _Pragma("unroll") for (int m = 0; m < 4; ++m) { At8[m] = (v8i_t){0x3a3b3c3d + tid, 0x38393a3b, 0x3c3d3e3f, 0x40414243, 0x34353637, 0x3b3c3d3e, 0x39383736, 0x3d3c3b3a}; asm volatile("" : "+v"(At8[m])); }
        _Pragma("unroll") for (int n = 0; n < 2; ++n) { B08[n] = At8[n]; B18[n] = At8[n + 2]; asm volatile("" : "+v"(B08[n]), "+v"(B18[n])); } }
    const __amdgpu_buffer_rsrc_t rsrcA = __builtin_amdgcn_make_buffer_rsrc((void*)g.A, 0, 0x7ffff000, 0x00020000), rsrcB = __builtin_amdgcn_make_buffer_rsrc((void*)g.Bt, 0, 0x7ffff000, 0x00020000);
    unsigned cA = (unsigned)cur.pm * (unsigned)tstepA, cB = (unsigned)cur.pn * (unsigned)tstepB;
    if constexpr (SP2) {
        PG8_STAGE(PG8_SB(0, 0), cB, voffB); PG8_STAGE(PG8_SB(0, 1), cB + hstepB, voffB); PG8_STAGE(PG8_SA(0, 0), cA, voffA); PG8_STAGE(PG8_SA(0, 1), cA + hstepA, voffA);
        if (wr == 1) PG8_BAR;
        PG8_WAIT_V(2); PG8_BAR;
        PG8_STAGE(PG8_SB(1, 0), cB + kstepB, voffB); PG8_STAGE(PG8_SA(1, 0), cA + kstepA, voffA); PG8_STAGE(PG8_SB(1, 1), cB + hstepB + kstepB, voffB);
        PG8_WAIT_V(6); PG8_BAR;
    } else {
        PG8_STAGE(PG8_SB(0, 0), cB, voffB); PG8_STAGE(PG8_SA(0, 0), cA, voffA); PG8_STAGE(PG8_SB(0, 1), cB + hstepB, voffB); PG8_STAGE(PG8_SA(0, 1), cA + hstepA, voffA);
        if (wr == 1) PG8_BAR;
        PG8_WAIT_V(4); PG8_BAR;
        PG8_STAGE(PG8_SB(1, 0), cB + kstepB, voffB); PG8_STAGE(PG8_SA(1, 0), cA + kstepA, voffA); PG8_STAGE(PG8_SB(1, 1), cB + hstepB + kstepB, voffB);
        PG8_WAIT_V(6); PG8_BAR;
    }
    for (;;) {
        const bool has_next = S.next(ui + 1, nxt);
        const unsigned nA = has_next ? (unsigned)nxt.pm * (unsigned)tstepA : cA, nB = has_next ? (unsigned)nxt.pn * (unsigned)tstepB : cB;
#pragma unroll 1
        for (int t = 0; t < nt; t += 2) {
            const bool last = (t == nt - 2);
            const unsigned a1 = cA + (unsigned)(t + 1) * kstepA;
            const unsigned a2 = last ? nA : cA + (unsigned)(t + 2) * kstepA, b2 = last ? nB : cB + (unsigned)(t + 2) * kstepB;
            const unsigned a3 = a2 + kstepA, b3 = b2 + kstepB;
            if constexpr (SP2) {
            PG8_LDB(B0, 0, 0); PG8_LDB(B1, 0, 1); PG8_SCHED; PG8_LDA(At, 0, 0); PG8_STAGE(PG8_SA(1, 1), a1 + hstepA, voffA);
            PG8_WAIT_V(8); PG8_WAIT_L(0); PG8_BAR; PG8_MMA(0, 0, At, B0); PG8_MMA(0, 1, At, B1); PG8_BAR; PG8_SCHED;
            PG8_LDA(At, 0, 1); PG8_STAGE(PG8_SB(0, 0), b2, voffB); PG8_STAGE(PG8_SB(0, 1), b2 + hstepB, voffB); PG8_STAGE(PG8_SA(0, 0), a2, voffA);
            PG8_WAIT_V(8); PG8_WAIT_L(0); PG8_BAR; PG8_MMA(1, 0, At, B0); PG8_MMA(1, 1, At, B1); PG8_BAR; PG8_SCHED;
            PG8_LDB(B0, 1, 0); PG8_LDB(B1, 1, 1); PG8_SCHED; PG8_LDA(At, 1, 0); PG8_STAGE(PG8_SA(0, 1), a2 + hstepA, voffA);
            PG8_WAIT_V(8); PG8_WAIT_L(0); PG8_BAR; PG8_MMA(0, 0, At, B0); PG8_MMA(0, 1, At, B1); PG8_BAR; PG8_SCHED;
            PG8_LDA(At, 1, 1); PG8_STAGE(PG8_SB(1, 0), b3, voffB); PG8_STAGE(PG8_SB(1, 1), b3 + hstepB, voffB); PG8_STAGE(PG8_SA(1, 0), a3, voffA);
            PG8_WAIT_V(8); PG8_WAIT_L(0); PG8_BAR; PG8_MMA(1, 0, At, B0); PG8_MMA(1, 1, At, B1); PG8_BAR; PG8_SCHED;
            } else {
            PG8_LDB(B0, 0, 0); PG8_SCHED; PG8_LDA(At, 0, 0); PG8_STAGE(PG8_SA(1, 1), a1 + hstepA, voffA);
            PG8_WAIT_L(8); PG8_BAR; PG8_WAIT_L(0); PG8_MMA(0, 0, At, B0); PG8_BAR; PG8_SCHED;
            PG8_LDB(B1, 0, 1); PG8_STAGE(PG8_SB(0, 0), b2, voffB);
            PG8_BAR; PG8_WAIT_L(0); PG8_MMA(0, 1, At, B1); PG8_BAR;
            PG8_LDA(At, 0, 1); PG8_STAGE(PG8_SA(0, 0), a2, voffA);
            PG8_BAR; PG8_WAIT_L(0); PG8_MMA(1, 0, At, B0); PG8_BAR; PG8_SCHED;
            PG8_STAGE(PG8_SB(0, 1), b2 + hstepB, voffB);
            PG8_WAIT_V(6); PG8_BAR; PG8_MMA(1, 1, At, B1); PG8_BAR;
            PG8_LDB(B0, 1, 0); PG8_SCHED; PG8_LDA(At, 1, 0); PG8_STAGE(PG8_SA(0, 1), a2 + hstepA, voffA);
            PG8_WAIT_L(8); PG8_BAR; PG8_WAIT_L(0); PG8_MMA(0, 0, At, B0); PG8_BAR; PG8_SCHED;
            PG8_LDB(B1, 1, 1); PG8_STAGE(PG8_SB(1, 0), b3, voffB);
            PG8_BAR; PG8_WAIT_L(0); PG8_MMA(0, 1, At, B1); PG8_BAR;
            PG8_LDA(At, 1, 1); PG8_STAGE(PG8_SA(1, 0), a3, voffA);
            PG8_BAR; PG8_WAIT_L(0); PG8_MMA(1, 0, At, B0); PG8_BAR; PG8_SCHED;
            PG8_STAGE(PG8_SB(1, 1), b3 + hstepB, voffB);
            PG8_WAIT_V(6); PG8_BAR; PG8_MMA(1, 1, At, B1); PG8_BAR;
            }
        }
        if constexpr (ALIGN_EPI) { if (wr == 0) PG8_BAR; }
        E(acc, cur, wr, wc, fr, fq);
        if (!has_next) break;
#pragma unroll
        for (int a = 0; a < 2; ++a)
#pragma unroll
            for (int b = 0; b < 2; ++b)
#pragma unroll
                for (int m = 0; m < 4; ++m)
#pragma unroll
                    for (int n = 0; n < 2; ++n) acc[a][b][m][n] = (f32x4){0.f, 0.f, 0.f, 0.f};
        cur = nxt; cA = nA; cB = nB; ++ui;
        if constexpr (ALIGN_EPI) { if (wr == 1) PG8_BAR; }
    }
    PG8_WAIT_V(0);
    if constexpr (!ALIGN_EPI) { if (wr == 0) PG8_BAR; }
    PG8_BAR;
#undef PG8_SA
#undef PG8_SB
#undef PG8_STAGE
#undef PG8_LDA
#undef PG8_LDB
#undef PG8_MMA
#undef PG8_WAIT_V
#undef PG8_WAIT_L
#undef PG8_BAR
#undef PG8_SCHED
}
}

constexpr int S = 16384, D = 2048, DIN = 4120, DCONV = 512, DATT = 1024, DSSM = 512;
constexpr int NH = 8, NKV = 2, HD = 128, NCMP = 1023, NSB = 256, CONVW = 31;
constexpr int DFF = 5632, NE = 8, DFFE = 7168, NGRP = 32, PST = 64;
constexpr int NPAD = 2 * S + NE * 256;
constexpr float EPS = 1e-5f;
constexpr int NWAVES = 8, NTHR = 512;

constexpr size_t MiB = 1u << 20;
constexpr size_t WS_CTL = 0, CTL_ZERO_BYTES = 1 * MiB;
constexpr size_t WS_H = 1 * MiB;
constexpr size_t WS_HN = WS_H + 128 * MiB;
constexpr size_t WS_MOE_GU = WS_HN + 64 * MiB;
constexpr size_t WS_MOE_D = WS_MOE_GU + 448 * MiB;
constexpr size_t WS_TOK = WS_MOE_D + 224 * MiB;
constexpr size_t WS_R = WS_TOK + 1 * MiB;
constexpr size_t R_WIN = WS_R;
constexpr size_t R_WOUT = R_WIN + 32 * MiB;
constexpr size_t R_WG = R_WOUT + 16 * MiB;
constexpr size_t R_CPW = R_WG + 1 * MiB;
constexpr size_t R_GLU = R_CPW + 1 * MiB;
constexpr size_t R_W1K = R_GLU + 1 * MiB;
constexpr size_t R_W1V = R_W1K + 2 * MiB;
constexpr size_t R_W2 = R_W1V + 2 * MiB;
constexpr size_t R_CB = R_W2 + 1 * MiB;
constexpr size_t R_TW = R_CB + 1 * MiB;
constexpr size_t R_WO2 = R_TW + 16 * MiB;
constexpr size_t R_FGU = R_WO2 + 8 * MiB;
constexpr size_t R_FD = R_FGU + 44 * MiB;
constexpr size_t R_CONVU = R_FD + 22 * MiB;
constexpr size_t R_Q = R_CONVU + 16 * MiB;
constexpr size_t R_QR = R_Q + 32 * MiB;
constexpr size_t R_KV = R_QR + 32 * MiB;
constexpr size_t R_VST = R_KV + 48 * MiB;
constexpr size_t R_VWT = R_VST + 8 * MiB;
constexpr size_t R_KC = R_VWT + 8 * MiB;
constexpr size_t R_VCT = R_KC + 1 * MiB;
constexpr size_t R_U = R_VCT + 1 * MiB;
constexpr size_t R_GATES = R_U + 16 * MiB;
constexpr size_t R_CONVACT = R_GATES + 2 * MiB;
constexpr size_t R_IMP = R_CONVACT + 16 * MiB;
constexpr size_t R_OC = R_IMP + 32 * MiB;
constexpr size_t R_OW = R_OC + 32 * MiB;
constexpr size_t R_OS = R_OW + 32 * MiB;
constexpr size_t R_CONVO = R_OS + 32 * MiB;
constexpr size_t R_SSMO = R_CONVO + 16 * MiB;
constexpr size_t R_YINTRA = R_SSMO + 16 * MiB;
constexpr size_t R_SC = R_YINTRA + 32 * MiB;
constexpr size_t R_HPREV = R_SC + 16 * MiB;
constexpr size_t R_YSSM = R_HPREV + 16 * MiB;
constexpr size_t R_GY = R_YSSM + 16 * MiB;
constexpr size_t R_MIXED = R_GY + 16 * MiB;
constexpr size_t R_ACT = R_MIXED + 64 * MiB;
constexpr size_t R_KSF = R_ACT + 176 * MiB;
constexpr size_t R_KWF = R_KSF + 8 * MiB;
constexpr size_t R_KS8 = R_KWF + 8 * MiB;
constexpr size_t R_VS8 = R_KS8 + 4 * MiB;
constexpr size_t R_HN8 = R_VS8 + 4 * MiB;
constexpr size_t R_END = R_HN8 + 32 * MiB;
constexpr size_t R_IMP2 = R_ACT;
constexpr size_t R_KW8 = R_KSF;
constexpr size_t R_VW8 = R_VST;
constexpr size_t M_ASORT = WS_R;
constexpr size_t M_ACTS = M_ASORT + 136 * MiB;
constexpr size_t M_YS = M_ACTS + 476 * MiB;
constexpr size_t M_END = M_YS + 136 * MiB;
constexpr size_t WS_END = R_END > M_END ? R_END : M_END;
static_assert((size_t)NPAD * D * 2 <= 136 * MiB && (size_t)NPAD * DFFE * 2 <= 476 * MiB, "moe buffers");
static_assert(WS_END <= 1792 * MiB, "workspace map must fit 4x the largest input tensor");
constexpr size_t TOK_E = 0;
constexpr size_t TOK_W = 128 * 1024;
constexpr size_t TOK_SLOT = 256 * 1024;
constexpr size_t TOK_POS = 384 * 1024;
constexpr size_t TOK_RW = 512 * 1024;
constexpr int CW_BAR = 4096;
constexpr int CW_ECNT = 131072;
constexpr int CW_DBG = 140000;
constexpr int CW_TAIL = 133120;
constexpr int CW_SSM2 = 132096;

constexpr int RING_OFF = 0, RING_BYTES = 131072;
constexpr int LDSCTL_OFF = RING_BYTES, MISC_OFF = LDSCTL_OFF + 320;
constexpr int LDS_BYTES = 147456;

#define GAS __attribute__((address_space(1)))
#define LAS __attribute__((address_space(3)))
#define DEVI __device__ __forceinline__
typedef unsigned short bf16;
typedef unsigned v4u __attribute__((ext_vector_type(4)));
typedef unsigned v2u __attribute__((ext_vector_type(2)));
typedef float f32x4 __attribute__((ext_vector_type(4)));
typedef float f32x2 __attribute__((ext_vector_type(2)));
typedef short bf16x8 __attribute__((ext_vector_type(8)));
typedef short bf16x4 __attribute__((ext_vector_type(4)));
typedef GAS unsigned gu32;
#define RLX_AGENT __ATOMIC_RELAXED, __HIP_MEMORY_SCOPE_AGENT
#define LDS_WAIT() asm volatile("s_waitcnt lgkmcnt(0)" ::: "memory")
#define VM_WAIT() asm volatile("s_waitcnt vmcnt(0)" ::: "memory")
DEVI unsigned f2bf(float f) { unsigned u = __builtin_bit_cast(unsigned, f); return (u + 0x7fffu + ((u >> 16) & 1u)) >> 16; }
DEVI unsigned pk2(float lo, float hi) { return f2bf(lo) | (f2bf(hi) << 16); }
DEVI float bf2f(unsigned b) { return __builtin_bit_cast(float, b << 16); }
DEVI float bflo(unsigned w) { return __builtin_bit_cast(float, w << 16); }
DEVI float bfhi(unsigned w) { return __builtin_bit_cast(float, w & 0xffff0000u); }
DEVI float sigmoidf_(float x) { return 1.f / (1.f + __expf(-x)); }
DEVI float siluf_(float x) { return x / (1.f + __expf(-x)); }
DEVI float clamp448(float x) { return fminf(fmaxf(x, -448.f), 448.f); }
DEVI unsigned pk4_fp8(float a, float b, float c, float d) { int w = 0; w = __builtin_amdgcn_cvt_pk_fp8_f32(a, b, w, false); w = __builtin_amdgcn_cvt_pk_fp8_f32(c, d, w, true); return (unsigned)w; }
DEVI size_t tix(size_t NR, size_t row, unsigned kbyte) { return ((size_t)(kbyte >> 7) * NR + row) * 128 + (kbyte & 127u); }
DEVI float wave_sum(float v) {
#pragma unroll
    for (int o = 1; o < 64; o <<= 1) v += __shfl_xor(v, o);
    return v;
}

#define XB_TMO      128
#define XB_XCNT(j)  (256  + 64 * (j))
#define XB_XSUB(j)  (1280 + 64 * (j))
#define XB_XGEN(j)  (2304 + 64 * (j))
#define XB_TOP      3328
#define XB_TOPGEN   3392
#define XCD_BAR_WORDS 3456
#define XB_SPIN_CAP (1u << 20)

__device__ __forceinline__ unsigned xb_ld(unsigned* p)              { return __hip_atomic_load(p, __ATOMIC_RELAXED, __HIP_MEMORY_SCOPE_AGENT); }
__device__ __forceinline__ unsigned xb_add(unsigned* p, unsigned v) { return __hip_atomic_fetch_add(p, v, __ATOMIC_RELAXED, __HIP_MEMORY_SCOPE_AGENT); }
__device__ __forceinline__ unsigned xb_xcc_id() { return (unsigned)__builtin_amdgcn_s_getreg((3 << 11) | 20) & 0xFu; }
#define XB_SPIN(cond, bar) do { unsigned _sp = 0; while (cond) { __builtin_amdgcn_s_sleep(1); \
    if ((++_sp & 255u) == 0u) { if (xb_ld(&(bar)[XB_TMO])) break; if (_sp > XB_SPIN_CAP) { atomicAdd(&(bar)[XB_TMO], 1u); break; } } } } while (0)

struct XcdBarrier { unsigned* bar; unsigned x; volatile LAS unsigned* st; };

__device__ __forceinline__ XcdBarrier xcd_barrier_post(unsigned* bar, volatile LAS unsigned* st) {
    XcdBarrier b; b.bar = bar; b.x = xb_xcc_id(); b.st = st;
    if (threadIdx.x == 0) (void)xb_add(&bar[XB_XCNT(b.x)], 1u);
    return b;
}
__device__ __forceinline__ void xcd_barrier_complete(unsigned* bar, unsigned x, unsigned& nloc, unsigned& nx) {
    const unsigned G = gridDim.x * gridDim.y * gridDim.z;
    unsigned sum, cnt, mine, sp = 0u;
    for (;;) {
        sum = 0u; cnt = 0u; mine = 0u;
#pragma unroll
        for (unsigned j = 0; j < 16; ++j) { const unsigned c = xb_ld(&bar[XB_XCNT(j)]); sum += c; cnt += (c > 0u) ? 1u : 0u; mine = (j == x) ? c : mine; }
        if (sum == G) break;
        __builtin_amdgcn_s_sleep(1);
        if ((++sp & 255u) == 0u) { if (xb_ld(&bar[XB_TMO])) break; if (sp > XB_SPIN_CAP) { atomicAdd(&bar[XB_TMO], 1u); break; } }
    }
    nloc = mine > 0u ? mine : 1u; nx = cnt > 0u ? cnt : 1u;
}
__device__ __forceinline__ void xcd_barrier(const XcdBarrier& b) {
    asm volatile("s_waitcnt vmcnt(0)" ::: "memory");
    __syncthreads();
    if (threadIdx.x == 0) {
        unsigned* bar = b.bar;
        __builtin_amdgcn_s_waitcnt(0);
        unsigned nloc = b.st[0], nx = b.st[1];
        if (nloc == 0u) { xcd_barrier_complete(bar, b.x, nloc, nx); b.st[0] = nloc; b.st[1] = nx; }
        const unsigned old = xb_add(&bar[XB_XSUB(b.x)], 1u);
        const unsigned gen = old / nloc;
        if (old + 1u == (gen + 1u) * nloc) {
            __builtin_amdgcn_fence(__ATOMIC_RELEASE, "agent");
            asm volatile("s_waitcnt vmcnt(0)" ::: "memory");
            const unsigned og = xb_add(&bar[XB_TOP], 1u);
            const unsigned tg = og / nx;
            if (og + 1u == (tg + 1u) * nx) xb_add(&bar[XB_TOPGEN], 1u);
            else XB_SPIN(xb_ld(&bar[XB_TOPGEN]) == tg, bar);
            __builtin_amdgcn_fence(__ATOMIC_ACQUIRE, "agent");
            xb_add(&bar[XB_XGEN(b.x)], 1u);
            asm volatile("s_waitcnt vmcnt(0)" ::: "memory");
        } else {
            XB_SPIN(xb_ld(&bar[XB_XGEN(b.x)]) == gen, bar);
            __builtin_amdgcn_fence(__ATOMIC_ACQUIRE, "agent");
            asm volatile("s_waitcnt vmcnt(0)" ::: "memory");
        }
    }
    __syncthreads();
}

using pg8::Unit; using pg8::BM; using pg8::HALF;
typedef const f32x4 (&AccT)[2][2][4][2];

struct EpiInProj {
    static constexpr bool PERM = true;
    bf16 *convu, *q, *kv, *u;
    DEVI void operator()(AccT acc, const Unit& un, int wr, int wc, int fr, int fq) const {
        const int row0 = un.pm * BM + wr * 64 + fr, pn = un.pn, cw = wc * 32 + 8 * fq;
#pragma unroll
        for (int ai = 0; ai < 2; ++ai)
#pragma unroll
            for (int m = 0; m < 4; ++m) {
                const int row = row0 + ai * HALF + m * 16;
                if (pn < 4) {
                    float o[8];
#pragma unroll
                    for (int n = 0; n < 2; ++n)
#pragma unroll
                        for (int j = 0; j < 4; ++j) o[4 * n + j] = acc[ai][0][m][n][j] * sigmoidf_(acc[ai][1][m][n][j]);
                    v4u w; w.x = pg8::cvt_pk_bf16(o[0], o[1]); w.y = pg8::cvt_pk_bf16(o[2], o[3]); w.z = pg8::cvt_pk_bf16(o[4], o[5]); w.w = pg8::cvt_pk_bf16(o[6], o[7]);
                    *(v4u*)(convu + (size_t)row * DCONV + pn * 128 + cw) = w;
                } else {
#pragma unroll
                    for (int bj = 0; bj < 2; ++bj) {
                        const f32x4 v0 = acc[ai][bj][m][0], v1 = acc[ai][bj][m][1];
                        v4u w; w.x = pg8::cvt_pk_bf16(v0[0], v0[1]); w.y = pg8::cvt_pk_bf16(v0[2], v0[3]); w.z = pg8::cvt_pk_bf16(v1[0], v1[1]); w.w = pg8::cvt_pk_bf16(v1[2], v1[3]);
                        bf16* dst;
                        if (pn < 8) dst = q + (size_t)row * DATT + (pn - 4) * 256 + bj * 128 + cw;
                        else if (pn < 14) dst = kv + ((size_t)((pn - 8) * 2 + bj) * S + row) * HD + cw;
                        else { const int ch = (pn - 14) * 256 + bj * 128 + cw;
                            dst = (bf16*)((unsigned char*)u + tix(32768, (size_t)(ch >> 4) * 1024 + (row >> 4), 2 * ((row & 15) * 16 + (ch & 15)))); }
                        *(v4u*)dst = w;
                    }
                }
            }
    }
};
struct EpiSsm1 {
    static constexpr bool PERM = false;
    float *yintra, *sc;
    DEVI void operator()(AccT acc, const Unit& un, int wr, int wc, int fr, int fq) const {
        const int row0 = un.pm * BM + wr * 64 + fr, cw = wc * 32 + 4 * fq;
        if ((un.pn & 1) == 0) {
#pragma unroll
            for (int ai = 0; ai < 2; ++ai)
#pragma unroll
                for (int m = 0; m < 4; ++m) { float* p = yintra + (size_t)(row0 + ai * HALF + m * 16) * 256 + cw;
#pragma unroll
                    for (int bj = 0; bj < 2; ++bj)
#pragma unroll
                        for (int n = 0; n < 2; ++n) *(f32x4*)(p + bj * 128 + 16 * n) = acc[ai][bj][m][n]; }
        } else {
#pragma unroll
            for (int ai = 0; ai < 2; ++ai)
#pragma unroll
                for (int m = 0; m < 4; ++m) { float* p = sc + (size_t)(row0 + ai * HALF + m * 16) * 128 + cw;
#pragma unroll
                    for (int n = 0; n < 2; ++n) *(f32x4*)(p + 16 * n) = acc[ai][0][m][n]; }
        }
    }
};
struct EpiBiasBf16 {
    static constexpr bool PERM = true;
    bf16* O; int ldc; const float* bias;
    DEVI void operator()(AccT acc, const Unit& un, int wr, int wc, int fr, int fq) const {
        const int row0 = un.pm * BM + wr * 64 + fr, col0 = un.pn * BM + wc * 32 + 8 * fq;
#pragma unroll
        for (int ai = 0; ai < 2; ++ai)
#pragma unroll
            for (int m = 0; m < 4; ++m)
#pragma unroll
                for (int bj = 0; bj < 2; ++bj) {
                    const int col = col0 + bj * HALF;
                    const f32x4 b0 = *(const f32x4*)(bias + col), b1 = *(const f32x4*)(bias + col + 4);
                    const f32x4 v0 = acc[ai][bj][m][0] + b0, v1 = acc[ai][bj][m][1] + b1;
                    v4u w; w.x = pg8::cvt_pk_bf16(v0[0], v0[1]); w.y = pg8::cvt_pk_bf16(v0[2], v0[3]); w.z = pg8::cvt_pk_bf16(v1[0], v1[1]); w.w = pg8::cvt_pk_bf16(v1[2], v1[3]);
                    *(v4u*)(O + (size_t)(row0 + ai * HALF + m * 16) * ldc + col) = w;
                }
    }
};
DEVI float gelu_tanh(float y) { const float z = 0.7978845608028654f * (y + 0.044715f * y * y * y); const float e = __expf(2.f * z); const float th = 1.f - 2.f / (e + 1.f); return 0.5f * y * (1.f + th); }
struct EpiSsm2 {
    static constexpr bool PERM = false;
    const float* yintra; const bf16* u; const float* dsk; bf16 *yssm, *gy;
    DEVI void operator()(AccT acc, const Unit& un, int wr, int wc, int fr, int fq) const {
        const int row0 = un.pm * BM + wr * 64 + fr, g = un.pn, cw = wc * 32 + 4 * fq;
#pragma unroll
        for (int ai = 0; ai < 2; ++ai)
#pragma unroll
            for (int m = 0; m < 4; ++m) {
                const int row = row0 + ai * HALF + m * 16, chunk = row & 1023;
#pragma unroll
                for (int bj = 0; bj < 2; ++bj)
#pragma unroll
                    for (int n = 0; n < 2; ++n) {
                        const int col = bj * 128 + cw + 16 * n, j = col >> 4, co = col & 15, t = chunk * 16 + j, ch = g * 16 + co;
                        const f32x4 yi = *(const f32x4*)(yintra + (size_t)row * 256 + col);
                        const v2u uu = *(const v2u*)((const unsigned char*)u + tix(32768, (size_t)g * 1024 + (t >> 4), 2 * ((t & 15) * 16 + co)));
                        const f32x4 dd = *(const f32x4*)(dsk + ch);
                        f32x4 y = acc[ai][bj][m][n] + yi;
                        y[0] += dd[0] * bflo(uu.x); y[1] += dd[1] * bfhi(uu.x); y[2] += dd[2] * bflo(uu.y); y[3] += dd[3] * bfhi(uu.y);
                        v2u w; w.x = pg8::cvt_pk_bf16(y[0], y[1]); w.y = pg8::cvt_pk_bf16(y[2], y[3]);
                        *(v2u*)((unsigned char*)yssm + tix(S, t, 2 * ch)) = w;
                        v2u w2; w2.x = pg8::cvt_pk_bf16(gelu_tanh(y[0]), gelu_tanh(y[1])); w2.y = pg8::cvt_pk_bf16(gelu_tanh(y[2]), gelu_tanh(y[3]));
                        *(v2u*)(gy + (size_t)t * DSSM + ch) = w2;
                    }
                asm volatile("" ::: "memory");
            }
    }
};
struct EpiGlu {
    static constexpr bool PERM = true;
    const bf16* gy; const float* bias; bf16* O;
    DEVI void operator()(AccT acc, const Unit& un, int wr, int wc, int fr, int fq) const {
        const int row0 = un.pm * BM + wr * 64 + fr, col0 = un.pn * BM + wc * 32 + 8 * fq;
#pragma unroll
        for (int ai = 0; ai < 2; ++ai)
#pragma unroll
            for (int m = 0; m < 4; ++m)
#pragma unroll
                for (int bj = 0; bj < 2; ++bj) {
                    const int col = col0 + bj * HALF; const size_t off = (size_t)(row0 + ai * HALF + m * 16) * DSSM + col;
                    const f32x4 b0 = *(const f32x4*)(bias + col), b1 = *(const f32x4*)(bias + col + 4);
                    const v4u g4 = *(const v4u*)(gy + off);
                    const f32x4 v0 = acc[ai][bj][m][0] + b0, v1 = acc[ai][bj][m][1] + b1;
                    v4u w;
                    w.x = pg8::cvt_pk_bf16(bflo(g4.x) * sigmoidf_(v0[0]), bfhi(g4.x) * sigmoidf_(v0[1]));
                    w.y = pg8::cvt_pk_bf16(bflo(g4.y) * sigmoidf_(v0[2]), bfhi(g4.y) * sigmoidf_(v0[3]));
                    w.z = pg8::cvt_pk_bf16(bflo(g4.z) * sigmoidf_(v1[0]), bfhi(g4.z) * sigmoidf_(v1[1]));
                    w.w = pg8::cvt_pk_bf16(bflo(g4.w) * sigmoidf_(v1[2]), bfhi(g4.w) * sigmoidf_(v1[3]));
                    *(v4u*)(O + off) = w;
                }
    }
};
struct EpiResid {
    static constexpr bool PERM = false;
    const void* base; bool b16; bf16* out; float scale;
    DEVI void operator()(AccT acc, const Unit& un, int wr, int wc, int fr, int fq) const {
        const int row0 = un.pm * BM + wr * 64 + fr, col0 = un.pn * BM + wc * 32 + 4 * fq;
#pragma unroll
        for (int ai = 0; ai < 2; ++ai) {
            f32x4 bs[4][2][2];
            if (b16) {
#pragma unroll
                for (int m = 0; m < 4; ++m) { const size_t off = (size_t)(row0 + ai * HALF + m * 16) * D + col0;
#pragma unroll
                    for (int bj = 0; bj < 2; ++bj)
#pragma unroll
                        for (int n = 0; n < 2; ++n) { const v2u w = *(const v2u*)((const bf16*)base + off + bj * HALF + n * 16); bs[m][bj][n] = (f32x4){bflo(w.x), bfhi(w.x), bflo(w.y), bfhi(w.y)}; } }
            } else {
#pragma unroll
                for (int m = 0; m < 4; ++m) { const size_t off = (size_t)(row0 + ai * HALF + m * 16) * D + col0;
#pragma unroll
                    for (int bj = 0; bj < 2; ++bj)
#pragma unroll
                        for (int n = 0; n < 2; ++n) bs[m][bj][n] = *(const f32x4*)((const float*)base + off + bj * HALF + n * 16); }
            }
#pragma unroll
            for (int m = 0; m < 4; ++m) { const size_t off = (size_t)(row0 + ai * HALF + m * 16) * D + col0;
#pragma unroll
                for (int bj = 0; bj < 2; ++bj)
#pragma unroll
                    for (int n = 0; n < 2; ++n) { const f32x4 r = bs[m][bj][n] + acc[ai][bj][m][n] * scale; v2u w; w.x = pk2(r[0], r[1]); w.y = pk2(r[2], r[3]); *(v2u*)(out + off + bj * HALF + n * 16) = w; } }
            asm volatile("" ::: "memory");
        }
    }
};
struct EpiSwiglu {
    static constexpr bool PERM = true;
    bf16* O; int ldc, nct;
    DEVI void operator()(AccT acc, const Unit& un, int wr, int wc, int fr, int fq) const {
        const int row0 = un.pm * BM + wr * 64 + fr, col0 = (un.pn % nct) * 128 + wc * 32 + 8 * fq;
#pragma unroll
        for (int ai = 0; ai < 2; ++ai)
#pragma unroll
            for (int m = 0; m < 4; ++m) {
                float o[8];
#pragma unroll
                for (int n = 0; n < 2; ++n)
#pragma unroll
                    for (int j = 0; j < 4; ++j) o[4 * n + j] = siluf_(acc[ai][0][m][n][j]) * acc[ai][1][m][n][j];
                v4u w; w.x = pg8::cvt_pk_bf16(o[0], o[1]); w.y = pg8::cvt_pk_bf16(o[2], o[3]); w.z = pg8::cvt_pk_bf16(o[4], o[5]); w.w = pg8::cvt_pk_bf16(o[6], o[7]);
                *(v4u*)(O + (size_t)(row0 + ai * HALF + m * 16) * ldc + col0) = w;
            }
    }
};
constexpr float MOE_WSCALE = 64.f, MOE_ASCALE = 4.f;
struct EpiSwiglu8 {
    static constexpr bool PERM = true;
    unsigned char* O; int nr, nct;
    DEVI void operator()(AccT acc, const Unit& un, int wr, int wc, int fr, int fq) const {
        const int row0 = un.pm * BM + wr * 64 + fr, col0 = (un.pn % nct) * 128 + wc * 32 + 8 * fq;
#pragma unroll
        for (int ai = 0; ai < 2; ++ai)
#pragma unroll
            for (int m = 0; m < 4; ++m) {
                float o[8];
#pragma unroll
                for (int n = 0; n < 2; ++n)
#pragma unroll
                    for (int j = 0; j < 4; ++j) o[4 * n + j] = clamp448(siluf_(acc[ai][0][m][n][j] * (1.f / MOE_WSCALE)) * acc[ai][1][m][n][j] * (MOE_ASCALE / MOE_WSCALE));
                v2u w; w.x = pk4_fp8(o[0], o[1], o[2], o[3]); w.y = pk4_fp8(o[4], o[5], o[6], o[7]);
                *(v2u*)(O + tix(nr, row0 + ai * HALF + m * 16, col0)) = w;
            }
    }
};
struct EpiMoeDown {
    static constexpr bool PERM = true;
    bf16* O; const float* rw; float scale;
    DEVI void operator()(AccT acc, const Unit& un, int wr, int wc, int fr, int fq) const {
        const int row0 = un.pm * BM + wr * 64 + fr, col0 = (un.pn & 7) * BM + wc * 32 + 8 * fq;
#pragma unroll
        for (int ai = 0; ai < 2; ++ai)
#pragma unroll
            for (int m = 0; m < 4; ++m) {
                const int row = row0 + ai * HALF + m * 16; const float s = rw[row] * scale;
#pragma unroll
                for (int bj = 0; bj < 2; ++bj) {
                    const f32x4 v0 = acc[ai][bj][m][0] * s, v1 = acc[ai][bj][m][1] * s;
                    v4u w; w.x = pg8::cvt_pk_bf16(v0[0], v0[1]); w.y = pg8::cvt_pk_bf16(v0[2], v0[3]); w.z = pg8::cvt_pk_bf16(v1[0], v1[1]); w.w = pg8::cvt_pk_bf16(v1[2], v1[3]);
                    *(v4u*)(O + (size_t)row * D + col0 + bj * HALF) = w;
                }
            }
    }
};

struct EpiMoePart {
    static constexpr bool PERM = true;
    float* P;
    DEVI void operator()(AccT acc, const Unit& un, int wr, int wc, int fr, int fq) const {
        const int row0 = wr * 64 + fr, col0 = wc * 32 + 8 * fq;
#pragma unroll
        for (int ai = 0; ai < 2; ++ai)
#pragma unroll
            for (int m = 0; m < 4; ++m) {
                float* pr = P + (size_t)(row0 + ai * HALF + m * 16) * 256 + col0;
#pragma unroll
                for (int bj = 0; bj < 2; ++bj) { *(f32x4*)(pr + bj * HALF) = acc[ai][bj][m][0]; *(f32x4*)(pr + bj * HALF + 4) = acc[ai][bj][m][1]; }
            }
    }
};

struct Ssm1Order { int G, c; DEVI bool next(int i, Unit& u) const { const int L = i * G + c; if (L >= 256) return false; u.pm = L >> 1; u.pn = (u.pm >> 2) * 2 + (L & 1); return true; } };
struct Ssm2Order { int G, c; DEVI bool next(int i, Unit& u) const { const int L = i * G + c; if (L >= 128) return false; u.pm = L; u.pn = L >> 2; return true; } };
struct OneUnit { int pm, pn; DEVI bool next(int i, Unit& u) const { if (i > 0) return false; u.pm = pm; u.pn = pn; return true; } };
struct MoeOrder {
    pg8::StaticOrder so; int nct; int pe[NE + 1]; int imax = 1 << 30;
    DEVI bool next(int i, Unit& u) const { return i < imax && at((long)i * so.G + so.c, u); }
    DEVI bool at(const long L, Unit& u) const {
        if (!so.at(L, u)) return false;
        int e = 0;
#pragma unroll
        for (int k = 1; k < NE; ++k) e += (u.pm >= pe[k]) ? 1 : 0;
        u.pn += e * nct; return true;
    }
};

struct Args { const float* in[38]; float* out; unsigned char* ws; int ph_lo, ph_hi, li, dbg; };
constexpr size_t CTL_TBL = 600000;
struct Frame {
    LAS unsigned char* lds; volatile LAS unsigned* MISC; gu32* ctl;
    int tid, lane, wave, G, gw, NGW;
    unsigned char* ws;
    DEVI const float* in(int i) const { const unsigned long long v = __hip_atomic_load((const unsigned long long*)(ws + CTL_TBL + (size_t)blockIdx.x * 512) + i, __ATOMIC_RELAXED, __HIP_MEMORY_SCOPE_WORKGROUP);
        return (const float*)(const GAS float*)(((unsigned long long)(unsigned)__builtin_amdgcn_readfirstlane((int)(v >> 32)) << 32) | (unsigned)__builtin_amdgcn_readfirstlane((int)v)); }
};
DEVI unsigned char* launder(unsigned char* p) { GAS unsigned char* g = (GAS unsigned char*)p; asm volatile("" : "+s"(g)); return (unsigned char*)g; }
DEVI int vlaunder(int v) { asm volatile("" : "+v"(v)); return v; }
enum { IN_X = 0, IN_POS, IN_NMG, IN_WIN, IN_DWW, IN_DWB, IN_LNG, IN_LNB, IN_PWW, IN_PWB, IN_GB, IN_PEK, IN_PEV, IN_W1K, IN_W2K, IN_W1V, IN_W2V,
       IN_LRE, IN_LIM, IN_LDT, IN_BRE, IN_BIM, IN_CRE, IN_CIM, IN_SD, IN_GLW, IN_GLB, IN_MOG, IN_WOUT, IN_NFG, IN_FG, IN_FU, IN_FD, IN_RW, IN_MG, IN_MU, IN_MD, IN_FNG };

DEVI void tr_item(const float* W, int ldw, int c0, int nvalid, int k0, bf16* dst, size_t ldd  , size_t nr  , int r0, LAS float* scr, int lane) {
    const int cg = (lane & 7) * 4;
#pragma unroll
    for (int i = 0; i < 8; ++i) {
        const int kk = 8 * i + (lane >> 3);
        const float* p = W + (size_t)(k0 + kk) * ldw + c0 + cg;
        f32x4 v;
        if (nvalid >= 32) { v = *(const f32x4*)p; }
        else { v[0] = cg + 0 < nvalid ? p[0] : 0.f; v[1] = cg + 1 < nvalid ? p[1] : 0.f; v[2] = cg + 2 < nvalid ? p[2] : 0.f; v[3] = cg + 3 < nvalid ? p[3] : 0.f; }
        scr[kk * 33 + cg + 0] = v[0]; scr[kk * 33 + cg + 1] = v[1]; scr[kk * 33 + cg + 2] = v[2]; scr[kk * 33 + cg + 3] = v[3];
    }
    LDS_WAIT(); asm volatile("" ::: "memory");
    const int c = lane & 7;
#pragma unroll
    for (int j = 0; j < 4; ++j) { const int n = (lane >> 3) + 8 * j; const LAS float* s = scr + (8 * c) * 33 + n;
        v4u o; o.x = pk2(s[0 * 33], s[1 * 33]); o.y = pk2(s[2 * 33], s[3 * 33]); o.z = pk2(s[4 * 33], s[5 * 33]); o.w = pk2(s[6 * 33], s[7 * 33]);
        if (nr) *(v4u*)((unsigned char*)dst + tix(nr, r0 + n, 2 * (k0 + 8 * c))) = o; else *(v4u*)(dst + (size_t)(r0 + n) * ldd + k0 + 8 * c) = o; }
    LDS_WAIT(); asm volatile("" ::: "memory");
}
DEVI void tr_item8(const float* W, int ldw, int c0, int k0, unsigned char* dst, size_t nr  , int r0, float scale, LAS float* scr, int lane) {
    const int cg = (lane & 7) * 4;
#pragma unroll
    for (int i = 0; i < 8; ++i) {
        const int kk = 8 * i + (lane >> 3);
        const f32x4 v = *(const f32x4*)(W + (size_t)(k0 + kk) * ldw + c0 + cg);
        scr[kk * 33 + cg + 0] = v[0]; scr[kk * 33 + cg + 1] = v[1]; scr[kk * 33 + cg + 2] = v[2]; scr[kk * 33 + cg + 3] = v[3];
    }
    LDS_WAIT(); asm volatile("" ::: "memory");
    const int c = lane & 7;
#pragma unroll
    for (int j = 0; j < 4; ++j) { const int n = (lane >> 3) + 8 * j; const LAS float* s = scr + (8 * c) * 33 + n;
        v2u o; o.x = pk4_fp8(s[0 * 33] * scale, s[1 * 33] * scale, s[2 * 33] * scale, s[3 * 33] * scale); o.y = pk4_fp8(s[4 * 33] * scale, s[5 * 33] * scale, s[6 * 33] * scale, s[7 * 33] * scale);
        *(v2u*)(dst + tix(nr, r0 + n, k0 + 8 * c)) = o; }
    LDS_WAIT(); asm volatile("" ::: "memory");
}
DEVI void tr_matrix_item(int item, const float* W, const float* W2, int K, int ldw, int Ndst, int kind, int nvalid_total, bf16* dst, LAS float* scr, int lane, bool tiled = true) {
    const int nblk = Ndst / 32, kb = item / nblk, nb = item % nblk, d0 = nb * 32;
    const float* src = W; int c0 = d0, nv = 32;
    if (kind == 1) { const int un = d0 >> 8, within = d0 & 255; src = (within >= 128) ? W2 : W; c0 = un * 128 + (within & 127); }
    else if (kind == 2) {
        const int un = d0 >> 8, within = d0 & 255;
        if (un < 4) c0 = (within >> 7) * 512 + un * 128 + (within & 127);
        else if (un < 14) c0 = d0;
        else c0 = 3608 + (d0 - 3584);
    }
    if (nvalid_total < Ndst) { nv = nvalid_total - d0; nv = nv < 0 ? 0 : (nv > 32 ? 32 : nv); }
    tr_item(src, ldw, c0, nv, kb * 64, dst, (size_t)K, tiled ? (size_t)Ndst : 0, d0, scr, lane);
}

template <bool B16>
DEVI f32x4 row_ld4(const void* xrow, int c) {
    if (B16) { const v2u w = *(const v2u*)((const bf16*)xrow + c); return (f32x4){bflo(w.x), bfhi(w.x), bflo(w.y), bfhi(w.y)}; }
    return *(const f32x4*)((const float*)xrow + c);
}
template <bool B16 = false>
DEVI void rms_row_to_bf16(const void* xrow, const float* g, unsigned char* obase  , int row, int lane) {
    f32x4 v[8]; float s = 0.f;
#pragma unroll
    for (int j = 0; j < 8; ++j) { v[j] = row_ld4<B16>(xrow, 4 * lane + 256 * j); s += (v[j].x * v[j].x + v[j].y * v[j].y) + (v[j].z * v[j].z + v[j].w * v[j].w); }
    const float r = 1.f / sqrtf(wave_sum(s) * (1.f / D) + EPS);
#pragma unroll
    for (int j = 0; j < 8; ++j) { const f32x4 gg = *(const f32x4*)(g + 4 * lane + 256 * j);
        v2u w; w.x = pk2(v[j].x * r * gg.x, v[j].y * r * gg.y); w.y = pk2(v[j].z * r * gg.z, v[j].w * r * gg.w);
        *(v2u*)(obase + tix(S, row, 2 * (4 * lane + 256 * j))) = w; }
}

DEVI void ssm_tables_job(Frame& F, int l, int g) {

    LAS float* apr = (LAS float*)F.lds;
    LAS float* api = apr + 18 * 64;
    LAS float* bbr = api + 18 * 64;
    LAS float* bbi = bbr + 1024;
    LAS float* ccr = bbi + 1024;
    LAS float* cci = ccr + 1024;
    LAS float* kt = cci + 1024;
    const int tid = F.tid;
    const size_t gp = (size_t)(l * NGRP + g) * PST;
    if (tid < 64) {
        const int p = tid;
        const float lr = fminf(F.in(IN_LRE)[gp + p], -1e-4f), li = F.in(IN_LIM)[gp + p], dt = expf(F.in(IN_LDT)[l * NGRP + g]);
        const float mag = expf(lr * dt), ar = mag * cosf(li * dt), ai = mag * sinf(li * dt);
        const float den = lr * lr + li * li, cr = ((ar - 1.f) * lr + ai * li) / den, ci = (ai * lr - (ar - 1.f) * li) / den;
        float pr = 1.f, pi = 0.f;
        for (int tau = 0; tau < 18; ++tau) { apr[tau * 64 + p] = pr; api[tau * 64 + p] = pi; const float nr = pr * ar - pi * ai, ni = pr * ai + pi * ar; pr = nr; pi = ni; }
        for (int c = 0; c < 16; ++c) { const float br = F.in(IN_BRE)[(gp + p) * 16 + c], bi = F.in(IN_BIM)[(gp + p) * 16 + c];
            bbr[p * 16 + c] = cr * br - ci * bi; bbi[p * 16 + c] = cr * bi + ci * br; }
        float* a16 = (float*)(F.ws + R_CB + 65536) + (gp + p) * 2;
        a16[0] = apr[16 * 64 + p]; a16[1] = api[16 * 64 + p];
    }
    for (int i = tid; i < 1024; i += NTHR) { const int co = i >> 6, p = i & 63; const size_t o = ((size_t)(l * NGRP + g) * 16 + co) * PST + p; ccr[i] = F.in(IN_CRE)[o]; cci[i] = F.in(IN_CIM)[o]; }
    __syncthreads();
    for (int i = tid; i < 4096; i += NTHR) {
        const int tau = i >> 8, co = (i >> 4) & 15, ci = i & 15; float s = 0.f;
        for (int p = 0; p < 64; ++p) {
            const float xr = apr[tau * 64 + p] * bbr[p * 16 + ci] - api[tau * 64 + p] * bbi[p * 16 + ci];
            const float xi = apr[tau * 64 + p] * bbi[p * 16 + ci] + api[tau * 64 + p] * bbr[p * 16 + ci];
            s += ccr[co * 64 + p] * xr - cci[co * 64 + p] * xi;
        }
        kt[i] = s;
    }
    __syncthreads();
    unsigned char* tw = (unsigned char*)(F.ws + R_TW) + (size_t)l * NGRP * 512 * 256 * 2;
    unsigned char* wo2 = (unsigned char*)(F.ws + R_WO2) + (size_t)l * NGRP * 256 * 256 * 2;
    for (int i2 = tid; i2 < 256 * 128; i2 += NTHR) {
        const int n = i2 >> 7, k = (i2 & 127) * 2, j = n >> 4, co = n & 15, ii = k >> 4, ci = k & 15;
        float v0 = 0.f, v1 = 0.f;
        if (ii <= j) { v0 = kt[(j - ii) * 256 + co * 16 + ci]; v1 = kt[(j - ii) * 256 + co * 16 + ci + 1]; }
        *(unsigned*)(tw + tix(16384, g * 512 + n, 2 * k)) = pk2(v0, v1);
    }
    for (int i2 = tid; i2 < 256 * 128; i2 += NTHR) {
        const int n = i2 >> 7, k = (i2 & 127) * 2, ii = k >> 4, ci = k & 15;
        float v0 = 0.f, v1 = 0.f;
        if (n < 128) { const int ri = n >> 6, p = n & 63; const float pr = apr[(15 - ii) * 64 + p], pi = api[(15 - ii) * 64 + p];
            const float b0r = bbr[p * 16 + ci], b0i = bbi[p * 16 + ci], b1r = bbr[p * 16 + ci + 1], b1i = bbi[p * 16 + ci + 1];
            if (ri == 0) { v0 = pr * b0r - pi * b0i; v1 = pr * b1r - pi * b1i; } else { v0 = pr * b0i + pi * b0r; v1 = pr * b1i + pi * b1r; } }
        *(unsigned*)(tw + tix(16384, g * 512 + 256 + n, 2 * k)) = pk2(v0, v1);
    }
    for (int i2 = tid; i2 < 256 * 128; i2 += NTHR) {
        const int n = i2 >> 7, k = (i2 & 127) * 2, j = n >> 4, co = n & 15;
        float v[2] = {0.f, 0.f};
#pragma unroll
        for (int e = 0; e < 2; ++e) { const int kk = k + e;
            if (kk < 128) { const int p = kk & 63; const float pr = apr[(j + 1) * 64 + p], pi = api[(j + 1) * 64 + p], cr = ccr[co * 64 + p], ci = cci[co * 64 + p];
                v[e] = (kk < 64) ? (cr * pr - ci * pi) : -(cr * pi + ci * pr); } }
        *(unsigned*)(wo2 + tix(8192, g * 256 + n, 2 * k)) = pk2(v[0], v[1]);
    }
    __syncthreads();
}
DEVI void cbias_job(Frame& F, int job) {
    LAS float* red = (LAS float*)F.lds;
    const int c = job & 15, kv = (job >> 4) & 1, l = job >> 5;
    const float* pe = F.in(kv ? IN_PEV : IN_PEK) + (size_t)l * 4096 + c * 256; const float* w1 = F.in(kv ? IN_W1V : IN_W1K) + (size_t)l * 4096 * 128 + (size_t)(c * 256) * 128;
    const int e = F.tid & 127, kq = F.tid >> 7; float s = 0.f;
#pragma unroll 16
    for (int k = kq * 64; k < kq * 64 + 64; ++k) s += pe[k] * w1[(size_t)k * 128 + e];
    red[F.tid] = s; __syncthreads();
    if (F.tid < 128) ((float*)(F.ws + R_CB))[(size_t)job * 128 + e] = (red[e] + red[128 + e]) + (red[256 + e] + red[384 + e]);
    __syncthreads();
}
DEVI void w1_tile_item(Frame& F, const float* pW1K, const float* pW1V, int item) {
    const int ks = item & 127, kv = (item >> 7) & 1, l = item >> 8, lane = F.lane, r = lane & 15, q = lane >> 4;
    const float* w1 = (kv ? pW1V : pW1K) + (size_t)l * 4096 * 128 + (size_t)(32 * ks + 8 * q) * 128 + r;
    bf16* dst = (bf16*)(F.ws + (kv ? R_W1V : R_W1K)) + (size_t)l * 128 * 4096 + ((size_t)ks * 8 * 64 + lane) * 8;
#pragma unroll
    for (int et = 0; et < 8; ++et) {
        float v[8];
#pragma unroll
        for (int j = 0; j < 8; ++j) v[j] = w1[(size_t)j * 128 + 16 * et];
        v4u o; o.x = pk2(v[0], v[1]); o.y = pk2(v[2], v[3]); o.z = pk2(v[4], v[5]); o.w = pk2(v[6], v[7]);
        *(v4u*)(dst + (size_t)et * 512) = o;
    }
}

struct Tile8 { const float* src; unsigned char* dst; int ldw; int nr, row0, k0; };
DEVI Tile8 moe_tile(Frame& F, const float* pMG, const float* pMU, const float* pMD, int r) {
    constexpr int I_MGU = 32 * (2 * DFFE / 32), I_MD = (DFFE / 64) * 64;
    const int e = r / (I_MGU + I_MD); r -= e * (I_MGU + I_MD);
    Tile8 t;
    if (r < I_MGU) { const int nblk = 2 * DFFE / 32, kb = r / nblk, nb = r % nblk, d0 = nb * 32, un = d0 >> 8, within = d0 & 255;
        t.src = (within >= 128 ? pMU : pMG) + (size_t)e * D * DFFE + (size_t)(kb * 64) * DFFE + un * 128 + (within & 127); t.ldw = DFFE;
        t.dst = (unsigned char*)(F.ws + WS_MOE_GU); t.nr = NE * 2 * DFFE; t.row0 = e * 2 * DFFE + d0; t.k0 = kb * 64; }
    else { r -= I_MGU; const int nblk = D / 32, kb = r / nblk, nb = r % nblk;
        t.src = pMD + (size_t)e * DFFE * D + (size_t)(kb * 64) * D + nb * 32; t.ldw = D;
        t.dst = (unsigned char*)(F.ws + WS_MOE_D); t.nr = NE * D; t.row0 = e * D + nb * 32; t.k0 = kb * 64; }
    return t;
}
DEVI Tile8 ffn_tile(Frame& F, const float* pFG, const float* pFU, const float* pFD, int r) {
    constexpr int I_FGU = 32 * (2 * DFF / 32);
    Tile8 t;
    if (r < I_FGU) { const int nblk = 2 * DFF / 32, kb = r / nblk, nb = r % nblk, d0 = nb * 32, un = d0 >> 8, within = d0 & 255;
        t.src = (within >= 128 ? pFU : pFG) + (size_t)(kb * 64) * DFF + un * 128 + (within & 127); t.ldw = DFF;
        t.dst = (unsigned char*)(F.ws + R_FGU); t.nr = 2 * DFF; t.row0 = d0; t.k0 = kb * 64; }
    else { r -= I_FGU; const int nblk = D / 32, kb = r / nblk, nb = r % nblk;
        t.src = pFD + (size_t)(kb * 64) * D + nb * 32; t.ldw = D;
        t.dst = (unsigned char*)(F.ws + R_FD); t.nr = D; t.row0 = nb * 32; t.k0 = kb * 64; }
    return t;
}
DEVI void tile8_load(const Tile8& t, f32x4 (&v)[8], int lane) {
#pragma unroll
    for (int i = 0; i < 8; ++i) v[i] = __builtin_nontemporal_load((const f32x4*)(t.src + (size_t)(8 * i + (lane >> 3)) * t.ldw + (lane & 7) * 4));
}
DEVI void tile8_store(const Tile8& t, const f32x4 (&v)[8], LAS float* scr, int lane) {
    const int cg = (lane & 7) * 4;
#pragma unroll
    for (int i = 0; i < 8; ++i) { const int kk = 8 * i + (lane >> 3); scr[kk * 33 + cg + 0] = v[i][0]; scr[kk * 33 + cg + 1] = v[i][1]; scr[kk * 33 + cg + 2] = v[i][2]; scr[kk * 33 + cg + 3] = v[i][3]; }
    LDS_WAIT(); asm volatile("" ::: "memory");
    const int c = lane & 7;
#pragma unroll
    for (int j = 0; j < 4; ++j) { const int n = (lane >> 3) + 8 * j; const LAS float* s = scr + (8 * c) * 33 + n;
        v2u o; o.x = pk4_fp8(s[0 * 33] * MOE_WSCALE, s[1 * 33] * MOE_WSCALE, s[2 * 33] * MOE_WSCALE, s[3 * 33] * MOE_WSCALE); o.y = pk4_fp8(s[4 * 33] * MOE_WSCALE, s[5 * 33] * MOE_WSCALE, s[6 * 33] * MOE_WSCALE, s[7 * 33] * MOE_WSCALE);
        *(v2u*)(t.dst + tix(t.nr, t.row0 + n, t.k0 + 8 * c)) = o; }
    LDS_WAIT(); asm volatile("" ::: "memory");
}

DEVI void p0_prologue(Frame& F, int variant = 0) {
     unsigned char* ws = F.ws;
    if (variant == 0) {
    for (int j = blockIdx.x; j < 128; j += F.G) { if (j < 64) ssm_tables_job(F, j >> 5, j & 31); else cbias_job(F, j - 64); }
    __syncthreads();
    }
    LAS float* scr = (LAS float*)(F.lds + RING_OFF + F.wave * 16384);
    if (variant == 0) {
    { const float* pX = F.in(IN_X); const float* pG = F.in(IN_NMG); for (int m = F.gw; m < S; m += F.NGW) rms_row_to_bf16(pX + (size_t)m * D, pG, (unsigned char*)(ws + WS_HN), m, F.lane); }
    constexpr int I_WIN = 32 * 128, I_WG = 32, I_WOUT = 32 * 64, I_SQ = 8 * 16, I_W1 = 64 * 4, I_W2 = 2 * 4;
    constexpr int I_LAYER = I_WIN + I_WG + I_WOUT + 2 * I_SQ + I_W1 + 2 * I_W2;
    constexpr int I_FGU = 32 * (2 * DFF / 32), I_FD = (DFF / 64) * 64, I_MGU = 32 * (2 * DFFE / 32), I_MD = (DFFE / 64) * 64;
    constexpr int NITEMS = 2 * I_LAYER;
    const float* pWIN = F.in(IN_WIN); const float* pWOUT = F.in(IN_WOUT); const float* pPWW = F.in(IN_PWW); const float* pGLW = F.in(IN_GLW); const float* pW2K = F.in(IN_W2K); const float* pW2V = F.in(IN_W2V);
    const float* pFG = F.in(IN_FG); const float* pFU = F.in(IN_FU); const float* pFD = F.in(IN_FD); const float* pW1K = F.in(IN_W1K); const float* pW1V = F.in(IN_W1V);
    for (int it = F.gw; it < NITEMS; it += F.NGW) {
        int r = it;
        if (r < 2 * I_LAYER) {
            const int l = r / I_LAYER; r -= l * I_LAYER;
            if (r < I_WIN) { tr_matrix_item(r, pWIN + (size_t)l * D * DIN, nullptr, D, DIN, 4096, 2, 4096, (bf16*)(ws + R_WIN) + (size_t)l * 4096 * D, scr, F.lane); continue; } r -= I_WIN;
            if (r < I_WG) {
#pragma unroll
                for (int h2 = 0; h2 < 2; ++h2) { const int ks = 2 * r + h2, rr = F.lane & 15, qq = F.lane >> 4;
#pragma unroll
                    for (int nt = 0; nt < 2; ++nt) { const int col = 16 * nt + rr; float v[8];
#pragma unroll
                        for (int j = 0; j < 8; ++j) v[j] = (col < 24) ? pWIN[(size_t)l * D * DIN + (size_t)(32 * ks + 8 * qq + j) * DIN + 3584 + col] : 0.f;
                        v4u o; o.x = pk2(v[0], v[1]); o.y = pk2(v[2], v[3]); o.z = pk2(v[4], v[5]); o.w = pk2(v[6], v[7]);
                        *(v4u*)((bf16*)(ws + R_WG) + (size_t)l * 32 * D + ((size_t)(ks * 2 + nt) * 64 + F.lane) * 8) = o; } }
                continue; } r -= I_WG;
            if (r < I_WOUT) { tr_matrix_item(r, pWOUT + (size_t)l * D * D, nullptr, D, D, D, 0, D, (bf16*)(ws + R_WOUT) + (size_t)l * D * D, scr, F.lane); continue; } r -= I_WOUT;
            if (r < I_SQ) { tr_matrix_item(r, pPWW + (size_t)l * 512 * 512, nullptr, 512, 512, 512, 0, 512, (bf16*)(ws + R_CPW) + (size_t)l * 512 * 512, scr, F.lane); continue; } r -= I_SQ;
            if (r < I_SQ) { tr_matrix_item(r, pGLW + (size_t)l * 512 * 512, nullptr, 512, 512, 512, 0, 512, (bf16*)(ws + R_GLU) + (size_t)l * 512 * 512, scr, F.lane); continue; } r -= I_SQ;
            if (r < I_W1) { w1_tile_item(F, pW1K, pW1V, l * 256 + r); continue; } r -= I_W1;
            if (r < I_W2) { tr_matrix_item(r, pW2K + (size_t)l * 128 * 128, nullptr, 128, 128, 128, 0, 128, (bf16*)(ws + R_W2) + (size_t)(l * 2 + 0) * 128 * 128, scr, F.lane, false); continue; } r -= I_W2;
            tr_matrix_item(r, pW2V + (size_t)l * 128 * 128, nullptr, 128, 128, 128, 0, 128, (bf16*)(ws + R_W2) + (size_t)(l * 2 + 1) * 128 * 128, scr, F.lane, false); continue;
        }
    }
    }
    constexpr int NMOE = NE * (32 * (2 * DFFE / 32) + (DFFE / 64) * 64), NFFN = 32 * (2 * DFF / 32) + (DFF / 64) * 64, NTOT = NMOE + NFFN;
    {
        const float* pMG = F.in(IN_MG); const float* pMU = F.in(IN_MU); const float* pMD = F.in(IN_MD);
        const float* pFG = F.in(IN_FG); const float* pFU = F.in(IN_FU); const float* pFD = F.in(IN_FD);
        const int NGW = F.NGW, NLATE = (F.G == 256) ? 512 : 0, RA = (F.G == 256) ? 84 : (1 << 20);
        auto item_of = [&](int k) -> int {
            if (k < RA) { const int it = k * NGW + F.gw; return it < NTOT ? it : -1; }
            if (F.gw < NLATE) return -1;
            const int it = RA * NGW + (k - RA) * (NGW - NLATE) + (F.gw - NLATE); return it < NTOT ? it : -1; };
        auto tile_of = [&](int it) -> Tile8 { return it < NMOE ? moe_tile(F, pMG, pMU, pMD, it) : ffn_tile(F, pFG, pFU, pFD, it - NMOE); };
        int it = item_of(0);
        if (it >= 0) {
            f32x4 va[8], vb[8];
            Tile8 t0 = tile_of(it); tile8_load(t0, va, F.lane);
            for (int k = 0; it >= 0; ++k) {
                const int itn = item_of(k + 1);
                const Tile8 t1 = tile_of(itn >= 0 ? itn : it); tile8_load(t1, vb, F.lane);
                if (variant == 1) { asm volatile("" :: "v"(va[0]), "v"(va[1]), "v"(va[2]), "v"(va[3]), "v"(va[4]), "v"(va[5]), "v"(va[6]), "v"(va[7])); } else tile8_store(t0, va, scr, F.lane);
                t0 = t1; it = itn;
#pragma unroll
                for (int i = 0; i < 8; ++i) va[i] = vb[i];
            }
        }
    }
}

#define MFMA16(a, b, c) __builtin_amdgcn_mfma_f32_16x16x32_bf16((a), (b), (c), 0, 0, 0)
DEVI bf16x8 ldg8(const bf16* p) { return *(const bf16x8*)p; }
DEVI bf16x8 zero8() { bf16x8 z = {0, 0, 0, 0, 0, 0, 0, 0}; return z; }
DEVI bf16x8 pack8(f32x4 a, f32x4 b) { v4u w; w.x = pg8::cvt_pk_bf16(a[0], a[1]); w.y = pg8::cvt_pk_bf16(a[2], a[3]); w.z = pg8::cvt_pk_bf16(b[0], b[1]); w.w = pg8::cvt_pk_bf16(b[2], b[3]); return __builtin_bit_cast(bf16x8, w); }

DEVI void gates_job(Frame& F, const float* pGB, int l, int job) {
    const int lane = F.lane, r = lane & 15, q = lane >> 4, t0 = job * 16;
    const unsigned char* hn = (const unsigned char*)(F.ws + WS_HN);
    const bf16* wg = (const bf16*)(F.ws + R_WG) + (size_t)l * 32 * D + lane * 8;
    f32x4 a0 = {0.f, 0.f, 0.f, 0.f}, a1 = a0;
#pragma unroll 8
    for (int ks = 0; ks < D / 32; ++ks) {
        const bf16x8 a = ldg8((const bf16*)(hn + tix(S, t0 + r, 64 * ks + 16 * q))), b0 = ldg8(wg + (size_t)(ks * 2) * 512), b1 = ldg8(wg + (size_t)(ks * 2 + 1) * 512);
        a0 = MFMA16(a, b0, a0); a1 = MFMA16(a, b1, a1);
    }
    const float* gb = pGB + l * 24; float* go = (float*)(F.ws + R_GATES);
#pragma unroll
    for (int j = 0; j < 4; ++j) { const int t = t0 + 4 * q + j;
        go[(size_t)t * 24 + r] = sigmoidf_(a0[j] + gb[r]);
        if (r < 8) go[(size_t)t * 24 + 16 + r] = sigmoidf_(a1[j] + gb[16 + r]); }
}

DEVI void rope_job(Frame& F, const int* pPOS, int t) {
    const int lane = F.lane;
    const float pos = (float)pPOS[t];
    float cs = 0.f, sn = 0.f;
    { const int i = lane & 15; const float inv = powf(500000.f, -(float)(2 * i) / 32.f); const float ang = pos * inv; cs = cosf(ang); sn = sinf(ang); }
    float cv[16], sv[16];
#pragma unroll
    for (int i = 0; i < 16; ++i) { cv[i] = __shfl(cs, i); sv[i] = __shfl(sn, i); }
    const bf16* qrow = (const bf16*)(F.ws + R_Q) + (size_t)t * DATT + 16 * lane;
    v4u w0 = *(const v4u*)qrow, w1 = *(const v4u*)(qrow + 8);
    unsigned w[8] = {w0.x, w0.y, w0.z, w0.w, w1.x, w1.y, w1.z, w1.w};
    const int sub = lane & 7;
    float x[16], o[16];
#pragma unroll
    for (int i = 0; i < 8; ++i) { x[2 * i] = bflo(w[i]); x[2 * i + 1] = bfhi(w[i]); }
#pragma unroll
    for (int i = 0; i < 16; ++i) { const float other = __shfl_xor(x[i], 1);
        o[i] = (sub == 0) ? (x[i] * cv[i] - other * sv[i]) : ((sub == 1) ? (x[i] * cv[i] + other * sv[i]) : x[i]); }
    v4u o0, o1; o0.x = pk2(o[0], o[1]); o0.y = pk2(o[2], o[3]); o0.z = pk2(o[4], o[5]); o0.w = pk2(o[6], o[7]); o1.x = pk2(o[8], o[9]); o1.y = pk2(o[10], o[11]); o1.z = pk2(o[12], o[13]); o1.w = pk2(o[14], o[15]);
    bf16* qr = (bf16*)(F.ws + R_QR) + (size_t)t * DATT + 16 * lane;
    if (sub >= 2) { o0 = w0; o1 = w1; }
    *(v4u*)qr = o0; *(v4u*)(qr + 8) = o1;
    {
        const int tz = lane >> 5, g = (lane >> 4) & 1, c = lane & 15;
        const bf16* kp = (const bf16*)(F.ws + R_KV) + ((size_t)((tz ? 4 : 2) * 2 + g) * S + t) * HD + 8 * c;
        const v4u wv = *(const v4u*)kp;
        const unsigned ww[4] = {wv.x, wv.y, wv.z, wv.w}; unsigned ow[4];
        const int i0 = 8 * (c & 1);
#pragma unroll
        for (int i = 0; i < 4; ++i) {
            const unsigned pw = (unsigned)__shfl_xor((int)ww[i], 2);
            float a0 = bflo(ww[i]), a1 = bfhi(ww[i]); const float b0 = bflo(pw), b1 = bfhi(pw);
            float cc0 = 0.f, ss0 = 0.f, cc1 = 0.f, ss1 = 0.f;
#pragma unroll
            for (int k = 0; k < 16; ++k) { if (k == i0 + 2 * i) { cc0 = cv[k]; ss0 = sv[k]; } if (k == i0 + 2 * i + 1) { cc1 = cv[k]; ss1 = sv[k]; } }
            const float sg = (c < 2) ? -1.f : 1.f;
            const float r0 = a0 * cc0 + sg * b0 * ss0, r1 = a1 * cc1 + sg * b1 * ss1;
            ow[i] = (c < 4) ? pk2(r0, r1) : ww[i];
        }
        {
            v2u o8; o8.x = pk4_fp8(bflo(ow[0]), bfhi(ow[0]), bflo(ow[1]), bfhi(ow[1])); o8.y = pk4_fp8(bflo(ow[2]), bfhi(ow[2]), bflo(ow[3]), bfhi(ow[3]));
            *(v2u*)((unsigned char*)(F.ws + (tz ? R_KW8 : R_KS8)) + (size_t)g * S * HD + (size_t)((t >> 6) * 4 + ((t >> 4) & 3)) * 2048 + ((c & 3) >> 1) * 1024 + ((t & 15) + 16 * (c >> 2)) * 16 + (c & 1) * 8) = o8; }
    }
}

DEVI void dwconv_job(Frame& F, const float* pDWW, const float* pDWB, const float* pLNG, const float* pLNB, int l, int job) {
    const int lane = F.lane, c0 = 8 * lane, t0 = job * 4;
    const bf16* u = (const bf16*)(F.ws + R_CONVU);
    const float* dww = pDWW + (size_t)l * CONVW * DCONV + c0;
    float acc[4][8], wk[4][8];
#pragma unroll
    for (int i = 0; i < 4; ++i)
#pragma unroll
        for (int c = 0; c < 8; ++c) { acc[i][c] = 0.f; wk[i][c] = 0.f; }
#pragma unroll 2
    for (int kr = 0; kr < 34; ++kr) {
#pragma unroll
        for (int c = 0; c < 8; ++c) { wk[3][c] = wk[2][c]; wk[2][c] = wk[1][c]; wk[1][c] = wk[0][c]; }
        const int kk = kr <= 30 ? kr : 30; const float wm = kr <= 30 ? 1.f : 0.f;
        const f32x4 a = *(const f32x4*)(dww + (size_t)kk * DCONV), b = *(const f32x4*)(dww + (size_t)kk * DCONV + 4);
        wk[0][0] = a[0] * wm; wk[0][1] = a[1] * wm; wk[0][2] = a[2] * wm; wk[0][3] = a[3] * wm; wk[0][4] = b[0] * wm; wk[0][5] = b[1] * wm; wk[0][6] = b[2] * wm; wk[0][7] = b[3] * wm;
        const int r = t0 - 30 + kr; const int rc = r < 0 ? 0 : r; const float xm = r < 0 ? 0.f : 1.f;
        const v4u w = *(const v4u*)(u + (size_t)rc * DCONV + c0);
        const float x[8] = {bflo(w.x) * xm, bfhi(w.x) * xm, bflo(w.y) * xm, bfhi(w.y) * xm, bflo(w.z) * xm, bfhi(w.z) * xm, bflo(w.w) * xm, bfhi(w.w) * xm};
#pragma unroll
        for (int i = 0; i < 4; ++i)
#pragma unroll
            for (int c = 0; c < 8; ++c) acc[i][c] += x[c] * wk[i][c];
    }
    const float* dwb = pDWB + l * DCONV + c0; const float* lng = pLNG + l * DCONV + c0; const float* lnb = pLNB + l * DCONV + c0;
    float bb[8], gg[8], be[8];
#pragma unroll
    for (int c = 0; c < 8; ++c) { bb[c] = dwb[c]; gg[c] = lng[c]; be[c] = lnb[c]; }
    unsigned char* out = (unsigned char*)(F.ws + R_CONVACT);
#pragma unroll
    for (int i = 0; i < 4; ++i) {
        float s = 0.f;
#pragma unroll
        for (int c = 0; c < 8; ++c) { acc[i][c] += bb[c]; s += acc[i][c]; }
        const float mu = wave_sum(s) * (1.f / DCONV); float q = 0.f;
#pragma unroll
        for (int c = 0; c < 8; ++c) { const float d = acc[i][c] - mu; q += d * d; }
        const float rstd = 1.f / sqrtf(wave_sum(q) * (1.f / DCONV) + EPS);
        float y[8];
#pragma unroll
        for (int c = 0; c < 8; ++c) y[c] = siluf_((acc[i][c] - mu) * rstd * gg[c] + be[c]);
        v4u w; w.x = pk2(y[0], y[1]); w.y = pk2(y[2], y[3]); w.z = pk2(y[4], y[5]); w.w = pk2(y[6], y[7]);
        *(v4u*)(out + tix(S, t0 + i, 2 * c0)) = w;
    }
}

DEVI void vt_job(Frame& F, int job) {
    const int lane = F.lane;
    const int dh = job & 1, chunk = (job >> 1) & 255, g = (job >> 9) & 1, tz = job >> 10;
    LAS unsigned* scr = (LAS unsigned*)(F.lds + RING_OFF + F.wave * 16384);
    const bf16* v = (const bf16*)(F.ws + R_KV) + ((size_t)((tz ? 5 : 3) * 2 + g) * S + chunk * 64) * HD + dh * 64;
#pragma unroll
    for (int i = 0; i < 8; ++i) { const int row = 8 * i + (lane >> 3), cg = (lane & 7) * 4;
        const v4u w = *(const v4u*)(v + (size_t)row * HD + cg * 2);
        scr[row * 33 + cg + 0] = w.x; scr[row * 33 + cg + 1] = w.y; scr[row * 33 + cg + 2] = w.z; scr[row * 33 + cg + 3] = w.w; }
    LDS_WAIT(); asm volatile("" ::: "memory");
    const int r = lane & 15, q = lane >> 4;
    const LAS unsigned short* s16 = (const LAS unsigned short*)scr;
    {
        unsigned char* v8 = (unsigned char*)(F.ws + (tz ? R_VW8 : R_VS8)) + (size_t)g * S * HD + (size_t)chunk * 8192 + lane * 16;
#pragma unroll
        for (int dtl = 0; dtl < 4; ++dtl) { v4u o;
            unsigned wds[4];
#pragma unroll
            for (int T = 0; T < 4; ++T) { const int tk = 16 * T + 4 * q; wds[T] = pk4_fp8(bf2f(s16[(tk + 0) * 66 + 16 * dtl + r]), bf2f(s16[(tk + 1) * 66 + 16 * dtl + r]), bf2f(s16[(tk + 2) * 66 + 16 * dtl + r]), bf2f(s16[(tk + 3) * 66 + 16 * dtl + r])); }
            o.x = wds[0]; o.y = wds[1]; o.z = wds[2]; o.w = wds[3];
            *(v4u*)(v8 + (size_t)(dh * 4 + dtl) * 1024) = o; }
    }
    LDS_WAIT(); asm volatile("" ::: "memory");
}

DEVI void compress_job(Frame& F, int l, int job) {
    const int lane = F.lane, r = lane & 15, q = lane >> 4, w = F.wave;
    const int nt = job & 63, g = (job >> 6) & 1, kv = job >> 7;
    const int n0 = nt * 16; int nn = n0 + r; nn = nn > NCMP - 1 ? NCMP - 1 : nn;
    const bf16* raw = (const bf16*)(F.ws + R_KV) + ((size_t)(kv * 2 + g) * S) * HD + (size_t)nn * 2048 + 8 * q;
    const bf16* w1f = (const bf16*)(F.ws + (kv ? R_W1V : R_W1K)) + (size_t)l * 128 * 4096 + lane * 8;
    LAS f32x4* part = (LAS f32x4*)(F.lds + RING_OFF);
    LAS bf16* hidT = (LAS bf16*)(F.lds + RING_OFF + 65536);
    f32x4 hid[8];
#pragma unroll
    for (int e = 0; e < 8; ++e) hid[e] = (f32x4){0.f, 0.f, 0.f, 0.f};
#pragma unroll 4
    for (int k = 0; k < 16; ++k) {
        const int ks = 16 * w + k;
        const bf16x8 b = ldg8(raw + 32 * ks);
#pragma unroll
        for (int e = 0; e < 8; ++e) { const bf16x8 a = ldg8(w1f + ((size_t)ks * 8 + e) * 512); hid[e] = MFMA16(a, b, hid[e]); }
    }
#pragma unroll
    for (int e = 0; e < 8; ++e) part[(w * 8 + e) * 64 + lane] = hid[e];
    __syncthreads();
    {
        f32x4 sacc = part[(0 * 8 + w) * 64 + lane];
#pragma unroll
        for (int w2 = 1; w2 < 8; ++w2) sacc = sacc + part[(w2 * 8 + w) * 64 + lane];
        const float* cb = (const float*)(F.ws + R_CB) + (size_t)(l * 2 + kv) * 16 * 128 + 16 * w + 4 * q;
        f32x4 bv = *(const f32x4*)cb;
#pragma unroll
        for (int cc = 1; cc < 16; ++cc) bv = bv + *(const f32x4*)(cb + cc * 128);
        v2u pk; pk.x = pk2(siluf_(sacc[0] + bv[0]), siluf_(sacc[1] + bv[1])); pk.y = pk2(siluf_(sacc[2] + bv[2]), siluf_(sacc[3] + bv[3]));
        *(LAS v2u*)(hidT + r * 128 + 16 * w + 4 * q) = pk;
    }
    __syncthreads();
    const bf16* w2t = (const bf16*)(F.ws + R_W2) + (size_t)(l * 2 + kv) * 128 * 128 + (size_t)(16 * w + r) * 128 + 8 * q;
    f32x4 o = {0.f, 0.f, 0.f, 0.f};
#pragma unroll
    for (int s = 0; s < 4; ++s) {
        const bf16x8 a = ldg8(w2t + 32 * s);
        const bf16x8 b = *(const LAS bf16x8*)(hidT + r * 128 + 32 * s + 8 * q);
        o = MFMA16(a, b, o);
    }
    const int n = n0 + r, stp = n >> 5, kk = n & 31;
    if (kv == 0) { const int T = (kk >> 2) & 1, rr = ((kk >> 3) << 2) | (kk & 3);
        bf16* kc = (bf16*)(F.ws + R_KC) + (size_t)g * 1024 * HD;
        const int d0 = 16 * w + 4 * q, ks = d0 >> 5, qq = (d0 >> 3) & 3, j0 = d0 & 7;
        v2u wv; wv.x = pk2(o[0], o[1]); wv.y = pk2(o[2], o[3]);
        *(v2u*)(kc + ((((size_t)stp * 2 + T) * 4 + ks) * 64 + rr + 16 * qq) * 8 + j0) = wv; }
    else { const int qq = kk >> 3, jj = kk & 7;
        bf16* vct = (bf16*)(F.ws + R_VCT) + (size_t)g * 1024 * HD;
#pragma unroll
        for (int j = 0; j < 4; ++j) vct[(((size_t)stp * 8 + w) * 64 + (4 * q + j) + 16 * qq) * 8 + jj] = (bf16)f2bf(o[j]); }
    __syncthreads();
}

DEVI void scan_job(Frame& F, int l, int g) {
    const int p = F.lane;
    const float* a16 = (const float*)(F.ws + R_CB + 65536) + ((size_t)(l * NGRP + g) * PST + p) * 2;
    const float ar = a16[0], ai = a16[1];
    const float* sc = (const float*)(F.ws + R_SC) + (size_t)g * 1024 * 128;
    unsigned char* hp = (unsigned char*)(F.ws + R_HPREV);
    float hr = 0.f, hi = 0.f;
    for (int c0 = 0; c0 < 1024; c0 += 32) {
        float sr[32], si[32];
#pragma unroll
        for (int k = 0; k < 32; ++k) { sr[k] = sc[(size_t)(c0 + k) * 128 + p]; si[k] = sc[(size_t)(c0 + k) * 128 + 64 + p]; }
#pragma unroll
        for (int k = 0; k < 32; ++k) {
            const size_t rw_ = (size_t)g * 1024 + c0 + k;
            *(bf16*)(hp + tix(32768, rw_, 2 * p)) = (bf16)f2bf(hr); *(bf16*)(hp + tix(32768, rw_, 128 + 2 * p)) = (bf16)f2bf(hi); *(unsigned*)(hp + tix(32768, rw_, 256 + 4 * p)) = 0u;
            const float nr = ar * hr - ai * hi + sr[k], ni = ar * hi + ai * hr + si[k]; hr = nr; hi = ni;
        }
    }
}

constexpr float QK_SCALE = 0.08838834764831845f;
constexpr float C2 = 1.4426950408889634f * QK_SCALE;
constexpr float NEG_INF = -__builtin_inff();

DEVI int krow(int r, int T) { return 8 * (r >> 2) + 4 * T + (r & 3); }

DEVI void cmp_stats_job(Frame& F, int g, int tile) {
    const int lane = F.lane, r = lane & 15, q = lane >> 4, t0 = tile * 16, t = t0 + r;
    if (tile == 0) return;
    const int nmax = tile - 1;
    const int nsteps = (nmax >> 5) + 1;
    const bf16* qp = (const bf16*)(F.ws + R_Q) + (size_t)t * DATT + (size_t)(4 * g) * HD + 8 * q;
    bf16x8 qf[4][4];
#pragma unroll
    for (int h = 0; h < 4; ++h)
#pragma unroll
        for (int ks = 0; ks < 4; ++ks) qf[h][ks] = ldg8(qp + h * HD + 32 * ks);
    const bf16* kc = (const bf16*)(F.ws + R_KC) + (size_t)g * 1024 * HD + lane * 8;
    const int nvis = (t - 31) >> 4;
    float m[4], lsum[4];
#pragma unroll
    for (int h = 0; h < 4; ++h) { m[h] = -1e30f; lsum[h] = 0.f; }
    for (int pass = 0; pass < 2; ++pass) {
        float inv_l[4];
        if (pass == 1) {
#pragma unroll
            for (int h = 0; h < 4; ++h) {
                float mm = m[h], ll = lsum[h];
#pragma unroll
                for (int o = 16; o < 64; o <<= 1) { const float om = __shfl_xor(mm, o), ol = __shfl_xor(ll, o); const float nm = fmaxf(mm, om);
                    ll = ll * __builtin_amdgcn_exp2f(mm - nm) + ol * __builtin_amdgcn_exp2f(om - nm); mm = nm; }
                m[h] = mm; inv_l[h] = ll > 0.f ? 1.f / ll : 0.f;
            }
        }
        float carry = 0.f;
        auto kload = [&](bf16x8 (&kf)[2][4], int st) { const size_t sc_ = (st < nsteps) ? st : nsteps - 1;
#pragma unroll
            for (int T = 0; T < 2; ++T)
#pragma unroll
                for (int ks = 0; ks < 4; ++ks) kf[T][ks] = ldg8(kc + ((sc_ * 2 + T) * 4 + ks) * 512); };
        auto step = [&](const bf16x8 (&kf)[2][4], const int st) {
            const int key0 = st * 32;
            f32x4 imp0 = {0.f, 0.f, 0.f, 0.f}, imp1 = imp0;
#pragma unroll
            for (int h = 0; h < 4; ++h) {
                f32x4 s0 = {0.f, 0.f, 0.f, 0.f}, s1 = s0;
#pragma unroll
                for (int ks = 0; ks < 4; ++ks) { s0 = MFMA16(kf[0][ks], qf[h][ks], s0); s1 = MFMA16(kf[1][ks], qf[h][ks], s1); }
#pragma unroll
                for (int j = 0; j < 4; ++j) { s0[j] = (key0 + 8 * q + j <= nvis) ? s0[j] * C2 : NEG_INF; s1[j] = (key0 + 8 * q + 4 + j <= nvis) ? s1[j] * C2 : NEG_INF; }
                if (pass == 0) {
                    float mx = fmaxf(fmaxf(fmaxf(s0[0], s0[1]), fmaxf(s0[2], s0[3])), fmaxf(fmaxf(s1[0], s1[1]), fmaxf(s1[2], s1[3])));
                    const float nm = fmaxf(m[h], mx); float ps = 0.f;
#pragma unroll
                    for (int j = 0; j < 4; ++j) ps += __builtin_amdgcn_exp2f(s0[j] - nm) + __builtin_amdgcn_exp2f(s1[j] - nm);
                    lsum[h] = lsum[h] * __builtin_amdgcn_exp2f(m[h] - nm) + ps; m[h] = nm;
                } else {
#pragma unroll
                    for (int j = 0; j < 4; ++j) { imp0[j] += __builtin_amdgcn_exp2f(s0[j] - m[h]) * inv_l[h]; imp1[j] += __builtin_amdgcn_exp2f(s1[j] - m[h]) * inv_l[h]; }
                }
            }
            if (pass == 1) {
                const float prev_lane = __shfl_up(imp1[3], 16);
                const float pm1 = (q == 0) ? carry : prev_lane;
                const float b0 = pm1 + (imp0[0] + imp0[1]) + (imp0[2] + imp0[3]);
                const float b1 = imp0[3] + (imp1[0] + imp1[1]) + (imp1[2] + imp1[3]);
                carry = __shfl(imp1[3], 48 + r);
                float* dst = (float*)(F.ws + R_IMP) + ((size_t)t * 2 + g) * NSB + (key0 >> 2) + 2 * q;
                f32x2 w = {b0, b1}; *(f32x2*)dst = w;
            }
                };
        bf16x8 kA[2][4], kB[2][4];
        kload(kA, 0);
        for (int st = 0; st < nsteps; st += 2) {
            kload(kB, st + 1);
            step(kA, st);
            kload(kA, st + 2);
            if (st + 1 < nsteps) step(kB, st + 1);
        }
        if (pass == 1 && q == 0 && 8 * nsteps < NSB) ((float*)(F.ws + R_IMP))[((size_t)t * 2 + g) * NSB + 8 * nsteps] = carry;
    }
}

struct AttnState { f32x4 o[8]; float m, l; };
struct KVFrag { bf16x8 k[2][4]; bf16x8 v[8]; };
DEVI void kv_load(KVFrag& f, const bf16* kbase  , const bf16* vtbase  , int key0, int r) {
    const size_t st = (size_t)(key0 >> 5);
#pragma unroll
    for (int T = 0; T < 2; ++T)
#pragma unroll
        for (int ks = 0; ks < 4; ++ks) f.k[T][ks] = ldg8(kbase + ((st * 2 + T) * 4 + ks) * 512);
#pragma unroll
    for (int dt = 0; dt < 8; ++dt) f.v[dt] = ldg8(vtbase + (st * 8 + dt) * 512);
}
template <int MODE>
DEVI void attn_compute(AttnState& st, const bf16x8 (&qf)[4], const KVFrag& f, int key0, int tq, int lane) {
    const int q = lane >> 4;
    f32x4 s0 = {0.f, 0.f, 0.f, 0.f}, s1 = s0;
#pragma unroll
    for (int ks = 0; ks < 4; ++ks) { s0 = MFMA16(f.k[0][ks], qf[ks], s0); s1 = MFMA16(f.k[1][ks], qf[ks], s1); }
#pragma unroll
    for (int j = 0; j < 4; ++j) {
        const int ka = key0 + 8 * q + j, kb = ka + 4; bool va, vb;
        if (MODE == 0) { va = 16 * ka + 31 <= tq; vb = 16 * kb + 31 <= tq; }
        else if (MODE == 1) { va = (unsigned)(tq - ka) < 512u; vb = (unsigned)(tq - kb) < 512u; }
        else { va = ka <= tq; vb = kb <= tq; }
        s0[j] = va ? s0[j] * C2 : NEG_INF; s1[j] = vb ? s1[j] * C2 : NEG_INF;
    }
    float mx = fmaxf(fmaxf(fmaxf(s0[0], s0[1]), fmaxf(s0[2], s0[3])), fmaxf(fmaxf(s1[0], s1[1]), fmaxf(s1[2], s1[3])));
    mx = fmaxf(mx, __shfl_xor(mx, 16)); mx = fmaxf(mx, __shfl_xor(mx, 32));
    const float nm = fmaxf(st.m, mx), alpha = __builtin_amdgcn_exp2f(st.m - nm);
    st.m = nm;
    float ps = 0.f;
#pragma unroll
    for (int j = 0; j < 4; ++j) { s0[j] = __builtin_amdgcn_exp2f(s0[j] - nm); s1[j] = __builtin_amdgcn_exp2f(s1[j] - nm); ps += s0[j] + s1[j]; }
    st.l = st.l * alpha + ps;
    if (!__all(alpha == 1.f)) {
#pragma unroll
        for (int dt = 0; dt < 8; ++dt) st.o[dt] = st.o[dt] * alpha;
    }
    const bf16x8 pf = pack8(s0, s1);
#pragma unroll
    for (int dt = 0; dt < 8; ++dt) st.o[dt] = MFMA16(f.v[dt], pf, st.o[dt]);
}
template <int MODE>
DEVI void attn_run_linear(AttnState& st, const bf16x8 (&qf)[4], const bf16* kbase, const bf16* vtbase, int kstart, int nsteps, int tq, int lane) {
    const int r = lane & 15;
    KVFrag A, B;
    kv_load(A, kbase, vtbase, kstart, r);
    for (int s = 0; s < nsteps; s += 2) {
        const int s1 = (s + 1 < nsteps) ? s + 1 : nsteps - 1, s2 = (s + 2 < nsteps) ? s + 2 : nsteps - 1;
        kv_load(B, kbase, vtbase, kstart + 32 * s1, r);
        attn_compute<MODE>(st, qf, A, kstart + 32 * s, tq, lane);
        kv_load(A, kbase, vtbase, kstart + 32 * s2, r);
        if (s + 1 < nsteps) attn_compute<MODE>(st, qf, B, kstart + 32 * s1, tq, lane);
    }
}
typedef long i64_t;
#define MFMA16F8(a, b, c) __builtin_amdgcn_mfma_f32_16x16x32_fp8_fp8((a), (b), (c), 0, 0, 0)
struct KVFrag8 { i64_t k[2][4]; i64_t v[8]; };
DEVI void kv_load8(KVFrag8& f, const unsigned char* kbase  , const unsigned char* vtbase  , int key0) {
    const size_t st = (size_t)(key0 >> 5);
#pragma unroll
    for (int T = 0; T < 2; ++T)
#pragma unroll
        for (int ks = 0; ks < 4; ++ks) f.k[T][ks] = *(const i64_t*)(kbase + ((st * 2 + T) * 4 + ks) * 512);
#pragma unroll
    for (int dt = 0; dt < 8; ++dt) f.v[dt] = *(const i64_t*)(vtbase + (st * 8 + dt) * 512);
}
template <bool MASK>
DEVI void attn_compute8(AttnState& st, const i64_t (&qf)[4], const KVFrag8& f, int key0, int tq, int lane) {
    const int q = lane >> 4;
    f32x4 s0 = {0.f, 0.f, 0.f, 0.f}, s1 = s0;
#pragma unroll
    for (int ks = 0; ks < 4; ++ks) { s0 = MFMA16F8(f.k[0][ks], qf[ks], s0); s1 = MFMA16F8(f.k[1][ks], qf[ks], s1); }
    if (MASK) {
#pragma unroll
        for (int j = 0; j < 4; ++j) { const int ka = key0 + 8 * q + j, kb = ka + 4; s0[j] = (ka <= tq) ? s0[j] : NEG_INF; s1[j] = (kb <= tq) ? s1[j] : NEG_INF; }
    }
    float mx = fmaxf(fmaxf(fmaxf(s0[0], s0[1]), fmaxf(s0[2], s0[3])), fmaxf(fmaxf(s1[0], s1[1]), fmaxf(s1[2], s1[3])));
    mx = fmaxf(mx, __shfl_xor(mx, 16)); mx = fmaxf(mx, __shfl_xor(mx, 32));
    const float nm = fmaxf(st.m, mx * C2), alpha = __builtin_amdgcn_exp2f(st.m - nm), bias = 8.f - nm;
    st.m = nm;
    float ps = 0.f;
#pragma unroll
    for (int j = 0; j < 4; ++j) { s0[j] = __builtin_amdgcn_exp2f(__builtin_fmaf(s0[j], C2, bias)); s1[j] = __builtin_amdgcn_exp2f(__builtin_fmaf(s1[j], C2, bias)); ps += s0[j] + s1[j]; }
    st.l = st.l * alpha + ps;
    if (!__all(alpha == 1.f)) {
#pragma unroll
        for (int dt = 0; dt < 8; ++dt) st.o[dt] = st.o[dt] * alpha;
    }
    const i64_t pf = (i64_t)(((unsigned long long)pk4_fp8(s1[0], s1[1], s1[2], s1[3]) << 32) | pk4_fp8(s0[0], s0[1], s0[2], s0[3]));
#pragma unroll
    for (int dt = 0; dt < 8; ++dt) st.o[dt] = MFMA16F8(f.v[dt], pf, st.o[dt]);
}
typedef int v8i __attribute__((ext_vector_type(8)));
#define MFMA128(a, b, c) __builtin_amdgcn_mfma_scale_f32_16x16x128_f8f6f4((a), (b), (c), 0, 0, 0, 0x7F7F7F7F, 0, 0x7F7F7F7F)
DEVI v8i ld32(const unsigned char* p) { const v4u a = *(const v4u*)p, b = *(const v4u*)(p + 1024);
    v8i r; r[0] = a.x; r[1] = a.y; r[2] = a.z; r[3] = a.w; r[4] = b.x; r[5] = b.y; r[6] = b.z; r[7] = b.w; return r; }
DEVI void attn_init(AttnState& st) {
#pragma unroll
    for (int dt = 0; dt < 8; ++dt) st.o[dt] = (f32x4){0.f, 0.f, 0.f, 0.f};
    st.m = -1e30f; st.l = 0.f;
}
template <int CTRL, int BANK> DEVI float dpp_merge(float old, float src) { return __builtin_bit_cast(float, __builtin_amdgcn_update_dpp(__builtin_bit_cast(int, old), __builtin_bit_cast(int, src), CTRL, 0xf, BANK, false)); }
template <int CTRL> DEVI int dpp_mov(int src) { return __builtin_amdgcn_update_dpp(0, src, CTRL, 0xf, 0xf, true); }
template <int CTRL> DEVI float dpp_movf(float src) { return __builtin_bit_cast(float, __builtin_amdgcn_update_dpp(0, __builtin_bit_cast(int, src), CTRL, 0xf, 0xf, true)); }
template <bool LATE_K, bool C4, class BlkFn, class MaskFn>
DEVI void attn128_run(AttnState& st, const v8i qf, const unsigned char* kb, const unsigned char* vb, int nblk, BlkFn blk, MaskFn M, int q, v8i (&KA)[4], v8i (&KB)[4]) {
    const int nst = (nblk + 1) >> 1;
    for (int ss = 0; ss < nst; ++ss) {
        const int bA = blk(2 * ss);
        const bool hasB = (2 * ss + 1 < nblk);
        const int bB = blk(hasB ? 2 * ss + 1 : 2 * ss);
        v8i vf[8];
#pragma unroll
        for (int dt = 0; dt < 8; ++dt) { const v4u a = *(const v4u*)(vb + (size_t)bA * 8192 + dt * 1024), b = *(const v4u*)(vb + (size_t)bB * 8192 + dt * 1024);
            vf[dt][0] = a.x; vf[dt][1] = a.y; vf[dt][2] = a.z; vf[dt][3] = a.w; vf[dt][4] = b.x; vf[dt][5] = b.y; vf[dt][6] = b.z; vf[dt][7] = b.w; }
        f32x4 sa[4], sb[4];
#pragma unroll
        for (int T = 0; T < 4; ++T) { const f32x4 z = {0.f, 0.f, 0.f, 0.f}; sa[T] = MFMA128(KA[T], qf, z); sb[T] = MFMA128(KB[T], qf, z); }
        if (M.need(bA)) {
#pragma unroll
            for (int T = 0; T < 4; ++T)
#pragma unroll
                for (int j = 0; j < 4; ++j) sa[T][j] = M.vis(64 * bA + 16 * T + 4 * q + j) ? sa[T][j] : NEG_INF; }
        if (!hasB || M.need(bB)) {
#pragma unroll
            for (int T = 0; T < 4; ++T)
#pragma unroll
                for (int j = 0; j < 4; ++j) sb[T][j] = (hasB && M.vis(64 * bB + 16 * T + 4 * q + j)) ? sb[T][j] : NEG_INF; }
        v8i pf;
        if (C4) {
            f32x4 ca, cb;
#pragma unroll
            for (int j = 0; j < 4; ++j) {
                float x = sa[0][j]; x = dpp_merge<0x114, 0x2>(x, sa[1][j]); x = dpp_merge<0x118, 0x4>(x, sa[2][j]); x = dpp_merge<0x11C, 0x8>(x, sa[3][j]); ca[j] = x;
                float y = sb[0][j]; y = dpp_merge<0x114, 0x2>(y, sb[1][j]); y = dpp_merge<0x118, 0x4>(y, sb[2][j]); y = dpp_merge<0x11C, 0x8>(y, sb[3][j]); cb[j] = y; }
            float mx = fmaxf(fmaxf(fmaxf(ca[0], ca[1]), fmaxf(ca[2], ca[3])), fmaxf(fmaxf(cb[0], cb[1]), fmaxf(cb[2], cb[3])));
            mx = fmaxf(mx, dpp_movf<0x124>(mx)); mx = fmaxf(mx, dpp_movf<0x128>(mx));
            mx = fmaxf(mx, __shfl_xor(mx, 16)); mx = fmaxf(mx, __shfl_xor(mx, 32));
            const float nm = fmaxf(st.m, mx * C2), alpha = __builtin_amdgcn_exp2f(st.m - nm), bias = 8.f - nm;
            st.m = nm;
            float ps = 0.f;
#pragma unroll
            for (int j = 0; j < 4; ++j) { ca[j] = __builtin_amdgcn_exp2f(__builtin_fmaf(ca[j], C2, bias)); cb[j] = __builtin_amdgcn_exp2f(__builtin_fmaf(cb[j], C2, bias)); ps += ca[j] + cb[j]; }
            st.l = st.l * alpha + ps;
            if (!__all(alpha == 1.f)) {
#pragma unroll
                for (int dt = 0; dt < 8; ++dt) st.o[dt] = st.o[dt] * alpha;
            }
            const int wa = (int)pk4_fp8(ca[0], ca[1], ca[2], ca[3]), wb = (int)pk4_fp8(cb[0], cb[1], cb[2], cb[3]);
            pf[0] = wa; pf[1] = dpp_mov<0x104>(wa); pf[2] = dpp_mov<0x108>(wa); pf[3] = dpp_mov<0x10C>(wa);
            pf[4] = wb; pf[5] = dpp_mov<0x104>(wb); pf[6] = dpp_mov<0x108>(wb); pf[7] = dpp_mov<0x10C>(wb);
        } else {
        float mx = NEG_INF;
#pragma unroll
            for (int T = 0; T < 4; ++T) { mx = fmaxf(mx, fmaxf(fmaxf(sa[T][0], sa[T][1]), fmaxf(sa[T][2], sa[T][3]))); mx = fmaxf(mx, fmaxf(fmaxf(sb[T][0], sb[T][1]), fmaxf(sb[T][2], sb[T][3]))); }
            mx = fmaxf(mx, __shfl_xor(mx, 16)); mx = fmaxf(mx, __shfl_xor(mx, 32));
            const float nm = fmaxf(st.m, mx * C2), alpha = __builtin_amdgcn_exp2f(st.m - nm), bias = 8.f - nm;
            st.m = nm;
            float ps = 0.f;
#pragma unroll
            for (int T = 0; T < 4; ++T)
#pragma unroll
                for (int j = 0; j < 4; ++j) { sa[T][j] = __builtin_amdgcn_exp2f(__builtin_fmaf(sa[T][j], C2, bias)); sb[T][j] = __builtin_amdgcn_exp2f(__builtin_fmaf(sb[T][j], C2, bias)); ps += sa[T][j] + sb[T][j]; }
            st.l = st.l * alpha + ps;
            if (!__all(alpha == 1.f)) {
#pragma unroll
                for (int dt = 0; dt < 8; ++dt) st.o[dt] = st.o[dt] * alpha;
            }
#pragma unroll
            for (int T = 0; T < 4; ++T) { pf[T] = (int)pk4_fp8(sa[T][0], sa[T][1], sa[T][2], sa[T][3]); pf[4 + T] = (int)pk4_fp8(sb[T][0], sb[T][1], sb[T][2], sb[T][3]); }
        }
        if (!LATE_K)
        { const int n0 = (2 * ss + 2 < nblk) ? 2 * ss + 2 : 2 * ss, n1 = (2 * ss + 3 < nblk) ? 2 * ss + 3 : n0;
          const int c0_ = blk(n0), c1_ = blk(n1);
#pragma unroll
          for (int T = 0; T < 4; ++T) { KA[T] = ld32(kb + (size_t)c0_ * 8192 + T * 2048); KB[T] = ld32(kb + (size_t)c1_ * 8192 + T * 2048); } }
#pragma unroll
        for (int dt = 0; dt < 8; ++dt) st.o[dt] = MFMA128(vf[dt], pf, st.o[dt]);
        if (LATE_K)
        { const int n0 = (2 * ss + 2 < nblk) ? 2 * ss + 2 : 2 * ss, n1 = (2 * ss + 3 < nblk) ? 2 * ss + 3 : n0;
          const int c0_ = blk(n0), c1_ = blk(n1);
#pragma unroll
          for (int T = 0; T < 4; ++T) { KA[T] = ld32(kb + (size_t)c0_ * 8192 + T * 2048); KB[T] = ld32(kb + (size_t)c1_ * 8192 + T * 2048); } }
    }
    if (C4) { st.l += dpp_movf<0x124>(st.l); st.l += dpp_movf<0x128>(st.l); }
}
DEVI void attn128_k0(v8i (&KA)[4], v8i (&KB)[4], const unsigned char* kb, int b0_, int b1_) {
#pragma unroll
    for (int T = 0; T < 4; ++T) { KA[T] = ld32(kb + (size_t)b0_ * 8192 + T * 2048); KB[T] = ld32(kb + (size_t)b1_ * 8192 + T * 2048); }
}
struct SelMask { int cur, t; DEVI bool need(int b) const { return b == cur; } DEVI bool vis(int key) const { return key <= t; } };
struct WinMask { int t0, tq; DEVI bool need(int b) const { return !(64 * b + 63 <= t0 && 64 * b >= t0 - 496); } DEVI bool vis(int key) const { return (unsigned)(tq - key) < 512u; } };
DEVI v8i q_frag8(const bf16* qp, bool on) {
    v8i qf;
#pragma unroll
    for (int i = 0; i < 4; ++i) { const v4u w = *(const v4u*)(qp + 8 * i);
        qf[2 * i] = on ? (int)pk4_fp8(bflo(w.x), bfhi(w.x), bflo(w.y), bfhi(w.y)) : 0; qf[2 * i + 1] = on ? (int)pk4_fp8(bflo(w.z), bfhi(w.z), bflo(w.w), bfhi(w.w)) : 0; }
    return qf;
}
DEVI void attn_store(AttnState& st, bf16* dst, bool active, int lane, float oscale = 1.f) {
    const int q = lane >> 4;
    float l = st.l; l += __shfl_xor(l, 16); l += __shfl_xor(l, 32);
    const float inv = l > 0.f ? oscale / l : 0.f;
    if (active) {
#pragma unroll
        for (int dt = 0; dt < 8; ++dt) { v2u w; w.x = pk2(st.o[dt][0] * inv, st.o[dt][1] * inv); w.y = pk2(st.o[dt][2] * inv, st.o[dt][3] * inv); *(v2u*)(dst + 16 * dt + 4 * q) = w; }
    }
}
template <int MODE>
DEVI void attn_run_linear2(AttnState& st0, AttnState& st1, const bf16x8 (&q0)[4], const bf16x8 (&q1)[4], const bf16* kbase, const bf16* vtbase, int kstart, int nsteps, int tq, int lane) {
    const int r = lane & 15;
    for (int s = 0; s < nsteps; ++s) {
        KVFrag A;
        kv_load(A, kbase, vtbase, kstart + 32 * s, r);
        attn_compute<MODE>(st0, q0, A, kstart + 32 * s, tq, lane);
        attn_compute<MODE>(st1, q1, A, kstart + 32 * s, tq, lane);
    }
}
DEVI void cmp_att_job2(Frame& F, int tile, int hp) {
    const int lane = F.lane, r = lane & 15, q = lane >> 4, t = tile * 16 + r, h = 2 * hp, g = h >> 2;
    AttnState st0, st1; attn_init(st0); attn_init(st1);
    bf16x8 q0[4], q1[4];
    const bf16* qp = (const bf16*)(F.ws + R_Q) + (size_t)t * DATT + (size_t)h * HD + 8 * q;
#pragma unroll
    for (int ks = 0; ks < 4; ++ks) { q0[ks] = ldg8(qp + 32 * ks); q1[ks] = ldg8(qp + HD + 32 * ks); }
    if (tile > 0) {
        const int nsteps = ((tile - 1) >> 5) + 1;
        const bf16* kb = (const bf16*)(F.ws + R_KC) + (size_t)g * 1024 * HD + lane * 8;
        const bf16* vb = (const bf16*)(F.ws + R_VCT) + (size_t)g * HD * 1024 + lane * 8;
        attn_run_linear2<0>(st0, st1, q0, q1, kb, vb, 0, nsteps, t, lane);
    }
    attn_store(st0, (bf16*)(F.ws + R_OC) + (size_t)t * DATT + (size_t)h * HD, true, lane);
    attn_store(st1, (bf16*)(F.ws + R_OC) + (size_t)t * DATT + (size_t)(h + 1) * HD, true, lane);
}
DEVI void win_att_job2(Frame& F, int tile, int hp) {
    const int lane = F.lane, r = lane & 15, q = lane >> 4, t0 = tile * 16, t = t0 + r, h = 2 * hp, g = h >> 2;
    AttnState st0, st1; attn_init(st0); attn_init(st1);
    bf16x8 q0[4], q1[4];
    const bf16* qp = (const bf16*)(F.ws + R_QR) + (size_t)t * DATT + (size_t)h * HD + 8 * q;
#pragma unroll
    for (int ks = 0; ks < 4; ++ks) { q0[ks] = ldg8(qp + 32 * ks); q1[ks] = ldg8(qp + HD + 32 * ks); }
    int k_lo = t0 - 511; k_lo = k_lo < 0 ? 0 : k_lo; k_lo &= ~31;
    const bf16* kb = (const bf16*)(F.ws + R_KWF) + (size_t)g * S * HD + lane * 8;
    const bf16* vb = (const bf16*)(F.ws + R_VWT) + (size_t)g * HD * S + lane * 8;
    attn_run_linear2<1>(st0, st1, q0, q1, kb, vb, k_lo, ((t0 + 15 - k_lo) >> 5) + 1, t, lane);
    attn_store(st0, (bf16*)(F.ws + R_OW) + (size_t)t * DATT + (size_t)h * HD, true, lane);
    attn_store(st1, (bf16*)(F.ws + R_OW) + (size_t)t * DATT + (size_t)(h + 1) * HD, true, lane);
}
DEVI void win_att_job8(Frame& F, int tile, int h) {
    const int lane = F.lane, r = lane & 15, q = lane >> 4, t0 = tile * 16, t = t0 + r, g = h >> 2;
    AttnState st; attn_init(st);
    const v8i qf = q_frag8((const bf16*)(F.ws + R_QR) + (size_t)t * DATT + (size_t)h * HD + 32 * q, true);
    const int lo = t0 - 511, blo = (lo < 0 ? 0 : lo) >> 6, nblk = (t0 >> 6) - blo + 1;
    v8i KA[4], KB[4]; const unsigned char* kb = (const unsigned char*)(F.ws + R_KW8) + (size_t)g * S * HD + lane * 16;
    attn128_k0(KA, KB, kb, blo, blo + (nblk > 1 ? 1 : 0));
    attn128_run<false, false>(st, qf, kb, (const unsigned char*)(F.ws + R_VW8) + (size_t)g * S * HD + lane * 16, nblk,
                [&](int i) { return blo + i; }, WinMask{t0, t}, q, KA, KB);
    attn_store(st, (bf16*)(F.ws + R_OW) + (size_t)t * DATT + (size_t)h * HD, true, lane);
}
DEVI void cmp_att_job(Frame& F, int tile, int h) {
    const int lane = F.lane, r = lane & 15, q = lane >> 4, t = tile * 16 + r, g = h >> 2;
    AttnState st; attn_init(st);
    bf16x8 qf[4];
    const bf16* qp = (const bf16*)(F.ws + R_Q) + (size_t)t * DATT + (size_t)h * HD + 8 * q;
#pragma unroll
    for (int ks = 0; ks < 4; ++ks) qf[ks] = ldg8(qp + 32 * ks);
    if (tile > 0) {
        const int nsteps = ((tile - 1) >> 5) + 1;
        const bf16* kb = (const bf16*)(F.ws + R_KC) + (size_t)g * 1024 * HD + lane * 8;
        const bf16* vb = (const bf16*)(F.ws + R_VCT) + (size_t)g * HD * 1024 + lane * 8;
        attn_run_linear<0>(st, qf, kb, vb, 0, nsteps, t, lane);
    }
    attn_store(st, (bf16*)(F.ws + R_OC) + (size_t)t * DATT + (size_t)h * HD, true, lane);
}
DEVI void win_att_job(Frame& F, int tile, int h) {
    const int lane = F.lane, r = lane & 15, q = lane >> 4, t0 = tile * 16, t = t0 + r, g = h >> 2;
    AttnState st; attn_init(st);
    bf16x8 qf[4];
    const bf16* qp = (const bf16*)(F.ws + R_QR) + (size_t)t * DATT + (size_t)h * HD + 8 * q;
#pragma unroll
    for (int ks = 0; ks < 4; ++ks) qf[ks] = ldg8(qp + 32 * ks);
    int k_lo = t0 - 511; k_lo = k_lo < 0 ? 0 : k_lo; k_lo &= ~31;
    const bf16* kb = (const bf16*)(F.ws + R_KWF) + (size_t)g * S * HD + lane * 8;
    const bf16* vb = (const bf16*)(F.ws + R_VWT) + (size_t)g * HD * S + lane * 8;
    attn_run_linear<1>(st, qf, kb, vb, k_lo, ((t0 + 15 - k_lo) >> 5) + 1, t, lane);
    attn_store(st, (bf16*)(F.ws + R_OW) + (size_t)t * DATT + (size_t)h * HD, true, lane);
}
DEVI f32x4 sel_imp_load(Frame& F, int t, int g) { return *(const f32x4*)((const float*)(F.ws + R_IMP) + ((size_t)t * 2 + g) * NSB + 4 * F.lane); }
DEVI void sel_att_job(Frame& F, int t, int g, const f32x4 iv, int variant = 0) {
    const int lane = F.lane, r = lane & 15, q = lane >> 4;
    v4u qraw[4];
    { const bf16* qp = (const bf16*)(F.ws + R_QR) + (size_t)t * DATT + (size_t)(4 * g + (r & 3)) * HD + 32 * q;
#pragma unroll
      for (int i = 0; i < 4; ++i) qraw[i] = *(const v4u*)(qp + 8 * i); }
    const int cur = t >> 6;
    v8i KA[4], KB[4]; const unsigned char* kb = (const unsigned char*)(F.ws + R_KS8) + (size_t)g * S * HD + lane * 16;
    attn128_k0(KA, KB, kb, 0, cur);
    const int nvis = (t - 31) >> 4, jlim = (t >= 31) ? ((nvis + 1) >> 2) : -1;
    unsigned ikey[4]; bool cand[4], sel[4];
    int nforced = 0, ncand = 0;
#pragma unroll
    for (int i = 0; i < 4; ++i) { const int j = 4 * lane + i; const float im = (j <= jlim) ? iv[i] : 0.f;
        const bool allowed = j <= cur, forced = allowed && ((j == 0) || (j == cur) || (j == cur - 1));
        ikey[i] = __float_as_uint(im); cand[i] = allowed && !forced; sel[i] = forced;
        nforced += __builtin_popcountll(__ballot(forced)); ncand += __builtin_popcountll(__ballot(cand[i])); }
    const int K = 16 - nforced;
    if (ncand <= K) {
#pragma unroll
        for (int i = 0; i < 4; ++i) sel[i] = sel[i] || cand[i];
    } else {
        unsigned thr = 0u;
        for (int bit = 30; bit >= 0; --bit) {
            const unsigned tr = thr | (1u << bit); int cnt = 0;
#pragma unroll
            for (int i = 0; i < 4; ++i) cnt += __builtin_popcountll(__ballot(cand[i] && ikey[i] >= tr));
            if (cnt >= K) { thr = tr; if (cnt == K) break; }
        }
        int cgt = 0; unsigned long long tm[4];
#pragma unroll
        for (int i = 0; i < 4; ++i) { const bool gt = cand[i] && ikey[i] > thr; sel[i] = sel[i] || gt; cgt += __builtin_popcountll(__ballot(gt)); tm[i] = __ballot(cand[i] && ikey[i] == thr); }
        for (int need = K - cgt; need > 0; --need) {
            int bestj = 1 << 30;
#pragma unroll
            for (int i = 0; i < 4; ++i) if (tm[i]) { const int j = 4 * (int)__builtin_ctzll(tm[i]) + i; bestj = j < bestj ? j : bestj; }
#pragma unroll
            for (int i = 0; i < 4; ++i) { if ((bestj & 3) == i) tm[i] &= tm[i] - 1ull; if (4 * lane + i == bestj) sel[i] = true; }
        }
    }
    int selv = 0, nsel = 1;
    if (cur >= 1) { selv = (lane == 1) ? cur : selv; nsel = 2; }
    if (cur >= 2) { selv = (lane == 2) ? cur - 1 : selv; nsel = 3; }
#pragma unroll
    for (int i = 0; i < 4; ++i) { const int jb = 4 * lane + i; unsigned long long m = __ballot(sel[i] && jb != 0 && jb != cur && jb != cur - 1);
        while (m) { const int bl = (int)__builtin_ctzll(m); m &= m - 1ull; selv = (lane == nsel) ? (4 * bl + i) : selv; ++nsel; } }
    if (variant == 4) nsel = 0;
#ifdef REP_PHASE
    if (variant == 1) selv = lane & 3;
    if (variant == 2) { selv = cur - lane; selv = selv < 0 ? 0 : selv; }
    if (variant == 4) { selv = lane & 3; nsel = 16; }
    if (variant == 3) nsel = 0;
#endif
    AttnState st; attn_init(st);
    v8i qf;
#pragma unroll
    for (int i = 0; i < 4; ++i) { const v4u w = qraw[i];
        qf[2 * i] = (r < 4) ? (int)pk4_fp8(bflo(w.x), bfhi(w.x), bflo(w.y), bfhi(w.y)) : 0; qf[2 * i + 1] = (r < 4) ? (int)pk4_fp8(bflo(w.z), bfhi(w.z), bflo(w.w), bfhi(w.w)) : 0; }
    attn128_run<false, true>(st, qf, kb, (const unsigned char*)(F.ws + R_VS8) + (size_t)g * S * HD + lane * 16, nsel,
                [&](int i) { return __builtin_amdgcn_readlane(selv, i); }, SelMask{cur, t}, q, KA, KB);
    attn_store(st, (bf16*)(F.ws + (variant ? R_ACT : R_OS)) + (size_t)t * DATT + (size_t)(4 * g + (r & 3)) * HD, r < 4, lane);
}

DEVI void mixnorm_job(Frame& F, const float* pMOG, int l, int t) {
    const int lane = F.lane;
    const float* mg = pMOG + (size_t)l * D;
    unsigned char* mixed = (unsigned char*)(F.ws + R_MIXED);
#pragma unroll
    for (int part = 0; part < 2; ++part) {
        const bf16* src = (const bf16*)(F.ws + (part ? R_SSMO : R_CONVO)) + (size_t)t * 512 + 8 * lane;
        const int gofs = part ? (DCONV + DATT) : 0;
        const v4u w = *(const v4u*)src; float x[8] = {bflo(w.x), bfhi(w.x), bflo(w.y), bfhi(w.y), bflo(w.z), bfhi(w.z), bflo(w.w), bfhi(w.w)};
        float s = 0.f;
#pragma unroll
        for (int c = 0; c < 8; ++c) s += x[c] * x[c];
        const float rr = 1.f / sqrtf(wave_sum(s) * (1.f / 512.f) + EPS);
        const f32x4 g0 = *(const f32x4*)(mg + gofs + 8 * lane), g1 = *(const f32x4*)(mg + gofs + 8 * lane + 4);
        v4u o; o.x = pk2(x[0] * rr * g0[0], x[1] * rr * g0[1]); o.y = pk2(x[2] * rr * g0[2], x[3] * rr * g0[3]); o.z = pk2(x[4] * rr * g1[0], x[5] * rr * g1[1]); o.w = pk2(x[6] * rr * g1[2], x[7] * rr * g1[3]);
        *(v4u*)(mixed + tix(S, t, 2 * (gofs + 8 * lane))) = o;
    }
    {
        const int h = lane >> 3; const float* gt = (const float*)(F.ws + R_GATES) + (size_t)t * 24 + 3 * h;
        const float gc = gt[0], gs = gt[1], gw = gt[2];
        const size_t off = (size_t)t * DATT + 16 * lane;
        const bf16* pc = (const bf16*)(F.ws + R_OC) + off; const bf16* ps = (const bf16*)(F.ws + R_OS) + off; const bf16* pw = (const bf16*)(F.ws + R_OW) + off;
        float x[16]; float s = 0.f;
#pragma unroll
        for (int hh = 0; hh < 2; ++hh) { const v4u a = *(const v4u*)(pc + 8 * hh), b = *(const v4u*)(ps + 8 * hh), c = *(const v4u*)(pw + 8 * hh);
            const unsigned aw[4] = {a.x, a.y, a.z, a.w}, bw[4] = {b.x, b.y, b.z, b.w}, cw[4] = {c.x, c.y, c.z, c.w};
#pragma unroll
            for (int i = 0; i < 4; ++i) { x[8 * hh + 2 * i] = gc * bflo(aw[i]) + gs * bflo(bw[i]) + gw * bflo(cw[i]); x[8 * hh + 2 * i + 1] = gc * bfhi(aw[i]) + gs * bfhi(bw[i]) + gw * bfhi(cw[i]); } }
#pragma unroll
        for (int c = 0; c < 16; ++c) s += x[c] * x[c];
        const float rr = 1.f / sqrtf(wave_sum(s) * (1.f / 1024.f) + EPS);
        const float* gp = mg + DCONV + 16 * lane;
        float gg[16];
#pragma unroll
        for (int c4 = 0; c4 < 4; ++c4) { const f32x4 v = *(const f32x4*)(gp + 4 * c4); gg[4 * c4] = v[0]; gg[4 * c4 + 1] = v[1]; gg[4 * c4 + 2] = v[2]; gg[4 * c4 + 3] = v[3]; }
        v4u o0, o1;
        o0.x = pk2(x[0] * rr * gg[0], x[1] * rr * gg[1]); o0.y = pk2(x[2] * rr * gg[2], x[3] * rr * gg[3]); o0.z = pk2(x[4] * rr * gg[4], x[5] * rr * gg[5]); o0.w = pk2(x[6] * rr * gg[6], x[7] * rr * gg[7]);
        o1.x = pk2(x[8] * rr * gg[8], x[9] * rr * gg[9]); o1.y = pk2(x[10] * rr * gg[10], x[11] * rr * gg[11]); o1.z = pk2(x[12] * rr * gg[12], x[13] * rr * gg[13]); o1.w = pk2(x[14] * rr * gg[14], x[15] * rr * gg[15]);
        *(v4u*)(mixed + tix(S, t, 2 * (DCONV + 16 * lane))) = o0; *(v4u*)(mixed + tix(S, t, 2 * (DCONV + 16 * lane + 8))) = o1;
    }
}

DEVI void norm_route_job(Frame& F, const float* g, const float* rw, int t, bool route) {
    const int lane = F.lane;
    const bf16* xrow = (const bf16*)(F.ws + WS_H) + (size_t)t * D;
    unsigned char* obase = (unsigned char*)(F.ws + WS_HN);
    f32x4 v[8]; float s = 0.f;
#pragma unroll
    for (int j = 0; j < 8; ++j) { v[j] = row_ld4<true>(xrow, 4 * lane + 256 * j); s += (v[j].x * v[j].x + v[j].y * v[j].y) + (v[j].z * v[j].z + v[j].w * v[j].w); }
    const float rr = 1.f / sqrtf(wave_sum(s) * (1.f / D) + EPS);
#pragma unroll
    for (int j = 0; j < 8; ++j) { const f32x4 gg = *(const f32x4*)(g + 4 * lane + 256 * j); v[j] = v[j] * rr * gg;
        *(unsigned*)((unsigned char*)(F.ws + R_HN8) + tix(S, t, 4 * lane + 256 * j)) = pk4_fp8(v[j].x, v[j].y, v[j].z, v[j].w); }
    if (!route) return;
    float lg[8];
#pragma unroll
    for (int e = 0; e < 8; ++e) lg[e] = 0.f;
#pragma unroll
    for (int j = 0; j < 8; ++j)
#pragma unroll
        for (int i = 0; i < 4; ++i) { const int k = 4 * lane + 256 * j + i; const f32x4 a = *(const f32x4*)(rw + (size_t)k * 8), b = *(const f32x4*)(rw + (size_t)k * 8 + 4); const float x = v[j][i];
            lg[0] += x * a[0]; lg[1] += x * a[1]; lg[2] += x * a[2]; lg[3] += x * a[3]; lg[4] += x * b[0]; lg[5] += x * b[1]; lg[6] += x * b[2]; lg[7] += x * b[3]; }
#pragma unroll
    for (int e = 0; e < 8; ++e) lg[e] = wave_sum(lg[e]);
    int e1 = 0; float v1 = lg[0];
#pragma unroll
    for (int e = 1; e < 8; ++e) if (lg[e] > v1) { v1 = lg[e]; e1 = e; }
    int e2 = -1; float v2 = -3.0e38f;
#pragma unroll
    for (int e = 0; e < 8; ++e) if (e != e1 && lg[e] > v2) { v2 = lg[e]; e2 = e; }
    const float p2 = __expf(v2 - v1), w1 = 1.f / (1.f + p2), w2 = p2 / (1.f + p2);
    if (lane < 2) {
        const int e = lane ? e2 : e1; const float w = lane ? w2 : w1;
        const unsigned slot = __hip_atomic_fetch_add((unsigned*)(F.ctl + CW_ECNT + 64 * e), 1u, RLX_AGENT);
        ((int*)(F.ws + WS_TOK + TOK_E))[2 * t + lane] = e; ((float*)(F.ws + WS_TOK + TOK_W))[2 * t + lane] = w; ((int*)(F.ws + WS_TOK + TOK_SLOT))[2 * t + lane] = (int)slot;
    }
}
DEVI void moe_prefix(Frame& F, int (&pe)[NE + 1]) {
    int acc = 0;
#pragma unroll
    for (int e = 0; e < NE; ++e) { pe[e] = acc; const unsigned c = __hip_atomic_load((unsigned*)(F.ctl + CW_ECNT + 64 * e), RLX_AGENT); acc += (int)((c + 255u) >> 8); }
    pe[NE] = acc;
}
DEVI void moe_gather_job(Frame& F, const int (&pe)[NE + 1], int job) {
    const int lane = F.lane, t = job >> 1;
    const int e = ((const int*)(F.ws + WS_TOK + TOK_E))[job], slot = ((const int*)(F.ws + WS_TOK + TOK_SLOT))[job];
    int p0 = 0;
#pragma unroll
    for (int k = 0; k < NE; ++k) p0 = (e == k) ? pe[k] : p0;
    const int row = p0 * 256 + slot;
    const unsigned char* src = (const unsigned char*)(F.ws + R_HN8); unsigned char* dst = (unsigned char*)(F.ws + M_ASORT);
#pragma unroll
    for (int i = 0; i < 4; ++i) { const int c8 = 8 * (lane + 64 * i); const v2u o = *(const v2u*)(src + tix(S, t, c8)); *(v2u*)(dst + tix(NPAD, row, c8)) = o; }
    if (lane == 0) { ((int*)(F.ws + WS_TOK + TOK_POS))[job] = row; ((float*)(F.ws + WS_TOK + TOK_RW))[row] = ((const float*)(F.ws + WS_TOK + TOK_W))[job]; }
}
DEVI void moe_combine_job(Frame& F, float* outp, const float* g, int t) {
    const int lane = F.lane;
    const bf16* xrow = (const bf16*)(F.ws + WS_H) + (size_t)t * D;
    const int r0 = ((const int*)(F.ws + WS_TOK + TOK_POS))[2 * t], r1 = ((const int*)(F.ws + WS_TOK + TOK_POS))[2 * t + 1];
    const bf16* y0 = (const bf16*)(F.ws + M_YS) + (size_t)r0 * D; const bf16* y1 = (const bf16*)(F.ws + M_YS) + (size_t)r1 * D;
    float* orow = outp + (size_t)t * D;
    f32x4 v[8]; float s = 0.f;
#pragma unroll
    for (int j = 0; j < 8; ++j) { const int c = 4 * lane + 256 * j; v[j] = row_ld4<true>(xrow, c);
        const v2u a = __builtin_nontemporal_load((const v2u*)(y0 + c)), b = __builtin_nontemporal_load((const v2u*)(y1 + c));
        v[j].x += bflo(a.x) + bflo(b.x); v[j].y += bfhi(a.x) + bfhi(b.x); v[j].z += bflo(a.y) + bflo(b.y); v[j].w += bfhi(a.y) + bfhi(b.y);
        s += (v[j].x * v[j].x + v[j].y * v[j].y) + (v[j].z * v[j].z + v[j].w * v[j].w); }
    const float rr = 1.f / sqrtf(wave_sum(s) * (1.f / D) + EPS);
#pragma unroll
    for (int j = 0; j < 8; ++j) { const int c = 4 * lane + 256 * j; const f32x4 gg = *(const f32x4*)(g + c); __builtin_nontemporal_store(v[j] * rr * gg, (f32x4*)(orow + c)); }
}

#ifndef REPV
#define REPV 0
#endif
#ifndef MK_N_LAUNCHES
#define MK_N_LAUNCHES 1
#endif
constexpr int N_PHASES = 25;

__global__ void __launch_bounds__(NTHR, 2) fwd_kernel(Args args) {
    extern __shared__ __attribute__((aligned(16))) unsigned char lds[];
    Frame F;
    F.lds = (LAS unsigned char*)lds;
    F.MISC = (volatile LAS unsigned*)(F.lds + MISC_OFF);
    F.tid = threadIdx.x; F.lane = F.tid & 63; F.wave = __builtin_amdgcn_readfirstlane(F.tid >> 6);
    F.G = gridDim.x; F.gw = blockIdx.x * NWAVES + F.wave; F.NGW = F.G * NWAVES;
    F.ws = args.ws; F.ctl = (gu32*)(args.ws + WS_CTL);
    if (F.tid < 38) ((const float**)(args.ws + CTL_TBL + (size_t)blockIdx.x * 512))[F.tid] = args.in[F.tid];
    unsigned char* ws = args.ws;
    for (int u = F.tid; u < (LDS_BYTES - LDSCTL_OFF) / 4; u += NTHR) ((LAS unsigned*)(F.lds + LDSCTL_OFF))[u] = 0u;
    __syncthreads();
    XcdBarrier bar = xcd_barrier_post((unsigned*)(F.ctl + CW_BAR) + args.li * XCD_BAR_WORDS, F.MISC + 8);
    const int lo = args.ph_lo, hi = args.ph_hi;
#define IN(k) (lo <= (k) && (k) < hi)
#ifdef PROBE_K
#define STAMP(i) do { if (blockIdx.x == 0 && threadIdx.x == 0) ((unsigned long long*)(args.ws + WS_CTL) + CW_DBG / 2)[(i)] = wall_clock64(); } while (0)
#else
#define STAMP(i) do { } while (0)
#endif
#define SEAM(k) do { if (IN(k) && IN((k) + 1)) xcd_barrier(bar); STAMP((k) + 1); } while (0)
    const int bx = blockIdx.x;
    STAMP(0);

#ifdef REP_PHASE
#define REPS(k) ((k) == REP_PHASE ? 1 + REP_N : 1)
#else
#define REPS(k) 1
#endif
#ifndef REPV
#define REPV 0
#endif
    for (int rep_ = 0; rep_ < REPS(0); ++rep_) if (IN(0)) { if (rep_) xcd_barrier(bar); F.ws = launder(args.ws); F.tid = vlaunder(threadIdx.x); F.lane = F.tid & 63; p0_prologue(F, rep_ ? REPV : 0); }
    SEAM(0);

#pragma unroll 1
    for (int l = 0; l < 2; ++l) {
        const int P = 1 + 12 * l;
#define PH(k) for (int rep_ = 0; rep_ < REPS(k); ++rep_) if (IN(k)) if ((rep_ == 0 || (xcd_barrier(bar), true)) && (F.ws = ws = launder(args.ws)) != nullptr && ((F.tid = vlaunder(threadIdx.x)), (F.lane = F.tid & 63), true))
        PH(P + 0) {
            pg8::Gemm g{(const bf16*)(ws + WS_HN), (const bf16*)(ws + R_WIN) + (size_t)l * 4096 * D, D, S, 4096};
            pg8::StaticOrder so; so.init(S, 4096, F.G, bx);
            if (rep_ && REPV == 1) { EpiBiasBf16 E2{(bf16*)(ws + R_ACT), 4096, F.in(IN_FNG)}; pg8::gemm_phase(F.lds + RING_OFF, g, so, E2); }
            else {
            EpiInProj E{(bf16*)(ws + R_CONVU), (bf16*)(ws + R_Q), (bf16*)(ws + R_KV), (bf16*)(ws + R_U)};
            pg8::gemm_phase(F.lds + RING_OFF, g, so, E); }
        }
        SEAM(P + 0);
        PH(P + 1) {
            if (!rep_ || REPV == 0 || REPV == 5)
            { pg8::Gemm g{(const bf16*)(ws + R_U), (const bf16*)(ws + R_TW) + (size_t)l * NGRP * 512 * 256, 256, 32768, 16384};
              Ssm1Order so{F.G, bx}; EpiSsm1 E{(float*)(ws + R_YINTRA), (float*)(ws + R_SC)};
              pg8::gemm_phase(F.lds + RING_OFF, g, so, E); }
            if (!rep_ || REPV == 0 || REPV == 1)
            for (int c = bx; c < 256; c += F.G) compress_job(F, l, c);
            const float* pGB = F.in(IN_GB); const int* pPOS = (const int*)F.in(IN_POS); const float* pDWW = F.in(IN_DWW); const float* pDWB = F.in(IN_DWB); const float* pLNG = F.in(IN_LNG); const float* pLNB = F.in(IN_LNB);
            for (int j = F.gw; j < 2048 + 4096 + 1024 + (rep_ ? 0 : S); j += F.NGW) {
                int r = j;
                if (r < 2048) { if (!rep_ || REPV == 0 || REPV == 2) vt_job(F, r); continue; } r -= 2048;
                if (r < 4096) { if (!rep_ || REPV == 0 || REPV == 3) dwconv_job(F, pDWW, pDWB, pLNG, pLNB, l, r); continue; } r -= 4096;
                if (r < 1024) { if (!rep_ || REPV == 0 || REPV == 4) gates_job(F, pGB, l, r); continue; } r -= 1024;
                rope_job(F, pPOS, r);
            }
        }
        SEAM(P + 1);
        PH(P + 2) {
            if (!rep_ || REPV == 0 || REPV == 1)
            { pg8::Gemm g{(const bf16*)(ws + R_CONVACT), (const bf16*)(ws + R_CPW) + (size_t)l * 512 * 512, 512, S, 512};
              pg8::StaticOrder so; so.init(S, 512, F.G, bx); EpiBiasBf16 E{(bf16*)(ws + R_CONVO), DCONV, F.in(IN_PWB) + l * DCONV};
              pg8::gemm_phase(F.lds + RING_OFF, g, so, E); }
            const bool scan_wave = (F.NGW >= 64) && (F.wave == 0) && (bx < 32);
            if (scan_wave) { if (!rep_ || REPV == 0 || REPV == 2) scan_job(F, l, bx); }
            else if (F.NGW < 64) { if (F.gw == 0) for (int gg = 0; gg < 32; ++gg) scan_job(F, l, gg); }
            const int nsw = (F.NGW >= 64) ? (bx < 32 ? bx + 1 : 32) : 0;
            if (!scan_wave) {
                const int NW = F.NGW - ((F.NGW >= 64) ? 32 : 0), w = F.gw - nsw;
                for (int k = 0; k * NW < 6144 + 8192; ++k) {
                    int r = k * NW + ((k & 1) ? NW - 1 - w : w);
                    if (r >= 6144 + 8192) continue;
                    if (r < 6144) { const int tile = 1023 - r / 6, kq = r % 6; if (kq < 2) { if (!rep_ || REPV == 0 || REPV == 3) cmp_stats_job(F, kq, tile); } else { if (!rep_ || REPV == 0 || REPV == 4) cmp_att_job2(F, tile, kq - 2); } continue; } r -= 6144;
                    if (!rep_ || REPV == 0 || REPV == 5) win_att_job8(F, r >> 3, r & 7);
                }
            }
        }
        SEAM(P + 2);
        PH(P + 3) {
            gu32* cnt2 = F.ctl + CW_SSM2 + l * 4 * 64;
            { pg8::Gemm g{(const bf16*)(ws + R_HPREV), (const bf16*)(ws + R_WO2) + (size_t)l * NGRP * 256 * 256, 256, 32768, 8192};
              Ssm2Order so{F.G, bx}; EpiSsm2 E{(const float*)(ws + R_YINTRA), (const bf16*)(ws + R_U), F.in(IN_SD) + l * DSSM, (bf16*)(ws + R_YSSM), (bf16*)(ws + R_GY)};
              pg8::gemm_phase(F.lds + RING_OFF, g, so, E);
              if (bx < 128) { VM_WAIT(); __syncthreads();
                  if (F.tid == 0) { __builtin_amdgcn_fence(__ATOMIC_RELEASE, "agent"); asm volatile("s_waitcnt vmcnt(0)" ::: "memory");
                      for (int L = bx; L < 128; L += F.G) __hip_atomic_fetch_add(cnt2 + 64 * (L & 3), 1u, RLX_AGENT); } } }
            if (F.G == 256) {
                const int x = bx & 7, g = x & 1, qbase = (x >> 1) * (S / 4), w = (bx >> 3) * NWAVES + F.wave;
                f32x4 iv = sel_imp_load(F, qbase + w, g);
                for (int i = 0; i < S / 4 / 256; ++i) { const int inx = (i + 1 < S / 4 / 256) ? i + 1 : i; const f32x4 ivn = sel_imp_load(F, qbase + inx * 256 + w, g);
                    sel_att_job(F, qbase + i * 256 + w, g, iv, rep_ ? REPV : 0); iv = ivn; }
            } else
            for (int j = F.gw; j < 2 * S; j += F.NGW) sel_att_job(F, S - 1 - (j >> 1), j & 1, sel_imp_load(F, S - 1 - (j >> 1), j & 1));
            for (int L2 = F.G - 1 - bx; L2 < 128; L2 += F.G) {
                const int pm = L2 >> 1, pn = L2 & 1;
                if (F.tid == 0) { unsigned sp = 0;
                    while (__hip_atomic_load(cnt2 + 64 * (pm >> 4), RLX_AGENT) < 32u) { __builtin_amdgcn_s_sleep(2);
                        if (++sp > (1u << 22)) { __hip_atomic_store(F.ctl + CW_SSM2 + 8 * 64, 1u, RLX_AGENT); break; } }
                    __builtin_amdgcn_fence(__ATOMIC_ACQUIRE, "agent"); asm volatile("s_waitcnt vmcnt(0)" ::: "memory"); }
                __syncthreads();
                pg8::Gemm g{(const bf16*)(ws + R_YSSM), (const bf16*)(ws + R_GLU) + (size_t)l * 512 * 512, 512, S, 512};
                OneUnit so{pm, pn}; EpiGlu E{(const bf16*)(ws + R_GY), F.in(IN_GLB) + l * DSSM, (bf16*)(ws + R_SSMO)};
                pg8::gemm_phase(F.lds + RING_OFF, g, so, E);
            }
        }
        SEAM(P + 3);
        PH(P + 5) { const float* pMOG = F.in(IN_MOG); for (int t = F.gw; t < S; t += F.NGW) mixnorm_job(F, pMOG, l, t); }
        SEAM(P + 5);
        PH(P + 6) {
            pg8::Gemm g{(const bf16*)(ws + R_MIXED), (const bf16*)(ws + R_WOUT) + (size_t)l * D * D, D, S, D};
            pg8::StaticOrder so; so.init(S, D, F.G, bx); EpiResid E{l == 0 ? (const void*)F.in(IN_X) : (const void*)(ws + WS_H), l != 0, (bf16*)(ws + WS_H), 1.f};
            pg8::gemm_phase(F.lds + RING_OFF, g, so, E);
        }
        SEAM(P + 6);
        PH(P + 7) { const float* gn = F.in(IN_NFG) + (size_t)l * D; const float* prw = F.in(IN_RW); for (int t = F.gw; t < S; t += F.NGW) norm_route_job(F, gn, prw, t, l == 1); }
        SEAM(P + 7);
        if (l == 0) {
            PH(P + 8) {
                pg8::Gemm g{(const bf16*)(ws + R_HN8), (const bf16*)(ws + R_FGU), D / 2, S, 2 * DFF};
                pg8::StaticOrder so; so.init(S, 2 * DFF, F.G, bx); EpiSwiglu8 E{(unsigned char*)(ws + R_ACT), S, 2 * DFF / 256};
                pg8::gemm_phase<EpiSwiglu8, pg8::StaticOrder, true, true, true, 0, true>(F.lds + RING_OFF, g, so, E);
            }
            SEAM(P + 8);
            PH(P + 9) {
                pg8::Gemm g{(const bf16*)(ws + R_ACT), (const bf16*)(ws + R_FD), DFF / 2, S, D};
                pg8::StaticOrder so; so.init(S, D, F.G, bx); EpiResid E{(const void*)(ws + WS_H), true, (bf16*)(ws + WS_H), 1.f / (MOE_WSCALE * MOE_ASCALE)};
                pg8::gemm_phase<EpiResid, pg8::StaticOrder, true, true, true, 0, true>(F.lds + RING_OFF, g, so, E);
            }
            SEAM(P + 9);
            PH(P + 10) { const float* gn = F.in(IN_NMG) + D; for (int t = F.gw; t < S; t += F.NGW) rms_row_to_bf16<true>((const bf16*)(ws + WS_H) + (size_t)t * D, gn, (unsigned char*)(ws + WS_HN), t, F.lane); }
            SEAM(P + 10);
            SEAM(P + 11);
        } else {
            PH(P + 8) { int pe[NE + 1]; moe_prefix(F, pe); for (int j = F.gw; j < 2 * S; j += F.NGW) moe_gather_job(F, pe, j); }
            SEAM(P + 8);
            PH(P + 9) {
                MoeOrder mo; moe_prefix(F, mo.pe); mo.nct = 2 * DFFE / 256; mo.so.init(mo.pe[NE] * 256, 2 * DFFE, F.G, bx);
                pg8::Gemm g{(const bf16*)(ws + M_ASORT), (const bf16*)(ws + WS_MOE_GU), D / 2, NPAD, NE * 2 * DFFE};
                EpiSwiglu8 E{(unsigned char*)(ws + M_ACTS), NPAD, 2 * DFFE / 256};
#if defined(REP_PHASE) && REPV == 1
                if (rep_) { EpiSwiglu8 E2{(unsigned char*)(ws + M_ACTS + 238 * MiB), NPAD, 2 * DFFE / 256}; pg8::gemm_phase<EpiSwiglu8, MoeOrder, true, true, true, 1>(F.lds + RING_OFF, g, mo, E2); } else
#elif defined(REP_PHASE) && REPV == 2
                if (rep_) { EpiSwiglu8 E2{(unsigned char*)(ws + M_ACTS + 238 * MiB), NPAD, 2 * DFFE / 256}; pg8::gemm_phase<EpiSwiglu8, MoeOrder, true, true, true, 2>(F.lds + RING_OFF, g, mo, E2); } else
#endif
                pg8::gemm_phase<EpiSwiglu8, MoeOrder, true, true, true>(F.lds + RING_OFF, g, mo, E);
            }
            SEAM(P + 9);
            PH(P + 10) {
                MoeOrder mo; moe_prefix(F, mo.pe); mo.nct = D / 256; mo.so.init(mo.pe[NE] * 256, D, F.G, bx);
                const int units = mo.pe[NE] * (D / 256), full = (F.G == 256) ? units / 256 : (1 << 30), T = (F.G == 256) ? units - full * 256 : 0;
                mo.imax = full;
                pg8::Gemm g{(const bf16*)(ws + M_ACTS), (const bf16*)(ws + WS_MOE_D), DFFE / 2, NPAD, NE * D};
                const float oscale = 1.f / (MOE_WSCALE * MOE_ASCALE);
                EpiMoeDown E{(bf16*)(ws + M_YS), (const float*)(ws + WS_TOK + TOK_RW), oscale};
                pg8::gemm_phase<EpiMoeDown, MoeOrder, true, true, true>(F.lds + RING_OFF, g, mo, E);
                if (T > 0) {
                    const int ns = (T <= 36) ? 7 : 4, kt = (DFFE / 128) / ns;
                    if (bx < T * ns) {
                        const int u = bx / ns, sl = bx - u * ns;
                        Unit uu; mo.at((long)full * 256 + u, uu);
                        float* part = (float*)(ws + M_ASORT) + (size_t)(u * ns) * 65536;
                        pg8::Gemm gs{(const bf16*)((const unsigned char*)(ws + M_ACTS) + (size_t)sl * kt * NPAD * 128), (const bf16*)((const unsigned char*)(ws + WS_MOE_D) + (size_t)sl * kt * (NE * D) * 128), kt * 64, NPAD, NE * D};
                        OneUnit ou{uu.pm, uu.pn}; EpiMoePart EP{part + (size_t)sl * 65536};
                        pg8::gemm_phase<EpiMoePart, OneUnit, true, true, true>(F.lds + RING_OFF, gs, ou, EP);
                        VM_WAIT(); __syncthreads();
                        if (F.tid == 0) { __builtin_amdgcn_fence(__ATOMIC_RELEASE, "agent"); asm volatile("s_waitcnt vmcnt(0)" ::: "memory");
                            __hip_atomic_fetch_add(F.ctl + CW_TAIL + 64 * u, 1u, RLX_AGENT);
                            unsigned sp = 0;
                            while (__hip_atomic_load(F.ctl + CW_TAIL + 64 * u, RLX_AGENT) < (unsigned)ns) { __builtin_amdgcn_s_sleep(2);
                                if (++sp > (1u << 22)) { __hip_atomic_store(F.ctl + CW_SSM2 + 8 * 64, 1u, RLX_AGENT); break; } }
                            __builtin_amdgcn_fence(__ATOMIC_ACQUIRE, "agent"); asm volatile("s_waitcnt vmcnt(0)" ::: "memory"); }
                        __syncthreads();
                        {
                            const float* rwp = (const float*)(ws + WS_TOK + TOK_RW); bf16* O = (bf16*)(ws + M_YS);
                            const int per = (256 * 32 + ns - 1) / ns, i0 = sl * per, i1 = (i0 + per < 256 * 32) ? i0 + per : 256 * 32;
                            for (int it = i0 + F.tid; it < i1; it += NTHR) {
                                const int row = it >> 5, c8 = (it & 31) * 8; const float* p = part + (size_t)row * 256 + c8;
                                f32x4 va[7], vb[7];
#pragma unroll
                                for (int k = 0; k < 7; ++k) { const float* pk = p + (size_t)(k < ns ? k : 0) * 65536; va[k] = *(const f32x4*)pk; vb[k] = *(const f32x4*)(pk + 4); }
                                f32x4 a = va[0], b = vb[0];
#pragma unroll
                                for (int k = 1; k < 7; ++k) if (k < ns) { a = a + va[k]; b = b + vb[k]; }
                                const int grow = uu.pm * 256 + row; const float sc = rwp[grow] * oscale;
                                v4u w; w.x = pg8::cvt_pk_bf16(a[0] * sc, a[1] * sc); w.y = pg8::cvt_pk_bf16(a[2] * sc, a[3] * sc); w.z = pg8::cvt_pk_bf16(b[0] * sc, b[1] * sc); w.w = pg8::cvt_pk_bf16(b[2] * sc, b[3] * sc);
                                *(v4u*)(O + (size_t)grow * D + (uu.pn & 7) * 256 + c8) = w;
                            }
                        }
                    }
                }
            }
            SEAM(P + 10);
            PH(P + 11) { const float* pFNG = F.in(IN_FNG); for (int t = F.gw; t < S; t += F.NGW) moe_combine_job(F, args.out, pFNG, t); }
        }
    }
#ifdef PROBE_K
    xcd_barrier(bar); STAMP(25);
    xcd_barrier(bar);
    { const unsigned long long* T = (const unsigned long long*)(args.ws + WS_CTL) + CW_DBG / 2;
      const float d1 = (float)(T[PROBE_K + 1] - T[PROBE_K]) * 0.01f, d2 = (float)(T[PROBE_K + 2] - T[PROBE_K + 1]) * 0.01f;
      const float c1 = sqrtf(d1), c2 = 10.f * d2;
      for (size_t i = (size_t)blockIdx.x * NTHR + threadIdx.x; i < (size_t)S * D; i += (size_t)gridDim.x * NTHR) args.out[i] = (i == 0) ? c2 : c1; }
#endif
#undef IN
#undef PH
#undef REPS
#undef SEAM
}

extern "C" void kernel_launch(void* const* d_in, const int* in_sizes, int n_in, void* d_out, int out_size, void* d_ws, size_t ws_size, hipStream_t stream) {
    static int grid = 0;
    if (grid == 0) {
        if (n_in != 38 || out_size != S * D || ws_size < WS_END) { fprintf(stderr, "kernel_launch: unexpected problem shape (n_in %d, out %d, ws %zu < %zu)\n", n_in, out_size, ws_size, (size_t)WS_END); grid = -1; return; }
        int dev = 0, cus = 0, per_cu = 0;
        if (hipGetDevice(&dev) != hipSuccess || hipDeviceGetAttribute(&cus, hipDeviceAttributeMultiprocessorCount, dev) != hipSuccess) { grid = -1; return; }
        if (hipFuncSetAttribute((const void*)fwd_kernel, hipFuncAttributeMaxDynamicSharedMemorySize, LDS_BYTES) != hipSuccess) { fprintf(stderr, "kernel_launch: hipFuncSetAttribute failed\n"); grid = -1; return; }
        if (hipOccupancyMaxActiveBlocksPerMultiprocessor(&per_cu, (const void*)fwd_kernel, NTHR, LDS_BYTES) != hipSuccess || per_cu < 1)
            fprintf(stderr, "kernel_launch: note: occupancy query says %d\n", per_cu);
        (void)hipGetLastError();
        grid = cus;
    }
    if (grid < 0) return;
    if (hipMemsetAsync((char*)d_ws + WS_CTL, 0, CTL_ZERO_BYTES, stream) != hipSuccess) return;
    Args a{};
    for (int i = 0; i < 38; ++i) a.in[i] = (const float*)d_in[i];
    a.out = (float*)d_out; a.ws = (unsigned char*)d_ws; a.dbg = 0;
    constexpr int NL = MK_N_LAUNCHES;
    for (int li = 0; li < NL; ++li) {
        a.ph_lo = (NL == 1) ? 0 : li; a.ph_hi = (NL == 1) ? N_PHASES : li + 1; a.li = li;
        hipLaunchKernelGGL(fwd_kernel, dim3(grid), dim3(NTHR), LDS_BYTES, stream, a);
        const hipError_t le = hipPeekAtLastError();
        if (le != hipSuccess) { fprintf(stderr, "kernel_launch: launch %d failed: %s\n", li, hipGetErrorName(le)); break; }
    }
}
```

```cpp
#include <hip/hip_runtime.h>
#include <cstdio>
#include <cstdint>

namespace pg8 {
#define PG8_LAS __attribute__((address_space(3)))
typedef unsigned short bf16_t;
typedef short bf16x8 __attribute__((ext_vector_type(8)));
typedef float f32x4 __attribute__((ext_vector_type(4)));
typedef unsigned u32x4 __attribute__((ext_vector_type(4)));
typedef unsigned u32x2 __attribute__((ext_vector_type(2)));
constexpr int BM = 256, BK = 64, HALF = 128, HTB = HALF * BK * 2, STAGE_BYTES = 8 * HTB, NXCD = 8, WGM = 8;

__host__ __device__ __forceinline__ int lds_byte(int r, int c) { const int st = (r >> 4) * 2 + (c >> 5), rr = r & 15, cc = c & 31, ob = rr * 64 + cc * 2; return st * 1024 + (ob ^ (((ob >> 9) & 1) << 5)); }
__host__ __device__ __forceinline__ void stage_rc(int b, int& R, int& C) { const int st = b / 1024, sb = b % 1024, swz = sb ^ (((sb >> 9) & 1) << 5); R = (st >> 1) * 16 + swz / 64; C = (st & 1) * 32 + (swz % 64) / 2; }
__host__ __device__ __forceinline__ int g_swz(int r) { const int x = (r >> 1) & 7; return (((0x1320 >> (4 * (x >> 1))) & 3) << 1) | (x & 1); }
__host__ __device__ __forceinline__ int lds_off(int r, int c) { return (r >> 3) * 1024 + (r & 7) * 128 + ((c ^ g_swz(r & 15)) << 4); }
__host__ __device__ __forceinline__ void stage_rc2(int p16, int& R, int& CH) { const int s = p16 >> 6, L = p16 & 63; R = s * 8 + (L >> 3); CH = (L & 7) ^ g_swz(R & 15); }
__host__ __device__ __forceinline__ int perm32(int rho) { const int n = rho >> 4, i = rho & 15; return 8 * (i >> 2) + 4 * n + (i & 3); }

struct Unit { int pm, pn; };
struct Gemm { const bf16_t* A; const bf16_t* Bt; int K, nra, nrb; };

struct StaticOrder {
    int nM, nN, nwg, G, c;
    __host__ __device__ void init(int M, int N, int G_, int c_) { nM = M / BM; nN = N / BM; nwg = nM * nN; G = G_; c = c_; }
    __host__ __device__ bool next(int i, Unit& u) const { return at((long)i * G + c, u); }
    __host__ __device__ bool at(const long L, Unit& u) const {
        if (L >= nwg) return false;
        int wgid = (int)L; { const int q = nwg / NXCD, r = nwg % NXCD, xcd = wgid % NXCD, off = wgid / NXCD; wgid = (xcd < r ? xcd * (q + 1) : r * (q + 1) + (xcd - r) * q) + off; }
        const int nig = WGM * nN, gid = wgid / nig, fm = gid * WGM, gsz = (nM - fm) < WGM ? (nM - fm) : WGM;
        u.pm = fm + ((wgid % nig) % gsz); u.pn = (wgid % nig) / gsz; return true;
    }
};

__device__ __forceinline__ unsigned cvt_pk_bf16(float lo, float hi) { unsigned r; asm volatile("v_cvt_pk_bf16_f32 %0, %1, %2" : "=v"(r) : "v"(lo), "v"(hi)); return r; }

typedef int v8i_t __attribute__((ext_vector_type(8)));
typedef int v4i_t __attribute__((ext_vector_type(4)));
__device__ __forceinline__ v8i_t cat8(bf16x8 lo, bf16x8 hi) { const v4i_t a = __builtin_bit_cast(v4i_t, lo), b = __builtin_bit_cast(v4i_t, hi); return __builtin_shufflevector(a, b, 0, 1, 2, 3, 4, 5, 6, 7); }
template <class Epi, class Sched, bool ALIGN_EPI = true, bool SP2 = true, bool FP8 = false, int PROBE = 0, bool RECOMP = false>
__device__ __forceinline__ void gemm_phase(PG8_LAS unsigned char* lds, const Gemm g, const Sched& S, const Epi& E) {
    int tid_ = threadIdx.x; asm volatile("" : "+v"(tid_));
    const int tid = tid_, wid = __builtin_amdgcn_readfirstlane(tid >> 6), lane = tid & 63, wr = wid >> 2, wc = wid & 3, fr = lane & 15, fq = lane >> 4;
    const int K = g.K, nt = K / BK;
    unsigned voffA[2], voffB[2];
#pragma unroll
    for (int i = 0; i < 2; ++i) { int R, CH; stage_rc2(tid + i * 512, R, CH); const int Rb = Epi::PERM ? ((R & ~31) + perm32(R & 31)) : R;
        voffA[i] = (unsigned)(R * 128 + CH * 16); voffB[i] = (unsigned)(Rb * 128 + CH * 16); }
    const unsigned kstepA = (unsigned)g.nra * 128u, kstepB = (unsigned)g.nrb * 128u;
    const unsigned hstepA = HALF * 128u, hstepB = HALF * 128u;
    const unsigned tstepA = 2 * hstepA, tstepB = 2 * hstepB;
    const unsigned ldsw = (unsigned)wid * 1024u;
    const int aoffk0 = lds_off(wr * 64 + fr, FP8 ? 2 * fq : fq), aoffk1 = FP8 ? (aoffk0 ^ 16) : lds_off(wr * 64 + fr, fq + 4);
    const int boffk0 = lds_off(wc * 32 + fr, FP8 ? 2 * fq : fq), boffk1 = FP8 ? (boffk0 ^ 16) : lds_off(wc * 32 + fr, fq + 4);
#define PG8_SA(b, h) (((b) * 2 + (h)) * HTB)
#define PG8_SB(b, h) ((4 + (b) * 2 + (h)) * HTB)
#define PG8_STAGE(bufoff, goff, voff) do { const bool isB_ = (&(voff)[0] == &voffB[0]); \
        if constexpr (RECOMP) { int t2_ = tid; asm volatile("" : "+v"(t2_));     \
            _Pragma("unroll") for (int _i = 0; _i < 2; ++_i) { int R_, C_; stage_rc2(t2_ + _i * 512, R_, C_); const int Rr_ = (isB_ && Epi::PERM) ? ((R_ & ~31) + perm32(R_ & 31)) : R_; \
                __builtin_amdgcn_raw_ptr_buffer_load_lds(isB_ ? rsrcB : rsrcA, (PG8_LAS void*)(lds + (bufoff) + ldsw + _i * 8192), 16, Rr_ * 128 + C_ * 16, (int)(goff), 0, 0); } } \
        else { _Pragma("unroll") for (int _i = 0; _i < 2; ++_i) \
        __builtin_amdgcn_raw_ptr_buffer_load_lds(isB_ ? rsrcB : rsrcA, (PG8_LAS void*)(lds + (bufoff) + ldsw + _i * 8192), 16, (int)(voff)[_i], (int)(goff), 0, 0); } } while (0)
#define PG8_LDA(dst, b, h) do { if constexpr (PROBE == 2) break; _Pragma("unroll") for (int m = 0; m < 4; ++m) { if constexpr (FP8) dst##8[m] = cat8(*(const PG8_LAS bf16x8*)(lds + PG8_SA(b, h) + aoffk0 + m * 2048), *(const PG8_LAS bf16x8*)(lds + PG8_SA(b, h) + aoffk1 + m * 2048)); \
        else { dst[m][0] = *(const PG8_LAS bf16x8*)(lds + PG8_SA(b, h) + aoffk0 + m * 2048); dst[m][1] = *(const PG8_LAS bf16x8*)(lds + PG8_SA(b, h) + aoffk1 + m * 2048); } } } while (0)
#define PG8_LDB(dst, b, h) do { if constexpr (PROBE == 2) break; _Pragma("unroll") for (int n = 0; n < 2; ++n) { if constexpr (FP8) dst##8[n] = cat8(*(const PG8_LAS bf16x8*)(lds + PG8_SB(b, h) + boffk0 + n * 2048), *(const PG8_LAS bf16x8*)(lds + PG8_SB(b, h) + boffk1 + n * 2048)); \
        else { dst[n][0] = *(const PG8_LAS bf16x8*)(lds + PG8_SB(b, h) + boffk0 + n * 2048); dst[n][1] = *(const PG8_LAS bf16x8*)(lds + PG8_SB(b, h) + boffk1 + n * 2048); } } } while (0)
#define PG8_MMA(ai, bj, At, Bt) do { if constexpr (PROBE == 1) { _Pragma("unroll") for (int m = 0; m < 4; ++m) asm volatile("" :: "v"(At##8[m])); _Pragma("unroll") for (int n = 0; n < 2; ++n) asm volatile("" :: "v"(Bt##8[n])); break; } __builtin_amdgcn_s_setprio(1); _Pragma("unroll") for (int m = 0; m < 4; ++m) _Pragma("unroll") for (int n = 0; n < 2; ++n) { \
        if constexpr (FP8) acc[ai][bj][m][n] = __builtin_amdgcn_mfma_scale_f32_16x16x128_f8f6f4(Bt##8[n], At##8[m], acc[ai][bj][m][n], 0, 0, 0, 0x7F7F7F7F, 0, 0x7F7F7F7F); \
        else { _Pragma("unroll") for (int k = 0; k < 2; ++k) acc[ai][bj][m][n] = __builtin_amdgcn_mfma_f32_16x16x32_bf16(Bt[n][k], At[m][k], acc[ai][bj][m][n], 0, 0, 0); } } __builtin_amdgcn_s_setprio(0); } while (0)
#define PG8_WAIT_V(n) asm volatile("s_waitcnt vmcnt(" #n ")" ::: "memory")
#define PG8_WAIT_L(n) asm volatile("s_waitcnt lgkmcnt(" #n ")" ::: "memory")
#define PG8_BAR __builtin_amdgcn_s_barrier()
#define PG8_SCHED __builtin_amdgcn_sched_barrier(0)
    Unit cur, nxt; int ui = 0;
    if (!S.next(0, cur)) return;
    f32x4 acc[2][2][4][2];
#pragma unroll
    for (int a = 0; a < 2; ++a)
#pragma unroll
        for (int b = 0; b < 2; ++b)
#pragma unroll
            for (int m = 0; m < 4; ++m)
#pragma unroll
                for (int n = 0; n < 2; ++n) acc[a][b][m][n] = (f32x4){0.f, 0.f, 0.f, 0.f};
    bf16x8 At[4][2], B0[2][2], B1[2][2]; v8i_t At8[4], B08[2], B18[2];
    if constexpr (PROBE == 2) { _Pragma("unroll") for (int m = 0; m < 4; ++m) { At8[m] = (v8i_t){0x3a3b3c3d + tid, 0x38393a3b, 0x3c3d3e3f, 0x40414243, 0x34353637, 0x3b3c3d3e, 0x39383736, 0x3d3c3b3a}; asm volatile("" : "+v"(At8[m])); }
        _Pragma("unroll") for (int n = 0; n < 2; ++n) { B08[n] = At8[n]; B18[n] = At8[n + 2]; asm volatile("" : "+v"(B08[n]), "+v"(B18[n])); } }
    const __amdgpu_buffer_rsrc_t rsrcA = __builtin_amdgcn_make_buffer_rsrc((void*)g.A, 0, 0x7ffff000, 0x00020000), rsrcB = __builtin_amdgcn_make_buffer_rsrc((void*)g.Bt, 0, 0x7ffff000, 0x00020000);
    unsigned cA = (unsigned)cur.pm * (unsigned)tstepA, cB = (unsigned)cur.pn * (unsigned)tstepB;
    if constexpr (SP2) {
        PG8_STAGE(PG8_SB(0, 0), cB, voffB); PG8_STAGE(PG8_SB(0, 1), cB + hstepB, voffB); PG8_STAGE(PG8_SA(0, 0), cA, voffA); PG8_STAGE(PG8_SA(0, 1), cA + hstepA, voffA);
        if (wr == 1) PG8_BAR;
        PG8_WAIT_V(2); PG8_BAR;
        PG8_STAGE(PG8_SB(1, 0), cB + kstepB, voffB); PG8_STAGE(PG8_SA(1, 0), cA + kstepA, voffA); PG8_STAGE(PG8_SB(1, 1), cB + hstepB + kstepB, voffB);
        PG8_WAIT_V(6); PG8_BAR;
    } else {
        PG8_STAGE(PG8_SB(0, 0), cB, voffB); PG8_STAGE(PG8_SA(0, 0), cA, voffA); PG8_STAGE(PG8_SB(0, 1), cB + hstepB, voffB); PG8_STAGE(PG8_SA(0, 1), cA + hstepA, voffA);
        if (wr == 1) PG8_BAR;
        PG8_WAIT_V(4); PG8_BAR;
        PG8_STAGE(PG8_SB(1, 0), cB + kstepB, voffB); PG8_STAGE(PG8_SA(1, 0), cA + kstepA, voffA); PG8_STAGE(PG8_SB(1, 1), cB + hstepB + kstepB, voffB);
        PG8_WAIT_V(6); PG8_BAR;
    }
    for (;;) {
        const bool has_next = S.next(ui + 1, nxt);
        const unsigned nA = has_next ? (unsigned)nxt.pm * (unsigned)tstepA : cA, nB = has_next ? (unsigned)nxt.pn * (unsigned)tstepB : cB;
#pragma unroll 1
        for (int t = 0; t < nt; t += 2) {
            const bool last = (t == nt - 2);
            const unsigned a1 = cA + (unsigned)(t + 1) * kstepA;
            const unsigned a2 = last ? nA : cA + (unsigned)(t + 2) * kstepA, b2 = last ? nB : cB + (unsigned)(t + 2) * kstepB;
            const unsigned a3 = a2 + kstepA, b3 = b2 + kstepB;
            if constexpr (SP2) {
            PG8_LDB(B0, 0, 0); PG8_LDB(B1, 0, 1); PG8_SCHED; PG8_LDA(At, 0, 0); PG8_STAGE(PG8_SA(1, 1), a1 + hstepA, voffA);
            PG8_WAIT_V(8); PG8_WAIT_L(0); PG8_BAR; PG8_MMA(0, 0, At, B0); PG8_MMA(0, 1, At, B1); PG8_BAR; PG8_SCHED;
            PG8_LDA(At, 0, 1); PG8_STAGE(PG8_SB(0, 0), b2, voffB); PG8_STAGE(PG8_SB(0, 1), b2 + hstepB, voffB); PG8_STAGE(PG8_SA(0, 0), a2, voffA);
            PG8_WAIT_V(8); PG8_WAIT_L(0); PG8_BAR; PG8_MMA(1, 0, At, B0); PG8_MMA(1, 1, At, B1); PG8_BAR; PG8_SCHED;
            PG8_LDB(B0, 1, 0); PG8_LDB(B1, 1, 1); PG8_SCHED; PG8_LDA(At, 1, 0); PG8_STAGE(PG8_SA(0, 1), a2 + hstepA, voffA);
            PG8_WAIT_V(8); PG8_WAIT_L(0); PG8_BAR; PG8_MMA(0, 0, At, B0); PG8_MMA(0, 1, At, B1); PG8_BAR; PG8_SCHED;
            PG8_LDA(At, 1, 1); PG8_STAGE(PG8_SB(1, 0), b3, voffB); PG8_STAGE(PG8_SB(1, 1), b3 + hstepB, voffB); PG8_STAGE(PG8_SA(1, 0), a3, voffA);
            PG8_WAIT_V(8); PG8_WAIT_L(0); PG8_BAR; PG8_MMA(1, 0, At, B0); PG8_MMA(1, 1, At, B1); PG8_BAR; PG8_SCHED;
            } else {
            PG8_LDB(B0, 0, 0); PG8_SCHED; PG8_LDA(At, 0, 0); PG8_STAGE(PG8_SA(1, 1), a1 + hstepA, voffA);
            PG8_WAIT_L(8); PG8_BAR; PG8_WAIT_L(0); PG8_MMA(0, 0, At, B0); PG8_BAR; PG8_SCHED;
            PG8_LDB(B1, 0, 1); PG8_STAGE(PG8_SB(0, 0), b2, voffB);
            PG8_BAR; PG8_WAIT_L(0); PG8_MMA(0, 1, At, B1); PG8_BAR;
            PG8_LDA(At, 0, 1); PG8_STAGE(PG8_SA(0, 0), a2, voffA);
            PG8_BAR; PG8_WAIT_L(0); PG8_MMA(1, 0, At, B0); PG8_BAR; PG8_SCHED;
            PG8_STAGE(PG8_SB(0, 1), b2 + hstepB, voffB);
            PG8_WAIT_V(6); PG8_BAR; PG8_MMA(1, 1, At, B1); PG8_BAR;
            PG8_LDB(B0, 1, 0); PG8_SCHED; PG8_LDA(At, 1, 0); PG8_STAGE(PG8_SA(0, 1), a2 + hstepA, voffA);
            PG8_WAIT_L(8); PG8_BAR; PG8_WAIT_L(0); PG8_MMA(0, 0, At, B0); PG8_BAR; PG8_SCHED;
            PG8_LDB(B1, 1, 1); PG8_STAGE(PG8_SB(1, 0), b3, voffB);
            PG8_BAR; PG8_WAIT_L(0); PG8_MMA(0, 1, At, B1); PG8_BAR;
            PG8_LDA(At, 1, 1); PG8_STAGE(PG8_SA(1, 0), a3, voffA);
            PG8_BAR; PG8_WAIT_L(0); PG8_MMA(1, 0, At, B0); PG8_BAR; PG8_SCHED;
            PG8_STAGE(PG8_SB(1, 1), b3 + hstepB, voffB);
            PG8_WAIT_V(6); PG8_BAR; PG8_MMA(1, 1, At, B1); PG8_BAR;
            }
        }
        if constexpr (ALIGN_EPI) { if (wr == 0) PG8_BAR; }
        E(acc, cur, wr, wc, fr, fq);
        if (!has_next) break;
#pragma unroll
        for (int a = 0; a < 2; ++a)
#pragma unroll
            for (int b = 0; b < 2; ++b)
#pragma unroll
                for (int m = 0; m < 4; ++m)
#pragma unroll
                    for (int n = 0; n < 2; ++n) acc[a][b][m][n] = (f32x4){0.f, 0.f, 0.f, 0.f};
        cur = nxt; cA = nA; cB = nB; ++ui;
        if constexpr (ALIGN_EPI) { if (wr == 1) PG8_BAR; }
    }
    PG8_WAIT_V(0);
    if constexpr (!ALIGN_EPI) { if (wr == 0) PG8_BAR; }
    PG8_BAR;
#undef PG8_SA
#undef PG8_SB
#undef PG8_STAGE
#undef PG8_LDA
#undef PG8_LDB
#undef PG8_MMA
#undef PG8_WAIT_V
#undef PG8_WAIT_L
#undef PG8_BAR
#undef PG8_SCHED
}
}

constexpr int S = 16384, D = 2048, DIN = 4120, DCONV = 512, DATT = 1024, DSSM = 512;
constexpr int NH = 8, NKV = 2, HD = 128, NCMP = 1023, NSB = 256, CONVW = 31;
constexpr int DFF = 5632, NE = 8, DFFE = 7168, NGRP = 32, PST = 64;
constexpr int NPAD = 2 * S + NE * 256;
constexpr float EPS = 1e-5f;
constexpr int NWAVES = 8, NTHR = 512;

constexpr size_t MiB = 1u << 20;
constexpr size_t WS_CTL = 0, CTL_ZERO_BYTES = 1 * MiB;
constexpr size_t WS_H = 1 * MiB;
constexpr size_t WS_HN = WS_H + 128 * MiB;
constexpr size_t WS_MOE_GU = WS_HN + 64 * MiB;
constexpr size_t WS_MOE_D = WS_MOE_GU + 448 * MiB;
constexpr size_t WS_TOK = WS_MOE_D + 224 * MiB;
constexpr size_t WS_R = WS_TOK + 1 * MiB;
constexpr size_t R_WIN = WS_R;
constexpr size_t R_WOUT = R_WIN + 32 * MiB;
constexpr size_t R_WG = R_WOUT + 16 * MiB;
constexpr size_t R_CPW = R_WG + 1 * MiB;
constexpr size_t R_GLU = R_CPW + 1 * MiB;
constexpr size_t R_W1K = R_GLU + 1 * MiB;
constexpr size_t R_W1V = R_W1K + 2 * MiB;
constexpr size_t R_W2 = R_W1V + 2 * MiB;
constexpr size_t R_CB = R_W2 + 1 * MiB;
constexpr size_t R_TW = R_CB + 1 * MiB;
constexpr size_t R_WO2 = R_TW + 16 * MiB;
constexpr size_t R_FGU = R_WO2 + 8 * MiB;
constexpr size_t R_FD = R_FGU + 44 * MiB;
constexpr size_t R_CONVU = R_FD + 22 * MiB;
constexpr size_t R_Q = R_CONVU + 16 * MiB;
constexpr size_t R_QR = R_Q + 32 * MiB;
constexpr size_t R_KV = R_QR + 32 * MiB;
constexpr size_t R_VST = R_KV + 48 * MiB;
constexpr size_t R_VWT = R_VST + 8 * MiB;
constexpr size_t R_KC = R_VWT + 8 * MiB;
constexpr size_t R_VCT = R_KC + 1 * MiB;
constexpr size_t R_U = R_VCT + 1 * MiB;
constexpr size_t R_GATES = R_U + 16 * MiB;
constexpr size_t R_CONVACT = R_GATES + 2 * MiB;
constexpr size_t R_IMP = R_CONVACT + 16 * MiB;
constexpr size_t R_OC = R_IMP + 32 * MiB;
constexpr size_t R_OW = R_OC + 32 * MiB;
constexpr size_t R_OS = R_OW + 32 * MiB;
constexpr size_t R_CONVO = R_OS + 32 * MiB;
constexpr size_t R_SSMO = R_CONVO + 16 * MiB;
constexpr size_t R_YINTRA = R_SSMO + 16 * MiB;
constexpr size_t R_SC = R_YINTRA + 32 * MiB;
constexpr size_t R_HPREV = R_SC + 16 * MiB;
constexpr size_t R_YSSM = R_HPREV + 16 * MiB;
constexpr size_t R_GY = R_YSSM + 16 * MiB;
constexpr size_t R_MIXED = R_GY + 16 * MiB;
constexpr size_t R_ACT = R_MIXED + 64 * MiB;
constexpr size_t R_KSF = R_ACT + 176 * MiB;
constexpr size_t R_KWF = R_KSF + 8 * MiB;
constexpr size_t R_KS8 = R_KWF + 8 * MiB;
constexpr size_t R_VS8 = R_KS8 + 4 * MiB;
constexpr size_t R_HN8 = R_VS8 + 4 * MiB;
constexpr size_t R_END = R_HN8 + 32 * MiB;
constexpr size_t R_IMP2 = R_ACT;
constexpr size_t R_KW8 = R_KSF;
constexpr size_t R_VW8 = R_VST;
constexpr size_t M_ASORT = WS_R;
constexpr size_t M_ACTS = M_ASORT + 136 * MiB;
constexpr size_t M_YS = M_ACTS + 476 * MiB;
constexpr size_t M_END = M_YS + 136 * MiB;
constexpr size_t WS_END = R_END > M_END ? R_END : M_END;
static_assert((size_t)NPAD * D * 2 <= 136 * MiB && (size_t)NPAD * DFFE * 2 <= 476 * MiB, "moe buffers");
static_assert(WS_END <= 1792 * MiB, "workspace map must fit 4x the largest input tensor");
constexpr size_t TOK_E = 0;
constexpr size_t TOK_W = 128 * 1024;
constexpr size_t TOK_SLOT = 256 * 1024;
constexpr size_t TOK_POS = 384 * 1024;
constexpr size_t TOK_RW = 512 * 1024;
constexpr int CW_BAR = 4096;
constexpr int CW_ECNT = 131072;
constexpr int CW_DBG = 140000;
constexpr int CW_JOBQ = 137216;
constexpr int CW_TAIL = 133120;
constexpr int CW_SSM2 = 132096;

constexpr int RING_OFF = 0, RING_BYTES = 131072;
constexpr int LDSCTL_OFF = RING_BYTES, MISC_OFF = LDSCTL_OFF + 320;
constexpr int LDS_BYTES = 147456;

#define GAS __attribute__((address_space(1)))
#define LAS __attribute__((address_space(3)))
#define DEVI __device__ __forceinline__
typedef unsigned short bf16;
typedef unsigned v4u __attribute__((ext_vector_type(4)));
typedef unsigned v2u __attribute__((ext_vector_type(2)));
typedef float f32x4 __attribute__((ext_vector_type(4)));
typedef float f32x2 __attribute__((ext_vector_type(2)));
typedef short bf16x8 __attribute__((ext_vector_type(8)));
typedef short bf16x4 __attribute__((ext_vector_type(4)));
typedef GAS unsigned gu32;
#define RLX_AGENT __ATOMIC_RELAXED, __HIP_MEMORY_SCOPE_AGENT
#define LDS_WAIT() asm volatile("s_waitcnt lgkmcnt(0)" ::: "memory")
#define VM_WAIT() asm volatile("s_waitcnt vmcnt(0)" ::: "memory")
DEVI unsigned f2bf(float f) { unsigned u = __builtin_bit_cast(unsigned, f); return (u + 0x7fffu + ((u >> 16) & 1u)) >> 16; }
DEVI unsigned pk2(float lo, float hi) { return f2bf(lo) | (f2bf(hi) << 16); }
DEVI float bf2f(unsigned b) { return __builtin_bit_cast(float, b << 16); }
DEVI float bflo(unsigned w) { return __builtin_bit_cast(float, w << 16); }
DEVI float bfhi(unsigned w) { return __builtin_bit_cast(float, w & 0xffff0000u); }
DEVI float sigmoidf_(float x) { return 1.f / (1.f + __expf(-x)); }
DEVI float siluf_(float x) { return x / (1.f + __expf(-x)); }
DEVI float clamp448(float x) { return fminf(fmaxf(x, -448.f), 448.f); }
DEVI unsigned pk4_fp8(float a, float b, float c, float d) { int w = 0; w = __builtin_amdgcn_cvt_pk_fp8_f32(a, b, w, false); w = __builtin_amdgcn_cvt_pk_fp8_f32(c, d, w, true); return (unsigned)w; }
DEVI size_t tix(size_t NR, size_t row, unsigned kbyte) { return ((size_t)(kbyte >> 7) * NR + row) * 128 + (kbyte & 127u); }
DEVI float wave_sum(float v) {
#pragma unroll
    for (int o = 1; o < 64; o <<= 1) v += __shfl_xor(v, o);
    return v;
}

#define XB_TMO      128
#define XB_XCNT(j)  (256  + 64 * (j))
#define XB_XSUB(j)  (1280 + 64 * (j))
#define XB_XGEN(j)  (2304 + 64 * (j))
#define XB_TOP      3328
#define XB_TOPGEN   3392
#define XCD_BAR_WORDS 3456
#define XB_SPIN_CAP (1u << 20)

__device__ __forceinline__ unsigned xb_ld(unsigned* p)              { return __hip_atomic_load(p, __ATOMIC_RELAXED, __HIP_MEMORY_SCOPE_AGENT); }
__device__ __forceinline__ unsigned xb_add(unsigned* p, unsigned v) { return __hip_atomic_fetch_add(p, v, __ATOMIC_RELAXED, __HIP_MEMORY_SCOPE_AGENT); }
__device__ __forceinline__ unsigned xb_xcc_id() { return (unsigned)__builtin_amdgcn_s_getreg((3 << 11) | 20) & 0xFu; }
#define XB_SPIN(cond, bar) do { unsigned _sp = 0; while (cond) { __builtin_amdgcn_s_sleep(1); \
    if ((++_sp & 255u) == 0u) { if (xb_ld(&(bar)[XB_TMO])) break; if (_sp > XB_SPIN_CAP) { atomicAdd(&(bar)[XB_TMO], 1u); break; } } } } while (0)

struct XcdBarrier { unsigned* bar; unsigned x; volatile LAS unsigned* st; };

__device__ __forceinline__ XcdBarrier xcd_barrier_post(unsigned* bar, volatile LAS unsigned* st) {
    XcdBarrier b; b.bar = bar; b.x = xb_xcc_id(); b.st = st;
    if (threadIdx.x == 0) (void)xb_add(&bar[XB_XCNT(b.x)], 1u);
    return b;
}
__device__ __forceinline__ void xcd_barrier_complete(unsigned* bar, unsigned x, unsigned& nloc, unsigned& nx) {
    const unsigned G = gridDim.x * gridDim.y * gridDim.z;
    unsigned sum, cnt, mine, sp = 0u;
    for (;;) {
        sum = 0u; cnt = 0u; mine = 0u;
#pragma unroll
        for (unsigned j = 0; j < 16; ++j) { const unsigned c = xb_ld(&bar[XB_XCNT(j)]); sum += c; cnt += (c > 0u) ? 1u : 0u; mine = (j == x) ? c : mine; }
        if (sum == G) break;
        __builtin_amdgcn_s_sleep(1);
        if ((++sp & 255u) == 0u) { if (xb_ld(&bar[XB_TMO])) break; if (sp > XB_SPIN_CAP) { atomicAdd(&bar[XB_TMO], 1u); break; } }
    }
    nloc = mine > 0u ? mine : 1u; nx = cnt > 0u ? cnt : 1u;
}
__device__ __forceinline__ void xcd_barrier(const XcdBarrier& b) {
    asm volatile("s_waitcnt vmcnt(0)" ::: "memory");
    __syncthreads();
    if (threadIdx.x == 0) {
        unsigned* bar = b.bar;
        __builtin_amdgcn_s_waitcnt(0);
        unsigned nloc = b.st[0], nx = b.st[1];
        if (nloc == 0u) { xcd_barrier_complete(bar, b.x, nloc, nx); b.st[0] = nloc; b.st[1] = nx; }
        const unsigned old = xb_add(&bar[XB_XSUB(b.x)], 1u);
        const unsigned gen = old / nloc;
        if (old + 1u == (gen + 1u) * nloc) {
            __builtin_amdgcn_fence(__ATOMIC_RELEASE, "agent");
            asm volatile("s_waitcnt vmcnt(0)" ::: "memory");
            const unsigned og = xb_add(&bar[XB_TOP], 1u);
            const unsigned tg = og / nx;
            if (og + 1u == (tg + 1u) * nx) xb_add(&bar[XB_TOPGEN], 1u);
            else XB_SPIN(xb_ld(&bar[XB_TOPGEN]) == tg, bar);
            __builtin_amdgcn_fence(__ATOMIC_ACQUIRE, "agent");
            xb_add(&bar[XB_XGEN(b.x)], 1u);
            asm volatile("s_waitcnt vmcnt(0)" ::: "memory");
        } else {
            XB_SPIN(xb_ld(&bar[XB_XGEN(b.x)]) == gen, bar);
            __builtin_amdgcn_fence(__ATOMIC_ACQUIRE, "agent");
            asm volatile("s_waitcnt vmcnt(0)" ::: "memory");
        }
    }
    __syncthreads();
}

using pg8::Unit; using pg8::BM; using pg8::HALF;
typedef const f32x4 (&AccT)[2][2][4][2];

struct EpiInProj {
    static constexpr bool PERM = true;
    bf16 *convu, *q, *kv, *u;
    DEVI void operator()(AccT acc, const Unit& un, int wr, int wc, int fr, int fq) const {
        const int row0 = un.pm * BM + wr * 64 + fr, pn = un.pn, cw = wc * 32 + 8 * fq;
#pragma unroll
        for (int ai = 0; ai < 2; ++ai)
#pragma unroll
            for (int m = 0; m < 4; ++m) {
                const int row = row0 + ai * HALF + m * 16;
                if (pn < 4) {
                    float o[8];
#pragma unroll
                    for (int n = 0; n < 2; ++n)
#pragma unroll
                        for (int j = 0; j < 4; ++j) o[4 * n + j] = acc[ai][0][m][n][j] * sigmoidf_(acc[ai][1][m][n][j]);
                    v4u w; w.x = pg8::cvt_pk_bf16(o[0], o[1]); w.y = pg8::cvt_pk_bf16(o[2], o[3]); w.z = pg8::cvt_pk_bf16(o[4], o[5]); w.w = pg8::cvt_pk_bf16(o[6], o[7]);
                    *(v4u*)(convu + (size_t)row * DCONV + pn * 128 + cw) = w;
                } else {
#pragma unroll
                    for (int bj = 0; bj < 2; ++bj) {
                        const f32x4 v0 = acc[ai][bj][m][0], v1 = acc[ai][bj][m][1];
                        v4u w; w.x = pg8::cvt_pk_bf16(v0[0], v0[1]); w.y = pg8::cvt_pk_bf16(v0[2], v0[3]); w.z = pg8::cvt_pk_bf16(v1[0], v1[1]); w.w = pg8::cvt_pk_bf16(v1[2], v1[3]);
                        bf16* dst;
                        if (pn < 8) dst = q + (size_t)row * DATT + (pn - 4) * 256 + bj * 128 + cw;
                        else if (pn < 14) dst = kv + ((size_t)((pn - 8) * 2 + bj) * S + row) * HD + cw;
                        else { const int ch = (pn - 14) * 256 + bj * 128 + cw;
                            dst = (bf16*)((unsigned char*)u + tix(32768, (size_t)(ch >> 4) * 1024 + (row >> 4), 2 * ((row & 15) * 16 + (ch & 15)))); }
                        *(v4u*)dst = w;
                    }
                }
            }
    }
};
struct EpiSsm1 {
    static constexpr bool PERM = false;
    float *yintra, *sc;
    DEVI void operator()(AccT acc, const Unit& un, int wr, int wc, int fr, int fq) const {
        const int row0 = un.pm * BM + wr * 64 + fr, cw = wc * 32 + 4 * fq;
        if ((un.pn & 1) == 0) {
#pragma unroll
            for (int ai = 0; ai < 2; ++ai)
#pragma unroll
                for (int m = 0; m < 4; ++m) { float* p = yintra + (size_t)(row0 + ai * HALF + m * 16) * 256 + cw;
#pragma unroll
                    for (int bj = 0; bj < 2; ++bj)
#pragma unroll
                        for (int n = 0; n < 2; ++n) *(f32x4*)(p + bj * 128 + 16 * n) = acc[ai][bj][m][n]; }
        } else {
#pragma unroll
            for (int ai = 0; ai < 2; ++ai)
#pragma unroll
                for (int m = 0; m < 4; ++m) { float* p = sc + (size_t)(row0 + ai * HALF + m * 16) * 128 + cw;
#pragma unroll
                    for (int n = 0; n < 2; ++n) *(f32x4*)(p + 16 * n) = acc[ai][0][m][n]; }
        }
    }
};
struct EpiBiasBf16 {
    static constexpr bool PERM = true;
    bf16* O; int ldc; const float* bias;
    DEVI void operator()(AccT acc, const Unit& un, int wr, int wc, int fr, int fq) const {
        const int row0 = un.pm * BM + wr * 64 + fr, col0 = un.pn * BM + wc * 32 + 8 * fq;
#pragma unroll
        for (int ai = 0; ai < 2; ++ai)
#pragma unroll
            for (int m = 0; m < 4; ++m)
#pragma unroll
                for (int bj = 0; bj < 2; ++bj) {
                    const int col = col0 + bj * HALF;
                    const f32x4 b0 = *(const f32x4*)(bias + col), b1 = *(const f32x4*)(bias + col + 4);
                    const f32x4 v0 = acc[ai][bj][m][0] + b0, v1 = acc[ai][bj][m][1] + b1;
                    v4u w; w.x = pg8::cvt_pk_bf16(v0[0], v0[1]); w.y = pg8::cvt_pk_bf16(v0[2], v0[3]); w.z = pg8::cvt_pk_bf16(v1[0], v1[1]); w.w = pg8::cvt_pk_bf16(v1[2], v1[3]);
                    *(v4u*)(O + (size_t)(row0 + ai * HALF + m * 16) * ldc + col) = w;
                }
    }
};
DEVI float gelu_tanh(float y) { const float z = 0.7978845608028654f * (y + 0.044715f * y * y * y); const float e = __expf(2.f * z); const float th = 1.f - 2.f / (e + 1.f); return 0.5f * y * (1.f + th); }
struct EpiSsm2 {
    static constexpr bool PERM = false;
    const float* yintra; const bf16* u; const float* dsk; bf16 *yssm, *gy;
    DEVI void operator()(AccT acc, const Unit& un, int wr, int wc, int fr, int fq) const {
        const int row0 = un.pm * BM + wr * 64 + fr, g = un.pn, cw = wc * 32 + 4 * fq;
#pragma unroll
        for (int ai = 0; ai < 2; ++ai)
#pragma unroll
            for (int m = 0; m < 4; ++m) {
                const int row = row0 + ai * HALF + m * 16, chunk = row & 1023;
#pragma unroll
                for (int bj = 0; bj < 2; ++bj)
#pragma unroll
                    for (int n = 0; n < 2; ++n) {
                        const int col = bj * 128 + cw + 16 * n, j = col >> 4, co = col & 15, t = chunk * 16 + j, ch = g * 16 + co;
                        const f32x4 yi = *(const f32x4*)(yintra + (size_t)row * 256 + col);
                        const v2u uu = *(const v2u*)((const unsigned char*)u + tix(32768, (size_t)g * 1024 + (t >> 4), 2 * ((t & 15) * 16 + co)));
                        const f32x4 dd = *(const f32x4*)(dsk + ch);
                        f32x4 y = acc[ai][bj][m][n] + yi;
                        y[0] += dd[0] * bflo(uu.x); y[1] += dd[1] * bfhi(uu.x); y[2] += dd[2] * bflo(uu.y); y[3] += dd[3] * bfhi(uu.y);
                        v2u w; w.x = pg8::cvt_pk_bf16(y[0], y[1]); w.y = pg8::cvt_pk_bf16(y[2], y[3]);
                        *(v2u*)((unsigned char*)yssm + tix(S, t, 2 * ch)) = w;
                        v2u w2; w2.x = pg8::cvt_pk_bf16(gelu_tanh(y[0]), gelu_tanh(y[1])); w2.y = pg8::cvt_pk_bf16(gelu_tanh(y[2]), gelu_tanh(y[3]));
                        *(v2u*)(gy + (size_t)t * DSSM + ch) = w2;
                    }
                asm volatile("" ::: "memory");
            }
    }
};
struct EpiGlu {
    static constexpr bool PERM = true;
    const bf16* gy; const float* bias; bf16* O;
    DEVI void operator()(AccT acc, const Unit& un, int wr, int wc, int fr, int fq) const {
        const int row0 = un.pm * BM + wr * 64 + fr, col0 = un.pn * BM + wc * 32 + 8 * fq;
#pragma unroll
        for (int ai = 0; ai < 2; ++ai)
#pragma unroll
            for (int m = 0; m < 4; ++m)
#pragma unroll
                for (int bj = 0; bj < 2; ++bj) {
                    const int col = col0 + bj * HALF; const size_t off = (size_t)(row0 + ai * HALF + m * 16) * DSSM + col;
                    const f32x4 b0 = *(const f32x4*)(bias + col), b1 = *(const f32x4*)(bias + col + 4);
                    const v4u g4 = *(const v4u*)(gy + off);
                    const f32x4 v0 = acc[ai][bj][m][0] + b0, v1 = acc[ai][bj][m][1] + b1;
                    v4u w;
                    w.x = pg8::cvt_pk_bf16(bflo(g4.x) * sigmoidf_(v0[0]), bfhi(g4.x) * sigmoidf_(v0[1]));
                    w.y = pg8::cvt_pk_bf16(bflo(g4.y) * sigmoidf_(v0[2]), bfhi(g4.y) * sigmoidf_(v0[3]));
                    w.z = pg8::cvt_pk_bf16(bflo(g4.z) * sigmoidf_(v1[0]), bfhi(g4.z) * sigmoidf_(v1[1]));
                    w.w = pg8::cvt_pk_bf16(bflo(g4.w) * sigmoidf_(v1[2]), bfhi(g4.w) * sigmoidf_(v1[3]));
                    *(v4u*)(O + off) = w;
                }
    }
};
struct EpiResid {
    static constexpr bool PERM = false;
    const void* base; bool b16; bf16* out; float scale;
    DEVI void operator()(AccT acc, const Unit& un, int wr, int wc, int fr, int fq) const {
        const int row0 = un.pm * BM + wr * 64 + fr, col0 = un.pn * BM + wc * 32 + 4 * fq;
#pragma unroll
        for (int ai = 0; ai < 2; ++ai) {
            f32x4 bs[4][2][2];
            if (b16) {
#pragma unroll
                for (int m = 0; m < 4; ++m) { const size_t off = (size_t)(row0 + ai * HALF + m * 16) * D + col0;
#pragma unroll
                    for (int bj = 0; bj < 2; ++bj)
#pragma unroll
                        for (int n = 0; n < 2; ++n) { const v2u w = *(const v2u*)((const bf16*)base + off + bj * HALF + n * 16); bs[m][bj][n] = (f32x4){bflo(w.x), bfhi(w.x), bflo(w.y), bfhi(w.y)}; } }
            } else {
#pragma unroll
                for (int m = 0; m < 4; ++m) { const size_t off = (size_t)(row0 + ai * HALF + m * 16) * D + col0;
#pragma unroll
                    for (int bj = 0; bj < 2; ++bj)
#pragma unroll
                        for (int n = 0; n < 2; ++n) bs[m][bj][n] = *(const f32x4*)((const float*)base + off + bj * HALF + n * 16); }
            }
#pragma unroll
            for (int m = 0; m < 4; ++m) { const size_t off = (size_t)(row0 + ai * HALF + m * 16) * D + col0;
#pragma unroll
                for (int bj = 0; bj < 2; ++bj)
#pragma unroll
                    for (int n = 0; n < 2; ++n) { const f32x4 r = bs[m][bj][n] + acc[ai][bj][m][n] * scale; v2u w; w.x = pk2(r[0], r[1]); w.y = pk2(r[2], r[3]); *(v2u*)(out + off + bj * HALF + n * 16) = w; } }
            asm volatile("" ::: "memory");
        }
    }
};
struct EpiSwiglu {
    static constexpr bool PERM = true;
    bf16* O; int ldc, nct;
    DEVI void operator()(AccT acc, const Unit& un, int wr, int wc, int fr, int fq) const {
        const int row0 = un.pm * BM + wr * 64 + fr, col0 = (un.pn % nct) * 128 + wc * 32 + 8 * fq;
#pragma unroll
        for (int ai = 0; ai < 2; ++ai)
#pragma unroll
            for (int m = 0; m < 4; ++m) {
                float o[8];
#pragma unroll
                for (int n = 0; n < 2; ++n)
#pragma unroll
                    for (int j = 0; j < 4; ++j) o[4 * n + j] = siluf_(acc[ai][0][m][n][j]) * acc[ai][1][m][n][j];
                v4u w; w.x = pg8::cvt_pk_bf16(o[0], o[1]); w.y = pg8::cvt_pk_bf16(o[2], o[3]); w.z = pg8::cvt_pk_bf16(o[4], o[5]); w.w = pg8::cvt_pk_bf16(o[6], o[7]);
                *(v4u*)(O + (size_t)(row0 + ai * HALF + m * 16) * ldc + col0) = w;
            }
    }
};
constexpr float MOE_WSCALE = 64.f, MOE_ASCALE = 4.f;
struct EpiSwiglu8 {
    static constexpr bool PERM = true;
    unsigned char* O; int nr, nct;
    DEVI void operator()(AccT acc, const Unit& un, int wr, int wc, int fr, int fq) const {
        const int row0 = un.pm * BM + wr * 64 + fr, col0 = (un.pn % nct) * 128 + wc * 32 + 8 * fq;
#pragma unroll
        for (int ai = 0; ai < 2; ++ai)
#pragma unroll
            for (int m = 0; m < 4; ++m) {
                float o[8];
#pragma unroll
                for (int n = 0; n < 2; ++n)
#pragma unroll
                    for (int j = 0; j < 4; ++j) o[4 * n + j] = clamp448(siluf_(acc[ai][0][m][n][j] * (1.f / MOE_WSCALE)) * acc[ai][1][m][n][j] * (MOE_ASCALE / MOE_WSCALE));
                v2u w; w.x = pk4_fp8(o[0], o[1], o[2], o[3]); w.y = pk4_fp8(o[4], o[5], o[6], o[7]);
                *(v2u*)(O + tix(nr, row0 + ai * HALF + m * 16, col0)) = w;
            }
    }
};
struct EpiMoeDown {
    static constexpr bool PERM = true;
    bf16* O; const float* rw; float scale;
    DEVI void operator()(AccT acc, const Unit& un, int wr, int wc, int fr, int fq) const {
        const int row0 = un.pm * BM + wr * 64 + fr, col0 = (un.pn & 7) * BM + wc * 32 + 8 * fq;
#pragma unroll
        for (int ai = 0; ai < 2; ++ai)
#pragma unroll
            for (int m = 0; m < 4; ++m) {
                const int row = row0 + ai * HALF + m * 16; const float s = rw[row] * scale;
#pragma unroll
                for (int bj = 0; bj < 2; ++bj) {
                    const f32x4 v0 = acc[ai][bj][m][0] * s, v1 = acc[ai][bj][m][1] * s;
                    v4u w; w.x = pg8::cvt_pk_bf16(v0[0], v0[1]); w.y = pg8::cvt_pk_bf16(v0[2], v0[3]); w.z = pg8::cvt_pk_bf16(v1[0], v1[1]); w.w = pg8::cvt_pk_bf16(v1[2], v1[3]);
                    *(v4u*)(O + (size_t)row * D + col0 + bj * HALF) = w;
                }
            }
    }
};

struct EpiMoePart {
    static constexpr bool PERM = true;
    float* P;
    DEVI void operator()(AccT acc, const Unit& un, int wr, int wc, int fr, int fq) const {
        const int row0 = wr * 64 + fr, col0 = wc * 32 + 8 * fq;
#pragma unroll
        for (int ai = 0; ai < 2; ++ai)
#pragma unroll
            for (int m = 0; m < 4; ++m) {
                float* pr = P + (size_t)(row0 + ai * HALF + m * 16) * 256 + col0;
#pragma unroll
                for (int bj = 0; bj < 2; ++bj) { *(f32x4*)(pr + bj * HALF) = acc[ai][bj][m][0]; *(f32x4*)(pr + bj * HALF + 4) = acc[ai][bj][m][1]; }
            }
    }
};

struct Ssm1Order { int G, c; DEVI bool next(int i, Unit& u) const { const int L = i * G + c; if (L >= 256) return false; u.pm = L >> 1; u.pn = (u.pm >> 2) * 2 + (L & 1); return true; } };
struct Ssm2Order { int G, c; DEVI bool next(int i, Unit& u) const { const int L = i * G + c; if (L >= 128) return false; u.pm = L; u.pn = L >> 2; return true; } };
struct OneUnit { int pm, pn; DEVI bool next(int i, Unit& u) const { if (i > 0) return false; u.pm = pm; u.pn = pn; return true; } };
struct MoeOrder {
    pg8::StaticOrder so; int nct; int pe[NE + 1]; int imax = 1 << 30;
    DEVI bool next(int i, Unit& u) const { return i < imax && at((long)i * so.G + so.c, u); }
    DEVI bool at(const long L, Unit& u) const {
        if (!so.at(L, u)) return false;
        int e = 0;
#pragma unroll
        for (int k = 1; k < NE; ++k) e += (u.pm >= pe[k]) ? 1 : 0;
        u.pn += e * nct; return true;
    }
};

struct Args { const float* in[38]; float* out; unsigned char* ws; int ph_lo, ph_hi, li, dbg; };
constexpr size_t CTL_TBL = 600000;
struct Frame {
    LAS unsigned char* lds; volatile LAS unsigned* MISC; gu32* ctl;
    int tid, lane, wave, G, gw, NGW;
    unsigned char* ws;
    DEVI const float* in(int i) const { const unsigned long long v = __hip_atomic_load((const unsigned long long*)(ws + CTL_TBL + (size_t)blockIdx.x * 512) + i, __ATOMIC_RELAXED, __HIP_MEMORY_SCOPE_WORKGROUP);
        return (const float*)(const GAS float*)(((unsigned long long)(unsigned)__builtin_amdgcn_readfirstlane((int)(v >> 32)) << 32) | (unsigned)__builtin_amdgcn_readfirstlane((int)v)); }
};
DEVI unsigned char* launder(unsigned char* p) { GAS unsigned char* g = (GAS unsigned char*)p; asm volatile("" : "+s"(g)); return (unsigned char*)g; }
DEVI int vlaunder(int v) { asm volatile("" : "+v"(v)); return v; }
enum { IN_X = 0, IN_POS, IN_NMG, IN_WIN, IN_DWW, IN_DWB, IN_LNG, IN_LNB, IN_PWW, IN_PWB, IN_GB, IN_PEK, IN_PEV, IN_W1K, IN_W2K, IN_W1V, IN_W2V,
       IN_LRE, IN_LIM, IN_LDT, IN_BRE, IN_BIM, IN_CRE, IN_CIM, IN_SD, IN_GLW, IN_GLB, IN_MOG, IN_WOUT, IN_NFG, IN_FG, IN_FU, IN_FD, IN_RW, IN_MG, IN_MU, IN_MD, IN_FNG };

DEVI void tr_item(const float* W, int ldw, int c0, int nvalid, int k0, bf16* dst, size_t ldd  , size_t nr  , int r0, LAS float* scr, int lane) {
    const int cg = (lane & 7) * 4;
#pragma unroll
    for (int i = 0; i < 8; ++i) {
        const int kk = 8 * i + (lane >> 3);
        const float* p = W + (size_t)(k0 + kk) * ldw + c0 + cg;
        f32x4 v;
        if (nvalid >= 32) { v = *(const f32x4*)p; }
        else { v[0] = cg + 0 < nvalid ? p[0] : 0.f; v[1] = cg + 1 < nvalid ? p[1] : 0.f; v[2] = cg + 2 < nvalid ? p[2] : 0.f; v[3] = cg + 3 < nvalid ? p[3] : 0.f; }
        scr[kk * 33 + cg + 0] = v[0]; scr[kk * 33 + cg + 1] = v[1]; scr[kk * 33 + cg + 2] = v[2]; scr[kk * 33 + cg + 3] = v[3];
    }
    LDS_WAIT(); asm volatile("" ::: "memory");
    const int c = lane & 7;
#pragma unroll
    for (int j = 0; j < 4; ++j) { const int n = (lane >> 3) + 8 * j; const LAS float* s = scr + (8 * c) * 33 + n;
        v4u o; o.x = pk2(s[0 * 33], s[1 * 33]); o.y = pk2(s[2 * 33], s[3 * 33]); o.z = pk2(s[4 * 33], s[5 * 33]); o.w = pk2(s[6 * 33], s[7 * 33]);
        if (nr) *(v4u*)((unsigned char*)dst + tix(nr, r0 + n, 2 * (k0 + 8 * c))) = o; else *(v4u*)(dst + (size_t)(r0 + n) * ldd + k0 + 8 * c) = o; }
    LDS_WAIT(); asm volatile("" ::: "memory");
}
DEVI void tr_item8(const float* W, int ldw, int c0, int k0, unsigned char* dst, size_t nr  , int r0, float scale, LAS float* scr, int lane) {
    const int cg = (lane & 7) * 4;
#pragma unroll
    for (int i = 0; i < 8; ++i) {
        const int kk = 8 * i + (lane >> 3);
        const f32x4 v = *(const f32x4*)(W + (size_t)(k0 + kk) * ldw + c0 + cg);
        scr[kk * 33 + cg + 0] = v[0]; scr[kk * 33 + cg + 1] = v[1]; scr[kk * 33 + cg + 2] = v[2]; scr[kk * 33 + cg + 3] = v[3];
    }
    LDS_WAIT(); asm volatile("" ::: "memory");
    const int c = lane & 7;
#pragma unroll
    for (int j = 0; j < 4; ++j) { const int n = (lane >> 3) + 8 * j; const LAS float* s = scr + (8 * c) * 33 + n;
        v2u o; o.x = pk4_fp8(s[0 * 33] * scale, s[1 * 33] * scale, s[2 * 33] * scale, s[3 * 33] * scale); o.y = pk4_fp8(s[4 * 33] * scale, s[5 * 33] * scale, s[6 * 33] * scale, s[7 * 33] * scale);
        *(v2u*)(dst + tix(nr, r0 + n, k0 + 8 * c)) = o; }
    LDS_WAIT(); asm volatile("" ::: "memory");
}
DEVI void tr_matrix_item(int item, const float* W, const float* W2, int K, int ldw, int Ndst, int kind, int nvalid_total, bf16* dst, LAS float* scr, int lane, bool tiled = true) {
    const int nblk = Ndst / 32, kb = item / nblk, nb = item % nblk, d0 = nb * 32;
    const float* src = W; int c0 = d0, nv = 32;
    if (kind == 1) { const int un = d0 >> 8, within = d0 & 255; src = (within >= 128) ? W2 : W; c0 = un * 128 + (within & 127); }
    else if (kind == 2) {
        const int un = d0 >> 8, within = d0 & 255;
        if (un < 4) c0 = (within >> 7) * 512 + un * 128 + (within & 127);
        else if (un < 14) c0 = d0;
        else c0 = 3608 + (d0 - 3584);
    }
    if (nvalid_total < Ndst) { nv = nvalid_total - d0; nv = nv < 0 ? 0 : (nv > 32 ? 32 : nv); }
    tr_item(src, ldw, c0, nv, kb * 64, dst, (size_t)K, tiled ? (size_t)Ndst : 0, d0, scr, lane);
}

template <bool B16>
DEVI f32x4 row_ld4(const void* xrow, int c) {
    if (B16) { const v2u w = *(const v2u*)((const bf16*)xrow + c); return (f32x4){bflo(w.x), bfhi(w.x), bflo(w.y), bfhi(w.y)}; }
    return *(const f32x4*)((const float*)xrow + c);
}
template <bool B16 = false>
DEVI void rms_row_to_bf16(const void* xrow, const float* g, unsigned char* obase  , int row, int lane) {
    f32x4 v[8]; float s = 0.f;
#pragma unroll
    for (int j = 0; j < 8; ++j) { v[j] = row_ld4<B16>(xrow, 4 * lane + 256 * j); s += (v[j].x * v[j].x + v[j].y * v[j].y) + (v[j].z * v[j].z + v[j].w * v[j].w); }
    const float r = 1.f / sqrtf(wave_sum(s) * (1.f / D) + EPS);
#pragma unroll
    for (int j = 0; j < 8; ++j) { const f32x4 gg = *(const f32x4*)(g + 4 * lane + 256 * j);
        v2u w; w.x = pk2(v[j].x * r * gg.x, v[j].y * r * gg.y); w.y = pk2(v[j].z * r * gg.z, v[j].w * r * gg.w);
        *(v2u*)(obase + tix(S, row, 2 * (4 * lane + 256 * j))) = w; }
}

DEVI void ssm_tables_job(Frame& F, int l, int g) {

    LAS float* apr = (LAS float*)F.lds;
    LAS float* api = apr + 18 * 64;
    LAS float* bbr = api + 18 * 64;
    LAS float* bbi = bbr + 1024;
    LAS float* ccr = bbi + 1024;
    LAS float* cci = ccr + 1024;
    LAS float* kt = cci + 1024;
    const int tid = F.tid;
    const size_t gp = (size_t)(l * NGRP + g) * PST;
    if (tid < 64) {
        const int p = tid;
        const float lr = fminf(F.in(IN_LRE)[gp + p], -1e-4f), li = F.in(IN_LIM)[gp + p], dt = expf(F.in(IN_LDT)[l * NGRP + g]);
        const float mag = expf(lr * dt), ar = mag * cosf(li * dt), ai = mag * sinf(li * dt);
        const float den = lr * lr + li * li, cr = ((ar - 1.f) * lr + ai * li) / den, ci = (ai * lr - (ar - 1.f) * li) / den;
        float pr = 1.f, pi = 0.f;
        for (int tau = 0; tau < 18; ++tau) { apr[tau * 64 + p] = pr; api[tau * 64 + p] = pi; const float nr = pr * ar - pi * ai, ni = pr * ai + pi * ar; pr = nr; pi = ni; }
        for (int c = 0; c < 16; ++c) { const float br = F.in(IN_BRE)[(gp + p) * 16 + c], bi = F.in(IN_BIM)[(gp + p) * 16 + c];
            bbr[p * 16 + c] = cr * br - ci * bi; bbi[p * 16 + c] = cr * bi + ci * br; }
        float* a16 = (float*)(F.ws + R_CB + 65536) + (gp + p) * 2;
        a16[0] = apr[16 * 64 + p]; a16[1] = api[16 * 64 + p];
    }
    for (int i = tid; i < 1024; i += NTHR) { const int co = i >> 6, p = i & 63; const size_t o = ((size_t)(l * NGRP + g) * 16 + co) * PST + p; ccr[i] = F.in(IN_CRE)[o]; cci[i] = F.in(IN_CIM)[o]; }
    __syncthreads();
    for (int i = tid; i < 4096; i += NTHR) {
        const int tau = i >> 8, co = (i >> 4) & 15, ci = i & 15; float s = 0.f;
        for (int p = 0; p < 64; ++p) {
            const float xr = apr[tau * 64 + p] * bbr[p * 16 + ci] - api[tau * 64 + p] * bbi[p * 16 + ci];
            const float xi = apr[tau * 64 + p] * bbi[p * 16 + ci] + api[tau * 64 + p] * bbr[p * 16 + ci];
            s += ccr[co * 64 + p] * xr - cci[co * 64 + p] * xi;
        }
        kt[i] = s;
    }
    __syncthreads();
    unsigned char* tw = (unsigned char*)(F.ws + R_TW) + (size_t)l * NGRP * 512 * 256 * 2;
    unsigned char* wo2 = (unsigned char*)(F.ws + R_WO2) + (size_t)l * NGRP * 256 * 256 * 2;
    for (int i2 = tid; i2 < 256 * 128; i2 += NTHR) {
        const int n = i2 >> 7, k = (i2 & 127) * 2, j = n >> 4, co = n & 15, ii = k >> 4, ci = k & 15;
        float v0 = 0.f, v1 = 0.f;
        if (ii <= j) { v0 = kt[(j - ii) * 256 + co * 16 + ci]; v1 = kt[(j - ii) * 256 + co * 16 + ci + 1]; }
        *(unsigned*)(tw + tix(16384, g * 512 + n, 2 * k)) = pk2(v0, v1);
    }
    for (int i2 = tid; i2 < 256 * 128; i2 += NTHR) {
        const int n = i2 >> 7, k = (i2 & 127) * 2, ii = k >> 4, ci = k & 15;
        float v0 = 0.f, v1 = 0.f;
        if (n < 128) { const int ri = n >> 6, p = n & 63; const float pr = apr[(15 - ii) * 64 + p], pi = api[(15 - ii) * 64 + p];
            const float b0r = bbr[p * 16 + ci], b0i = bbi[p * 16 + ci], b1r = bbr[p * 16 + ci + 1], b1i = bbi[p * 16 + ci + 1];
            if (ri == 0) { v0 = pr * b0r - pi * b0i; v1 = pr * b1r - pi * b1i; } else { v0 = pr * b0i + pi * b0r; v1 = pr * b1i + pi * b1r; } }
        *(unsigned*)(tw + tix(16384, g * 512 + 256 + n, 2 * k)) = pk2(v0, v1);
    }
    for (int i2 = tid; i2 < 256 * 128; i2 += NTHR) {
        const int n = i2 >> 7, k = (i2 & 127) * 2, j = n >> 4, co = n & 15;
        float v[2] = {0.f, 0.f};
#pragma unroll
        for (int e = 0; e < 2; ++e) { const int kk = k + e;
            if (kk < 128) { const int p = kk & 63; const float pr = apr[(j + 1) * 64 + p], pi = api[(j + 1) * 64 + p], cr = ccr[co * 64 + p], ci = cci[co * 64 + p];
                v[e] = (kk < 64) ? (cr * pr - ci * pi) : -(cr * pi + ci * pr); } }
        *(unsigned*)(wo2 + tix(8192, g * 256 + n, 2 * k)) = pk2(v[0], v[1]);
    }
    __syncthreads();
}
DEVI void cbias_job(Frame& F, int job) {
    LAS float* red = (LAS float*)F.lds;
    const int c = job & 15, kv = (job >> 4) & 1, l = job >> 5;
    const float* pe = F.in(kv ? IN_PEV : IN_PEK) + (size_t)l * 4096 + c * 256; const float* w1 = F.in(kv ? IN_W1V : IN_W1K) + (size_t)l * 4096 * 128 + (size_t)(c * 256) * 128;
    const int e = F.tid & 127, kq = F.tid >> 7; float s = 0.f;
#pragma unroll 16
    for (int k = kq * 64; k < kq * 64 + 64; ++k) s += pe[k] * w1[(size_t)k * 128 + e];
    red[F.tid] = s; __syncthreads();
    if (F.tid < 128) ((float*)(F.ws + R_CB))[(size_t)job * 128 + e] = (red[e] + red[128 + e]) + (red[256 + e] + red[384 + e]);
    __syncthreads();
}
DEVI void w1_tile_item(Frame& F, const float* pW1K, const float* pW1V, int item) {
    const int ks = item & 127, kv = (item >> 7) & 1, l = item >> 8, lane = F.lane, r = lane & 15, q = lane >> 4;
    const float* w1 = (kv ? pW1V : pW1K) + (size_t)l * 4096 * 128 + (size_t)(32 * ks + 8 * q) * 128 + r;
    bf16* dst = (bf16*)(F.ws + (kv ? R_W1V : R_W1K)) + (size_t)l * 128 * 4096 + ((size_t)ks * 8 * 64 + lane) * 8;
#pragma unroll
    for (int et = 0; et < 8; ++et) {
        float v[8];
#pragma unroll
        for (int j = 0; j < 8; ++j) v[j] = w1[(size_t)j * 128 + 16 * et];
        v4u o; o.x = pk2(v[0], v[1]); o.y = pk2(v[2], v[3]); o.z = pk2(v[4], v[5]); o.w = pk2(v[6], v[7]);
        *(v4u*)(dst + (size_t)et * 512) = o;
    }
}

struct Tile8 { const float* src; unsigned char* dst; int ldw; int nr, row0, k0; };
DEVI Tile8 moe_tile(Frame& F, const float* pMG, const float* pMU, const float* pMD, int r) {
    constexpr int I_MGU = 32 * (2 * DFFE / 32), I_MD = (DFFE / 64) * 64;
    const int e = r / (I_MGU + I_MD); r -= e * (I_MGU + I_MD);
    Tile8 t;
    if (r < I_MGU) { const int nblk = 2 * DFFE / 32, kb = r / nblk, nb = r % nblk, d0 = nb * 32, un = d0 >> 8, within = d0 & 255;
        t.src = (within >= 128 ? pMU : pMG) + (size_t)e * D * DFFE + (size_t)(kb * 64) * DFFE + un * 128 + (within & 127); t.ldw = DFFE;
        t.dst = (unsigned char*)(F.ws + WS_MOE_GU); t.nr = NE * 2 * DFFE; t.row0 = e * 2 * DFFE + d0; t.k0 = kb * 64; }
    else { r -= I_MGU; const int nblk = D / 32, kb = r / nblk, nb = r % nblk;
        t.src = pMD + (size_t)e * DFFE * D + (size_t)(kb * 64) * D + nb * 32; t.ldw = D;
        t.dst = (unsigned char*)(F.ws + WS_MOE_D); t.nr = NE * D; t.row0 = e * D + nb * 32; t.k0 = kb * 64; }
    return t;
}
DEVI Tile8 ffn_tile(Frame& F, const float* pFG, const float* pFU, const float* pFD, int r) {
    constexpr int I_FGU = 32 * (2 * DFF / 32);
    Tile8 t;
    if (r < I_FGU) { const int nblk = 2 * DFF / 32, kb = r / nblk, nb = r % nblk, d0 = nb * 32, un = d0 >> 8, within = d0 & 255;
        t.src = (within >= 128 ? pFU : pFG) + (size_t)(kb * 64) * DFF + un * 128 + (within & 127); t.ldw = DFF;
        t.dst = (unsigned char*)(F.ws + R_FGU); t.nr = 2 * DFF; t.row0 = d0; t.k0 = kb * 64; }
    else { r -= I_FGU; const int nblk = D / 32, kb = r / nblk, nb = r % nblk;
        t.src = pFD + (size_t)(kb * 64) * D + nb * 32; t.ldw = D;
        t.dst = (unsigned char*)(F.ws + R_FD); t.nr = D; t.row0 = nb * 32; t.k0 = kb * 64; }
    return t;
}
DEVI void tile8_load(const Tile8& t, f32x4 (&v)[8], int lane) {
#pragma unroll
    for (int i = 0; i < 8; ++i) v[i] = __builtin_nontemporal_load((const f32x4*)(t.src + (size_t)(8 * i + (lane >> 3)) * t.ldw + (lane & 7) * 4));
}
DEVI void tile8_store(const Tile8& t, const f32x4 (&v)[8], LAS float* scr, int lane) {
    const int cg = (lane & 7) * 4;
#pragma unroll
    for (int i = 0; i < 8; ++i) { const int kk = 8 * i + (lane >> 3); scr[kk * 33 + cg + 0] = v[i][0]; scr[kk * 33 + cg + 1] = v[i][1]; scr[kk * 33 + cg + 2] = v[i][2]; scr[kk * 33 + cg + 3] = v[i][3]; }
    LDS_WAIT(); asm volatile("" ::: "memory");
    const int c = lane & 7;
#pragma unroll
    for (int j = 0; j < 4; ++j) { const int n = (lane >> 3) + 8 * j; const LAS float* s = scr + (8 * c) * 33 + n;
        v2u o; o.x = pk4_fp8(s[0 * 33] * MOE_WSCALE, s[1 * 33] * MOE_WSCALE, s[2 * 33] * MOE_WSCALE, s[3 * 33] * MOE_WSCALE); o.y = pk4_fp8(s[4 * 33] * MOE_WSCALE, s[5 * 33] * MOE_WSCALE, s[6 * 33] * MOE_WSCALE, s[7 * 33] * MOE_WSCALE);
        *(v2u*)(t.dst + tix(t.nr, t.row0 + n, t.k0 + 8 * c)) = o; }
    LDS_WAIT(); asm volatile("" ::: "memory");
}

DEVI void p0_prologue(Frame& F, int variant = 0) {
     unsigned char* ws = F.ws;
    if (variant == 0) {
    for (int j = blockIdx.x; j < 128; j += F.G) { if (j < 64) ssm_tables_job(F, j >> 5, j & 31); else cbias_job(F, j - 64); }
    __syncthreads();
    }
    LAS float* scr = (LAS float*)(F.lds + RING_OFF + F.wave * 16384);
    if (variant == 0) {
    { const float* pX = F.in(IN_X); const float* pG = F.in(IN_NMG); for (int m = F.gw; m < S; m += F.NGW) rms_row_to_bf16(pX + (size_t)m * D, pG, (unsigned char*)(ws + WS_HN), m, F.lane); }
    constexpr int I_WIN = 32 * 128, I_WG = 32, I_WOUT = 32 * 64, I_SQ = 8 * 16, I_W1 = 64 * 4, I_W2 = 2 * 4;
    constexpr int I_LAYER = I_WIN + I_WG + I_WOUT + 2 * I_SQ + I_W1 + 2 * I_W2;
    constexpr int I_FGU = 32 * (2 * DFF / 32), I_FD = (DFF / 64) * 64, I_MGU = 32 * (2 * DFFE / 32), I_MD = (DFFE / 64) * 64;
    constexpr int NITEMS = 2 * I_LAYER;
    const float* pWIN = F.in(IN_WIN); const float* pWOUT = F.in(IN_WOUT); const float* pPWW = F.in(IN_PWW); const float* pGLW = F.in(IN_GLW); const float* pW2K = F.in(IN_W2K); const float* pW2V = F.in(IN_W2V);
    const float* pFG = F.in(IN_FG); const float* pFU = F.in(IN_FU); const float* pFD = F.in(IN_FD); const float* pW1K = F.in(IN_W1K); const float* pW1V = F.in(IN_W1V);
    for (int it = F.gw; it < NITEMS; it += F.NGW) {
        int r = it;
        if (r < 2 * I_LAYER) {
            const int l = r / I_LAYER; r -= l * I_LAYER;
            if (r < I_WIN) { tr_matrix_item(r, pWIN + (size_t)l * D * DIN, nullptr, D, DIN, 4096, 2, 4096, (bf16*)(ws + R_WIN) + (size_t)l * 4096 * D, scr, F.lane); continue; } r -= I_WIN;
            if (r < I_WG) {
#pragma unroll
                for (int h2 = 0; h2 < 2; ++h2) { const int ks = 2 * r + h2, rr = F.lane & 15, qq = F.lane >> 4;
#pragma unroll
                    for (int nt = 0; nt < 2; ++nt) { const int col = 16 * nt + rr; float v[8];
#pragma unroll
                        for (int j = 0; j < 8; ++j) v[j] = (col < 24) ? pWIN[(size_t)l * D * DIN + (size_t)(32 * ks + 8 * qq + j) * DIN + 3584 + col] : 0.f;
                        v4u o; o.x = pk2(v[0], v[1]); o.y = pk2(v[2], v[3]); o.z = pk2(v[4], v[5]); o.w = pk2(v[6], v[7]);
                        *(v4u*)((bf16*)(ws + R_WG) + (size_t)l * 32 * D + ((size_t)(ks * 2 + nt) * 64 + F.lane) * 8) = o; } }
                continue; } r -= I_WG;
            if (r < I_WOUT) { tr_matrix_item(r, pWOUT + (size_t)l * D * D, nullptr, D, D, D, 0, D, (bf16*)(ws + R_WOUT) + (size_t)l * D * D, scr, F.lane); continue; } r -= I_WOUT;
            if (r < I_SQ) { tr_matrix_item(r, pPWW + (size_t)l * 512 * 512, nullptr, 512, 512, 512, 0, 512, (bf16*)(ws + R_CPW) + (size_t)l * 512 * 512, scr, F.lane); continue; } r -= I_SQ;
            if (r < I_SQ) { tr_matrix_item(r, pGLW + (size_t)l * 512 * 512, nullptr, 512, 512, 512, 0, 512, (bf16*)(ws + R_GLU) + (size_t)l * 512 * 512, scr, F.lane); continue; } r -= I_SQ;
            if (r < I_W1) { w1_tile_item(F, pW1K, pW1V, l * 256 + r); continue; } r -= I_W1;
            if (r < I_W2) { tr_matrix_item(r, pW2K + (size_t)l * 128 * 128, nullptr, 128, 128, 128, 0, 128, (bf16*)(ws + R_W2) + (size_t)(l * 2 + 0) * 128 * 128, scr, F.lane, false); continue; } r -= I_W2;
            tr_matrix_item(r, pW2V + (size_t)l * 128 * 128, nullptr, 128, 128, 128, 0, 128, (bf16*)(ws + R_W2) + (size_t)(l * 2 + 1) * 128 * 128, scr, F.lane, false); continue;
        }
    }
    }
    constexpr int NMOE = NE * (32 * (2 * DFFE / 32) + (DFFE / 64) * 64), NFFN = 32 * (2 * DFF / 32) + (DFF / 64) * 64, NTOT = NMOE + NFFN;
    {
        const float* pMG = F.in(IN_MG); const float* pMU = F.in(IN_MU); const float* pMD = F.in(IN_MD);
        const float* pFG = F.in(IN_FG); const float* pFU = F.in(IN_FU); const float* pFD = F.in(IN_FD);
        const int NGW = F.NGW, NLATE = (F.G == 256) ? 512 : 0, RA = (F.G == 256) ? 84 : (1 << 20);
        auto item_of = [&](int k) -> int {
            if (k < RA) { const int it = k * NGW + F.gw; return it < NTOT ? it : -1; }
            if (F.gw < NLATE) return -1;
            const int it = RA * NGW + (k - RA) * (NGW - NLATE) + (F.gw - NLATE); return it < NTOT ? it : -1; };
        auto tile_of = [&](int it) -> Tile8 { return it < NMOE ? moe_tile(F, pMG, pMU, pMD, it) : ffn_tile(F, pFG, pFU, pFD, it - NMOE); };
        int it = item_of(0);
        if (it >= 0) {
            f32x4 va[8], vb[8];
            Tile8 t0 = tile_of(it); tile8_load(t0, va, F.lane);
            for (int k = 0; it >= 0; ++k) {
                const int itn = item_of(k + 1);
                const Tile8 t1 = tile_of(itn >= 0 ? itn : it); tile8_load(t1, vb, F.lane);
                if (variant == 1) { asm volatile("" :: "v"(va[0]), "v"(va[1]), "v"(va[2]), "v"(va[3]), "v"(va[4]), "v"(va[5]), "v"(va[6]), "v"(va[7])); } else tile8_store(t0, va, scr, F.lane);
                t0 = t1; it = itn;
#pragma unroll
                for (int i = 0; i < 8; ++i) va[i] = vb[i];
            }
        }
    }
}

#define MFMA16(a, b, c) __builtin_amdgcn_mfma_f32_16x16x32_bf16((a), (b), (c), 0, 0, 0)
DEVI bf16x8 ldg8(const bf16* p) { return *(const bf16x8*)p; }
DEVI bf16x8 zero8() { bf16x8 z = {0, 0, 0, 0, 0, 0, 0, 0}; return z; }
DEVI bf16x8 pack8(f32x4 a, f32x4 b) { v4u w; w.x = pg8::cvt_pk_bf16(a[0], a[1]); w.y = pg8::cvt_pk_bf16(a[2], a[3]); w.z = pg8::cvt_pk_bf16(b[0], b[1]); w.w = pg8::cvt_pk_bf16(b[2], b[3]); return __builtin_bit_cast(bf16x8, w); }

DEVI void gates_job(Frame& F, const float* pGB, int l, int job) {
    const int lane = F.lane, r = lane & 15, q = lane >> 4, t0 = job * 16;
    const unsigned char* hn = (const unsigned char*)(F.ws + WS_HN);
    const bf16* wg = (const bf16*)(F.ws + R_WG) + (size_t)l * 32 * D + lane * 8;
    f32x4 a0 = {0.f, 0.f, 0.f, 0.f}, a1 = a0;
#pragma unroll 8
    for (int ks = 0; ks < D / 32; ++ks) {
        const bf16x8 a = ldg8((const bf16*)(hn + tix(S, t0 + r, 64 * ks + 16 * q))), b0 = ldg8(wg + (size_t)(ks * 2) * 512), b1 = ldg8(wg + (size_t)(ks * 2 + 1) * 512);
        a0 = MFMA16(a, b0, a0); a1 = MFMA16(a, b1, a1);
    }
    const float* gb = pGB + l * 24; float* go = (float*)(F.ws + R_GATES);
#pragma unroll
    for (int j = 0; j < 4; ++j) { const int t = t0 + 4 * q + j;
        go[(size_t)t * 24 + r] = sigmoidf_(a0[j] + gb[r]);
        if (r < 8) go[(size_t)t * 24 + 16 + r] = sigmoidf_(a1[j] + gb[16 + r]); }
}

DEVI void rope_job(Frame& F, const int* pPOS, int t) {
    const int lane = F.lane;
    const float pos = (float)pPOS[t];
    float cs = 0.f, sn = 0.f;
    { const int i = lane & 15; const float inv = powf(500000.f, -(float)(2 * i) / 32.f); const float ang = pos * inv; cs = cosf(ang); sn = sinf(ang); }
    float cv[16], sv[16];
#pragma unroll
    for (int i = 0; i < 16; ++i) { cv[i] = __shfl(cs, i); sv[i] = __shfl(sn, i); }
    const bf16* qrow = (const bf16*)(F.ws + R_Q) + (size_t)t * DATT + 16 * lane;
    v4u w0 = *(const v4u*)qrow, w1 = *(const v4u*)(qrow + 8);
    unsigned w[8] = {w0.x, w0.y, w0.z, w0.w, w1.x, w1.y, w1.z, w1.w};
    const int sub = lane & 7;
    float x[16], o[16];
#pragma unroll
    for (int i = 0; i < 8; ++i) { x[2 * i] = bflo(w[i]); x[2 * i + 1] = bfhi(w[i]); }
#pragma unroll
    for (int i = 0; i < 16; ++i) { const float other = __shfl_xor(x[i], 1);
        o[i] = (sub == 0) ? (x[i] * cv[i] - other * sv[i]) : ((sub == 1) ? (x[i] * cv[i] + other * sv[i]) : x[i]); }
    v4u o0, o1; o0.x = pk2(o[0], o[1]); o0.y = pk2(o[2], o[3]); o0.z = pk2(o[4], o[5]); o0.w = pk2(o[6], o[7]); o1.x = pk2(o[8], o[9]); o1.y = pk2(o[10], o[11]); o1.z = pk2(o[12], o[13]); o1.w = pk2(o[14], o[15]);
    bf16* qr = (bf16*)(F.ws + R_QR) + (size_t)t * DATT + 16 * lane;
    if (sub >= 2) { o0 = w0; o1 = w1; }
    *(v4u*)qr = o0; *(v4u*)(qr + 8) = o1;
    {
        const int tz = lane >> 5, g = (lane >> 4) & 1, c = lane & 15;
        const bf16* kp = (const bf16*)(F.ws + R_KV) + ((size_t)((tz ? 4 : 2) * 2 + g) * S + t) * HD + 8 * c;
        const v4u wv = *(const v4u*)kp;
        const unsigned ww[4] = {wv.x, wv.y, wv.z, wv.w}; unsigned ow[4];
        const int i0 = 8 * (c & 1);
#pragma unroll
        for (int i = 0; i < 4; ++i) {
            const unsigned pw = (unsigned)__shfl_xor((int)ww[i], 2);
            float a0 = bflo(ww[i]), a1 = bfhi(ww[i]); const float b0 = bflo(pw), b1 = bfhi(pw);
            float cc0 = 0.f, ss0 = 0.f, cc1 = 0.f, ss1 = 0.f;
#pragma unroll
            for (int k = 0; k < 16; ++k) { if (k == i0 + 2 * i) { cc0 = cv[k]; ss0 = sv[k]; } if (k == i0 + 2 * i + 1) { cc1 = cv[k]; ss1 = sv[k]; } }
            const float sg = (c < 2) ? -1.f : 1.f;
            const float r0 = a0 * cc0 + sg * b0 * ss0, r1 = a1 * cc1 + sg * b1 * ss1;
            ow[i] = (c < 4) ? pk2(r0, r1) : ww[i];
        }
        {
            v2u o8; o8.x = pk4_fp8(bflo(ow[0]), bfhi(ow[0]), bflo(ow[1]), bfhi(ow[1])); o8.y = pk4_fp8(bflo(ow[2]), bfhi(ow[2]), bflo(ow[3]), bfhi(ow[3]));
            *(v2u*)((unsigned char*)(F.ws + (tz ? R_KW8 : R_KS8)) + (size_t)g * S * HD + (size_t)((t >> 6) * 4 + ((t >> 4) & 3)) * 2048 + ((c & 3) >> 1) * 1024 + ((t & 15) + 16 * (c >> 2)) * 16 + (c & 1) * 8) = o8; }
    }
}

DEVI void dwconv_job(Frame& F, const float* pDWW, const float* pDWB, const float* pLNG, const float* pLNB, int l, int job) {
    const int lane = F.lane, c0 = 8 * lane, t0 = job * 4;
    const bf16* u = (const bf16*)(F.ws + R_CONVU);
    const float* dww = pDWW + (size_t)l * CONVW * DCONV + c0;
    float acc[4][8], wk[4][8];
#pragma unroll
    for (int i = 0; i < 4; ++i)
#pragma unroll
        for (int c = 0; c < 8; ++c) { acc[i][c] = 0.f; wk[i][c] = 0.f; }
#pragma unroll 2
    for (int kr = 0; kr < 34; ++kr) {
#pragma unroll
        for (int c = 0; c < 8; ++c) { wk[3][c] = wk[2][c]; wk[2][c] = wk[1][c]; wk[1][c] = wk[0][c]; }
        const int kk = kr <= 30 ? kr : 30; const float wm = kr <= 30 ? 1.f : 0.f;
        const f32x4 a = *(const f32x4*)(dww + (size_t)kk * DCONV), b = *(const f32x4*)(dww + (size_t)kk * DCONV + 4);
        wk[0][0] = a[0] * wm; wk[0][1] = a[1] * wm; wk[0][2] = a[2] * wm; wk[0][3] = a[3] * wm; wk[0][4] = b[0] * wm; wk[0][5] = b[1] * wm; wk[0][6] = b[2] * wm; wk[0][7] = b[3] * wm;
        const int r = t0 - 30 + kr; const int rc = r < 0 ? 0 : r; const float xm = r < 0 ? 0.f : 1.f;
        const v4u w = *(const v4u*)(u + (size_t)rc * DCONV + c0);
        const float x[8] = {bflo(w.x) * xm, bfhi(w.x) * xm, bflo(w.y) * xm, bfhi(w.y) * xm, bflo(w.z) * xm, bfhi(w.z) * xm, bflo(w.w) * xm, bfhi(w.w) * xm};
#pragma unroll
        for (int i = 0; i < 4; ++i)
#pragma unroll
            for (int c = 0; c < 8; ++c) acc[i][c] += x[c] * wk[i][c];
    }
    const float* dwb = pDWB + l * DCONV + c0; const float* lng = pLNG + l * DCONV + c0; const float* lnb = pLNB + l * DCONV + c0;
    float bb[8], gg[8], be[8];
#pragma unroll
    for (int c = 0; c < 8; ++c) { bb[c] = dwb[c]; gg[c] = lng[c]; be[c] = lnb[c]; }
    unsigned char* out = (unsigned char*)(F.ws + R_CONVACT);
#pragma unroll
    for (int i = 0; i < 4; ++i) {
        float s = 0.f;
#pragma unroll
        for (int c = 0; c < 8; ++c) { acc[i][c] += bb[c]; s += acc[i][c]; }
        const float mu = wave_sum(s) * (1.f / DCONV); float q = 0.f;
#pragma unroll
        for (int c = 0; c < 8; ++c) { const float d = acc[i][c] - mu; q += d * d; }
        const float rstd = 1.f / sqrtf(wave_sum(q) * (1.f / DCONV) + EPS);
        float y[8];
#pragma unroll
        for (int c = 0; c < 8; ++c) y[c] = siluf_((acc[i][c] - mu) * rstd * gg[c] + be[c]);
        v4u w; w.x = pk2(y[0], y[1]); w.y = pk2(y[2], y[3]); w.z = pk2(y[4], y[5]); w.w = pk2(y[6], y[7]);
        *(v4u*)(out + tix(S, t0 + i, 2 * c0)) = w;
    }
}

DEVI void vt_job(Frame& F, int job) {
    const int lane = F.lane;
    const int dh = job & 1, chunk = (job >> 1) & 255, g = (job >> 9) & 1, tz = job >> 10;
    LAS unsigned* scr = (LAS unsigned*)(F.lds + RING_OFF + F.wave * 16384);
    const bf16* v = (const bf16*)(F.ws + R_KV) + ((size_t)((tz ? 5 : 3) * 2 + g) * S + chunk * 64) * HD + dh * 64;
#pragma unroll
    for (int i = 0; i < 8; ++i) { const int row = 8 * i + (lane >> 3), cg = (lane & 7) * 4;
        const v4u w = *(const v4u*)(v + (size_t)row * HD + cg * 2);
        scr[row * 33 + cg + 0] = w.x; scr[row * 33 + cg + 1] = w.y; scr[row * 33 + cg + 2] = w.z; scr[row * 33 + cg + 3] = w.w; }
    LDS_WAIT(); asm volatile("" ::: "memory");
    const int r = lane & 15, q = lane >> 4;
    const LAS unsigned short* s16 = (const LAS unsigned short*)scr;
    {
        unsigned char* v8 = (unsigned char*)(F.ws + (tz ? R_VW8 : R_VS8)) + (size_t)g * S * HD + (size_t)chunk * 8192 + lane * 16;
#pragma unroll
        for (int dtl = 0; dtl < 4; ++dtl) { v4u o;
            unsigned wds[4];
#pragma unroll
            for (int T = 0; T < 4; ++T) { const int tk = 16 * T + 4 * q; wds[T] = pk4_fp8(bf2f(s16[(tk + 0) * 66 + 16 * dtl + r]), bf2f(s16[(tk + 1) * 66 + 16 * dtl + r]), bf2f(s16[(tk + 2) * 66 + 16 * dtl + r]), bf2f(s16[(tk + 3) * 66 + 16 * dtl + r])); }
            o.x = wds[0]; o.y = wds[1]; o.z = wds[2]; o.w = wds[3];
            *(v4u*)(v8 + (size_t)(dh * 4 + dtl) * 1024) = o; }
    }
    LDS_WAIT(); asm volatile("" ::: "memory");
}

DEVI void compress_job(Frame& F, int l, int job) {
    const int lane = F.lane, r = lane & 15, q = lane >> 4, w = F.wave;
    const int nt = job & 63, g = (job >> 6) & 1, kv = job >> 7;
    const int n0 = nt * 16; int nn = n0 + r; nn = nn > NCMP - 1 ? NCMP - 1 : nn;
    const bf16* raw = (const bf16*)(F.ws + R_KV) + ((size_t)(kv * 2 + g) * S) * HD + (size_t)nn * 2048 + 8 * q;
    const bf16* w1f = (const bf16*)(F.ws + (kv ? R_W1V : R_W1K)) + (size_t)l * 128 * 4096 + lane * 8;
    LAS f32x4* part = (LAS f32x4*)(F.lds + RING_OFF);
    LAS bf16* hidT = (LAS bf16*)(F.lds + RING_OFF + 65536);
    f32x4 hid[8];
#pragma unroll
    for (int e = 0; e < 8; ++e) hid[e] = (f32x4){0.f, 0.f, 0.f, 0.f};
#pragma unroll 4
    for (int k = 0; k < 16; ++k) {
        const int ks = 16 * w + k;
        const bf16x8 b = ldg8(raw + 32 * ks);
#pragma unroll
        for (int e = 0; e < 8; ++e) { const bf16x8 a = ldg8(w1f + ((size_t)ks * 8 + e) * 512); hid[e] = MFMA16(a, b, hid[e]); }
    }
#pragma unroll
    for (int e = 0; e < 8; ++e) part[(w * 8 + e) * 64 + lane] = hid[e];
    __syncthreads();
    {
        f32x4 sacc = part[(0 * 8 + w) * 64 + lane];
#pragma unroll
        for (int w2 = 1; w2 < 8; ++w2) sacc = sacc + part[(w2 * 8 + w) * 64 + lane];
        const float* cb = (const float*)(F.ws + R_CB) + (size_t)(l * 2 + kv) * 16 * 128 + 16 * w + 4 * q;
        f32x4 bv = *(const f32x4*)cb;
#pragma unroll
        for (int cc = 1; cc < 16; ++cc) bv = bv + *(const f32x4*)(cb + cc * 128);
        v2u pk; pk.x = pk2(siluf_(sacc[0] + bv[0]), siluf_(sacc[1] + bv[1])); pk.y = pk2(siluf_(sacc[2] + bv[2]), siluf_(sacc[3] + bv[3]));
        *(LAS v2u*)(hidT + r * 128 + 16 * w + 4 * q) = pk;
    }
    __syncthreads();
    const bf16* w2t = (const bf16*)(F.ws + R_W2) + (size_t)(l * 2 + kv) * 128 * 128 + (size_t)(16 * w + r) * 128 + 8 * q;
    f32x4 o = {0.f, 0.f, 0.f, 0.f};
#pragma unroll
    for (int s = 0; s < 4; ++s) {
        const bf16x8 a = ldg8(w2t + 32 * s);
        const bf16x8 b = *(const LAS bf16x8*)(hidT + r * 128 + 32 * s + 8 * q);
        o = MFMA16(a, b, o);
    }
    const int n = n0 + r, stp = n >> 5, kk = n & 31;
    if (kv == 0) { const int T = (kk >> 2) & 1, rr = ((kk >> 3) << 2) | (kk & 3);
        bf16* kc = (bf16*)(F.ws + R_KC) + (size_t)g * 1024 * HD;
        const int d0 = 16 * w + 4 * q, ks = d0 >> 5, qq = (d0 >> 3) & 3, j0 = d0 & 7;
        v2u wv; wv.x = pk2(o[0], o[1]); wv.y = pk2(o[2], o[3]);
        *(v2u*)(kc + ((((size_t)stp * 2 + T) * 4 + ks) * 64 + rr + 16 * qq) * 8 + j0) = wv; }
    else { const int qq = kk >> 3, jj = kk & 7;
        bf16* vct = (bf16*)(F.ws + R_VCT) + (size_t)g * 1024 * HD;
#pragma unroll
        for (int j = 0; j < 4; ++j) vct[(((size_t)stp * 8 + w) * 64 + (4 * q + j) + 16 * qq) * 8 + jj] = (bf16)f2bf(o[j]); }
    __syncthreads();
}

DEVI void scan_job(Frame& F, int l, int g) {
    const int p = F.lane;
    const float* a16 = (const float*)(F.ws + R_CB + 65536) + ((size_t)(l * NGRP + g) * PST + p) * 2;
    const float ar = a16[0], ai = a16[1];
    const float* sc = (const float*)(F.ws + R_SC) + (size_t)g * 1024 * 128;
    unsigned char* hp = (unsigned char*)(F.ws + R_HPREV);
    float hr = 0.f, hi = 0.f;
    for (int c0 = 0; c0 < 1024; c0 += 32) {
        float sr[32], si[32];
#pragma unroll
        for (int k = 0; k < 32; ++k) { sr[k] = sc[(size_t)(c0 + k) * 128 + p]; si[k] = sc[(size_t)(c0 + k) * 128 + 64 + p]; }
#pragma unroll
        for (int k = 0; k < 32; ++k) {
            const size_t rw_ = (size_t)g * 1024 + c0 + k;
            *(bf16*)(hp + tix(32768, rw_, 2 * p)) = (bf16)f2bf(hr); *(bf16*)(hp + tix(32768, rw_, 128 + 2 * p)) = (bf16)f2bf(hi); *(unsigned*)(hp + tix(32768, rw_, 256 + 4 * p)) = 0u;
            const float nr = ar * hr - ai * hi + sr[k], ni = ar * hi + ai * hr + si[k]; hr = nr; hi = ni;
        }
    }
}

constexpr float QK_SCALE = 0.08838834764831845f;
constexpr float C2 = 1.4426950408889634f * QK_SCALE;
constexpr float NEG_INF = -__builtin_inff();

DEVI int krow(int r, int T) { return 8 * (r >> 2) + 4 * T + (r & 3); }

DEVI void cmp_stats_job(Frame& F, int g, int tile) {
    const int lane = F.lane, r = lane & 15, q = lane >> 4, t0 = tile * 16, t = t0 + r;
    if (tile == 0) return;
    const int nmax = tile - 1;
    const int nsteps = (nmax >> 5) + 1;
    const bf16* qp = (const bf16*)(F.ws + R_Q) + (size_t)t * DATT + (size_t)(4 * g) * HD + 8 * q;
    bf16x8 qf[4][4];
#pragma unroll
    for (int h = 0; h < 4; ++h)
#pragma unroll
        for (int ks = 0; ks < 4; ++ks) qf[h][ks] = ldg8(qp + h * HD + 32 * ks);
    const bf16* kc = (const bf16*)(F.ws + R_KC) + (size_t)g * 1024 * HD + lane * 8;
    const int nvis = (t - 31) >> 4;
    float m[4], lsum[4];
#pragma unroll
    for (int h = 0; h < 4; ++h) { m[h] = -1e30f; lsum[h] = 0.f; }
    for (int pass = 0; pass < 2; ++pass) {
        float inv_l[4];
        if (pass == 1) {
#pragma unroll
            for (int h = 0; h < 4; ++h) {
                float mm = m[h], ll = lsum[h];
#pragma unroll
                for (int o = 16; o < 64; o <<= 1) { const float om = __shfl_xor(mm, o), ol = __shfl_xor(ll, o); const float nm = fmaxf(mm, om);
                    ll = ll * __builtin_amdgcn_exp2f(mm - nm) + ol * __builtin_amdgcn_exp2f(om - nm); mm = nm; }
                m[h] = mm; inv_l[h] = ll > 0.f ? 1.f / ll : 0.f;
            }
        }
        float carry = 0.f;
        auto kload = [&](bf16x8 (&kf)[2][4], int st) { const size_t sc_ = (st < nsteps) ? st : nsteps - 1;
#pragma unroll
            for (int T = 0; T < 2; ++T)
#pragma unroll
                for (int ks = 0; ks < 4; ++ks) kf[T][ks] = ldg8(kc + ((sc_ * 2 + T) * 4 + ks) * 512); };
        auto step = [&](const bf16x8 (&kf)[2][4], const int st) {
            const int key0 = st * 32;
            f32x4 imp0 = {0.f, 0.f, 0.f, 0.f}, imp1 = imp0;
#pragma unroll
            for (int h = 0; h < 4; ++h) {
                f32x4 s0 = {0.f, 0.f, 0.f, 0.f}, s1 = s0;
#pragma unroll
                for (int ks = 0; ks < 4; ++ks) { s0 = MFMA16(kf[0][ks], qf[h][ks], s0); s1 = MFMA16(kf[1][ks], qf[h][ks], s1); }
#pragma unroll
                for (int j = 0; j < 4; ++j) { s0[j] = (key0 + 8 * q + j <= nvis) ? s0[j] * C2 : NEG_INF; s1[j] = (key0 + 8 * q + 4 + j <= nvis) ? s1[j] * C2 : NEG_INF; }
                if (pass == 0) {
                    float mx = fmaxf(fmaxf(fmaxf(s0[0], s0[1]), fmaxf(s0[2], s0[3])), fmaxf(fmaxf(s1[0], s1[1]), fmaxf(s1[2], s1[3])));
                    const float nm = fmaxf(m[h], mx); float ps = 0.f;
#pragma unroll
                    for (int j = 0; j < 4; ++j) ps += __builtin_amdgcn_exp2f(s0[j] - nm) + __builtin_amdgcn_exp2f(s1[j] - nm);
                    lsum[h] = lsum[h] * __builtin_amdgcn_exp2f(m[h] - nm) + ps; m[h] = nm;
                } else {
#pragma unroll
                    for (int j = 0; j < 4; ++j) { imp0[j] += __builtin_amdgcn_exp2f(s0[j] - m[h]) * inv_l[h]; imp1[j] += __builtin_amdgcn_exp2f(s1[j] - m[h]) * inv_l[h]; }
                }
            }
            if (pass == 1) {
                const float prev_lane = __shfl_up(imp1[3], 16);
                const float pm1 = (q == 0) ? carry : prev_lane;
                const float b0 = pm1 + (imp0[0] + imp0[1]) + (imp0[2] + imp0[3]);
                const float b1 = imp0[3] + (imp1[0] + imp1[1]) + (imp1[2] + imp1[3]);
                carry = __shfl(imp1[3], 48 + r);
                float* dst = (float*)(F.ws + R_IMP) + ((size_t)t * 2 + g) * NSB + (key0 >> 2) + 2 * q;
                f32x2 w = {b0, b1}; *(f32x2*)dst = w;
            }
                };
        bf16x8 kA[2][4], kB[2][4];
        kload(kA, 0);
        for (int st = 0; st < nsteps; st += 2) {
            kload(kB, st + 1);
            step(kA, st);
            kload(kA, st + 2);
            if (st + 1 < nsteps) step(kB, st + 1);
        }
        if (pass == 1 && q == 0 && 8 * nsteps < NSB) ((float*)(F.ws + R_IMP))[((size_t)t * 2 + g) * NSB + 8 * nsteps] = carry;
    }
}

struct AttnState { f32x4 o[8]; float m, l; };
struct KVFrag { bf16x8 k[2][4]; bf16x8 v[8]; };
DEVI void kv_load(KVFrag& f, const bf16* kbase  , const bf16* vtbase  , int key0, int r) {
    const size_t st = (size_t)(key0 >> 5);
#pragma unroll
    for (int T = 0; T < 2; ++T)
#pragma unroll
        for (int ks = 0; ks < 4; ++ks) f.k[T][ks] = ldg8(kbase + ((st * 2 + T) * 4 + ks) * 512);
#pragma unroll
    for (int dt = 0; dt < 8; ++dt) f.v[dt] = ldg8(vtbase + (st * 8 + dt) * 512);
}
template <int MODE>
DEVI void attn_compute(AttnState& st, const bf16x8 (&qf)[4], const KVFrag& f, int key0, int tq, int lane) {
    const int q = lane >> 4;
    f32x4 s0 = {0.f, 0.f, 0.f, 0.f}, s1 = s0;
#pragma unroll
    for (int ks = 0; ks < 4; ++ks) { s0 = MFMA16(f.k[0][ks], qf[ks], s0); s1 = MFMA16(f.k[1][ks], qf[ks], s1); }
#pragma unroll
    for (int j = 0; j < 4; ++j) {
        const int ka = key0 + 8 * q + j, kb = ka + 4; bool va, vb;
        if (MODE == 0) { va = 16 * ka + 31 <= tq; vb = 16 * kb + 31 <= tq; }
        else if (MODE == 1) { va = (unsigned)(tq - ka) < 512u; vb = (unsigned)(tq - kb) < 512u; }
        else { va = ka <= tq; vb = kb <= tq; }
        s0[j] = va ? s0[j] * C2 : NEG_INF; s1[j] = vb ? s1[j] * C2 : NEG_INF;
    }
    float mx = fmaxf(fmaxf(fmaxf(s0[0], s0[1]), fmaxf(s0[2], s0[3])), fmaxf(fmaxf(s1[0], s1[1]), fmaxf(s1[2], s1[3])));
    mx = fmaxf(mx, __shfl_xor(mx, 16)); mx = fmaxf(mx, __shfl_xor(mx, 32));
    const float nm = fmaxf(st.m, mx), alpha = __builtin_amdgcn_exp2f(st.m - nm);
    st.m = nm;
    float ps = 0.f;
#pragma unroll
    for (int j = 0; j < 4; ++j) { s0[j] = __builtin_amdgcn_exp2f(s0[j] - nm); s1[j] = __builtin_amdgcn_exp2f(s1[j] - nm); ps += s0[j] + s1[j]; }
    st.l = st.l * alpha + ps;
    if (!__all(alpha == 1.f)) {
#pragma unroll
        for (int dt = 0; dt < 8; ++dt) st.o[dt] = st.o[dt] * alpha;
    }
    const bf16x8 pf = pack8(s0, s1);
#pragma unroll
    for (int dt = 0; dt < 8; ++dt) st.o[dt] = MFMA16(f.v[dt], pf, st.o[dt]);
}
template <int MODE>
DEVI void attn_run_linear(AttnState& st, const bf16x8 (&qf)[4], const bf16* kbase, const bf16* vtbase, int kstart, int nsteps, int tq, int lane) {
    const int r = lane & 15;
    KVFrag A, B;
    kv_load(A, kbase, vtbase, kstart, r);
    for (int s = 0; s < nsteps; s += 2) {
        const int s1 = (s + 1 < nsteps) ? s + 1 : nsteps - 1, s2 = (s + 2 < nsteps) ? s + 2 : nsteps - 1;
        kv_load(B, kbase, vtbase, kstart + 32 * s1, r);
        attn_compute<MODE>(st, qf, A, kstart + 32 * s, tq, lane);
        kv_load(A, kbase, vtbase, kstart + 32 * s2, r);
        if (s + 1 < nsteps) attn_compute<MODE>(st, qf, B, kstart + 32 * s1, tq, lane);
    }
}
typedef long i64_t;
#define MFMA16F8(a, b, c) __builtin_amdgcn_mfma_f32_16x16x32_fp8_fp8((a), (b), (c), 0, 0, 0)
struct KVFrag8 { i64_t k[2][4]; i64_t v[8]; };
DEVI void kv_load8(KVFrag8& f, const unsigned char* kbase  , const unsigned char* vtbase  , int key0) {
    const size_t st = (size_t)(key0 >> 5);
#pragma unroll
    for (int T = 0; T < 2; ++T)
#pragma unroll
        for (int ks = 0; ks < 4; ++ks) f.k[T][ks] = *(const i64_t*)(kbase + ((st * 2 + T) * 4 + ks) * 512);
#pragma unroll
    for (int dt = 0; dt < 8; ++dt) f.v[dt] = *(const i64_t*)(vtbase + (st * 8 + dt) * 512);
}
template <bool MASK>
DEVI void attn_compute8(AttnState& st, const i64_t (&qf)[4], const KVFrag8& f, int key0, int tq, int lane) {
    const int q = lane >> 4;
    f32x4 s0 = {0.f, 0.f, 0.f, 0.f}, s1 = s0;
#pragma unroll
    for (int ks = 0; ks < 4; ++ks) { s0 = MFMA16F8(f.k[0][ks], qf[ks], s0); s1 = MFMA16F8(f.k[1][ks], qf[ks], s1); }
    if (MASK) {
#pragma unroll
        for (int j = 0; j < 4; ++j) { const int ka = key0 + 8 * q + j, kb = ka + 4; s0[j] = (ka <= tq) ? s0[j] : NEG_INF; s1[j] = (kb <= tq) ? s1[j] : NEG_INF; }
    }
    float mx = fmaxf(fmaxf(fmaxf(s0[0], s0[1]), fmaxf(s0[2], s0[3])), fmaxf(fmaxf(s1[0], s1[1]), fmaxf(s1[2], s1[3])));
    mx = fmaxf(mx, __shfl_xor(mx, 16)); mx = fmaxf(mx, __shfl_xor(mx, 32));
    const float nm = fmaxf(st.m, mx * C2), alpha = __builtin_amdgcn_exp2f(st.m - nm), bias = 8.f - nm;
    st.m = nm;
    float ps = 0.f;
#pragma unroll
    for (int j = 0; j < 4; ++j) { s0[j] = __builtin_amdgcn_exp2f(__builtin_fmaf(s0[j], C2, bias)); s1[j] = __builtin_amdgcn_exp2f(__builtin_fmaf(s1[j], C2, bias)); ps += s0[j] + s1[j]; }
    st.l = st.l * alpha + ps;
    if (!__all(alpha == 1.f)) {
#pragma unroll
        for (int dt = 0; dt < 8; ++dt) st.o[dt] = st.o[dt] * alpha;
    }
    const i64_t pf = (i64_t)(((unsigned long long)pk4_fp8(s1[0], s1[1], s1[2], s1[3]) << 32) | pk4_fp8(s0[0], s0[1], s0[2], s0[3]));
#pragma unroll
    for (int dt = 0; dt < 8; ++dt) st.o[dt] = MFMA16F8(f.v[dt], pf, st.o[dt]);
}
typedef int v8i __attribute__((ext_vector_type(8)));
#define MFMA128(a, b, c) __builtin_amdgcn_mfma_scale_f32_16x16x128_f8f6f4((a), (b), (c), 0, 0, 0, 0x7F7F7F7F, 0, 0x7F7F7F7F)
DEVI v8i ld32(const unsigned char* p) { const v4u a = *(const v4u*)p, b = *(const v4u*)(p + 1024);
    v8i r; r[0] = a.x; r[1] = a.y; r[2] = a.z; r[3] = a.w; r[4] = b.x; r[5] = b.y; r[6] = b.z; r[7] = b.w; return r; }
DEVI void attn_init(AttnState& st) {
#pragma unroll
    for (int dt = 0; dt < 8; ++dt) st.o[dt] = (f32x4){0.f, 0.f, 0.f, 0.f};
    st.m = -1e30f; st.l = 0.f;
}
template <int CTRL, int BANK> DEVI float dpp_merge(float old, float src) { return __builtin_bit_cast(float, __builtin_amdgcn_update_dpp(__builtin_bit_cast(int, old), __builtin_bit_cast(int, src), CTRL, 0xf, BANK, false)); }
template <int CTRL> DEVI int dpp_mov(int src) { return __builtin_amdgcn_update_dpp(0, src, CTRL, 0xf, 0xf, true); }
template <int CTRL> DEVI float dpp_movf(float src) { return __builtin_bit_cast(float, __builtin_amdgcn_update_dpp(0, __builtin_bit_cast(int, src), CTRL, 0xf, 0xf, true)); }
template <bool LATE_K, bool C4, class BlkFn, class MaskFn>
DEVI void attn128_run(AttnState& st, const v8i qf, const unsigned char* kb, const unsigned char* vb, int nblk, BlkFn blk, MaskFn M, int q, v8i (&KA)[4], v8i (&KB)[4]) {
    const int nst = (nblk + 1) >> 1;
    for (int ss = 0; ss < nst; ++ss) {
        const int bA = blk(2 * ss);
        const bool hasB = (2 * ss + 1 < nblk);
        const int bB = blk(hasB ? 2 * ss + 1 : 2 * ss);
        v8i vf[8];
#pragma unroll
        for (int dt = 0; dt < 8; ++dt) { const v4u a = *(const v4u*)(vb + (size_t)bA * 8192 + dt * 1024), b = *(const v4u*)(vb + (size_t)bB * 8192 + dt * 1024);
            vf[dt][0] = a.x; vf[dt][1] = a.y; vf[dt][2] = a.z; vf[dt][3] = a.w; vf[dt][4] = b.x; vf[dt][5] = b.y; vf[dt][6] = b.z; vf[dt][7] = b.w; }
        f32x4 sa[4], sb[4];
#pragma unroll
        for (int T = 0; T < 4; ++T) { const f32x4 z = {0.f, 0.f, 0.f, 0.f}; sa[T] = MFMA128(KA[T], qf, z); sb[T] = MFMA128(KB[T], qf, z); }
        if (M.need(bA)) {
#pragma unroll
            for (int T = 0; T < 4; ++T)
#pragma unroll
                for (int j = 0; j < 4; ++j) sa[T][j] = M.vis(64 * bA + 16 * T + 4 * q + j) ? sa[T][j] : NEG_INF; }
        if (!hasB || M.need(bB)) {
#pragma unroll
            for (int T = 0; T < 4; ++T)
#pragma unroll
                for (int j = 0; j < 4; ++j) sb[T][j] = (hasB && M.vis(64 * bB + 16 * T + 4 * q + j)) ? sb[T][j] : NEG_INF; }
        v8i pf;
        if (C4) {
            f32x4 ca, cb;
#pragma unroll
            for (int j = 0; j < 4; ++j) {
                float x = sa[0][j]; x = dpp_merge<0x114, 0x2>(x, sa[1][j]); x = dpp_merge<0x118, 0x4>(x, sa[2][j]); x = dpp_merge<0x11C, 0x8>(x, sa[3][j]); ca[j] = x;
                float y = sb[0][j]; y = dpp_merge<0x114, 0x2>(y, sb[1][j]); y = dpp_merge<0x118, 0x4>(y, sb[2][j]); y = dpp_merge<0x11C, 0x8>(y, sb[3][j]); cb[j] = y; }
            float mx = fmaxf(fmaxf(fmaxf(ca[0], ca[1]), fmaxf(ca[2], ca[3])), fmaxf(fmaxf(cb[0], cb[1]), fmaxf(cb[2], cb[3])));
            mx = fmaxf(mx, dpp_movf<0x124>(mx)); mx = fmaxf(mx, dpp_movf<0x128>(mx));
            mx = fmaxf(mx, __shfl_xor(mx, 16)); mx = fmaxf(mx, __shfl_xor(mx, 32));
            const float nm = fmaxf(st.m, mx * C2), alpha = __builtin_amdgcn_exp2f(st.m - nm), bias = 8.f - nm;
            st.m = nm;
            float ps = 0.f;
#pragma unroll
            for (int j = 0; j < 4; ++j) { ca[j] = __builtin_amdgcn_exp2f(__builtin_fmaf(ca[j], C2, bias)); cb[j] = __builtin_amdgcn_exp2f(__builtin_fmaf(cb[j], C2, bias)); ps += ca[j] + cb[j]; }
            st.l = st.l * alpha + ps;
            if (!__all(alpha == 1.f)) {
#pragma unroll
                for (int dt = 0; dt < 8; ++dt) st.o[dt] = st.o[dt] * alpha;
            }
            const int wa = (int)pk4_fp8(ca[0], ca[1], ca[2], ca[3]), wb = (int)pk4_fp8(cb[0], cb[1], cb[2], cb[3]);
            pf[0] = wa; pf[1] = dpp_mov<0x104>(wa); pf[2] = dpp_mov<0x108>(wa); pf[3] = dpp_mov<0x10C>(wa);
            pf[4] = wb; pf[5] = dpp_mov<0x104>(wb); pf[6] = dpp_mov<0x108>(wb); pf[7] = dpp_mov<0x10C>(wb);
        } else {
        float mx = NEG_INF;
#pragma unroll
            for (int T = 0; T < 4; ++T) { mx = fmaxf(mx, fmaxf(fmaxf(sa[T][0], sa[T][1]), fmaxf(sa[T][2], sa[T][3]))); mx = fmaxf(mx, fmaxf(fmaxf(sb[T][0], sb[T][1]), fmaxf(sb[T][2], sb[T][3]))); }
            mx = fmaxf(mx, __shfl_xor(mx, 16)); mx = fmaxf(mx, __shfl_xor(mx, 32));
            const float nm = fmaxf(st.m, mx * C2), alpha = __builtin_amdgcn_exp2f(st.m - nm), bias = 8.f - nm;
            st.m = nm;
            float ps = 0.f;
#pragma unroll
            for (int T = 0; T < 4; ++T)
#pragma unroll
                for (int j = 0; j < 4; ++j) { sa[T][j] = __builtin_amdgcn_exp2f(__builtin_fmaf(sa[T][j], C2, bias)); sb[T][j] = __builtin_amdgcn_exp2f(__builtin_fmaf(sb[T][j], C2, bias)); ps += sa[T][j] + sb[T][j]; }
            st.l = st.l * alpha + ps;
            if (!__all(alpha == 1.f)) {
#pragma unroll
                for (int dt = 0; dt < 8; ++dt) st.o[dt] = st.o[dt] * alpha;
            }
#pragma unroll
            for (int T = 0; T < 4; ++T) { pf[T] = (int)pk4_fp8(sa[T][0], sa[T][1], sa[T][2], sa[T][3]); pf[4 + T] = (int)pk4_fp8(sb[T][0], sb[T][1], sb[T][2], sb[T][3]); }
        }
        if (!LATE_K)
        { const int n0 = (2 * ss + 2 < nblk) ? 2 * ss + 2 : 2 * ss, n1 = (2 * ss + 3 < nblk) ? 2 * ss + 3 : n0;
          const int c0_ = blk(n0), c1_ = blk(n1);
#pragma unroll
          for (int T = 0; T < 4; ++T) { KA[T] = ld32(kb + (size_t)c0_ * 8192 + T * 2048); KB[T] = ld32(kb + (size_t)c1_ * 8192 + T * 2048); } }
#pragma unroll
        for (int dt = 0; dt < 8; ++dt) st.o[dt] = MFMA128(vf[dt], pf, st.o[dt]);
        if (LATE_K)
        { const int n0 = (2 * ss + 2 < nblk) ? 2 * ss + 2 : 2 * ss, n1 = (2 * ss + 3 < nblk) ? 2 * ss + 3 : n0;
          const int c0_ = blk(n0), c1_ = blk(n1);
#pragma unroll
          for (int T = 0; T < 4; ++T) { KA[T] = ld32(kb + (size_t)c0_ * 8192 + T * 2048); KB[T] = ld32(kb + (size_t)c1_ * 8192 + T * 2048); } }
    }
    if (C4) { st.l += dpp_movf<0x124>(st.l); st.l += dpp_movf<0x128>(st.l); }
}
DEVI void attn128_k0(v8i (&KA)[4], v8i (&KB)[4], const unsigned char* kb, int b0_, int b1_) {
#pragma unroll
    for (int T = 0; T < 4; ++T) { KA[T] = ld32(kb + (size_t)b0_ * 8192 + T * 2048); KB[T] = ld32(kb + (size_t)b1_ * 8192 + T * 2048); }
}
struct SelMask { int cur, t; DEVI bool need(int b) const { return b == cur; } DEVI bool vis(int key) const { return key <= t; } };
struct WinMask { int t0, tq; DEVI bool need(int b) const { return !(64 * b + 63 <= t0 && 64 * b >= t0 - 496); } DEVI bool vis(int key) const { return (unsigned)(tq - key) < 512u; } };
DEVI v8i q_frag8(const bf16* qp, bool on) {
    v8i qf;
#pragma unroll
    for (int i = 0; i < 4; ++i) { const v4u w = *(const v4u*)(qp + 8 * i);
        qf[2 * i] = on ? (int)pk4_fp8(bflo(w.x), bfhi(w.x), bflo(w.y), bfhi(w.y)) : 0; qf[2 * i + 1] = on ? (int)pk4_fp8(bflo(w.z), bfhi(w.z), bflo(w.w), bfhi(w.w)) : 0; }
    return qf;
}
DEVI void attn_store(AttnState& st, bf16* dst, bool active, int lane, float oscale = 1.f) {
    const int q = lane >> 4;
    float l = st.l; l += __shfl_xor(l, 16); l += __shfl_xor(l, 32);
    const float inv = l > 0.f ? oscale / l : 0.f;
    if (active) {
#pragma unroll
        for (int dt = 0; dt < 8; ++dt) { v2u w; w.x = pk2(st.o[dt][0] * inv, st.o[dt][1] * inv); w.y = pk2(st.o[dt][2] * inv, st.o[dt][3] * inv); *(v2u*)(dst + 16 * dt + 4 * q) = w; }
    }
}
template <int MODE>
DEVI void attn_run_linear2(AttnState& st0, AttnState& st1, const bf16x8 (&q0)[4], const bf16x8 (&q1)[4], const bf16* kbase, const bf16* vtbase, int kstart, int nsteps, int tq, int lane) {
    const int r = lane & 15;
    for (int s = 0; s < nsteps; ++s) {
        KVFrag A;
        kv_load(A, kbase, vtbase, kstart + 32 * s, r);
        attn_compute<MODE>(st0, q0, A, kstart + 32 * s, tq, lane);
        attn_compute<MODE>(st1, q1, A, kstart + 32 * s, tq, lane);
    }
}
DEVI void cmp_att_job2(Frame& F, int tile, int hp) {
    const int lane = F.lane, r = lane & 15, q = lane >> 4, t = tile * 16 + r, h = 2 * hp, g = h >> 2;
    AttnState st0, st1; attn_init(st0); attn_init(st1);
    bf16x8 q0[4], q1[4];
    const bf16* qp = (const bf16*)(F.ws + R_Q) + (size_t)t * DATT + (size_t)h * HD + 8 * q;
#pragma unroll
    for (int ks = 0; ks < 4; ++ks) { q0[ks] = ldg8(qp + 32 * ks); q1[ks] = ldg8(qp + HD + 32 * ks); }
    if (tile > 0) {
        const int nsteps = ((tile - 1) >> 5) + 1;
        const bf16* kb = (const bf16*)(F.ws + R_KC) + (size_t)g * 1024 * HD + lane * 8;
        const bf16* vb = (const bf16*)(F.ws + R_VCT) + (size_t)g * HD * 1024 + lane * 8;
        attn_run_linear2<0>(st0, st1, q0, q1, kb, vb, 0, nsteps, t, lane);
    }
    attn_store(st0, (bf16*)(F.ws + R_OC) + (size_t)t * DATT + (size_t)h * HD, true, lane);
    attn_store(st1, (bf16*)(F.ws + R_OC) + (size_t)t * DATT + (size_t)(h + 1) * HD, true, lane);
}
DEVI void win_att_job2(Frame& F, int tile, int hp) {
    const int lane = F.lane, r = lane & 15, q = lane >> 4, t0 = tile * 16, t = t0 + r, h = 2 * hp, g = h >> 2;
    AttnState st0, st1; attn_init(st0); attn_init(st1);
    bf16x8 q0[4], q1[4];
    const bf16* qp = (const bf16*)(F.ws + R_QR) + (size_t)t * DATT + (size_t)h * HD + 8 * q;
#pragma unroll
    for (int ks = 0; ks < 4; ++ks) { q0[ks] = ldg8(qp + 32 * ks); q1[ks] = ldg8(qp + HD + 32 * ks); }
    int k_lo = t0 - 511; k_lo = k_lo < 0 ? 0 : k_lo; k_lo &= ~31;
    const bf16* kb = (const bf16*)(F.ws + R_KWF) + (size_t)g * S * HD + lane * 8;
    const bf16* vb = (const bf16*)(F.ws + R_VWT) + (size_t)g * HD * S + lane * 8;
    attn_run_linear2<1>(st0, st1, q0, q1, kb, vb, k_lo, ((t0 + 15 - k_lo) >> 5) + 1, t, lane);
    attn_store(st0, (bf16*)(F.ws + R_OW) + (size_t)t * DATT + (size_t)h * HD, true, lane);
    attn_store(st1, (bf16*)(F.ws + R_OW) + (size_t)t * DATT + (size_t)(h + 1) * HD, true, lane);
}
DEVI void win_att_job8(Frame& F, int tile, int h) {
    const int lane = F.lane, r = lane & 15, q = lane >> 4, t0 = tile * 16, t = t0 + r, g = h >> 2;
    AttnState st; attn_init(st);
    const v8i qf = q_frag8((const bf16*)(F.ws + R_QR) + (size_t)t * DATT + (size_t)h * HD + 32 * q, true);
    const int lo = t0 - 511, blo = (lo < 0 ? 0 : lo) >> 6, nblk = (t0 >> 6) - blo + 1;
    v8i KA[4], KB[4]; const unsigned char* kb = (const unsigned char*)(F.ws + R_KW8) + (size_t)g * S * HD + lane * 16;
    attn128_k0(KA, KB, kb, blo, blo + (nblk > 1 ? 1 : 0));
    attn128_run<false, false>(st, qf, kb, (const unsigned char*)(F.ws + R_VW8) + (size_t)g * S * HD + lane * 16, nblk,
                [&](int i) { return blo + i; }, WinMask{t0, t}, q, KA, KB);
    attn_store(st, (bf16*)(F.ws + R_OW) + (size_t)t * DATT + (size_t)h * HD, true, lane);
}
DEVI void cmp_att_job(Frame& F, int tile, int h) {
    const int lane = F.lane, r = lane & 15, q = lane >> 4, t = tile * 16 + r, g = h >> 2;
    AttnState st; attn_init(st);
    bf16x8 qf[4];
    const bf16* qp = (const bf16*)(F.ws + R_Q) + (size_t)t * DATT + (size_t)h * HD + 8 * q;
#pragma unroll
    for (int ks = 0; ks < 4; ++ks) qf[ks] = ldg8(qp + 32 * ks);
    if (tile > 0) {
        const int nsteps = ((tile - 1) >> 5) + 1;
        const bf16* kb = (const bf16*)(F.ws + R_KC) + (size_t)g * 1024 * HD + lane * 8;
        const bf16* vb = (const bf16*)(F.ws + R_VCT) + (size_t)g * HD * 1024 + lane * 8;
        attn_run_linear<0>(st, qf, kb, vb, 0, nsteps, t, lane);
    }
    attn_store(st, (bf16*)(F.ws + R_OC) + (size_t)t * DATT + (size_t)h * HD, true, lane);
}
DEVI void win_att_job(Frame& F, int tile, int h) {
    const int lane = F.lane, r = lane & 15, q = lane >> 4, t0 = tile * 16, t = t0 + r, g = h >> 2;
    AttnState st; attn_init(st);
    bf16x8 qf[4];
    const bf16* qp = (const bf16*)(F.ws + R_QR) + (size_t)t * DATT + (size_t)h * HD + 8 * q;
#pragma unroll
    for (int ks = 0; ks < 4; ++ks) qf[ks] = ldg8(qp + 32 * ks);
    int k_lo = t0 - 511; k_lo = k_lo < 0 ? 0 : k_lo; k_lo &= ~31;
    const bf16* kb = (const bf16*)(F.ws + R_KWF) + (size_t)g * S * HD + lane * 8;
    const bf16* vb = (const bf16*)(F.ws + R_VWT) + (size_t)g * HD * S + lane * 8;
    attn_run_linear<1>(st, qf, kb, vb, k_lo, ((t0 + 15 - k_lo) >> 5) + 1, t, lane);
    attn_store(st, (bf16*)(F.ws + R_OW) + (size_t)t * DATT + (size_t)h * HD, true, lane);
}
DEVI f32x4 sel_imp_load(Frame& F, int t, int g) { return *(const f32x4*)((const float*)(F.ws + R_IMP) + ((size_t)t * 2 + g) * NSB + 4 * F.lane); }
DEVI void sel_att_job(Frame& F, int t, int g, const f32x4 iv, int variant = 0) {
    const int lane = F.lane, r = lane & 15, q = lane >> 4;
    v4u qraw[4];
    { const bf16* qp = (const bf16*)(F.ws + R_QR) + (size_t)t * DATT + (size_t)(4 * g + (r & 3)) * HD + 32 * q;
#pragma unroll
      for (int i = 0; i < 4; ++i) qraw[i] = *(const v4u*)(qp + 8 * i); }
    const int cur = t >> 6;
    v8i KA[4], KB[4]; const unsigned char* kb = (const unsigned char*)(F.ws + R_KS8) + (size_t)g * S * HD + lane * 16;
    attn128_k0(KA, KB, kb, 0, cur);
    const int nvis = (t - 31) >> 4, jlim = (t >= 31) ? ((nvis + 1) >> 2) : -1;
    unsigned ikey[4]; bool cand[4], sel[4];
    int nforced = 0, ncand = 0;
#pragma unroll
    for (int i = 0; i < 4; ++i) { const int j = 4 * lane + i; const float im = (j <= jlim) ? iv[i] : 0.f;
        const bool allowed = j <= cur, forced = allowed && ((j == 0) || (j == cur) || (j == cur - 1));
        ikey[i] = __float_as_uint(im); cand[i] = allowed && !forced; sel[i] = forced;
        nforced += __builtin_popcountll(__ballot(forced)); ncand += __builtin_popcountll(__ballot(cand[i])); }
    const int K = 16 - nforced;
    if (ncand <= K) {
#pragma unroll
        for (int i = 0; i < 4; ++i) sel[i] = sel[i] || cand[i];
    } else {
        unsigned thr = 0u;
        for (int bit = 30; bit >= 0; --bit) {
            const unsigned tr = thr | (1u << bit); int cnt = 0;
#pragma unroll
            for (int i = 0; i < 4; ++i) cnt += __builtin_popcountll(__ballot(cand[i] && ikey[i] >= tr));
            if (cnt >= K) { thr = tr; if (cnt == K) break; }
        }
        int cgt = 0; unsigned long long tm[4];
#pragma unroll
        for (int i = 0; i < 4; ++i) { const bool gt = cand[i] && ikey[i] > thr; sel[i] = sel[i] || gt; cgt += __builtin_popcountll(__ballot(gt)); tm[i] = __ballot(cand[i] && ikey[i] == thr); }
        for (int need = K - cgt; need > 0; --need) {
            int bestj = 1 << 30;
#pragma unroll
            for (int i = 0; i < 4; ++i) if (tm[i]) { const int j = 4 * (int)__builtin_ctzll(tm[i]) + i; bestj = j < bestj ? j : bestj; }
#pragma unroll
            for (int i = 0; i < 4; ++i) { if ((bestj & 3) == i) tm[i] &= tm[i] - 1ull; if (4 * lane + i == bestj) sel[i] = true; }
        }
    }
    int selv = 0, nsel = 1;
    if (cur >= 1) { selv = (lane == 1) ? cur : selv; nsel = 2; }
    if (cur >= 2) { selv = (lane == 2) ? cur - 1 : selv; nsel = 3; }
#pragma unroll
    for (int i = 0; i < 4; ++i) { const int jb = 4 * lane + i; unsigned long long m = __ballot(sel[i] && jb != 0 && jb != cur && jb != cur - 1);
        while (m) { const int bl = (int)__builtin_ctzll(m); m &= m - 1ull; selv = (lane == nsel) ? (4 * bl + i) : selv; ++nsel; } }
    if (variant == 4) nsel = 0;
#ifdef REP_PHASE
    if (variant == 1) selv = lane & 3;
    if (variant == 2) { selv = cur - lane; selv = selv < 0 ? 0 : selv; }
    if (variant == 4) { selv = lane & 3; nsel = 16; }
    if (variant == 3) nsel = 0;
#endif
    AttnState st; attn_init(st);
    v8i qf;
#pragma unroll
    for (int i = 0; i < 4; ++i) { const v4u w = qraw[i];
        qf[2 * i] = (r < 4) ? (int)pk4_fp8(bflo(w.x), bfhi(w.x), bflo(w.y), bfhi(w.y)) : 0; qf[2 * i + 1] = (r < 4) ? (int)pk4_fp8(bflo(w.z), bfhi(w.z), bflo(w.w), bfhi(w.w)) : 0; }
    attn128_run<false, true>(st, qf, kb, (const unsigned char*)(F.ws + R_VS8) + (size_t)g * S * HD + lane * 16, nsel,
                [&](int i) { return __builtin_amdgcn_readlane(selv, i); }, SelMask{cur, t}, q, KA, KB);
    attn_store(st, (bf16*)(F.ws + (variant ? R_ACT : R_OS)) + (size_t)t * DATT + (size_t)(4 * g + (r & 3)) * HD, r < 4, lane);
}

DEVI void mixnorm_job(Frame& F, const float* pMOG, int l, int t) {
    const int lane = F.lane;
    const float* mg = pMOG + (size_t)l * D;
    unsigned char* mixed = (unsigned char*)(F.ws + R_MIXED);
#pragma unroll
    for (int part = 0; part < 2; ++part) {
        const bf16* src = (const bf16*)(F.ws + (part ? R_SSMO : R_CONVO)) + (size_t)t * 512 + 8 * lane;
        const int gofs = part ? (DCONV + DATT) : 0;
        const v4u w = *(const v4u*)src; float x[8] = {bflo(w.x), bfhi(w.x), bflo(w.y), bfhi(w.y), bflo(w.z), bfhi(w.z), bflo(w.w), bfhi(w.w)};
        float s = 0.f;
#pragma unroll
        for (int c = 0; c < 8; ++c) s += x[c] * x[c];
        const float rr = 1.f / sqrtf(wave_sum(s) * (1.f / 512.f) + EPS);
        const f32x4 g0 = *(const f32x4*)(mg + gofs + 8 * lane), g1 = *(const f32x4*)(mg + gofs + 8 * lane + 4);
        v4u o; o.x = pk2(x[0] * rr * g0[0], x[1] * rr * g0[1]); o.y = pk2(x[2] * rr * g0[2], x[3] * rr * g0[3]); o.z = pk2(x[4] * rr * g1[0], x[5] * rr * g1[1]); o.w = pk2(x[6] * rr * g1[2], x[7] * rr * g1[3]);
        *(v4u*)(mixed + tix(S, t, 2 * (gofs + 8 * lane))) = o;
    }
    {
        const int h = lane >> 3; const float* gt = (const float*)(F.ws + R_GATES) + (size_t)t * 24 + 3 * h;
        const float gc = gt[0], gs = gt[1], gw = gt[2];
        const size_t off = (size_t)t * DATT + 16 * lane;
        const bf16* pc = (const bf16*)(F.ws + R_OC) + off; const bf16* ps = (const bf16*)(F.ws + R_OS) + off; const bf16* pw = (const bf16*)(F.ws + R_OW) + off;
        float x[16]; float s = 0.f;
#pragma unroll
        for (int hh = 0; hh < 2; ++hh) { const v4u a = *(const v4u*)(pc + 8 * hh), b = *(const v4u*)(ps + 8 * hh), c = *(const v4u*)(pw + 8 * hh);
            const unsigned aw[4] = {a.x, a.y, a.z, a.w}, bw[4] = {b.x, b.y, b.z, b.w}, cw[4] = {c.x, c.y, c.z, c.w};
#pragma unroll
            for (int i = 0; i < 4; ++i) { x[8 * hh + 2 * i] = gc * bflo(aw[i]) + gs * bflo(bw[i]) + gw * bflo(cw[i]); x[8 * hh + 2 * i + 1] = gc * bfhi(aw[i]) + gs * bfhi(bw[i]) + gw * bfhi(cw[i]); } }
#pragma unroll
        for (int c = 0; c < 16; ++c) s += x[c] * x[c];
        const float rr = 1.f / sqrtf(wave_sum(s) * (1.f / 1024.f) + EPS);
        const float* gp = mg + DCONV + 16 * lane;
        float gg[16];
#pragma unroll
        for (int c4 = 0; c4 < 4; ++c4) { const f32x4 v = *(const f32x4*)(gp + 4 * c4); gg[4 * c4] = v[0]; gg[4 * c4 + 1] = v[1]; gg[4 * c4 + 2] = v[2]; gg[4 * c4 + 3] = v[3]; }
        v4u o0, o1;
        o0.x = pk2(x[0] * rr * gg[0], x[1] * rr * gg[1]); o0.y = pk2(x[2] * rr * gg[2], x[3] * rr * gg[3]); o0.z = pk2(x[4] * rr * gg[4], x[5] * rr * gg[5]); o0.w = pk2(x[6] * rr * gg[6], x[7] * rr * gg[7]);
        o1.x = pk2(x[8] * rr * gg[8], x[9] * rr * gg[9]); o1.y = pk2(x[10] * rr * gg[10], x[11] * rr * gg[11]); o1.z = pk2(x[12] * rr * gg[12], x[13] * rr * gg[13]); o1.w = pk2(x[14] * rr * gg[14], x[15] * rr * gg[15]);
        *(v4u*)(mixed + tix(S, t, 2 * (DCONV + 16 * lane))) = o0; *(v4u*)(mixed + tix(S, t, 2 * (DCONV + 16 * lane + 8))) = o1;
    }
}

DEVI void norm_route_job(Frame& F, const float* g, const float* rw, int t, bool route) {
    const int lane = F.lane;
    const bf16* xrow = (const bf16*)(F.ws + WS_H) + (size_t)t * D;
    unsigned char* obase = (unsigned char*)(F.ws + WS_HN);
    f32x4 v[8]; float s = 0.f;
#pragma unroll
    for (int j = 0; j < 8; ++j) { v[j] = row_ld4<true>(xrow, 4 * lane + 256 * j); s += (v[j].x * v[j].x + v[j].y * v[j].y) + (v[j].z * v[j].z + v[j].w * v[j].w); }
    const float rr = 1.f / sqrtf(wave_sum(s) * (1.f / D) + EPS);
#pragma unroll
    for (int j = 0; j < 8; ++j) { const f32x4 gg = *(const f32x4*)(g + 4 * lane + 256 * j); v[j] = v[j] * rr * gg;
        *(unsigned*)((unsigned char*)(F.ws + R_HN8) + tix(S, t, 4 * lane + 256 * j)) = pk4_fp8(v[j].x, v[j].y, v[j].z, v[j].w); }
    if (!route) return;
    float lg[8];
#pragma unroll
    for (int e = 0; e < 8; ++e) lg[e] = 0.f;
#pragma unroll
    for (int j = 0; j < 8; ++j)
#pragma unroll
        for (int i = 0; i < 4; ++i) { const int k = 4 * lane + 256 * j + i; const f32x4 a = *(const f32x4*)(rw + (size_t)k * 8), b = *(const f32x4*)(rw + (size_t)k * 8 + 4); const float x = v[j][i];
            lg[0] += x * a[0]; lg[1] += x * a[1]; lg[2] += x * a[2]; lg[3] += x * a[3]; lg[4] += x * b[0]; lg[5] += x * b[1]; lg[6] += x * b[2]; lg[7] += x * b[3]; }
#pragma unroll
    for (int e = 0; e < 8; ++e) lg[e] = wave_sum(lg[e]);
    int e1 = 0; float v1 = lg[0];
#pragma unroll
    for (int e = 1; e < 8; ++e) if (lg[e] > v1) { v1 = lg[e]; e1 = e; }
    int e2 = -1; float v2 = -3.0e38f;
#pragma unroll
    for (int e = 0; e < 8; ++e) if (e != e1 && lg[e] > v2) { v2 = lg[e]; e2 = e; }
    const float p2 = __expf(v2 - v1), w1 = 1.f / (1.f + p2), w2 = p2 / (1.f + p2);
    if (lane < 2) {
        const int e = lane ? e2 : e1; const float w = lane ? w2 : w1;
        const unsigned slot = __hip_atomic_fetch_add((unsigned*)(F.ctl + CW_ECNT + 64 * e), 1u, RLX_AGENT);
        ((int*)(F.ws + WS_TOK + TOK_E))[2 * t + lane] = e; ((float*)(F.ws + WS_TOK + TOK_W))[2 * t + lane] = w; ((int*)(F.ws + WS_TOK + TOK_SLOT))[2 * t + lane] = (int)slot;
    }
}
DEVI void moe_prefix(Frame& F, int (&pe)[NE + 1]) {
    int acc = 0;
#pragma unroll
    for (int e = 0; e < NE; ++e) { pe[e] = acc; const unsigned c = __hip_atomic_load((unsigned*)(F.ctl + CW_ECNT + 64 * e), RLX_AGENT); acc += (int)((c + 255u) >> 8); }
    pe[NE] = acc;
}
DEVI void moe_gather_job(Frame& F, const int (&pe)[NE + 1], int job) {
    const int lane = F.lane, t = job >> 1;
    const int e = ((const int*)(F.ws + WS_TOK + TOK_E))[job], slot = ((const int*)(F.ws + WS_TOK + TOK_SLOT))[job];
    int p0 = 0;
#pragma unroll
    for (int k = 0; k < NE; ++k) p0 = (e == k) ? pe[k] : p0;
    const int row = p0 * 256 + slot;
    const unsigned char* src = (const unsigned char*)(F.ws + R_HN8); unsigned char* dst = (unsigned char*)(F.ws + M_ASORT);
#pragma unroll
    for (int i = 0; i < 4; ++i) { const int c8 = 8 * (lane + 64 * i); const v2u o = *(const v2u*)(src + tix(S, t, c8)); *(v2u*)(dst + tix(NPAD, row, c8)) = o; }
    if (lane == 0) { ((int*)(F.ws + WS_TOK + TOK_POS))[job] = row; ((float*)(F.ws + WS_TOK + TOK_RW))[row] = ((const float*)(F.ws + WS_TOK + TOK_W))[job]; }
}
DEVI void moe_combine_job(Frame& F, float* outp, const float* g, int t) {
    const int lane = F.lane;
    const bf16* xrow = (const bf16*)(F.ws + WS_H) + (size_t)t * D;
    const int r0 = ((const int*)(F.ws + WS_TOK + TOK_POS))[2 * t], r1 = ((const int*)(F.ws + WS_TOK + TOK_POS))[2 * t + 1];
    const bf16* y0 = (const bf16*)(F.ws + M_YS) + (size_t)r0 * D; const bf16* y1 = (const bf16*)(F.ws + M_YS) + (size_t)r1 * D;
    float* orow = outp + (size_t)t * D;
    f32x4 v[8]; float s = 0.f;
#pragma unroll
    for (int j = 0; j < 8; ++j) { const int c = 4 * lane + 256 * j; v[j] = row_ld4<true>(xrow, c);
        const v2u a = __builtin_nontemporal_load((const v2u*)(y0 + c)), b = __builtin_nontemporal_load((const v2u*)(y1 + c));
        v[j].x += bflo(a.x) + bflo(b.x); v[j].y += bfhi(a.x) + bfhi(b.x); v[j].z += bflo(a.y) + bflo(b.y); v[j].w += bfhi(a.y) + bfhi(b.y);
        s += (v[j].x * v[j].x + v[j].y * v[j].y) + (v[j].z * v[j].z + v[j].w * v[j].w); }
    const float rr = 1.f / sqrtf(wave_sum(s) * (1.f / D) + EPS);
#pragma unroll
    for (int j = 0; j < 8; ++j) { const int c = 4 * lane + 256 * j; const f32x4 gg = *(const f32x4*)(g + c); __builtin_nontemporal_store(v[j] * rr * gg, (f32x4*)(orow + c)); }
}

#ifndef REPV
#define REPV 0
#endif
#ifndef MK_N_LAUNCHES
#define MK_N_LAUNCHES 1
#endif
constexpr int N_PHASES = 25;

__global__ void __launch_bounds__(NTHR, 2) fwd_kernel(Args args) {
    extern __shared__ __attribute__((aligned(16))) unsigned char lds[];
    Frame F;
    F.lds = (LAS unsigned char*)lds;
    F.MISC = (volatile LAS unsigned*)(F.lds + MISC_OFF);
    F.tid = threadIdx.x; F.lane = F.tid & 63; F.wave = __builtin_amdgcn_readfirstlane(F.tid >> 6);
    F.G = gridDim.x; F.gw = blockIdx.x * NWAVES + F.wave; F.NGW = F.G * NWAVES;
    F.ws = args.ws; F.ctl = (gu32*)(args.ws + WS_CTL);
    if (F.tid < 38) ((const float**)(args.ws + CTL_TBL + (size_t)blockIdx.x * 512))[F.tid] = args.in[F.tid];
    unsigned char* ws = args.ws;
    for (int u = F.tid; u < (LDS_BYTES - LDSCTL_OFF) / 4; u += NTHR) ((LAS unsigned*)(F.lds + LDSCTL_OFF))[u] = 0u;
    __syncthreads();
    XcdBarrier bar = xcd_barrier_post((unsigned*)(F.ctl + CW_BAR) + args.li * XCD_BAR_WORDS, F.MISC + 8);
    const int lo = args.ph_lo, hi = args.ph_hi;
#define IN(k) (lo <= (k) && (k) < hi)
#ifdef PROBE_K
#define STAMP(i) do { if (blockIdx.x == 0 && threadIdx.x == 0) ((unsigned long long*)(args.ws + WS_CTL) + CW_DBG / 2)[(i)] = wall_clock64(); } while (0)
#else
#define STAMP(i) do { } while (0)
#endif
#define SEAM(k) do { if (IN(k) && IN((k) + 1)) xcd_barrier(bar); STAMP((k) + 1); } while (0)
    const int bx = blockIdx.x;
    STAMP(0);

#ifdef REP_PHASE
#define REPS(k) ((k) == REP_PHASE ? 1 + REP_N : 1)
#else
#define REPS(k) 1
#endif
#ifndef REPV
#define REPV 0
#endif
    for (int rep_ = 0; rep_ < REPS(0); ++rep_) if (IN(0)) { if (rep_) xcd_barrier(bar); F.ws = launder(args.ws); F.tid = vlaunder(threadIdx.x); F.lane = F.tid & 63; p0_prologue(F, rep_ ? REPV : 0); }
    SEAM(0);

#pragma unroll 1
    for (int l = 0; l < 2; ++l) {
        const int P = 1 + 12 * l;
#define PH(k) for (int rep_ = 0; rep_ < REPS(k); ++rep_) if (IN(k)) if ((rep_ == 0 || (xcd_barrier(bar), true)) && (F.ws = ws = launder(args.ws)) != nullptr && ((F.tid = vlaunder(threadIdx.x)), (F.lane = F.tid & 63), true))
        PH(P + 0) {
            pg8::Gemm g{(const bf16*)(ws + WS_HN), (const bf16*)(ws + R_WIN) + (size_t)l * 4096 * D, D, S, 4096};
            pg8::StaticOrder so; so.init(S, 4096, F.G, bx);
            if (rep_ && REPV == 1) { EpiBiasBf16 E2{(bf16*)(ws + R_ACT), 4096, F.in(IN_FNG)}; pg8::gemm_phase(F.lds + RING_OFF, g, so, E2); }
            else {
            EpiInProj E{(bf16*)(ws + R_CONVU), (bf16*)(ws + R_Q), (bf16*)(ws + R_KV), (bf16*)(ws + R_U)};
            pg8::gemm_phase(F.lds + RING_OFF, g, so, E); }
        }
        SEAM(P + 0);
        PH(P + 1) {
            if (!rep_ || REPV == 0 || REPV == 5)
            { pg8::Gemm g{(const bf16*)(ws + R_U), (const bf16*)(ws + R_TW) + (size_t)l * NGRP * 512 * 256, 256, 32768, 16384};
              Ssm1Order so{F.G, bx}; EpiSsm1 E{(float*)(ws + R_YINTRA), (float*)(ws + R_SC)};
              pg8::gemm_phase(F.lds + RING_OFF, g, so, E); }
            if (!rep_ || REPV == 0 || REPV == 1)
            for (int c = bx; c < 256; c += F.G) compress_job(F, l, c);
            const float* pGB = F.in(IN_GB); const int* pPOS = (const int*)F.in(IN_POS); const float* pDWW = F.in(IN_DWW); const float* pDWB = F.in(IN_DWB); const float* pLNG = F.in(IN_LNG); const float* pLNB = F.in(IN_LNB);
            for (int j = F.gw; j < 2048 + 4096 + 1024 + (rep_ ? 0 : S); j += F.NGW) {
                int r = j;
                if (r < 2048) { if (!rep_ || REPV == 0 || REPV == 2) vt_job(F, r); continue; } r -= 2048;
                if (r < 4096) { if (!rep_ || REPV == 0 || REPV == 3) dwconv_job(F, pDWW, pDWB, pLNG, pLNB, l, r); continue; } r -= 4096;
                if (r < 1024) { if (!rep_ || REPV == 0 || REPV == 4) gates_job(F, pGB, l, r); continue; } r -= 1024;
                rope_job(F, pPOS, r);
            }
        }
        SEAM(P + 1);
        PH(P + 2) {
            if (!rep_ || REPV == 0 || REPV == 1)
            { pg8::Gemm g{(const bf16*)(ws + R_CONVACT), (const bf16*)(ws + R_CPW) + (size_t)l * 512 * 512, 512, S, 512};
              pg8::StaticOrder so; so.init(S, 512, F.G, bx); EpiBiasBf16 E{(bf16*)(ws + R_CONVO), DCONV, F.in(IN_PWB) + l * DCONV};
              pg8::gemm_phase(F.lds + RING_OFF, g, so, E); }
            const bool scan_wave = (F.NGW >= 64) && (F.wave == 0) && (bx < 32);
            if (scan_wave) { if (!rep_ || REPV == 0 || REPV == 2) scan_job(F, l, bx); }
            else if (F.NGW < 64) { if (F.gw == 0) for (int gg = 0; gg < 32; ++gg) scan_job(F, l, gg); }
            if (F.NGW == 2048) {
                if (F.gw < 1024) { const int i = F.gw >> 1, g = F.gw & 1;
                    if (!rep_ || REPV == 0 || REPV == 3) { cmp_stats_job(F, g, 1023 - i); cmp_stats_job(F, g, i); } }
                else { const int e = F.gw - 1024;
                    if (!rep_ || REPV == 0 || REPV == 4)
                    for (int pp = 0; pp < 2; ++pp) { const int p = 2 * e + pp, i = p >> 2, hp = p & 3; cmp_att_job2(F, 1023 - i, hp); cmp_att_job2(F, i, hp); } }
                if (!scan_wave) { const int nsw = bx < 32 ? bx + 1 : 32;
                    if (!rep_ || REPV == 0 || REPV == 5)
                    for (int r = F.gw - nsw; r < 8192; r += 2016) win_att_job8(F, r >> 3, r & 7); }
            } else {
                for (int j = F.gw; j < 2048 + 4096 + 8192; j += F.NGW) {
                    if (j < 2048) cmp_stats_job(F, j & 1, 1023 - (j >> 1));
                    else if (j < 6144) cmp_att_job2(F, 1023 - ((j - 2048) >> 2), (j - 2048) & 3);
                    else win_att_job8(F, (j - 6144) >> 3, (j - 6144) & 7);
                }
            }
        }
        SEAM(P + 2);
        PH(P + 3) {
            gu32* cnt2 = F.ctl + CW_SSM2 + l * 4 * 64;
            { pg8::Gemm g{(const bf16*)(ws + R_HPREV), (const bf16*)(ws + R_WO2) + (size_t)l * NGRP * 256 * 256, 256, 32768, 8192};
              Ssm2Order so{F.G, bx}; EpiSsm2 E{(const float*)(ws + R_YINTRA), (const bf16*)(ws + R_U), F.in(IN_SD) + l * DSSM, (bf16*)(ws + R_YSSM), (bf16*)(ws + R_GY)};
              pg8::gemm_phase(F.lds + RING_OFF, g, so, E);
              if (bx < 128) { VM_WAIT(); __syncthreads();
                  if (F.tid == 0) { __builtin_amdgcn_fence(__ATOMIC_RELEASE, "agent"); asm volatile("s_waitcnt vmcnt(0)" ::: "memory");
                      for (int L = bx; L < 128; L += F.G) __hip_atomic_fetch_add(cnt2 + 64 * (L & 3), 1u, RLX_AGENT); } } }
            if (F.G == 256) {
                const int x = bx & 7, g = x & 1, qbase = (x >> 1) * (S / 4), w = (bx >> 3) * NWAVES + F.wave;
                f32x4 iv = sel_imp_load(F, qbase + w, g);
                for (int i = 0; i < S / 4 / 256; ++i) { const int inx = (i + 1 < S / 4 / 256) ? i + 1 : i; const f32x4 ivn = sel_imp_load(F, qbase + inx * 256 + w, g);
                    sel_att_job(F, qbase + i * 256 + w, g, iv, rep_ ? REPV : 0); iv = ivn; }
            } else
            for (int j = F.gw; j < 2 * S; j += F.NGW) sel_att_job(F, S - 1 - (j >> 1), j & 1, sel_imp_load(F, S - 1 - (j >> 1), j & 1));
            for (int L2 = F.G - 1 - bx; L2 < 128; L2 += F.G) {
                const int pm = L2 >> 1, pn = L2 & 1;
                if (F.tid == 0) { unsigned sp = 0;
                    while (__hip_atomic_load(cnt2 + 64 * (pm >> 4), RLX_AGENT) < 32u) { __builtin_amdgcn_s_sleep(2);
                        if (++sp > (1u << 22)) { __hip_atomic_store(F.ctl + CW_SSM2 + 8 * 64, 1u, RLX_AGENT); break; } }
                    __builtin_amdgcn_fence(__ATOMIC_ACQUIRE, "agent"); asm volatile("s_waitcnt vmcnt(0)" ::: "memory"); }
                __syncthreads();
                pg8::Gemm g{(const bf16*)(ws + R_YSSM), (const bf16*)(ws + R_GLU) + (size_t)l * 512 * 512, 512, S, 512};
                OneUnit so{pm, pn}; EpiGlu E{(const bf16*)(ws + R_GY), F.in(IN_GLB) + l * DSSM, (bf16*)(ws + R_SSMO)};
                pg8::gemm_phase(F.lds + RING_OFF, g, so, E);
            }
        }
        SEAM(P + 3);
        PH(P + 5) { const float* pMOG = F.in(IN_MOG); for (int t = F.gw; t < S; t += F.NGW) mixnorm_job(F, pMOG, l, t); }
        SEAM(P + 5);
        PH(P + 6) {
            pg8::Gemm g{(const bf16*)(ws + R_MIXED), (const bf16*)(ws + R_WOUT) + (size_t)l * D * D, D, S, D};
            pg8::StaticOrder so; so.init(S, D, F.G, bx); EpiResid E{l == 0 ? (const void*)F.in(IN_X) : (const void*)(ws + WS_H), l != 0, (bf16*)(ws + WS_H), 1.f};
            pg8::gemm_phase(F.lds + RING_OFF, g, so, E);
        }
        SEAM(P + 6);
        PH(P + 7) { const float* gn = F.in(IN_NFG) + (size_t)l * D; const float* prw = F.in(IN_RW); for (int t = F.gw; t < S; t += F.NGW) norm_route_job(F, gn, prw, t, l == 1); }
        SEAM(P + 7);
        if (l == 0) {
            PH(P + 8) {
                pg8::Gemm g{(const bf16*)(ws + R_HN8), (const bf16*)(ws + R_FGU), D / 2, S, 2 * DFF};
                pg8::StaticOrder so; so.init(S, 2 * DFF, F.G, bx); EpiSwiglu8 E{(unsigned char*)(ws + R_ACT), S, 2 * DFF / 256};
                pg8::gemm_phase<EpiSwiglu8, pg8::StaticOrder, true, true, true, 0, true>(F.lds + RING_OFF, g, so, E);
            }
            SEAM(P + 8);
            PH(P + 9) {
                pg8::Gemm g{(const bf16*)(ws + R_ACT), (const bf16*)(ws + R_FD), DFF / 2, S, D};
                pg8::StaticOrder so; so.init(S, D, F.G, bx); EpiResid E{(const void*)(ws + WS_H), true, (bf16*)(ws + WS_H), 1.f / (MOE_WSCALE * MOE_ASCALE)};
                pg8::gemm_phase<EpiResid, pg8::StaticOrder, true, true, true, 0, true>(F.lds + RING_OFF, g, so, E);
            }
            SEAM(P + 9);
            PH(P + 10) { const float* gn = F.in(IN_NMG) + D; for (int t = F.gw; t < S; t += F.NGW) rms_row_to_bf16<true>((const bf16*)(ws + WS_H) + (size_t)t * D, gn, (unsigned char*)(ws + WS_HN), t, F.lane); }
            SEAM(P + 10);
            SEAM(P + 11);
        } else {
            PH(P + 8) { int pe[NE + 1]; moe_prefix(F, pe); for (int j = F.gw; j < 2 * S; j += F.NGW) moe_gather_job(F, pe, j); }
            SEAM(P + 8);
            PH(P + 9) {
                MoeOrder mo; moe_prefix(F, mo.pe); mo.nct = 2 * DFFE / 256; mo.so.init(mo.pe[NE] * 256, 2 * DFFE, F.G, bx);
                pg8::Gemm g{(const bf16*)(ws + M_ASORT), (const bf16*)(ws + WS_MOE_GU), D / 2, NPAD, NE * 2 * DFFE};
                EpiSwiglu8 E{(unsigned char*)(ws + M_ACTS), NPAD, 2 * DFFE / 256};
#if defined(REP_PHASE) && REPV == 1
                if (rep_) { EpiSwiglu8 E2{(unsigned char*)(ws + M_ACTS + 238 * MiB), NPAD, 2 * DFFE / 256}; pg8::gemm_phase<EpiSwiglu8, MoeOrder, true, true, true, 1>(F.lds + RING_OFF, g, mo, E2); } else
#elif defined(REP_PHASE) && REPV == 2
                if (rep_) { EpiSwiglu8 E2{(unsigned char*)(ws + M_ACTS + 238 * MiB), NPAD, 2 * DFFE / 256}; pg8::gemm_phase<EpiSwiglu8, MoeOrder, true, true, true, 2>(F.lds + RING_OFF, g, mo, E2); } else
#endif
                pg8::gemm_phase<EpiSwiglu8, MoeOrder, true, true, true>(F.lds + RING_OFF, g, mo, E);
            }
            SEAM(P + 9);
            PH(P + 10) {
                MoeOrder mo; moe_prefix(F, mo.pe); mo.nct = D / 256; mo.so.init(mo.pe[NE] * 256, D, F.G, bx);
                const int units = mo.pe[NE] * (D / 256), full = (F.G == 256) ? units / 256 : (1 << 30), T = (F.G == 256) ? units - full * 256 : 0;
                mo.imax = full;
                pg8::Gemm g{(const bf16*)(ws + M_ACTS), (const bf16*)(ws + WS_MOE_D), DFFE / 2, NPAD, NE * D};
                const float oscale = 1.f / (MOE_WSCALE * MOE_ASCALE);
                EpiMoeDown E{(bf16*)(ws + M_YS), (const float*)(ws + WS_TOK + TOK_RW), oscale};
                pg8::gemm_phase<EpiMoeDown, MoeOrder, true, true, true>(F.lds + RING_OFF, g, mo, E);
                if (T > 0) {
                    const int ns = (T <= 36) ? 7 : 4, kt = (DFFE / 128) / ns;
                    if (bx < T * ns) {
                        const int u = bx / ns, sl = bx - u * ns;
                        Unit uu; mo.at((long)full * 256 + u, uu);
                        float* part = (float*)(ws + M_ASORT) + (size_t)(u * ns) * 65536;
                        pg8::Gemm gs{(const bf16*)((const unsigned char*)(ws + M_ACTS) + (size_t)sl * kt * NPAD * 128), (const bf16*)((const unsigned char*)(ws + WS_MOE_D) + (size_t)sl * kt * (NE * D) * 128), kt * 64, NPAD, NE * D};
                        OneUnit ou{uu.pm, uu.pn}; EpiMoePart EP{part + (size_t)sl * 65536};
                        pg8::gemm_phase<EpiMoePart, OneUnit, true, true, true>(F.lds + RING_OFF, gs, ou, EP);
                        VM_WAIT(); __syncthreads();
                        if (F.tid == 0) { __builtin_amdgcn_fence(__ATOMIC_RELEASE, "agent"); asm volatile("s_waitcnt vmcnt(0)" ::: "memory");
                            __hip_atomic_fetch_add(F.ctl + CW_TAIL + 64 * u, 1u, RLX_AGENT);
                            unsigned sp = 0;
                            while (__hip_atomic_load(F.ctl + CW_TAIL + 64 * u, RLX_AGENT) < (unsigned)ns) { __builtin_amdgcn_s_sleep(2);
                                if (++sp > (1u << 22)) { __hip_atomic_store(F.ctl + CW_SSM2 + 8 * 64, 1u, RLX_AGENT); break; } }
                            __builtin_amdgcn_fence(__ATOMIC_ACQUIRE, "agent"); asm volatile("s_waitcnt vmcnt(0)" ::: "memory"); }
                        __syncthreads();
                        {
                            const float* rwp = (const float*)(ws + WS_TOK + TOK_RW); bf16* O = (bf16*)(ws + M_YS);
                            const int per = (256 * 32 + ns - 1) / ns, i0 = sl * per, i1 = (i0 + per < 256 * 32) ? i0 + per : 256 * 32;
                            for (int it = i0 + F.tid; it < i1; it += NTHR) {
                                const int row = it >> 5, c8 = (it & 31) * 8; const float* p = part + (size_t)row * 256 + c8;
                                f32x4 va[7], vb[7];
#pragma unroll
                                for (int k = 0; k < 7; ++k) { const float* pk = p + (size_t)(k < ns ? k : 0) * 65536; va[k] = *(const f32x4*)pk; vb[k] = *(const f32x4*)(pk + 4); }
                                f32x4 a = va[0], b = vb[0];
#pragma unroll
                                for (int k = 1; k < 7; ++k) if (k < ns) { a = a + va[k]; b = b + vb[k]; }
                                const int grow = uu.pm * 256 + row; const float sc = rwp[grow] * oscale;
                                v4u w; w.x = pg8::cvt_pk_bf16(a[0] * sc, a[1] * sc); w.y = pg8::cvt_pk_bf16(a[2] * sc, a[3] * sc); w.z = pg8::cvt_pk_bf16(b[0] * sc, b[1] * sc); w.w = pg8::cvt_pk_bf16(b[2] * sc, b[3] * sc);
                                *(v4u*)(O + (size_t)grow * D + (uu.pn & 7) * 256 + c8) = w;
                            }
                        }
                    }
                }
            }
            SEAM(P + 10);
            PH(P + 11) { const float* pFNG = F.in(IN_FNG); for (int t = F.gw; t < S; t += F.NGW) moe_combine_job(F, args.out, pFNG, t); }
        }
    }
#ifdef PROBE_K
    xcd_barrier(bar); STAMP(25);
    xcd_barrier(bar);
    { const unsigned long long* T = (const unsigned long long*)(args.ws + WS_CTL) + CW_DBG / 2;
      const float d1 = (float)(T[PROBE_K + 1] - T[PROBE_K]) * 0.01f, d2 = (float)(T[PROBE_K + 2] - T[PROBE_K + 1]) * 0.01f;
      const float c1 = sqrtf(d1), c2 = 10.f * d2;
      for (size_t i = (size_t)blockIdx.x * NTHR + threadIdx.x; i < (size_t)S * D; i += (size_t)gridDim.x * NTHR) args.out[i] = (i == 0) ? c2 : c1; }
#endif
#undef IN
#undef PH
#undef REPS
#undef SEAM
}

extern "C" void kernel_launch(void* const* d_in, const int* in_sizes, int n_in, void* d_out, int out_size, void* d_ws, size_t ws_size, hipStream_t stream) {
    static int grid = 0;
    if (grid == 0) {
        if (n_in != 38 || out_size != S * D || ws_size < WS_END) { fprintf(stderr, "kernel_launch: unexpected problem shape (n_in %d, out %d, ws %zu < %zu)\n", n_in, out_size, ws_size, (size_t)WS_END); grid = -1; return; }
        int dev = 0, cus = 0, per_cu = 0;
        if (hipGetDevice(&dev) != hipSuccess || hipDeviceGetAttribute(&cus, hipDeviceAttributeMultiprocessorCount, dev) != hipSuccess) { grid = -1; return; }
        if (hipFuncSetAttribute((const void*)fwd_kernel, hipFuncAttributeMaxDynamicSharedMemorySize, LDS_BYTES) != hipSuccess) { fprintf(stderr, "kernel_launch: hipFuncSetAttribute failed\n"); grid = -1; return; }
        if (hipOccupancyMaxActiveBlocksPerMultiprocessor(&per_cu, (const void*)fwd_kernel, NTHR, LDS_BYTES) != hipSuccess || per_cu < 1)
            fprintf(stderr, "kernel_launch: note: occupancy query says %d\n", per_cu);
        (void)hipGetLastError();
        grid = cus;
    }
    if (grid < 0) return;
    if (hipMemsetAsync((char*)d_ws + WS_CTL, 0, CTL_ZERO_BYTES, stream) != hipSuccess) return;
    Args a{};
    for (int i = 0; i < 38; ++i) a.in[i] = (const float*)d_in[i];
    a.out = (float*)d_out; a.ws = (unsigned char*)d_ws; a.dbg = 0;
    constexpr int NL = MK_N_LAUNCHES;
    for (int li = 0; li < NL; ++li) {
        a.ph_lo = (NL == 1) ? 0 : li; a.ph_hi = (NL == 1) ? N_PHASES : li + 1; a.li = li;
        hipLaunchKernelGGL(fwd_kernel, dim3(grid), dim3(NTHR), LDS_BYTES, stream, a);
        const hipError_t le = hipPeekAtLastError();
        if (le != hipSuccess) { fprintf(stderr, "kernel_launch: launch %d failed: %s\n", li, hipGetErrorName(le)); break; }
    }
}
```

```cpp
#include <hip/hip_runtime.h>
#include <cstdio>
#include <cstdint>

namespace pg8 {
#define PG8_LAS __attribute__((address_space(3)))
typedef unsigned short bf16_t;
typedef short bf16x8 __attribute__((ext_vector_type(8)));
typedef float f32x4 __attribute__((ext_vector_type(4)));
typedef unsigned u32x4 __attribute__((ext_vector_type(4)));
typedef unsigned u32x2 __attribute__((ext_vector_type(2)));
constexpr int BM = 256, BK = 64, HALF = 128, HTB = HALF * BK * 2, STAGE_BYTES = 8 * HTB, NXCD = 8, WGM = 8;

__host__ __device__ __forceinline__ int lds_byte(int r, int c) { const int st = (r >> 4) * 2 + (c >> 5), rr = r & 15, cc = c & 31, ob = rr * 64 + cc * 2; return st * 1024 + (ob ^ (((ob >> 9) & 1) << 5)); }
__host__ __device__ __forceinline__ void stage_rc(int b, int& R, int& C) { const int st = b / 1024, sb = b % 1024, swz = sb ^ (((sb >> 9) & 1) << 5); R = (st >> 1) * 16 + swz / 64; C = (st & 1) * 32 + (swz % 64) / 2; }
__host__ __device__ __forceinline__ int g_swz(int r) { const int x = (r >> 1) & 7; return (((0x1320 >> (4 * (x >> 1))) & 3) << 1) | (x & 1); }
__host__ __device__ __forceinline__ int lds_off(int r, int c) { return (r >> 3) * 1024 + (r & 7) * 128 + ((c ^ g_swz(r & 15)) << 4); }
__host__ __device__ __forceinline__ void stage_rc2(int p16, int& R, int& CH) { const int s = p16 >> 6, L = p16 & 63; R = s * 8 + (L >> 3); CH = (L & 7) ^ g_swz(R & 15); }
__host__ __device__ __forceinline__ int perm32(int rho) { const int n = rho >> 4, i = rho & 15; return 8 * (i >> 2) + 4 * n + (i & 3); }

struct Unit { int pm, pn; };
struct Gemm { const bf16_t* A; const bf16_t* Bt; int K, nra, nrb; };

struct StaticOrder {
    int nM, nN, nwg, G, c;
    __host__ __device__ void init(int M, int N, int G_, int c_) { nM = M / BM; nN = N / BM; nwg = nM * nN; G = G_; c = c_; }
    __host__ __device__ bool next(int i, Unit& u) const { return at((long)i * G + c, u); }
    __host__ __device__ bool at(const long L, Unit& u) const {
        if (L >= nwg) return false;
        int wgid = (int)L; { const int q = nwg / NXCD, r = nwg % NXCD, xcd = wgid % NXCD, off = wgid / NXCD; wgid = (xcd < r ? xcd * (q + 1) : r * (q + 1) + (xcd - r) * q) + off; }
        const int nig = WGM * nN, gid = wgid / nig, fm = gid * WGM, gsz = (nM - fm) < WGM ? (nM - fm) : WGM;
        u.pm = fm + ((wgid % nig) % gsz); u.pn = (wgid % nig) / gsz; return true;
    }
};

__device__ __forceinline__ unsigned cvt_pk_bf16(float lo, float hi) { unsigned r; asm volatile("v_cvt_pk_bf16_f32 %0, %1, %2" : "=v"(r) : "v"(lo), "v"(hi)); return r; }

typedef int v8i_t __attribute__((ext_vector_type(8)));
typedef int v4i_t __attribute__((ext_vector_type(4)));
__device__ __forceinline__ v8i_t cat8(bf16x8 lo, bf16x8 hi) { const v4i_t a = __builtin_bit_cast(v4i_t, lo), b = __builtin_bit_cast(v4i_t, hi); return __builtin_shufflevector(a, b, 0, 1, 2, 3, 4, 5, 6, 7); }
template <class Epi, class Sched, bool ALIGN_EPI = true, bool SP2 = true, bool FP8 = false, int PROBE = 0, bool RECOMP = false>
__device__ __forceinline__ void gemm_phase(PG8_LAS unsigned char* lds, const Gemm g, const Sched& S, const Epi& E) {
    int tid_ = threadIdx.x; asm volatile("" : "+v"(tid_));
    const int tid = tid_, wid = __builtin_amdgcn_readfirstlane(tid >> 6), lane = tid & 63, wr = wid >> 2, wc = wid & 3, fr = lane & 15, fq = lane >> 4;
    const int K = g.K, nt = K / BK;
    unsigned voffA[2], voffB[2];
#pragma unroll
    for (int i = 0; i < 2; ++i) { int R, CH; stage_rc2(tid + i * 512, R, CH); const int Rb = Epi::PERM ? ((R & ~31) + perm32(R & 31)) : R;
        voffA[i] = (unsigned)(R * 128 + CH * 16); voffB[i] = (unsigned)(Rb * 128 + CH * 16); }
    const unsigned kstepA = (unsigned)g.nra * 128u, kstepB = (unsigned)g.nrb * 128u;
    const unsigned hstepA = HALF * 128u, hstepB = HALF * 128u;
    const unsigned tstepA = 2 * hstepA, tstepB = 2 * hstepB;
    const unsigned ldsw = (unsigned)wid * 1024u;
    const int aoffk0 = lds_off(wr * 64 + fr, FP8 ? 2 * fq : fq), aoffk1 = FP8 ? (aoffk0 ^ 16) : lds_off(wr * 64 + fr, fq + 4);
    const int boffk0 = lds_off(wc * 32 + fr, FP8 ? 2 * fq : fq), boffk1 = FP8 ? (boffk0 ^ 16) : lds_off(wc * 32 + fr, fq + 4);
#define PG8_SA(b, h) (((b) * 2 + (h)) * HTB)
#define PG8_SB(b, h) ((4 + (b) * 2 + (h)) * HTB)
#define PG8_STAGE(bufoff, goff, voff) do { const bool isB_ = (&(voff)[0] == &voffB[0]); \
        if constexpr (RECOMP) { int t2_ = tid; asm volatile("" : "+v"(t2_));     \
            _Pragma("unroll") for (int _i = 0; _i < 2; ++_i) { int R_, C_; stage_rc2(t2_ + _i * 512, R_, C_); const int Rr_ = (isB_ && Epi::PERM) ? ((R_ & ~31) + perm32(R_ & 31)) : R_; \
                __builtin_amdgcn_raw_ptr_buffer_load_lds(isB_ ? rsrcB : rsrcA, (PG8_LAS void*)(lds + (bufoff) + ldsw + _i * 8192), 16, Rr_ * 128 + C_ * 16, (int)(goff), 0, 0); } } \
        else { _Pragma("unroll") for (int _i = 0; _i < 2; ++_i) \
        __builtin_amdgcn_raw_ptr_buffer_load_lds(isB_ ? rsrcB : rsrcA, (PG8_LAS void*)(lds + (bufoff) + ldsw + _i * 8192), 16, (int)(voff)[_i], (int)(goff), 0, 0); } } while (0)
#define PG8_LDA(dst, b, h) do { if constexpr (PROBE == 2) break; _Pragma("unroll") for (int m = 0; m < 4; ++m) { if constexpr (FP8) dst##8[m] = cat8(*(const PG8_LAS bf16x8*)(lds + PG8_SA(b, h) + aoffk0 + m * 2048), *(const PG8_LAS bf16x8*)(lds + PG8_SA(b, h) + aoffk1 + m * 2048)); \
        else { dst[m][0] = *(const PG8_LAS bf16x8*)(lds + PG8_SA(b, h) + aoffk0 + m * 2048); dst[m][1] = *(const PG8_LAS bf16x8*)(lds + PG8_SA(b, h) + aoffk1 + m * 2048); } } } while (0)
#define PG8_LDB(dst, b, h) do { if constexpr (PROBE == 2) break; _Pragma("unroll") for (int n = 0; n < 2; ++n) { if constexpr (FP8) dst##8[n] = cat8(*(const PG8_LAS bf16x8*)(lds + PG8_SB(b, h) + boffk0 + n * 2048), *(const PG8_LAS bf16x8*)(lds + PG8_SB(b, h) + boffk1 + n * 2048)); \
        else { dst[n][0] = *(const PG8_LAS bf16x8*)(lds + PG8_SB(b, h) + boffk0 + n * 2048); dst[n][1] = *(const PG8_LAS bf16x8*)(lds + PG8_SB(b, h) + boffk1 + n * 2048); } } } while (0)
#define PG8_MMA(ai, bj, At, Bt) do { if constexpr (PROBE == 1) { _Pragma("unroll") for (int m = 0; m < 4; ++m) asm volatile("" :: "v"(At##8[m])); _Pragma("unroll") for (int n = 0; n < 2; ++n) asm volatile("" :: "v"(Bt##8[n])); break; } __builtin_amdgcn_s_setprio(1); _Pragma("unroll") for (int m = 0; m < 4; ++m) _Pragma("unroll") for (int n = 0; n < 2; ++n) { \
        if constexpr (FP8) acc[ai][bj][m][n] = __builtin_amdgcn_mfma_scale_f32_16x16x128_f8f6f4(Bt##8[n], At##8[m], acc[ai][bj][m][n], 0, 0, 0, 0x7F7F7F7F, 0, 0x7F7F7F7F); \
        else { _Pragma("unroll") for (int k = 0; k < 2; ++k) acc[ai][bj][m][n] = __builtin_amdgcn_mfma_f32_16x16x32_bf16(Bt[n][k], At[m][k], acc[ai][bj][m][n], 0, 0, 0); } } __builtin_amdgcn_s_setprio(0); } while (0)
#define PG8_WAIT_V(n) asm volatile("s_waitcnt vmcnt(" #n ")" ::: "memory")
#define PG8_WAIT_L(n) asm volatile("s_waitcnt lgkmcnt(" #n ")" ::: "memory")
#define PG8_BAR __builtin_amdgcn_s_barrier()
#define PG8_SCHED __builtin_amdgcn_sched_barrier(0)
    Unit cur, nxt; int ui = 0;
    if (!S.next(0, cur)) return;
    f32x4 acc[2][2][4][2];
#pragma unroll
    for (int a = 0; a < 2; ++a)
#pragma unroll
        for (int b = 0; b < 2; ++b)
#pragma unroll
            for (int m = 0; m < 4; ++m)
#pragma unroll
                for (int n = 0; n < 2; ++n) acc[a][b][m][n] = (f32x4){0.f, 0.f, 0.f, 0.f};
    bf16x8 At[4][2], B0[2][2], B1[2][2]; v8i_t At8[4], B08[2], B18[2];
    if constexpr (PROBE == 2) { _Pragma("unroll") for (int m = 0; m < 4; ++m) { At8[m] = (v8i_t){0x3a3b3c3d + tid, 0x38393a3b, 0x3c3d3e3f, 0x40414243, 0x34353637, 0x3b3c3d3e, 0x39383736, 0x3d3c3b3a}; asm volatile("" : "+v"(At8[m])); }
        _Pragma("unroll") for (int n = 0; n < 2; ++n) { B08[n] = At8[n]; B18[n] = At8[n + 2]; asm volatile("" : "+v"(B08[n]), "+v"(B18[n])); } }
    const __amdgpu_buffer_rsrc_t rsrcA = __builtin_amdgcn_make_buffer_rsrc((void*)g.A, 0, 0x7ffff000, 0x00020000), rsrcB = __builtin_amdgcn_make_buffer_rsrc((void*)g.Bt, 0, 0x7ffff000, 0x00020000);
    unsigned cA = (unsigned)cur.pm * (unsigned)tstepA, cB = (unsigned)cur.pn * (unsigned)tstepB;
    if constexpr (SP2) {
        PG8_STAGE(PG8_SB(0, 0), cB, voffB); PG8_STAGE(PG8_SB(0, 1), cB + hstepB, voffB); PG8_STAGE(PG8_SA(0, 0), cA, voffA); PG8_STAGE(PG8_SA(0, 1), cA + hstepA, voffA);
        if (wr == 1) PG8_BAR;
        PG8_WAIT_V(2); PG8_BAR;
        PG8_STAGE(PG8_SB(1, 0), cB + kstepB, voffB); PG8_STAGE(PG8_SA(1, 0), cA + kstepA, voffA); PG8_STAGE(PG8_SB(1, 1), cB + hstepB + kstepB, voffB);
        PG8_WAIT_V(6); PG8_BAR;
    } else {
        PG8_STAGE(PG8_SB(0, 0), cB, voffB); PG8_STAGE(PG8_SA(0, 0), cA, voffA); PG8_STAGE(PG8_SB(0, 1), cB + hstepB, voffB); PG8_STAGE(PG8_SA(0, 1), cA + hstepA, voffA);
        if (wr == 1) PG8_BAR;
        PG8_WAIT_V(4); PG8_BAR;
        PG8_STAGE(PG8_SB(1, 0), cB + kstepB, voffB); PG8_STAGE(PG8_SA(1, 0), cA + kstepA, voffA); PG8_STAGE(PG8_SB(1, 1), cB + hstepB + kstepB, voffB);
        PG8_WAIT_V(6); PG8_BAR;
    }
    for (;;) {
        const bool has_next = S.next(ui + 1, nxt);
        const unsigned nA = has_next ? (unsigned)nxt.pm * (unsigned)tstepA : cA, nB = has_next ? (unsigned)nxt.pn * (unsigned)tstepB : cB;
#pragma unroll 1
        for (int t = 0; t < nt; t += 2) {
            const bool last = (t == nt - 2);
            const unsigned a1 = cA + (unsigned)(t + 1) * kstepA;
            const unsigned a2 = last ? nA : cA + (unsigned)(t + 2) * kstepA, b2 = last ? nB : cB + (unsigned)(t + 2) * kstepB;
            const unsigned a3 = a2 + kstepA, b3 = b2 + kstepB;
            if constexpr (SP2) {
            PG8_LDB(B0, 0, 0); PG8_LDB(B1, 0, 1); PG8_SCHED; PG8_LDA(At, 0, 0); PG8_STAGE(PG8_SA(1, 1), a1 + hstepA, voffA);
            PG8_WAIT_V(8); PG8_WAIT_L(0); PG8_BAR; PG8_MMA(0, 0, At, B0); PG8_MMA(0, 1, At, B1); PG8_BAR; PG8_SCHED;
            PG8_LDA(At, 0, 1); PG8_STAGE(PG8_SB(0, 0), b2, voffB); PG8_STAGE(PG8_SB(0, 1), b2 + hstepB, voffB); PG8_STAGE(PG8_SA(0, 0), a2, voffA);
            PG8_WAIT_V(8); PG8_WAIT_L(0); PG8_BAR; PG8_MMA(1, 0, At, B0); PG8_MMA(1, 1, At, B1); PG8_BAR; PG8_SCHED;
            PG8_LDB(B0, 1, 0); PG8_LDB(B1, 1, 1); PG8_SCHED; PG8_LDA(At, 1, 0); PG8_STAGE(PG8_SA(0, 1), a2 + hstepA, voffA);
            PG8_WAIT_V(8); PG8_WAIT_L(0); PG8_BAR; PG8_MMA(0, 0, At, B0); PG8_MMA(0, 1, At, B1); PG8_BAR; PG8_SCHED;
            PG8_LDA(At, 1, 1); PG8_STAGE(PG8_SB(1, 0), b3, voffB); PG8_STAGE(PG8_SB(1, 1), b3 + hstepB, voffB); PG8_STAGE(PG8_SA(1, 0), a3, voffA);
            PG8_WAIT_V(8); PG8_WAIT_L(0); PG8_BAR; PG8_MMA(1, 0, At, B0); PG8_MMA(1, 1, At, B1); PG8_BAR; PG8_SCHED;
            } else {
            PG8_LDB(B0, 0, 0); PG8_SCHED; PG8_LDA(At, 0, 0); PG8_STAGE(PG8_SA(1, 1), a1 + hstepA, voffA);
            PG8_WAIT_L(8); PG8_BAR; PG8_WAIT_L(0); PG8_MMA(0, 0, At, B0); PG8_BAR; PG8_SCHED;
            PG8_LDB(B1, 0, 1); PG8_STAGE(PG8_SB(0, 0), b2, voffB);
            PG8_BAR; PG8_WAIT_L(0); PG8_MMA(0, 1, At, B1); PG8_BAR;
            PG8_LDA(At, 0, 1); PG8_STAGE(PG8_SA(0, 0), a2, voffA);
            PG8_BAR; PG8_WAIT_L(0); PG8_MMA(1, 0, At, B0); PG8_BAR; PG8_SCHED;
            PG8_STAGE(PG8_SB(0, 1), b2 + hstepB, voffB);
            PG8_WAIT_V(6); PG8_BAR; PG8_MMA(1, 1, At, B1); PG8_BAR;
            PG8_LDB(B0, 1, 0); PG8_SCHED; PG8_LDA(At, 1, 0); PG8_STAGE(PG8_SA(0, 1), a2 + hstepA, voffA);
            PG8_WAIT_L(8); PG8_BAR; PG8_WAIT_L(0); PG8_MMA(0, 0, At, B0); PG8_BAR; PG8_SCHED;
            PG8_LDB(B1, 1, 1); PG8_STAGE(PG8_SB(1, 0), b3, voffB);
            PG8_BAR; PG8_WAIT_L(0); PG8_MMA(0, 1, At, B1); PG8_BAR;
            PG8_LDA(At, 1, 1); PG8_STAGE(PG8_SA(1, 0), a3, voffA);
            PG8_BAR; PG8_WAIT_L(0); PG8_MMA(1, 0, At, B0); PG8_BAR; PG8_SCHED;
            PG8_STAGE(PG8_SB(1, 1), b3 + hstepB, voffB);
            PG8_WAIT_V(6); PG8_BAR; PG8_MMA(1, 1, At, B1); PG8_BAR;
            }
        }
        if constexpr (ALIGN_EPI) { if (wr == 0) PG8_BAR; }
        E(acc, cur, wr, wc, fr, fq);
        if (!has_next) break;
#pragma unroll
        for (int a = 0; a < 2; ++a)
#pragma unroll
            for (int b = 0; b < 2; ++b)
#pragma unroll
                for (int m = 0; m < 4; ++m)
#pragma unroll
                    for (int n = 0; n < 2; ++n) acc[a][b][m][n] = (f32x4){0.f, 0.f, 0.f, 0.f};
        cur = nxt; cA = nA; cB = nB; ++ui;
        if constexpr (ALIGN_EPI) { if (wr == 1) PG8_BAR; }
    }
    PG8_WAIT_V(0);
    if constexpr (!ALIGN_EPI) { if (wr == 0) PG8_BAR; }
    PG8_BAR;
#undef PG8_SA
#undef PG8_SB
#undef PG8_STAGE
#undef PG8_LDA
#undef PG8_LDB
#undef PG8_MMA
#undef PG8_WAIT_V
#undef PG8_WAIT_L
#undef PG8_BAR
#undef PG8_SCHED
}
}

constexpr int S = 16384, D = 2048, DIN = 4120, DCONV = 512, DATT = 1024, DSSM = 512;
constexpr int NH = 8, NKV = 2, HD = 128, NCMP = 1023, NSB = 256, CONVW = 31;
constexpr int DFF = 5632, NE = 8, DFFE = 7168, NGRP = 32, PST = 64;
constexpr int NPAD = 2 * S + NE * 256;
constexpr float EPS = 1e-5f;
constexpr int NWAVES = 8, NTHR = 512;

constexpr size_t MiB = 1u << 20;
constexpr size_t WS_CTL = 0, CTL_ZERO_BYTES = 1 * MiB;
constexpr size_t WS_H = 1 * MiB;
constexpr size_t WS_HN = WS_H + 128 * MiB;
constexpr size_t WS_MOE_GU = WS_HN + 64 * MiB;
constexpr size_t WS_MOE_D = WS_MOE_GU + 448 * MiB;
constexpr size_t WS_TOK = WS_MOE_D + 224 * MiB;
constexpr size_t WS_R = WS_TOK + 1 * MiB;
constexpr size_t R_WIN = WS_R;
constexpr size_t R_WOUT = R_WIN + 32 * MiB;
constexpr size_t R_WG = R_WOUT + 16 * MiB;
constexpr size_t R_CPW = R_WG + 1 * MiB;
constexpr size_t R_GLU = R_CPW + 1 * MiB;
constexpr size_t R_W1K = R_GLU + 1 * MiB;
constexpr size_t R_W1V = R_W1K + 2 * MiB;
constexpr size_t R_W2 = R_W1V + 2 * MiB;
constexpr size_t R_CB = R_W2 + 1 * MiB;
constexpr size_t R_TW = R_CB + 1 * MiB;
constexpr size_t R_WO2 = R_TW + 16 * MiB;
constexpr size_t R_FGU = R_WO2 + 8 * MiB;
constexpr size_t R_FD = R_FGU + 44 * MiB;
constexpr size_t R_CONVU = R_FD + 22 * MiB;
constexpr size_t R_Q = R_CONVU + 16 * MiB;
constexpr size_t R_QR = R_Q + 32 * MiB;
constexpr size_t R_KV = R_QR + 32 * MiB;
constexpr size_t R_VST = R_KV + 48 * MiB;
constexpr size_t R_VWT = R_VST + 8 * MiB;
constexpr size_t R_KC = R_VWT + 8 * MiB;
constexpr size_t R_VCT = R_KC + 1 * MiB;
constexpr size_t R_U = R_VCT + 1 * MiB;
constexpr size_t R_GATES = R_U + 16 * MiB;
constexpr size_t R_CONVACT = R_GATES + 2 * MiB;
constexpr size_t R_IMP = R_CONVACT + 16 * MiB;
constexpr size_t R_OC = R_IMP + 32 * MiB;
constexpr size_t R_OW = R_OC + 32 * MiB;
constexpr size_t R_OS = R_OW + 32 * MiB;
constexpr size_t R_CONVO = R_OS + 32 * MiB;
constexpr size_t R_SSMO = R_CONVO + 16 * MiB;
constexpr size_t R_YINTRA = R_SSMO + 16 * MiB;
constexpr size_t R_SC = R_YINTRA + 32 * MiB;
constexpr size_t R_HPREV = R_SC + 16 * MiB;
constexpr size_t R_YSSM = R_HPREV + 16 * MiB;
constexpr size_t R_GY = R_YSSM + 16 * MiB;
constexpr size_t R_MIXED = R_GY + 16 * MiB;
constexpr size_t R_ACT = R_MIXED + 64 * MiB;
constexpr size_t R_KSF = R_ACT + 176 * MiB;
constexpr size_t R_KWF = R_KSF + 8 * MiB;
constexpr size_t R_KS8 = R_KWF + 8 * MiB;
constexpr size_t R_VS8 = R_KS8 + 4 * MiB;
constexpr size_t R_HN8 = R_VS8 + 4 * MiB;
constexpr size_t R_END = R_HN8 + 32 * MiB;
constexpr size_t R_IMP2 = R_ACT;
constexpr size_t R_KW8 = R_KSF;
constexpr size_t R_VW8 = R_VST;
constexpr size_t M_ASORT = WS_R;
constexpr size_t M_ACTS = M_ASORT + 136 * MiB;
constexpr size_t M_YS = M_ACTS + 476 * MiB;
constexpr size_t M_END = M_YS + 136 * MiB;
constexpr size_t WS_END = R_END > M_END ? R_END : M_END;
static_assert((size_t)NPAD * D * 2 <= 136 * MiB && (size_t)NPAD * DFFE * 2 <= 476 * MiB, "moe buffers");
static_assert(WS_END <= 1792 * MiB, "workspace map must fit 4x the largest input tensor");
constexpr size_t TOK_E = 0;
constexpr size_t TOK_W = 128 * 1024;
constexpr size_t TOK_SLOT = 256 * 1024;
constexpr size_t TOK_POS = 384 * 1024;
constexpr size_t TOK_RW = 512 * 1024;
constexpr int CW_BAR = 4096;
constexpr int CW_ECNT = 131072;
constexpr int CW_DBG = 140000;
constexpr int CW_JOBQ = 137216;
constexpr int CW_TAIL = 133120;
constexpr int CW_SSM2 = 132096;

constexpr int RING_OFF = 0, RING_BYTES = 131072;
constexpr int LDSCTL_OFF = RING_BYTES, MISC_OFF = LDSCTL_OFF + 320;
constexpr int LDS_BYTES = 147456;

#define GAS __attribute__((address_space(1)))
#define LAS __attribute__((address_space(3)))
#define DEVI __device__ __forceinline__
typedef unsigned short bf16;
typedef unsigned v4u __attribute__((ext_vector_type(4)));
typedef unsigned v2u __attribute__((ext_vector_type(2)));
typedef float f32x4 __attribute__((ext_vector_type(4)));
typedef float f32x2 __attribute__((ext_vector_type(2)));
typedef short bf16x8 __attribute__((ext_vector_type(8)));
typedef short bf16x4 __attribute__((ext_vector_type(4)));
typedef GAS unsigned gu32;
#define RLX_AGENT __ATOMIC_RELAXED, __HIP_MEMORY_SCOPE_AGENT
#define LDS_WAIT() asm volatile("s_waitcnt lgkmcnt(0)" ::: "memory")
#define VM_WAIT() asm volatile("s_waitcnt vmcnt(0)" ::: "memory")
DEVI unsigned f2bf(float f) { unsigned u = __builtin_bit_cast(unsigned, f); return (u + 0x7fffu + ((u >> 16) & 1u)) >> 16; }
DEVI unsigned pk2(float lo, float hi) { return f2bf(lo) | (f2bf(hi) << 16); }
DEVI float bf2f(unsigned b) { return __builtin_bit_cast(float, b << 16); }
DEVI float bflo(unsigned w) { return __builtin_bit_cast(float, w << 16); }
DEVI float bfhi(unsigned w) { return __builtin_bit_cast(float, w & 0xffff0000u); }
DEVI float sigmoidf_(float x) { return 1.f / (1.f + __expf(-x)); }
DEVI float siluf_(float x) { return x / (1.f + __expf(-x)); }
DEVI float clamp448(float x) { return fminf(fmaxf(x, -448.f), 448.f); }
DEVI unsigned pk4_fp8(float a, float b, float c, float d) { int w = 0; w = __builtin_amdgcn_cvt_pk_fp8_f32(a, b, w, false); w = __builtin_amdgcn_cvt_pk_fp8_f32(c, d, w, true); return (unsigned)w; }
DEVI size_t tix(size_t NR, size_t row, unsigned kbyte) { return ((size_t)(kbyte >> 7) * NR + row) * 128 + (kbyte & 127u); }
DEVI float wave_sum(float v) {
#pragma unroll
    for (int o = 1; o < 64; o <<= 1) v += __shfl_xor(v, o);
    return v;
}

#define XB_TMO      128
#define XB_XCNT(j)  (256  + 64 * (j))
#define XB_XSUB(j)  (1280 + 64 * (j))
#define XB_XGEN(j)  (2304 + 64 * (j))
#define XB_TOP      3328
#define XB_TOPGEN   3392
#define XCD_BAR_WORDS 3456
#define XB_SPIN_CAP (1u << 20)

__device__ __forceinline__ unsigned xb_ld(unsigned* p)              { return __hip_atomic_load(p, __ATOMIC_RELAXED, __HIP_MEMORY_SCOPE_AGENT); }
__device__ __forceinline__ unsigned xb_add(unsigned* p, unsigned v) { return __hip_atomic_fetch_add(p, v, __ATOMIC_RELAXED, __HIP_MEMORY_SCOPE_AGENT); }
__device__ __forceinline__ unsigned xb_xcc_id() { return (unsigned)__builtin_amdgcn_s_getreg((3 << 11) | 20) & 0xFu; }
#define XB_SPIN(cond, bar) do { unsigned _sp = 0; while (cond) { __builtin_amdgcn_s_sleep(1); \
    if ((++_sp & 255u) == 0u) { if (xb_ld(&(bar)[XB_TMO])) break; if (_sp > XB_SPIN_CAP) { atomicAdd(&(bar)[XB_TMO], 1u); break; } } } } while (0)

struct XcdBarrier { unsigned* bar; unsigned x; volatile LAS unsigned* st; };

__device__ __forceinline__ XcdBarrier xcd_barrier_post(unsigned* bar, volatile LAS unsigned* st) {
    XcdBarrier b; b.bar = bar; b.x = xb_xcc_id(); b.st = st;
    if (threadIdx.x == 0) (void)xb_add(&bar[XB_XCNT(b.x)], 1u);
    return b;
}
__device__ __forceinline__ void xcd_barrier_complete(unsigned* bar, unsigned x, unsigned& nloc, unsigned& nx) {
    const unsigned G = gridDim.x * gridDim.y * gridDim.z;
    unsigned sum, cnt, mine, sp = 0u;
    for (;;) {
        sum = 0u; cnt = 0u; mine = 0u;
#pragma unroll
        for (unsigned j = 0; j < 16; ++j) { const unsigned c = xb_ld(&bar[XB_XCNT(j)]); sum += c; cnt += (c > 0u) ? 1u : 0u; mine = (j == x) ? c : mine; }
        if (sum == G) break;
        __builtin_amdgcn_s_sleep(1);
        if ((++sp & 255u) == 0u) { if (xb_ld(&bar[XB_TMO])) break; if (sp > XB_SPIN_CAP) { atomicAdd(&bar[XB_TMO], 1u); break; } }
    }
    nloc = mine > 0u ? mine : 1u; nx = cnt > 0u ? cnt : 1u;
}
__device__ __forceinline__ void xcd_barrier(const XcdBarrier& b) {
    asm volatile("s_waitcnt vmcnt(0)" ::: "memory");
    __syncthreads();
    if (threadIdx.x == 0) {
        unsigned* bar = b.bar;
        __builtin_amdgcn_s_waitcnt(0);
        unsigned nloc = b.st[0], nx = b.st[1];
        if (nloc == 0u) { xcd_barrier_complete(bar, b.x, nloc, nx); b.st[0] = nloc; b.st[1] = nx; }
        const unsigned old = xb_add(&bar[XB_XSUB(b.x)], 1u);
        const unsigned gen = old / nloc;
        if (old + 1u == (gen + 1u) * nloc) {
            __builtin_amdgcn_fence(__ATOMIC_RELEASE, "agent");
            asm volatile("s_waitcnt vmcnt(0)" ::: "memory");
            const unsigned og = xb_add(&bar[XB_TOP], 1u);
            const unsigned tg = og / nx;
            if (og + 1u == (tg + 1u) * nx) xb_add(&bar[XB_TOPGEN], 1u);
            else XB_SPIN(xb_ld(&bar[XB_TOPGEN]) == tg, bar);
            __builtin_amdgcn_fence(__ATOMIC_ACQUIRE, "agent");
            xb_add(&bar[XB_XGEN(b.x)], 1u);
            asm volatile("s_waitcnt vmcnt(0)" ::: "memory");
        } else {
            XB_SPIN(xb_ld(&bar[XB_XGEN(b.x)]) == gen, bar);
            __builtin_amdgcn_fence(__ATOMIC_ACQUIRE, "agent");
            asm volatile("s_waitcnt vmcnt(0)" ::: "memory");
        }
    }
    __syncthreads();
}

using pg8::Unit; using pg8::BM; using pg8::HALF;
typedef const f32x4 (&AccT)[2][2][4][2];

struct EpiInProj {
    static constexpr bool PERM = true;
    bf16 *convu, *q, *kv, *u;
    DEVI void operator()(AccT acc, const Unit& un, int wr, int wc, int fr, int fq) const {
        const int row0 = un.pm * BM + wr * 64 + fr, pn = un.pn, cw = wc * 32 + 8 * fq;
#pragma unroll
        for (int ai = 0; ai < 2; ++ai)
#pragma unroll
            for (int m = 0; m < 4; ++m) {
                const int row = row0 + ai * HALF + m * 16;
                if (pn < 4) {
                    float o[8];
#pragma unroll
                    for (int n = 0; n < 2; ++n)
#pragma unroll
                        for (int j = 0; j < 4; ++j) o[4 * n + j] = acc[ai][0][m][n][j] * sigmoidf_(acc[ai][1][m][n][j]);
                    v4u w; w.x = pg8::cvt_pk_bf16(o[0], o[1]); w.y = pg8::cvt_pk_bf16(o[2], o[3]); w.z = pg8::cvt_pk_bf16(o[4], o[5]); w.w = pg8::cvt_pk_bf16(o[6], o[7]);
                    *(v4u*)(convu + (size_t)row * DCONV + pn * 128 + cw) = w;
                } else {
#pragma unroll
                    for (int bj = 0; bj < 2; ++bj) {
                        const f32x4 v0 = acc[ai][bj][m][0], v1 = acc[ai][bj][m][1];
                        v4u w; w.x = pg8::cvt_pk_bf16(v0[0], v0[1]); w.y = pg8::cvt_pk_bf16(v0[2], v0[3]); w.z = pg8::cvt_pk_bf16(v1[0], v1[1]); w.w = pg8::cvt_pk_bf16(v1[2], v1[3]);
                        bf16* dst;
                        if (pn < 8) dst = q + (size_t)row * DATT + (pn - 4) * 256 + bj * 128 + cw;
                        else if (pn < 14) dst = kv + ((size_t)((pn - 8) * 2 + bj) * S + row) * HD + cw;
                        else { const int ch = (pn - 14) * 256 + bj * 128 + cw;
                            dst = (bf16*)((unsigned char*)u + tix(32768, (size_t)(ch >> 4) * 1024 + (row >> 4), 2 * ((row & 15) * 16 + (ch & 15)))); }
                        *(v4u*)dst = w;
                    }
                }
            }
    }
};
struct EpiSsm1 {
    static constexpr bool PERM = false;
    float *yintra, *sc;
    DEVI void operator()(AccT acc, const Unit& un, int wr, int wc, int fr, int fq) const {
        const int row0 = un.pm * BM + wr * 64 + fr, cw = wc * 32 + 4 * fq;
        if ((un.pn & 1) == 0) {
#pragma unroll
            for (int ai = 0; ai < 2; ++ai)
#pragma unroll
                for (int m = 0; m < 4; ++m) { float* p = yintra + (size_t)(row0 + ai * HALF + m * 16) * 256 + cw;
#pragma unroll
                    for (int bj = 0; bj < 2; ++bj)
#pragma unroll
                        for (int n = 0; n < 2; ++n) *(f32x4*)(p + bj * 128 + 16 * n) = acc[ai][bj][m][n]; }
        } else {
#pragma unroll
            for (int ai = 0; ai < 2; ++ai)
#pragma unroll
                for (int m = 0; m < 4; ++m) { float* p = sc + (size_t)(row0 + ai * HALF + m * 16) * 128 + cw;
#pragma unroll
                    for (int n = 0; n < 2; ++n) *(f32x4*)(p + 16 * n) = acc[ai][0][m][n]; }
        }
    }
};
struct EpiBiasBf16 {
    static constexpr bool PERM = true;
    bf16* O; int ldc; const float* bias;
    DEVI void operator()(AccT acc, const Unit& un, int wr, int wc, int fr, int fq) const {
        const int row0 = un.pm * BM + wr * 64 + fr, col0 = un.pn * BM + wc * 32 + 8 * fq;
#pragma unroll
        for (int ai = 0; ai < 2; ++ai)
#pragma unroll
            for (int m = 0; m < 4; ++m)
#pragma unroll
                for (int bj = 0; bj < 2; ++bj) {
                    const int col = col0 + bj * HALF;
                    const f32x4 b0 = *(const f32x4*)(bias + col), b1 = *(const f32x4*)(bias + col + 4);
                    const f32x4 v0 = acc[ai][bj][m][0] + b0, v1 = acc[ai][bj][m][1] + b1;
                    v4u w; w.x = pg8::cvt_pk_bf16(v0[0], v0[1]); w.y = pg8::cvt_pk_bf16(v0[2], v0[3]); w.z = pg8::cvt_pk_bf16(v1[0], v1[1]); w.w = pg8::cvt_pk_bf16(v1[2], v1[3]);
                    *(v4u*)(O + (size_t)(row0 + ai * HALF + m * 16) * ldc + col) = w;
                }
    }
};
DEVI float gelu_tanh(float y) { const float z = 0.7978845608028654f * (y + 0.044715f * y * y * y); const float e = __expf(2.f * z); const float th = 1.f - 2.f / (e + 1.f); return 0.5f * y * (1.f + th); }
struct EpiSsm2 {
    static constexpr bool PERM = false;
    const float* yintra; const bf16* u; const float* dsk; bf16 *yssm, *gy;
    DEVI void operator()(AccT acc, const Unit& un, int wr, int wc, int fr, int fq) const {
        const int row0 = un.pm * BM + wr * 64 + fr, g = un.pn, cw = wc * 32 + 4 * fq;
#pragma unroll
        for (int ai = 0; ai < 2; ++ai)
#pragma unroll
            for (int m = 0; m < 4; ++m) {
                const int row = row0 + ai * HALF + m * 16, chunk = row & 1023;
#pragma unroll
                for (int bj = 0; bj < 2; ++bj)
#pragma unroll
                    for (int n = 0; n < 2; ++n) {
                        const int col = bj * 128 + cw + 16 * n, j = col >> 4, co = col & 15, t = chunk * 16 + j, ch = g * 16 + co;
                        const f32x4 yi = *(const f32x4*)(yintra + (size_t)row * 256 + col);
                        const v2u uu = *(const v2u*)((const unsigned char*)u + tix(32768, (size_t)g * 1024 + (t >> 4), 2 * ((t & 15) * 16 + co)));
                        const f32x4 dd = *(const f32x4*)(dsk + ch);
                        f32x4 y = acc[ai][bj][m][n] + yi;
                        y[0] += dd[0] * bflo(uu.x); y[1] += dd[1] * bfhi(uu.x); y[2] += dd[2] * bflo(uu.y); y[3] += dd[3] * bfhi(uu.y);
                        v2u w; w.x = pg8::cvt_pk_bf16(y[0], y[1]); w.y = pg8::cvt_pk_bf16(y[2], y[3]);
                        *(v2u*)((unsigned char*)yssm + tix(S, t, 2 * ch)) = w;
                        v2u w2; w2.x = pg8::cvt_pk_bf16(gelu_tanh(y[0]), gelu_tanh(y[1])); w2.y = pg8::cvt_pk_bf16(gelu_tanh(y[2]), gelu_tanh(y[3]));
                        *(v2u*)(gy + (size_t)t * DSSM + ch) = w2;
                    }
                asm volatile("" ::: "memory");
            }
    }
};
struct EpiGlu {
    static constexpr bool PERM = true;
    const bf16* gy; const float* bias; bf16* O;
    DEVI void operator()(AccT acc, const Unit& un, int wr, int wc, int fr, int fq) const {
        const int row0 = un.pm * BM + wr * 64 + fr, col0 = un.pn * BM + wc * 32 + 8 * fq;
#pragma unroll
        for (int ai = 0; ai < 2; ++ai)
#pragma unroll
            for (int m = 0; m < 4; ++m)
#pragma unroll
                for (int bj = 0; bj < 2; ++bj) {
                    const int col = col0 + bj * HALF; const size_t off = (size_t)(row0 + ai * HALF + m * 16) * DSSM + col;
                    const f32x4 b0 = *(const f32x4*)(bias + col), b1 = *(const f32x4*)(bias + col + 4);
                    const v4u g4 = *(const v4u*)(gy + off);
                    const f32x4 v0 = acc[ai][bj][m][0] + b0, v1 = acc[ai][bj][m][1] + b1;
                    v4u w;
                    w.x = pg8::cvt_pk_bf16(bflo(g4.x) * sigmoidf_(v0[0]), bfhi(g4.x) * sigmoidf_(v0[1]));
                    w.y = pg8::cvt_pk_bf16(bflo(g4.y) * sigmoidf_(v0[2]), bfhi(g4.y) * sigmoidf_(v0[3]));
                    w.z = pg8::cvt_pk_bf16(bflo(g4.z) * sigmoidf_(v1[0]), bfhi(g4.z) * sigmoidf_(v1[1]));
                    w.w = pg8::cvt_pk_bf16(bflo(g4.w) * sigmoidf_(v1[2]), bfhi(g4.w) * sigmoidf_(v1[3]));
                    *(v4u*)(O + off) = w;
                }
    }
};
struct EpiResid {
    static constexpr bool PERM = false;
    const void* base; bool b16; bf16* out; float scale;
    DEVI void operator()(AccT acc, const Unit& un, int wr, int wc, int fr, int fq) const {
        const int row0 = un.pm * BM + wr * 64 + fr, col0 = un.pn * BM + wc * 32 + 4 * fq;
#pragma unroll
        for (int ai = 0; ai < 2; ++ai) {
            f32x4 bs[4][2][2];
            if (b16) {
#pragma unroll
                for (int m = 0; m < 4; ++m) { const size_t off = (size_t)(row0 + ai * HALF + m * 16) * D + col0;
#pragma unroll
                    for (int bj = 0; bj < 2; ++bj)
#pragma unroll
                        for (int n = 0; n < 2; ++n) { const v2u w = *(const v2u*)((const bf16*)base + off + bj * HALF + n * 16); bs[m][bj][n] = (f32x4){bflo(w.x), bfhi(w.x), bflo(w.y), bfhi(w.y)}; } }
            } else {
#pragma unroll
                for (int m = 0; m < 4; ++m) { const size_t off = (size_t)(row0 + ai * HALF + m * 16) * D + col0;
#pragma unroll
                    for (int bj = 0; bj < 2; ++bj)
#pragma unroll
                        for (int n = 0; n < 2; ++n) bs[m][bj][n] = *(const f32x4*)((const float*)base + off + bj * HALF + n * 16); }
            }
#pragma unroll
            for (int m = 0; m < 4; ++m) { const size_t off = (size_t)(row0 + ai * HALF + m * 16) * D + col0;
#pragma unroll
                for (int bj = 0; bj < 2; ++bj)
#pragma unroll
                    for (int n = 0; n < 2; ++n) { const f32x4 r = bs[m][bj][n] + acc[ai][bj][m][n] * scale; v2u w; w.x = pk2(r[0], r[1]); w.y = pk2(r[2], r[3]); *(v2u*)(out + off + bj * HALF + n * 16) = w; } }
            asm volatile("" ::: "memory");
        }
    }
};
struct EpiSwiglu {
    static constexpr bool PERM = true;
    bf16* O; int ldc, nct;
    DEVI void operator()(AccT acc, const Unit& un, int wr, int wc, int fr, int fq) const {
        const int row0 = un.pm * BM + wr * 64 + fr, col0 = (un.pn % nct) * 128 + wc * 32 + 8 * fq;
#pragma unroll
        for (int ai = 0; ai < 2; ++ai)
#pragma unroll
            for (int m = 0; m < 4; ++m) {
                float o[8];
#pragma unroll
                for (int n = 0; n < 2; ++n)
#pragma unroll
                    for (int j = 0; j < 4; ++j) o[4 * n + j] = siluf_(acc[ai][0][m][n][j]) * acc[ai][1][m][n][j];
                v4u w; w.x = pg8::cvt_pk_bf16(o[0], o[1]); w.y = pg8::cvt_pk_bf16(o[2], o[3]); w.z = pg8::cvt_pk_bf16(o[4], o[5]); w.w = pg8::cvt_pk_bf16(o[6], o[7]);
                *(v4u*)(O + (size_t)(row0 + ai * HALF + m * 16) * ldc + col0) = w;
            }
    }
};
constexpr float MOE_WSCALE = 64.f, MOE_ASCALE = 4.f;
struct EpiSwiglu8 {
    static constexpr bool PERM = true;
    unsigned char* O; int nr, nct;
    DEVI void operator()(AccT acc, const Unit& un, int wr, int wc, int fr, int fq) const {
        const int row0 = un.pm * BM + wr * 64 + fr, col0 = (un.pn % nct) * 128 + wc * 32 + 8 * fq;
#pragma unroll
        for (int ai = 0; ai < 2; ++ai)
#pragma unroll
            for (int m = 0; m < 4; ++m) {
                float o[8];
#pragma unroll
                for (int n = 0; n < 2; ++n)
#pragma unroll
                    for (int j = 0; j < 4; ++j) o[4 * n + j] = clamp448(siluf_(acc[ai][0][m][n][j] * (1.f / MOE_WSCALE)) * acc[ai][1][m][n][j] * (MOE_ASCALE / MOE_WSCALE));
                v2u w; w.x = pk4_fp8(o[0], o[1], o[2], o[3]); w.y = pk4_fp8(o[4], o[5], o[6], o[7]);
                *(v2u*)(O + tix(nr, row0 + ai * HALF + m * 16, col0)) = w;
            }
    }
};
struct EpiMoeDown {
    static constexpr bool PERM = true;
    bf16* O; const float* rw; float scale;
    DEVI void operator()(AccT acc, const Unit& un, int wr, int wc, int fr, int fq) const {
        const int row0 = un.pm * BM + wr * 64 + fr, col0 = (un.pn & 7) * BM + wc * 32 + 8 * fq;
#pragma unroll
        for (int ai = 0; ai < 2; ++ai)
#pragma unroll
            for (int m = 0; m < 4; ++m) {
                const int row = row0 + ai * HALF + m * 16; const float s = rw[row] * scale;
#pragma unroll
                for (int bj = 0; bj < 2; ++bj) {
                    const f32x4 v0 = acc[ai][bj][m][0] * s, v1 = acc[ai][bj][m][1] * s;
                    v4u w; w.x = pg8::cvt_pk_bf16(v0[0], v0[1]); w.y = pg8::cvt_pk_bf16(v0[2], v0[3]); w.z = pg8::cvt_pk_bf16(v1[0], v1[1]); w.w = pg8::cvt_pk_bf16(v1[2], v1[3]);
                    *(v4u*)(O + (size_t)row * D + col0 + bj * HALF) = w;
                }
            }
    }
};

struct EpiMoePart {
    static constexpr bool PERM = true;
    float* P;
    DEVI void operator()(AccT acc, const Unit& un, int wr, int wc, int fr, int fq) const {
        const int row0 = wr * 64 + fr, col0 = wc * 32 + 8 * fq;
#pragma unroll
        for (int ai = 0; ai < 2; ++ai)
#pragma unroll
            for (int m = 0; m < 4; ++m) {
                float* pr = P + (size_t)(row0 + ai * HALF + m * 16) * 256 + col0;
#pragma unroll
                for (int bj = 0; bj < 2; ++bj) { *(f32x4*)(pr + bj * HALF) = acc[ai][bj][m][0]; *(f32x4*)(pr + bj * HALF + 4) = acc[ai][bj][m][1]; }
            }
    }
};

struct Ssm1Order { int G, c; DEVI bool next(int i, Unit& u) const { const int L = i * G + c; if (L >= 256) return false; u.pm = L >> 1; u.pn = (u.pm >> 2) * 2 + (L & 1); return true; } };
struct Ssm2Order { int G, c; DEVI bool next(int i, Unit& u) const { const int L = i * G + c; if (L >= 128) return false; u.pm = L; u.pn = L >> 2; return true; } };
struct OneUnit { int pm, pn; DEVI bool next(int i, Unit& u) const { if (i > 0) return false; u.pm = pm; u.pn = pn; return true; } };
struct MoeOrder {
    pg8::StaticOrder so; int nct; int pe[NE + 1]; int imax = 1 << 30;
    DEVI bool next(int i, Unit& u) const { return i < imax && at((long)i * so.G + so.c, u); }
    DEVI bool at(const long L, Unit& u) const {
        if (!so.at(L, u)) return false;
        int e = 0;
#pragma unroll
        for (int k = 1; k < NE; ++k) e += (u.pm >= pe[k]) ? 1 : 0;
        u.pn += e * nct; return true;
    }
};

struct Args { const float* in[38]; float* out; unsigned char* ws; int ph_lo, ph_hi, li, dbg; };
constexpr size_t CTL_TBL = 600000;
struct Frame {
    LAS unsigned char* lds; volatile LAS unsigned* MISC; gu32* ctl;
    int tid, lane, wave, G, gw, NGW;
    unsigned char* ws;
    DEVI const float* in(int i) const { const unsigned long long v = __hip_atomic_load((const unsigned long long*)(ws + CTL_TBL + (size_t)blockIdx.x * 512) + i, __ATOMIC_RELAXED, __HIP_MEMORY_SCOPE_WORKGROUP);
        return (const float*)(const GAS float*)(((unsigned long long)(unsigned)__builtin_amdgcn_readfirstlane((int)(v >> 32)) << 32) | (unsigned)__builtin_amdgcn_readfirstlane((int)v)); }
};
DEVI unsigned char* launder(unsigned char* p) { GAS unsigned char* g = (GAS unsigned char*)p; asm volatile("" : "+s"(g)); return (unsigned char*)g; }
DEVI int vlaunder(int v) { asm volatile("" : "+v"(v)); return v; }
enum { IN_X = 0, IN_POS, IN_NMG, IN_WIN, IN_DWW, IN_DWB, IN_LNG, IN_LNB, IN_PWW, IN_PWB, IN_GB, IN_PEK, IN_PEV, IN_W1K, IN_W2K, IN_W1V, IN_W2V,
       IN_LRE, IN_LIM, IN_LDT, IN_BRE, IN_BIM, IN_CRE, IN_CIM, IN_SD, IN_GLW, IN_GLB, IN_MOG, IN_WOUT, IN_NFG, IN_FG, IN_FU, IN_FD, IN_RW, IN_MG, IN_MU, IN_MD, IN_FNG };

DEVI void tr_item(const float* W, int ldw, int c0, int nvalid, int k0, bf16* dst, size_t ldd  , size_t nr  , int r0, LAS float* scr, int lane) {
    const int cg = (lane & 7) * 4;
#pragma unroll
    for (int i = 0; i < 8; ++i) {
        const int kk = 8 * i + (lane >> 3);
        const float* p = W + (size_t)(k0 + kk) * ldw + c0 + cg;
        f32x4 v;
        if (nvalid >= 32) { v = *(const f32x4*)p; }
        else { v[0] = cg + 0 < nvalid ? p[0] : 0.f; v[1] = cg + 1 < nvalid ? p[1] : 0.f; v[2] = cg + 2 < nvalid ? p[2] : 0.f; v[3] = cg + 3 < nvalid ? p[3] : 0.f; }
        scr[kk * 33 + cg + 0] = v[0]; scr[kk * 33 + cg + 1] = v[1]; scr[kk * 33 + cg + 2] = v[2]; scr[kk * 33 + cg + 3] = v[3];
    }
    LDS_WAIT(); asm volatile("" ::: "memory");
    const int c = lane & 7;
#pragma unroll
    for (int j = 0; j < 4; ++j) { const int n = (lane >> 3) + 8 * j; const LAS float* s = scr + (8 * c) * 33 + n;
        v4u o; o.x = pk2(s[0 * 33], s[1 * 33]); o.y = pk2(s[2 * 33], s[3 * 33]); o.z = pk2(s[4 * 33], s[5 * 33]); o.w = pk2(s[6 * 33], s[7 * 33]);
        if (nr) *(v4u*)((unsigned char*)dst + tix(nr, r0 + n, 2 * (k0 + 8 * c))) = o; else *(v4u*)(dst + (size_t)(r0 + n) * ldd + k0 + 8 * c) = o; }
    LDS_WAIT(); asm volatile("" ::: "memory");
}
DEVI void tr_item8(const float* W, int ldw, int c0, int k0, unsigned char* dst, size_t nr  , int r0, float scale, LAS float* scr, int lane) {
    const int cg = (lane & 7) * 4;
#pragma unroll
    for (int i = 0; i < 8; ++i) {
        const int kk = 8 * i + (lane >> 3);
        const f32x4 v = *(const f32x4*)(W + (size_t)(k0 + kk) * ldw + c0 + cg);
        scr[kk * 33 + cg + 0] = v[0]; scr[kk * 33 + cg + 1] = v[1]; scr[kk * 33 + cg + 2] = v[2]; scr[kk * 33 + cg + 3] = v[3];
    }
    LDS_WAIT(); asm volatile("" ::: "memory");
    const int c = lane & 7;
#pragma unroll
    for (int j = 0; j < 4; ++j) { const int n = (lane >> 3) + 8 * j; const LAS float* s = scr + (8 * c) * 33 + n;
        v2u o; o.x = pk4_fp8(s[0 * 33] * scale, s[1 * 33] * scale, s[2 * 33] * scale, s[3 * 33] * scale); o.y = pk4_fp8(s[4 * 33] * scale, s[5 * 33] * scale, s[6 * 33] * scale, s[7 * 33] * scale);
        *(v2u*)(dst + tix(nr, r0 + n, k0 + 8 * c)) = o; }
    LDS_WAIT(); asm volatile("" ::: "memory");
}
DEVI void tr_matrix_item(int item, const float* W, const float* W2, int K, int ldw, int Ndst, int kind, int nvalid_total, bf16* dst, LAS float* scr, int lane, bool tiled = true) {
    const int nblk = Ndst / 32, kb = item / nblk, nb = item % nblk, d0 = nb * 32;
    const float* src = W; int c0 = d0, nv = 32;
    if (kind == 1) { const int un = d0 >> 8, within = d0 & 255; src = (within >= 128) ? W2 : W; c0 = un * 128 + (within & 127); }
    else if (kind == 2) {
        const int un = d0 >> 8, within = d0 & 255;
        if (un < 4) c0 = (within >> 7) * 512 + un * 128 + (within & 127);
        else if (un < 14) c0 = d0;
        else c0 = 3608 + (d0 - 3584);
    }
    if (nvalid_total < Ndst) { nv = nvalid_total - d0; nv = nv < 0 ? 0 : (nv > 32 ? 32 : nv); }
    tr_item(src, ldw, c0, nv, kb * 64, dst, (size_t)K, tiled ? (size_t)Ndst : 0, d0, scr, lane);
}

template <bool B16>
DEVI f32x4 row_ld4(const void* xrow, int c) {
    if (B16) { const v2u w = *(const v2u*)((const bf16*)xrow + c); return (f32x4){bflo(w.x), bfhi(w.x), bflo(w.y), bfhi(w.y)}; }
    return *(const f32x4*)((const float*)xrow + c);
}
template <bool B16 = false>
DEVI void rms_row_to_bf16(const void* xrow, const float* g, unsigned char* obase  , int row, int lane) {
    f32x4 v[8]; float s = 0.f;
#pragma unroll
    for (int j = 0; j < 8; ++j) { v[j] = row_ld4<B16>(xrow, 4 * lane + 256 * j); s += (v[j].x * v[j].x + v[j].y * v[j].y) + (v[j].z * v[j].z + v[j].w * v[j].w); }
    const float r = 1.f / sqrtf(wave_sum(s) * (1.f / D) + EPS);
#pragma unroll
    for (int j = 0; j < 8; ++j) { const f32x4 gg = *(const f32x4*)(g + 4 * lane + 256 * j);
        v2u w; w.x = pk2(v[j].x * r * gg.x, v[j].y * r * gg.y); w.y = pk2(v[j].z * r * gg.z, v[j].w * r * gg.w);
        *(v2u*)(obase + tix(S, row, 2 * (4 * lane + 256 * j))) = w; }
}

DEVI void ssm_tables_job(Frame& F, int l, int g) {

    LAS float* apr = (LAS float*)F.lds;
    LAS float* api = apr + 18 * 64;
    LAS float* bbr = api + 18 * 64;
    LAS float* bbi = bbr + 1024;
    LAS float* ccr = bbi + 1024;
    LAS float* cci = ccr + 1024;
    LAS float* kt = cci + 1024;
    const int tid = F.tid;
    const size_t gp = (size_t)(l * NGRP + g) * PST;
    if (tid < 64) {
        const int p = tid;
        const float lr = fminf(F.in(IN_LRE)[gp + p], -1e-4f), li = F.in(IN_LIM)[gp + p], dt = expf(F.in(IN_LDT)[l * NGRP + g]);
        const float mag = expf(lr * dt), ar = mag * cosf(li * dt), ai = mag * sinf(li * dt);
        const float den = lr * lr + li * li, cr = ((ar - 1.f) * lr + ai * li) / den, ci = (ai * lr - (ar - 1.f) * li) / den;
        float pr = 1.f, pi = 0.f;
        for (int tau = 0; tau < 18; ++tau) { apr[tau * 64 + p] = pr; api[tau * 64 + p] = pi; const float nr = pr * ar - pi * ai, ni = pr * ai + pi * ar; pr = nr; pi = ni; }
        for (int c = 0; c < 16; ++c) { const float br = F.in(IN_BRE)[(gp + p) * 16 + c], bi = F.in(IN_BIM)[(gp + p) * 16 + c];
            bbr[p * 16 + c] = cr * br - ci * bi; bbi[p * 16 + c] = cr * bi + ci * br; }
        float* a16 = (float*)(F.ws + R_CB + 65536) + (gp + p) * 2;
        a16[0] = apr[16 * 64 + p]; a16[1] = api[16 * 64 + p];
    }
    for (int i = tid; i < 1024; i += NTHR) { const int co = i >> 6, p = i & 63; const size_t o = ((size_t)(l * NGRP + g) * 16 + co) * PST + p; ccr[i] = F.in(IN_CRE)[o]; cci[i] = F.in(IN_CIM)[o]; }
    __syncthreads();
    for (int i = tid; i < 4096; i += NTHR) {
        const int tau = i >> 8, co = (i >> 4) & 15, ci = i & 15; float s = 0.f;
        for (int p = 0; p < 64; ++p) {
            const float xr = apr[tau * 64 + p] * bbr[p * 16 + ci] - api[tau * 64 + p] * bbi[p * 16 + ci];
            const float xi = apr[tau * 64 + p] * bbi[p * 16 + ci] + api[tau * 64 + p] * bbr[p * 16 + ci];
            s += ccr[co * 64 + p] * xr - cci[co * 64 + p] * xi;
        }
        kt[i] = s;
    }
    __syncthreads();
    unsigned char* tw = (unsigned char*)(F.ws + R_TW) + (size_t)l * NGRP * 512 * 256 * 2;
    unsigned char* wo2 = (unsigned char*)(F.ws + R_WO2) + (size_t)l * NGRP * 256 * 256 * 2;
    for (int i2 = tid; i2 < 256 * 128; i2 += NTHR) {
        const int n = i2 >> 7, k = (i2 & 127) * 2, j = n >> 4, co = n & 15, ii = k >> 4, ci = k & 15;
        float v0 = 0.f, v1 = 0.f;
        if (ii <= j) { v0 = kt[(j - ii) * 256 + co * 16 + ci]; v1 = kt[(j - ii) * 256 + co * 16 + ci + 1]; }
        *(unsigned*)(tw + tix(16384, g * 512 + n, 2 * k)) = pk2(v0, v1);
    }
    for (int i2 = tid; i2 < 256 * 128; i2 += NTHR) {
        const int n = i2 >> 7, k = (i2 & 127) * 2, ii = k >> 4, ci = k & 15;
        float v0 = 0.f, v1 = 0.f;
        if (n < 128) { const int ri = n >> 6, p = n & 63; const float pr = apr[(15 - ii) * 64 + p], pi = api[(15 - ii) * 64 + p];
            const float b0r = bbr[p * 16 + ci], b0i = bbi[p * 16 + ci], b1r = bbr[p * 16 + ci + 1], b1i = bbi[p * 16 + ci + 1];
            if (ri == 0) { v0 = pr * b0r - pi * b0i; v1 = pr * b1r - pi * b1i; } else { v0 = pr * b0i + pi * b0r; v1 = pr * b1i + pi * b1r; } }
        *(unsigned*)(tw + tix(16384, g * 512 + 256 + n, 2 * k)) = pk2(v0, v1);
    }
    for (int i2 = tid; i2 < 256 * 128; i2 += NTHR) {
        const int n = i2 >> 7, k = (i2 & 127) * 2, j = n >> 4, co = n & 15;
        float v[2] = {0.f, 0.f};
#pragma unroll
        for (int e = 0; e < 2; ++e) { const int kk = k + e;
            if (kk < 128) { const int p = kk & 63; const float pr = apr[(j + 1) * 64 + p], pi = api[(j + 1) * 64 + p], cr = ccr[co * 64 + p], ci = cci[co * 64 + p];
                v[e] = (kk < 64) ? (cr * pr - ci * pi) : -(cr * pi + ci * pr); } }
        *(unsigned*)(wo2 + tix(8192, g * 256 + n, 2 * k)) = pk2(v[0], v[1]);
    }
    __syncthreads();
}
DEVI void cbias_job(Frame& F, int job) {
    LAS float* red = (LAS float*)F.lds;
    const int c = job & 15, kv = (job >> 4) & 1, l = job >> 5;
    const float* pe = F.in(kv ? IN_PEV : IN_PEK) + (size_t)l * 4096 + c * 256; const float* w1 = F.in(kv ? IN_W1V : IN_W1K) + (size_t)l * 4096 * 128 + (size_t)(c * 256) * 128;
    const int e = F.tid & 127, kq = F.tid >> 7; float s = 0.f;
#pragma unroll 16
    for (int k = kq * 64; k < kq * 64 + 64; ++k) s += pe[k] * w1[(size_t)k * 128 + e];
    red[F.tid] = s; __syncthreads();
    if (F.tid < 128) ((float*)(F.ws + R_CB))[(size_t)job * 128 + e] = (red[e] + red[128 + e]) + (red[256 + e] + red[384 + e]);
    __syncthreads();
}
DEVI void w1_tile_item(Frame& F, const float* pW1K, const float* pW1V, int item) {
    const int ks = item & 127, kv = (item >> 7) & 1, l = item >> 8, lane = F.lane, r = lane & 15, q = lane >> 4;
    const float* w1 = (kv ? pW1V : pW1K) + (size_t)l * 4096 * 128 + (size_t)(32 * ks + 8 * q) * 128 + r;
    bf16* dst = (bf16*)(F.ws + (kv ? R_W1V : R_W1K)) + (size_t)l * 128 * 4096 + ((size_t)ks * 8 * 64 + lane) * 8;
#pragma unroll
    for (int et = 0; et < 8; ++et) {
        float v[8];
#pragma unroll
        for (int j = 0; j < 8; ++j) v[j] = w1[(size_t)j * 128 + 16 * et];
        v4u o; o.x = pk2(v[0], v[1]); o.y = pk2(v[2], v[3]); o.z = pk2(v[4], v[5]); o.w = pk2(v[6], v[7]);
        *(v4u*)(dst + (size_t)et * 512) = o;
    }
}

struct Tile8 { const float* src; unsigned char* dst; int ldw; int nr, row0, k0; };
DEVI Tile8 moe_tile(Frame& F, const float* pMG, const float* pMU, const float* pMD, int r) {
    constexpr int I_MGU = 32 * (2 * DFFE / 32), I_MD = (DFFE / 64) * 64;
    const int e = r / (I_MGU + I_MD); r -= e * (I_MGU + I_MD);
    Tile8 t;
    if (r < I_MGU) { const int nblk = 2 * DFFE / 32, pq = r >> 1, kb = 2 * (pq / nblk) + (r & 1), nb = pq % nblk, d0 = nb * 32, un = d0 >> 8, within = d0 & 255;
        t.src = (within >= 128 ? pMU : pMG) + (size_t)e * D * DFFE + (size_t)(kb * 64) * DFFE + un * 128 + (within & 127); t.ldw = DFFE;
        t.dst = (unsigned char*)(F.ws + WS_MOE_GU); t.nr = NE * 2 * DFFE; t.row0 = e * 2 * DFFE + d0; t.k0 = kb * 64; }
    else { r -= I_MGU; const int nblk = D / 32, pq = r >> 1, kb = 2 * (pq / nblk) + (r & 1), nb = pq % nblk;
        t.src = pMD + (size_t)e * DFFE * D + (size_t)(kb * 64) * D + nb * 32; t.ldw = D;
        t.dst = (unsigned char*)(F.ws + WS_MOE_D); t.nr = NE * D; t.row0 = e * D + nb * 32; t.k0 = kb * 64; }
    return t;
}
DEVI Tile8 ffn_tile(Frame& F, const float* pFG, const float* pFU, const float* pFD, int r) {
    constexpr int I_FGU = 32 * (2 * DFF / 32);
    Tile8 t;
    if (r < I_FGU) { const int nblk = 2 * DFF / 32, pq = r >> 1, kb = 2 * (pq / nblk) + (r & 1), nb = pq % nblk, d0 = nb * 32, un = d0 >> 8, within = d0 & 255;
        t.src = (within >= 128 ? pFU : pFG) + (size_t)(kb * 64) * DFF + un * 128 + (within & 127); t.ldw = DFF;
        t.dst = (unsigned char*)(F.ws + R_FGU); t.nr = 2 * DFF; t.row0 = d0; t.k0 = kb * 64; }
    else { r -= I_FGU; const int nblk = D / 32, pq = r >> 1, kb = 2 * (pq / nblk) + (r & 1), nb = pq % nblk;
        t.src = pFD + (size_t)(kb * 64) * D + nb * 32; t.ldw = D;
        t.dst = (unsigned char*)(F.ws + R_FD); t.nr = D; t.row0 = nb * 32; t.k0 = kb * 64; }
    return t;
}
DEVI void tile8_load(const Tile8& t, f32x4 (&v)[8], int lane) {
#pragma unroll
    for (int i = 0; i < 8; ++i) v[i] = __builtin_nontemporal_load((const f32x4*)(t.src + (size_t)(8 * i + (lane >> 3)) * t.ldw + (lane & 7) * 4));
}
DEVI void tile8_store(const Tile8& t, const f32x4 (&v)[8], LAS float* scr, int lane) {
    const int cg = (lane & 7) * 4;
#pragma unroll
    for (int i = 0; i < 8; ++i) { const int kk = 8 * i + (lane >> 3); scr[kk * 33 + cg + 0] = v[i][0]; scr[kk * 33 + cg + 1] = v[i][1]; scr[kk * 33 + cg + 2] = v[i][2]; scr[kk * 33 + cg + 3] = v[i][3]; }
    LDS_WAIT(); asm volatile("" ::: "memory");
    const int c = lane & 7;
#pragma unroll
    for (int j = 0; j < 4; ++j) { const int n = (lane >> 3) + 8 * j; const LAS float* s = scr + (8 * c) * 33 + n;
        v2u o; o.x = pk4_fp8(s[0 * 33] * MOE_WSCALE, s[1 * 33] * MOE_WSCALE, s[2 * 33] * MOE_WSCALE, s[3 * 33] * MOE_WSCALE); o.y = pk4_fp8(s[4 * 33] * MOE_WSCALE, s[5 * 33] * MOE_WSCALE, s[6 * 33] * MOE_WSCALE, s[7 * 33] * MOE_WSCALE);
        *(v2u*)(t.dst + tix(t.nr, t.row0 + n, t.k0 + 8 * c)) = o; }
    LDS_WAIT(); asm volatile("" ::: "memory");
}

DEVI void p0_prologue(Frame& F, int variant = 0) {
     unsigned char* ws = F.ws;
    if (variant == 0) {
    for (int j = blockIdx.x; j < 128; j += F.G) { if (j < 64) ssm_tables_job(F, j >> 5, j & 31); else cbias_job(F, j - 64); }
    __syncthreads();
    }
    LAS float* scr = (LAS float*)(F.lds + RING_OFF + F.wave * 16384);
    if (variant == 0) {
    { const float* pX = F.in(IN_X); const float* pG = F.in(IN_NMG); for (int m = F.gw; m < S; m += F.NGW) rms_row_to_bf16(pX + (size_t)m * D, pG, (unsigned char*)(ws + WS_HN), m, F.lane); }
    constexpr int I_WIN = 32 * 128, I_WG = 32, I_WOUT = 32 * 64, I_SQ = 8 * 16, I_W1 = 64 * 4, I_W2 = 2 * 4;
    constexpr int I_LAYER = I_WIN + I_WG + I_WOUT + 2 * I_SQ + I_W1 + 2 * I_W2;
    constexpr int I_FGU = 32 * (2 * DFF / 32), I_FD = (DFF / 64) * 64, I_MGU = 32 * (2 * DFFE / 32), I_MD = (DFFE / 64) * 64;
    constexpr int NITEMS = 2 * I_LAYER;
    const float* pWIN = F.in(IN_WIN); const float* pWOUT = F.in(IN_WOUT); const float* pPWW = F.in(IN_PWW); const float* pGLW = F.in(IN_GLW); const float* pW2K = F.in(IN_W2K); const float* pW2V = F.in(IN_W2V);
    const float* pFG = F.in(IN_FG); const float* pFU = F.in(IN_FU); const float* pFD = F.in(IN_FD); const float* pW1K = F.in(IN_W1K); const float* pW1V = F.in(IN_W1V);
    for (int it = F.gw; it < NITEMS; it += F.NGW) {
        int r = it;
        if (r < 2 * I_LAYER) {
            const int l = r / I_LAYER; r -= l * I_LAYER;
            if (r < I_WIN) { tr_matrix_item(r, pWIN + (size_t)l * D * DIN, nullptr, D, DIN, 4096, 2, 4096, (bf16*)(ws + R_WIN) + (size_t)l * 4096 * D, scr, F.lane); continue; } r -= I_WIN;
            if (r < I_WG) {
#pragma unroll
                for (int h2 = 0; h2 < 2; ++h2) { const int ks = 2 * r + h2, rr = F.lane & 15, qq = F.lane >> 4;
#pragma unroll
                    for (int nt = 0; nt < 2; ++nt) { const int col = 16 * nt + rr; float v[8];
#pragma unroll
                        for (int j = 0; j < 8; ++j) v[j] = (col < 24) ? pWIN[(size_t)l * D * DIN + (size_t)(32 * ks + 8 * qq + j) * DIN + 3584 + col] : 0.f;
                        v4u o; o.x = pk2(v[0], v[1]); o.y = pk2(v[2], v[3]); o.z = pk2(v[4], v[5]); o.w = pk2(v[6], v[7]);
                        *(v4u*)((bf16*)(ws + R_WG) + (size_t)l * 32 * D + ((size_t)(ks * 2 + nt) * 64 + F.lane) * 8) = o; } }
                continue; } r -= I_WG;
            if (r < I_WOUT) { tr_matrix_item(r, pWOUT + (size_t)l * D * D, nullptr, D, D, D, 0, D, (bf16*)(ws + R_WOUT) + (size_t)l * D * D, scr, F.lane); continue; } r -= I_WOUT;
            if (r < I_SQ) { tr_matrix_item(r, pPWW + (size_t)l * 512 * 512, nullptr, 512, 512, 512, 0, 512, (bf16*)(ws + R_CPW) + (size_t)l * 512 * 512, scr, F.lane); continue; } r -= I_SQ;
            if (r < I_SQ) { tr_matrix_item(r, pGLW + (size_t)l * 512 * 512, nullptr, 512, 512, 512, 0, 512, (bf16*)(ws + R_GLU) + (size_t)l * 512 * 512, scr, F.lane); continue; } r -= I_SQ;
            if (r < I_W1) { w1_tile_item(F, pW1K, pW1V, l * 256 + r); continue; } r -= I_W1;
            if (r < I_W2) { tr_matrix_item(r, pW2K + (size_t)l * 128 * 128, nullptr, 128, 128, 128, 0, 128, (bf16*)(ws + R_W2) + (size_t)(l * 2 + 0) * 128 * 128, scr, F.lane, false); continue; } r -= I_W2;
            tr_matrix_item(r, pW2V + (size_t)l * 128 * 128, nullptr, 128, 128, 128, 0, 128, (bf16*)(ws + R_W2) + (size_t)(l * 2 + 1) * 128 * 128, scr, F.lane, false); continue;
        }
    }
    }
    constexpr int NMOE = NE * (32 * (2 * DFFE / 32) + (DFFE / 64) * 64), NFFN = 32 * (2 * DFF / 32) + (DFF / 64) * 64, NTOT = NMOE + NFFN;
    {
        const float* pMG = F.in(IN_MG); const float* pMU = F.in(IN_MU); const float* pMD = F.in(IN_MD);
        const float* pFG = F.in(IN_FG); const float* pFU = F.in(IN_FU); const float* pFD = F.in(IN_FD);
        const int NGW = F.NGW, NLATE = (F.G == 256) ? 512 : 0, RA = (F.G == 256) ? 84 : (1 << 20);
        auto item_of = [&](int k) -> int {
            const int q2 = k >> 1, RP = RA >> 1;
            int pr;
            if (q2 < RP) pr = q2 * NGW + F.gw;
            else { if (F.gw < NLATE) return -1; pr = RP * NGW + (q2 - RP) * (NGW - NLATE) + (F.gw - NLATE); }
            return pr < NTOT / 2 ? 2 * pr + (k & 1) : -1; };
        auto tile_of = [&](int it) -> Tile8 { return it < NMOE ? moe_tile(F, pMG, pMU, pMD, it) : ffn_tile(F, pFG, pFU, pFD, it - NMOE); };
        int it = item_of(0);
        if (it >= 0) {
            f32x4 va[8], vb[8];
            Tile8 t0 = tile_of(it); tile8_load(t0, va, F.lane);
            for (int k = 0; it >= 0; ++k) {
                const int itn = item_of(k + 1);
                const Tile8 t1 = tile_of(itn >= 0 ? itn : it); tile8_load(t1, vb, F.lane);
                if (variant == 1) { asm volatile("" :: "v"(va[0]), "v"(va[1]), "v"(va[2]), "v"(va[3]), "v"(va[4]), "v"(va[5]), "v"(va[6]), "v"(va[7])); } else tile8_store(t0, va, scr, F.lane);
                t0 = t1; it = itn;
#pragma unroll
                for (int i = 0; i < 8; ++i) va[i] = vb[i];
            }
        }
    }
}

#define MFMA16(a, b, c) __builtin_amdgcn_mfma_f32_16x16x32_bf16((a), (b), (c), 0, 0, 0)
DEVI bf16x8 ldg8(const bf16* p) { return *(const bf16x8*)p; }
DEVI bf16x8 zero8() { bf16x8 z = {0, 0, 0, 0, 0, 0, 0, 0}; return z; }
DEVI bf16x8 pack8(f32x4 a, f32x4 b) { v4u w; w.x = pg8::cvt_pk_bf16(a[0], a[1]); w.y = pg8::cvt_pk_bf16(a[2], a[3]); w.z = pg8::cvt_pk_bf16(b[0], b[1]); w.w = pg8::cvt_pk_bf16(b[2], b[3]); return __builtin_bit_cast(bf16x8, w); }

DEVI void gates_job(Frame& F, const float* pGB, int l, int job) {
    const int lane = F.lane, r = lane & 15, q = lane >> 4, t0 = job * 16;
    const unsigned char* hn = (const unsigned char*)(F.ws + WS_HN);
    const bf16* wg = (const bf16*)(F.ws + R_WG) + (size_t)l * 32 * D + lane * 8;
    f32x4 a0 = {0.f, 0.f, 0.f, 0.f}, a1 = a0;
#pragma unroll 8
    for (int ks = 0; ks < D / 32; ++ks) {
        const bf16x8 a = ldg8((const bf16*)(hn + tix(S, t0 + r, 64 * ks + 16 * q))), b0 = ldg8(wg + (size_t)(ks * 2) * 512), b1 = ldg8(wg + (size_t)(ks * 2 + 1) * 512);
        a0 = MFMA16(a, b0, a0); a1 = MFMA16(a, b1, a1);
    }
    const float* gb = pGB + l * 24; float* go = (float*)(F.ws + R_GATES);
#pragma unroll
    for (int j = 0; j < 4; ++j) { const int t = t0 + 4 * q + j;
        go[(size_t)t * 24 + r] = sigmoidf_(a0[j] + gb[r]);
        if (r < 8) go[(size_t)t * 24 + 16 + r] = sigmoidf_(a1[j] + gb[16 + r]); }
}

DEVI void rope_job(Frame& F, const int* pPOS, int t) {
    const int lane = F.lane;
    const float pos = (float)pPOS[t];
    float cs = 0.f, sn = 0.f;
    { const int i = lane & 15; const float inv = powf(500000.f, -(float)(2 * i) / 32.f); const float ang = pos * inv; cs = cosf(ang); sn = sinf(ang); }
    float cv[16], sv[16];
#pragma unroll
    for (int i = 0; i < 16; ++i) { cv[i] = __shfl(cs, i); sv[i] = __shfl(sn, i); }
    const bf16* qrow = (const bf16*)(F.ws + R_Q) + (size_t)t * DATT + 16 * lane;
    v4u w0 = *(const v4u*)qrow, w1 = *(const v4u*)(qrow + 8);
    unsigned w[8] = {w0.x, w0.y, w0.z, w0.w, w1.x, w1.y, w1.z, w1.w};
    const int sub = lane & 7;
    float x[16], o[16];
#pragma unroll
    for (int i = 0; i < 8; ++i) { x[2 * i] = bflo(w[i]); x[2 * i + 1] = bfhi(w[i]); }
#pragma unroll
    for (int i = 0; i < 16; ++i) { const float other = __shfl_xor(x[i], 1);
        o[i] = (sub == 0) ? (x[i] * cv[i] - other * sv[i]) : ((sub == 1) ? (x[i] * cv[i] + other * sv[i]) : x[i]); }
    v4u o0, o1; o0.x = pk2(o[0], o[1]); o0.y = pk2(o[2], o[3]); o0.z = pk2(o[4], o[5]); o0.w = pk2(o[6], o[7]); o1.x = pk2(o[8], o[9]); o1.y = pk2(o[10], o[11]); o1.z = pk2(o[12], o[13]); o1.w = pk2(o[14], o[15]);
    bf16* qr = (bf16*)(F.ws + R_QR) + (size_t)t * DATT + 16 * lane;
    if (sub >= 2) { o0 = w0; o1 = w1; }
    *(v4u*)qr = o0; *(v4u*)(qr + 8) = o1;
    {
        const int tz = lane >> 5, g = (lane >> 4) & 1, c = lane & 15;
        const bf16* kp = (const bf16*)(F.ws + R_KV) + ((size_t)((tz ? 4 : 2) * 2 + g) * S + t) * HD + 8 * c;
        const v4u wv = *(const v4u*)kp;
        const unsigned ww[4] = {wv.x, wv.y, wv.z, wv.w}; unsigned ow[4];
        const int i0 = 8 * (c & 1);
#pragma unroll
        for (int i = 0; i < 4; ++i) {
            const unsigned pw = (unsigned)__shfl_xor((int)ww[i], 2);
            float a0 = bflo(ww[i]), a1 = bfhi(ww[i]); const float b0 = bflo(pw), b1 = bfhi(pw);
            float cc0 = 0.f, ss0 = 0.f, cc1 = 0.f, ss1 = 0.f;
#pragma unroll
            for (int k = 0; k < 16; ++k) { if (k == i0 + 2 * i) { cc0 = cv[k]; ss0 = sv[k]; } if (k == i0 + 2 * i + 1) { cc1 = cv[k]; ss1 = sv[k]; } }
            const float sg = (c < 2) ? -1.f : 1.f;
            const float r0 = a0 * cc0 + sg * b0 * ss0, r1 = a1 * cc1 + sg * b1 * ss1;
            ow[i] = (c < 4) ? pk2(r0, r1) : ww[i];
        }
        {
            v2u o8; o8.x = pk4_fp8(bflo(ow[0]), bfhi(ow[0]), bflo(ow[1]), bfhi(ow[1])); o8.y = pk4_fp8(bflo(ow[2]), bfhi(ow[2]), bflo(ow[3]), bfhi(ow[3]));
            *(v2u*)((unsigned char*)(F.ws + (tz ? R_KW8 : R_KS8)) + (size_t)g * S * HD + (size_t)((t >> 6) * 4 + ((t >> 4) & 3)) * 2048 + ((c & 3) >> 1) * 1024 + ((t & 15) + 16 * (c >> 2)) * 16 + (c & 1) * 8) = o8; }
    }
}

DEVI void dwconv_job(Frame& F, const float* pDWW, const float* pDWB, const float* pLNG, const float* pLNB, int l, int job) {
    const int lane = F.lane, c0 = 8 * lane, t0 = job * 4;
    const bf16* u = (const bf16*)(F.ws + R_CONVU);
    const float* dww = pDWW + (size_t)l * CONVW * DCONV + c0;
    float acc[4][8], wk[4][8];
#pragma unroll
    for (int i = 0; i < 4; ++i)
#pragma unroll
        for (int c = 0; c < 8; ++c) { acc[i][c] = 0.f; wk[i][c] = 0.f; }
#pragma unroll 2
    for (int kr = 0; kr < 34; ++kr) {
#pragma unroll
        for (int c = 0; c < 8; ++c) { wk[3][c] = wk[2][c]; wk[2][c] = wk[1][c]; wk[1][c] = wk[0][c]; }
        const int kk = kr <= 30 ? kr : 30; const float wm = kr <= 30 ? 1.f : 0.f;
        const f32x4 a = *(const f32x4*)(dww + (size_t)kk * DCONV), b = *(const f32x4*)(dww + (size_t)kk * DCONV + 4);
        wk[0][0] = a[0] * wm; wk[0][1] = a[1] * wm; wk[0][2] = a[2] * wm; wk[0][3] = a[3] * wm; wk[0][4] = b[0] * wm; wk[0][5] = b[1] * wm; wk[0][6] = b[2] * wm; wk[0][7] = b[3] * wm;
        const int r = t0 - 30 + kr; const int rc = r < 0 ? 0 : r; const float xm = r < 0 ? 0.f : 1.f;
        const v4u w = *(const v4u*)(u + (size_t)rc * DCONV + c0);
        const float x[8] = {bflo(w.x) * xm, bfhi(w.x) * xm, bflo(w.y) * xm, bfhi(w.y) * xm, bflo(w.z) * xm, bfhi(w.z) * xm, bflo(w.w) * xm, bfhi(w.w) * xm};
#pragma unroll
        for (int i = 0; i < 4; ++i)
#pragma unroll
            for (int c = 0; c < 8; ++c) acc[i][c] += x[c] * wk[i][c];
    }
    const float* dwb = pDWB + l * DCONV + c0; const float* lng = pLNG + l * DCONV + c0; const float* lnb = pLNB + l * DCONV + c0;
    float bb[8], gg[8], be[8];
#pragma unroll
    for (int c = 0; c < 8; ++c) { bb[c] = dwb[c]; gg[c] = lng[c]; be[c] = lnb[c]; }
    unsigned char* out = (unsigned char*)(F.ws + R_CONVACT);
#pragma unroll
    for (int i = 0; i < 4; ++i) {
        float s = 0.f;
#pragma unroll
        for (int c = 0; c < 8; ++c) { acc[i][c] += bb[c]; s += acc[i][c]; }
        const float mu = wave_sum(s) * (1.f / DCONV); float q = 0.f;
#pragma unroll
        for (int c = 0; c < 8; ++c) { const float d = acc[i][c] - mu; q += d * d; }
        const float rstd = 1.f / sqrtf(wave_sum(q) * (1.f / DCONV) + EPS);
        float y[8];
#pragma unroll
        for (int c = 0; c < 8; ++c) y[c] = siluf_((acc[i][c] - mu) * rstd * gg[c] + be[c]);
        v4u w; w.x = pk2(y[0], y[1]); w.y = pk2(y[2], y[3]); w.z = pk2(y[4], y[5]); w.w = pk2(y[6], y[7]);
        *(v4u*)(out + tix(S, t0 + i, 2 * c0)) = w;
    }
}

DEVI void vt_job(Frame& F, int job) {
    const int lane = F.lane;
    const int dh = job & 1, chunk = (job >> 1) & 255, g = (job >> 9) & 1, tz = job >> 10;
    LAS unsigned* scr = (LAS unsigned*)(F.lds + RING_OFF + F.wave * 16384);
    const bf16* v = (const bf16*)(F.ws + R_KV) + ((size_t)((tz ? 5 : 3) * 2 + g) * S + chunk * 64) * HD + dh * 64;
#pragma unroll
    for (int i = 0; i < 8; ++i) { const int row = 8 * i + (lane >> 3), cg = (lane & 7) * 4;
        const v4u w = *(const v4u*)(v + (size_t)row * HD + cg * 2);
        scr[row * 33 + cg + 0] = w.x; scr[row * 33 + cg + 1] = w.y; scr[row * 33 + cg + 2] = w.z; scr[row * 33 + cg + 3] = w.w; }
    LDS_WAIT(); asm volatile("" ::: "memory");
    const int r = lane & 15, q = lane >> 4;
    const LAS unsigned short* s16 = (const LAS unsigned short*)scr;
    {
        unsigned char* v8 = (unsigned char*)(F.ws + (tz ? R_VW8 : R_VS8)) + (size_t)g * S * HD + (size_t)chunk * 8192 + lane * 16;
#pragma unroll
        for (int dtl = 0; dtl < 4; ++dtl) { v4u o;
            unsigned wds[4];
#pragma unroll
            for (int T = 0; T < 4; ++T) { const int tk = 16 * T + 4 * q; wds[T] = pk4_fp8(bf2f(s16[(tk + 0) * 66 + 16 * dtl + r]), bf2f(s16[(tk + 1) * 66 + 16 * dtl + r]), bf2f(s16[(tk + 2) * 66 + 16 * dtl + r]), bf2f(s16[(tk + 3) * 66 + 16 * dtl + r])); }
            o.x = wds[0]; o.y = wds[1]; o.z = wds[2]; o.w = wds[3];
            *(v4u*)(v8 + (size_t)(dh * 4 + dtl) * 1024) = o; }
    }
    LDS_WAIT(); asm volatile("" ::: "memory");
}

DEVI void compress_job(Frame& F, int l, int job) {
    const int lane = F.lane, r = lane & 15, q = lane >> 4, w = F.wave;
    const int nt = job & 63, g = (job >> 6) & 1, kv = job >> 7;
    const int n0 = nt * 16; int nn = n0 + r; nn = nn > NCMP - 1 ? NCMP - 1 : nn;
    const bf16* raw = (const bf16*)(F.ws + R_KV) + ((size_t)(kv * 2 + g) * S) * HD + (size_t)nn * 2048 + 8 * q;
    const bf16* w1f = (const bf16*)(F.ws + (kv ? R_W1V : R_W1K)) + (size_t)l * 128 * 4096 + lane * 8;
    LAS f32x4* part = (LAS f32x4*)(F.lds + RING_OFF);
    LAS bf16* hidT = (LAS bf16*)(F.lds + RING_OFF + 65536);
    f32x4 hid[8];
#pragma unroll
    for (int e = 0; e < 8; ++e) hid[e] = (f32x4){0.f, 0.f, 0.f, 0.f};
#pragma unroll 4
    for (int k = 0; k < 16; ++k) {
        const int ks = 16 * w + k;
        const bf16x8 b = ldg8(raw + 32 * ks);
#pragma unroll
        for (int e = 0; e < 8; ++e) { const bf16x8 a = ldg8(w1f + ((size_t)ks * 8 + e) * 512); hid[e] = MFMA16(a, b, hid[e]); }
    }
#pragma unroll
    for (int e = 0; e < 8; ++e) part[(w * 8 + e) * 64 + lane] = hid[e];
    __syncthreads();
    {
        f32x4 sacc = part[(0 * 8 + w) * 64 + lane];
#pragma unroll
        for (int w2 = 1; w2 < 8; ++w2) sacc = sacc + part[(w2 * 8 + w) * 64 + lane];
        const float* cb = (const float*)(F.ws + R_CB) + (size_t)(l * 2 + kv) * 16 * 128 + 16 * w + 4 * q;
        f32x4 bv = *(const f32x4*)cb;
#pragma unroll
        for (int cc = 1; cc < 16; ++cc) bv = bv + *(const f32x4*)(cb + cc * 128);
        v2u pk; pk.x = pk2(siluf_(sacc[0] + bv[0]), siluf_(sacc[1] + bv[1])); pk.y = pk2(siluf_(sacc[2] + bv[2]), siluf_(sacc[3] + bv[3]));
        *(LAS v2u*)(hidT + r * 128 + 16 * w + 4 * q) = pk;
    }
    __syncthreads();
    const bf16* w2t = (const bf16*)(F.ws + R_W2) + (size_t)(l * 2 + kv) * 128 * 128 + (size_t)(16 * w + r) * 128 + 8 * q;
    f32x4 o = {0.f, 0.f, 0.f, 0.f};
#pragma unroll
    for (int s = 0; s < 4; ++s) {
        const bf16x8 a = ldg8(w2t + 32 * s);
        const bf16x8 b = *(const LAS bf16x8*)(hidT + r * 128 + 32 * s + 8 * q);
        o = MFMA16(a, b, o);
    }
    const int n = n0 + r, stp = n >> 5, kk = n & 31;
    if (kv == 0) { const int T = (kk >> 2) & 1, rr = ((kk >> 3) << 2) | (kk & 3);
        bf16* kc = (bf16*)(F.ws + R_KC) + (size_t)g * 1024 * HD;
        const int d0 = 16 * w + 4 * q, ks = d0 >> 5, qq = (d0 >> 3) & 3, j0 = d0 & 7;
        v2u wv; wv.x = pk2(o[0], o[1]); wv.y = pk2(o[2], o[3]);
        *(v2u*)(kc + ((((size_t)stp * 2 + T) * 4 + ks) * 64 + rr + 16 * qq) * 8 + j0) = wv; }
    else { const int qq = kk >> 3, jj = kk & 7;
        bf16* vct = (bf16*)(F.ws + R_VCT) + (size_t)g * 1024 * HD;
#pragma unroll
        for (int j = 0; j < 4; ++j) vct[(((size_t)stp * 8 + w) * 64 + (4 * q + j) + 16 * qq) * 8 + jj] = (bf16)f2bf(o[j]); }
    __syncthreads();
}

DEVI void scan_job(Frame& F, int l, int g) {
    const int p = F.lane;
    const float* a16 = (const float*)(F.ws + R_CB + 65536) + ((size_t)(l * NGRP + g) * PST + p) * 2;
    const float ar = a16[0], ai = a16[1];
    const float* sc = (const float*)(F.ws + R_SC) + (size_t)g * 1024 * 128;
    unsigned char* hp = (unsigned char*)(F.ws + R_HPREV);
    float hr = 0.f, hi = 0.f;
    for (int c0 = 0; c0 < 1024; c0 += 32) {
        float sr[32], si[32];
#pragma unroll
        for (int k = 0; k < 32; ++k) { sr[k] = sc[(size_t)(c0 + k) * 128 + p]; si[k] = sc[(size_t)(c0 + k) * 128 + 64 + p]; }
#pragma unroll
        for (int k = 0; k < 32; ++k) {
            const size_t rw_ = (size_t)g * 1024 + c0 + k;
            *(bf16*)(hp + tix(32768, rw_, 2 * p)) = (bf16)f2bf(hr); *(bf16*)(hp + tix(32768, rw_, 128 + 2 * p)) = (bf16)f2bf(hi); *(unsigned*)(hp + tix(32768, rw_, 256 + 4 * p)) = 0u;
            const float nr = ar * hr - ai * hi + sr[k], ni = ar * hi + ai * hr + si[k]; hr = nr; hi = ni;
        }
    }
}

constexpr float QK_SCALE = 0.08838834764831845f;
constexpr float C2 = 1.4426950408889634f * QK_SCALE;
constexpr float NEG_INF = -__builtin_inff();

DEVI int krow(int r, int T) { return 8 * (r >> 2) + 4 * T + (r & 3); }

DEVI void cmp_stats_job(Frame& F, int g, int tile) {
    const int lane = F.lane, r = lane & 15, q = lane >> 4, t0 = tile * 16, t = t0 + r;
    if (tile == 0) return;
    const int nmax = tile - 1;
    const int nsteps = (nmax >> 5) + 1;
    const bf16* qp = (const bf16*)(F.ws + R_Q) + (size_t)t * DATT + (size_t)(4 * g) * HD + 8 * q;
    bf16x8 qf[4][4];
#pragma unroll
    for (int h = 0; h < 4; ++h)
#pragma unroll
        for (int ks = 0; ks < 4; ++ks) qf[h][ks] = ldg8(qp + h * HD + 32 * ks);
    const bf16* kc = (const bf16*)(F.ws + R_KC) + (size_t)g * 1024 * HD + lane * 8;
    const int nvis = (t - 31) >> 4;
    float m[4], lsum[4];
#pragma unroll
    for (int h = 0; h < 4; ++h) { m[h] = -1e30f; lsum[h] = 0.f; }
    for (int pass = 0; pass < 2; ++pass) {
        float inv_l[4];
        if (pass == 1) {
#pragma unroll
            for (int h = 0; h < 4; ++h) {
                float mm = m[h], ll = lsum[h];
#pragma unroll
                for (int o = 16; o < 64; o <<= 1) { const float om = __shfl_xor(mm, o), ol = __shfl_xor(ll, o); const float nm = fmaxf(mm, om);
                    ll = ll * __builtin_amdgcn_exp2f(mm - nm) + ol * __builtin_amdgcn_exp2f(om - nm); mm = nm; }
                m[h] = mm; inv_l[h] = ll > 0.f ? 1.f / ll : 0.f;
            }
        }
        float carry = 0.f;
        auto kload = [&](bf16x8 (&kf)[2][4], int st) { const size_t sc_ = (st < nsteps) ? st : nsteps - 1;
#pragma unroll
            for (int T = 0; T < 2; ++T)
#pragma unroll
                for (int ks = 0; ks < 4; ++ks) kf[T][ks] = ldg8(kc + ((sc_ * 2 + T) * 4 + ks) * 512); };
        auto step = [&](const bf16x8 (&kf)[2][4], const int st) {
            const int key0 = st * 32;
            f32x4 imp0 = {0.f, 0.f, 0.f, 0.f}, imp1 = imp0;
#pragma unroll
            for (int h = 0; h < 4; ++h) {
                f32x4 s0 = {0.f, 0.f, 0.f, 0.f}, s1 = s0;
#pragma unroll
                for (int ks = 0; ks < 4; ++ks) { s0 = MFMA16(kf[0][ks], qf[h][ks], s0); s1 = MFMA16(kf[1][ks], qf[h][ks], s1); }
#pragma unroll
                for (int j = 0; j < 4; ++j) { s0[j] = (key0 + 8 * q + j <= nvis) ? s0[j] * C2 : NEG_INF; s1[j] = (key0 + 8 * q + 4 + j <= nvis) ? s1[j] * C2 : NEG_INF; }
                if (pass == 0) {
                    float mx = fmaxf(fmaxf(fmaxf(s0[0], s0[1]), fmaxf(s0[2], s0[3])), fmaxf(fmaxf(s1[0], s1[1]), fmaxf(s1[2], s1[3])));
                    const float nm = fmaxf(m[h], mx); float ps = 0.f;
#pragma unroll
                    for (int j = 0; j < 4; ++j) ps += __builtin_amdgcn_exp2f(s0[j] - nm) + __builtin_amdgcn_exp2f(s1[j] - nm);
                    lsum[h] = lsum[h] * __builtin_amdgcn_exp2f(m[h] - nm) + ps; m[h] = nm;
                } else {
#pragma unroll
                    for (int j = 0; j < 4; ++j) { imp0[j] += __builtin_amdgcn_exp2f(s0[j] - m[h]) * inv_l[h]; imp1[j] += __builtin_amdgcn_exp2f(s1[j] - m[h]) * inv_l[h]; }
                }
            }
            if (pass == 1) {
                const float prev_lane = __shfl_up(imp1[3], 16);
                const float pm1 = (q == 0) ? carry : prev_lane;
                const float b0 = pm1 + (imp0[0] + imp0[1]) + (imp0[2] + imp0[3]);
                const float b1 = imp0[3] + (imp1[0] + imp1[1]) + (imp1[2] + imp1[3]);
                carry = __shfl(imp1[3], 48 + r);
                float* dst = (float*)(F.ws + R_IMP) + ((size_t)t * 2 + g) * NSB + (key0 >> 2) + 2 * q;
                f32x2 w = {b0, b1}; *(f32x2*)dst = w;
            }
                };
        bf16x8 kA[2][4], kB[2][4];
        kload(kA, 0);
        for (int st = 0; st < nsteps; st += 2) {
            kload(kB, st + 1);
            step(kA, st);
            kload(kA, st + 2);
            if (st + 1 < nsteps) step(kB, st + 1);
        }
        if (pass == 1 && q == 0 && 8 * nsteps < NSB) ((float*)(F.ws + R_IMP))[((size_t)t * 2 + g) * NSB + 8 * nsteps] = carry;
    }
}

struct AttnState { f32x4 o[8]; float m, l; };
struct KVFrag { bf16x8 k[2][4]; bf16x8 v[8]; };
DEVI void kv_load(KVFrag& f, const bf16* kbase  , const bf16* vtbase  , int key0, int r) {
    const size_t st = (size_t)(key0 >> 5);
#pragma unroll
    for (int T = 0; T < 2; ++T)
#pragma unroll
        for (int ks = 0; ks < 4; ++ks) f.k[T][ks] = ldg8(kbase + ((st * 2 + T) * 4 + ks) * 512);
#pragma unroll
    for (int dt = 0; dt < 8; ++dt) f.v[dt] = ldg8(vtbase + (st * 8 + dt) * 512);
}
template <int MODE>
DEVI void attn_compute(AttnState& st, const bf16x8 (&qf)[4], const KVFrag& f, int key0, int tq, int lane) {
    const int q = lane >> 4;
    f32x4 s0 = {0.f, 0.f, 0.f, 0.f}, s1 = s0;
#pragma unroll
    for (int ks = 0; ks < 4; ++ks) { s0 = MFMA16(f.k[0][ks], qf[ks], s0); s1 = MFMA16(f.k[1][ks], qf[ks], s1); }
#pragma unroll
    for (int j = 0; j < 4; ++j) {
        const int ka = key0 + 8 * q + j, kb = ka + 4; bool va, vb;
        if (MODE == 0) { va = 16 * ka + 31 <= tq; vb = 16 * kb + 31 <= tq; }
        else if (MODE == 1) { va = (unsigned)(tq - ka) < 512u; vb = (unsigned)(tq - kb) < 512u; }
        else { va = ka <= tq; vb = kb <= tq; }
        s0[j] = va ? s0[j] * C2 : NEG_INF; s1[j] = vb ? s1[j] * C2 : NEG_INF;
    }
    float mx = fmaxf(fmaxf(fmaxf(s0[0], s0[1]), fmaxf(s0[2], s0[3])), fmaxf(fmaxf(s1[0], s1[1]), fmaxf(s1[2], s1[3])));
    mx = fmaxf(mx, __shfl_xor(mx, 16)); mx = fmaxf(mx, __shfl_xor(mx, 32));
    const float nm = fmaxf(st.m, mx), alpha = __builtin_amdgcn_exp2f(st.m - nm);
    st.m = nm;
    float ps = 0.f;
#pragma unroll
    for (int j = 0; j < 4; ++j) { s0[j] = __builtin_amdgcn_exp2f(s0[j] - nm); s1[j] = __builtin_amdgcn_exp2f(s1[j] - nm); ps += s0[j] + s1[j]; }
    st.l = st.l * alpha + ps;
    if (!__all(alpha == 1.f)) {
#pragma unroll
        for (int dt = 0; dt < 8; ++dt) st.o[dt] = st.o[dt] * alpha;
    }
    const bf16x8 pf = pack8(s0, s1);
#pragma unroll
    for (int dt = 0; dt < 8; ++dt) st.o[dt] = MFMA16(f.v[dt], pf, st.o[dt]);
}
template <int MODE>
DEVI void attn_run_linear(AttnState& st, const bf16x8 (&qf)[4], const bf16* kbase, const bf16* vtbase, int kstart, int nsteps, int tq, int lane) {
    const int r = lane & 15;
    KVFrag A, B;
    kv_load(A, kbase, vtbase, kstart, r);
    for (int s = 0; s < nsteps; s += 2) {
        const int s1 = (s + 1 < nsteps) ? s + 1 : nsteps - 1, s2 = (s + 2 < nsteps) ? s + 2 : nsteps - 1;
        kv_load(B, kbase, vtbase, kstart + 32 * s1, r);
        attn_compute<MODE>(st, qf, A, kstart + 32 * s, tq, lane);
        kv_load(A, kbase, vtbase, kstart + 32 * s2, r);
        if (s + 1 < nsteps) attn_compute<MODE>(st, qf, B, kstart + 32 * s1, tq, lane);
    }
}
typedef long i64_t;
#define MFMA16F8(a, b, c) __builtin_amdgcn_mfma_f32_16x16x32_fp8_fp8((a), (b), (c), 0, 0, 0)
struct KVFrag8 { i64_t k[2][4]; i64_t v[8]; };
DEVI void kv_load8(KVFrag8& f, const unsigned char* kbase  , const unsigned char* vtbase  , int key0) {
    const size_t st = (size_t)(key0 >> 5);
#pragma unroll
    for (int T = 0; T < 2; ++T)
#pragma unroll
        for (int ks = 0; ks < 4; ++ks) f.k[T][ks] = *(const i64_t*)(kbase + ((st * 2 + T) * 4 + ks) * 512);
#pragma unroll
    for (int dt = 0; dt < 8; ++dt) f.v[dt] = *(const i64_t*)(vtbase + (st * 8 + dt) * 512);
}
template <bool MASK>
DEVI void attn_compute8(AttnState& st, const i64_t (&qf)[4], const KVFrag8& f, int key0, int tq, int lane) {
    const int q = lane >> 4;
    f32x4 s0 = {0.f, 0.f, 0.f, 0.f}, s1 = s0;
#pragma unroll
    for (int ks = 0; ks < 4; ++ks) { s0 = MFMA16F8(f.k[0][ks], qf[ks], s0); s1 = MFMA16F8(f.k[1][ks], qf[ks], s1); }
    if (MASK) {
#pragma unroll
        for (int j = 0; j < 4; ++j) { const int ka = key0 + 8 * q + j, kb = ka + 4; s0[j] = (ka <= tq) ? s0[j] : NEG_INF; s1[j] = (kb <= tq) ? s1[j] : NEG_INF; }
    }
    float mx = fmaxf(fmaxf(fmaxf(s0[0], s0[1]), fmaxf(s0[2], s0[3])), fmaxf(fmaxf(s1[0], s1[1]), fmaxf(s1[2], s1[3])));
    mx = fmaxf(mx, __shfl_xor(mx, 16)); mx = fmaxf(mx, __shfl_xor(mx, 32));
    const float nm = fmaxf(st.m, mx * C2), alpha = __builtin_amdgcn_exp2f(st.m - nm), bias = 8.f - nm;
    st.m = nm;
    float ps = 0.f;
#pragma unroll
    for (int j = 0; j < 4; ++j) { s0[j] = __builtin_amdgcn_exp2f(__builtin_fmaf(s0[j], C2, bias)); s1[j] = __builtin_amdgcn_exp2f(__builtin_fmaf(s1[j], C2, bias)); ps += s0[j] + s1[j]; }
    st.l = st.l * alpha + ps;
    if (!__all(alpha == 1.f)) {
#pragma unroll
        for (int dt = 0; dt < 8; ++dt) st.o[dt] = st.o[dt] * alpha;
    }
    const i64_t pf = (i64_t)(((unsigned long long)pk4_fp8(s1[0], s1[1], s1[2], s1[3]) << 32) | pk4_fp8(s0[0], s0[1], s0[2], s0[3]));
#pragma unroll
    for (int dt = 0; dt < 8; ++dt) st.o[dt] = MFMA16F8(f.v[dt], pf, st.o[dt]);
}
typedef int v8i __attribute__((ext_vector_type(8)));
#define MFMA128(a, b, c) __builtin_amdgcn_mfma_scale_f32_16x16x128_f8f6f4((a), (b), (c), 0, 0, 0, 0x7F7F7F7F, 0, 0x7F7F7F7F)
DEVI v8i ld32(const unsigned char* p) { const v4u a = *(const v4u*)p, b = *(const v4u*)(p + 1024);
    v8i r; r[0] = a.x; r[1] = a.y; r[2] = a.z; r[3] = a.w; r[4] = b.x; r[5] = b.y; r[6] = b.z; r[7] = b.w; return r; }
DEVI void attn_init(AttnState& st) {
#pragma unroll
    for (int dt = 0; dt < 8; ++dt) st.o[dt] = (f32x4){0.f, 0.f, 0.f, 0.f};
    st.m = -1e30f; st.l = 0.f;
}
template <int CTRL, int BANK> DEVI float dpp_merge(float old, float src) { return __builtin_bit_cast(float, __builtin_amdgcn_update_dpp(__builtin_bit_cast(int, old), __builtin_bit_cast(int, src), CTRL, 0xf, BANK, false)); }
template <int CTRL> DEVI int dpp_mov(int src) { return __builtin_amdgcn_update_dpp(0, src, CTRL, 0xf, 0xf, true); }
template <int CTRL> DEVI float dpp_movf(float src) { return __builtin_bit_cast(float, __builtin_amdgcn_update_dpp(0, __builtin_bit_cast(int, src), CTRL, 0xf, 0xf, true)); }
template <bool LATE_K, bool C4, class BlkFn, class MaskFn>
DEVI void attn128_run(AttnState& st, const v8i qf, const unsigned char* kb, const unsigned char* vb, int nblk, BlkFn blk, MaskFn M, int q, v8i (&KA)[4], v8i (&KB)[4]) {
    const int nst = (nblk + 1) >> 1;
    for (int ss = 0; ss < nst; ++ss) {
        const int bA = blk(2 * ss);
        const bool hasB = (2 * ss + 1 < nblk);
        const int bB = blk(hasB ? 2 * ss + 1 : 2 * ss);
        v8i vf[8];
#pragma unroll
        for (int dt = 0; dt < 8; ++dt) { const v4u a = *(const v4u*)(vb + (size_t)bA * 8192 + dt * 1024), b = *(const v4u*)(vb + (size_t)bB * 8192 + dt * 1024);
            vf[dt][0] = a.x; vf[dt][1] = a.y; vf[dt][2] = a.z; vf[dt][3] = a.w; vf[dt][4] = b.x; vf[dt][5] = b.y; vf[dt][6] = b.z; vf[dt][7] = b.w; }
        f32x4 sa[4], sb[4];
#pragma unroll
        for (int T = 0; T < 4; ++T) { const f32x4 z = {0.f, 0.f, 0.f, 0.f}; sa[T] = MFMA128(KA[T], qf, z); sb[T] = MFMA128(KB[T], qf, z); }
        if (M.need(bA)) {
#pragma unroll
            for (int T = 0; T < 4; ++T)
#pragma unroll
                for (int j = 0; j < 4; ++j) sa[T][j] = M.vis(64 * bA + 16 * T + 4 * q + j) ? sa[T][j] : NEG_INF; }
        if (!hasB || M.need(bB)) {
#pragma unroll
            for (int T = 0; T < 4; ++T)
#pragma unroll
                for (int j = 0; j < 4; ++j) sb[T][j] = (hasB && M.vis(64 * bB + 16 * T + 4 * q + j)) ? sb[T][j] : NEG_INF; }
        v8i pf;
        if (C4) {
            f32x4 ca, cb;
#pragma unroll
            for (int j = 0; j < 4; ++j) {
                float x = sa[0][j]; x = dpp_merge<0x114, 0x2>(x, sa[1][j]); x = dpp_merge<0x118, 0x4>(x, sa[2][j]); x = dpp_merge<0x11C, 0x8>(x, sa[3][j]); ca[j] = x;
                float y = sb[0][j]; y = dpp_merge<0x114, 0x2>(y, sb[1][j]); y = dpp_merge<0x118, 0x4>(y, sb[2][j]); y = dpp_merge<0x11C, 0x8>(y, sb[3][j]); cb[j] = y; }
            float mx = fmaxf(fmaxf(fmaxf(ca[0], ca[1]), fmaxf(ca[2], ca[3])), fmaxf(fmaxf(cb[0], cb[1]), fmaxf(cb[2], cb[3])));
            mx = fmaxf(mx, dpp_movf<0x124>(mx)); mx = fmaxf(mx, dpp_movf<0x128>(mx));
            mx = fmaxf(mx, __shfl_xor(mx, 16)); mx = fmaxf(mx, __shfl_xor(mx, 32));
            const float nm = fmaxf(st.m, mx * C2), alpha = __builtin_amdgcn_exp2f(st.m - nm), bias = 8.f - nm;
            st.m = nm;
            float ps = 0.f;
#pragma unroll
            for (int j = 0; j < 4; ++j) { ca[j] = __builtin_amdgcn_exp2f(__builtin_fmaf(ca[j], C2, bias)); cb[j] = __builtin_amdgcn_exp2f(__builtin_fmaf(cb[j], C2, bias)); ps += ca[j] + cb[j]; }
            st.l = st.l * alpha + ps;
            if (!__all(alpha == 1.f)) {
#pragma unroll
                for (int dt = 0; dt < 8; ++dt) st.o[dt] = st.o[dt] * alpha;
            }
            const int wa = (int)pk4_fp8(ca[0], ca[1], ca[2], ca[3]), wb = (int)pk4_fp8(cb[0], cb[1], cb[2], cb[3]);
            pf[0] = wa; pf[1] = dpp_mov<0x104>(wa); pf[2] = dpp_mov<0x108>(wa); pf[3] = dpp_mov<0x10C>(wa);
            pf[4] = wb; pf[5] = dpp_mov<0x104>(wb); pf[6] = dpp_mov<0x108>(wb); pf[7] = dpp_mov<0x10C>(wb);
        } else {
        float mx = NEG_INF;
#pragma unroll
            for (int T = 0; T < 4; ++T) { mx = fmaxf(mx, fmaxf(fmaxf(sa[T][0], sa[T][1]), fmaxf(sa[T][2], sa[T][3]))); mx = fmaxf(mx, fmaxf(fmaxf(sb[T][0], sb[T][1]), fmaxf(sb[T][2], sb[T][3]))); }
            mx = fmaxf(mx, __shfl_xor(mx, 16)); mx = fmaxf(mx, __shfl_xor(mx, 32));
            const float nm = fmaxf(st.m, mx * C2), alpha = __builtin_amdgcn_exp2f(st.m - nm), bias = 8.f - nm;
            st.m = nm;
            float ps = 0.f;
#pragma unroll
            for (int T = 0; T < 4; ++T)
#pragma unroll
                for (int j = 0; j < 4; ++j) { sa[T][j] = __builtin_amdgcn_exp2f(__builtin_fmaf(sa[T][j], C2, bias)); sb[T][j] = __builtin_amdgcn_exp2f(__builtin_fmaf(sb[T][j], C2, bias)); ps += sa[T][j] + sb[T][j]; }
            st.l = st.l * alpha + ps;
            if (!__all(alpha == 1.f)) {
#pragma unroll
                for (int dt = 0; dt < 8; ++dt) st.o[dt] = st.o[dt] * alpha;
            }
#pragma unroll
            for (int T = 0; T < 4; ++T) { pf[T] = (int)pk4_fp8(sa[T][0], sa[T][1], sa[T][2], sa[T][3]); pf[4 + T] = (int)pk4_fp8(sb[T][0], sb[T][1], sb[T][2], sb[T][3]); }
        }
        if (!LATE_K)
        { const int n0 = (2 * ss + 2 < nblk) ? 2 * ss + 2 : 2 * ss, n1 = (2 * ss + 3 < nblk) ? 2 * ss + 3 : n0;
          const int c0_ = blk(n0), c1_ = blk(n1);
#pragma unroll
          for (int T = 0; T < 4; ++T) { KA[T] = ld32(kb + (size_t)c0_ * 8192 + T * 2048); KB[T] = ld32(kb + (size_t)c1_ * 8192 + T * 2048); } }
#pragma unroll
        for (int dt = 0; dt < 8; ++dt) st.o[dt] = MFMA128(vf[dt], pf, st.o[dt]);
        if (LATE_K)
        { const int n0 = (2 * ss + 2 < nblk) ? 2 * ss + 2 : 2 * ss, n1 = (2 * ss + 3 < nblk) ? 2 * ss + 3 : n0;
          const int c0_ = blk(n0), c1_ = blk(n1);
#pragma unroll
          for (int T = 0; T < 4; ++T) { KA[T] = ld32(kb + (size_t)c0_ * 8192 + T * 2048); KB[T] = ld32(kb + (size_t)c1_ * 8192 + T * 2048); } }
    }
    if (C4) { st.l += dpp_movf<0x124>(st.l); st.l += dpp_movf<0x128>(st.l); }
}
DEVI void attn128_k0(v8i (&KA)[4], v8i (&KB)[4], const unsigned char* kb, int b0_, int b1_) {
#pragma unroll
    for (int T = 0; T < 4; ++T) { KA[T] = ld32(kb + (size_t)b0_ * 8192 + T * 2048); KB[T] = ld32(kb + (size_t)b1_ * 8192 + T * 2048); }
}
struct SelMask { int cur, t; DEVI bool need(int b) const { return b == cur; } DEVI bool vis(int key) const { return key <= t; } };
struct WinMask { int t0, tq; DEVI bool need(int b) const { return !(64 * b + 63 <= t0 && 64 * b >= t0 - 496); } DEVI bool vis(int key) const { return (unsigned)(tq - key) < 512u; } };
DEVI v8i q_frag8(const bf16* qp, bool on) {
    v8i qf;
#pragma unroll
    for (int i = 0; i < 4; ++i) { const v4u w = *(const v4u*)(qp + 8 * i);
        qf[2 * i] = on ? (int)pk4_fp8(bflo(w.x), bfhi(w.x), bflo(w.y), bfhi(w.y)) : 0; qf[2 * i + 1] = on ? (int)pk4_fp8(bflo(w.z), bfhi(w.z), bflo(w.w), bfhi(w.w)) : 0; }
    return qf;
}
DEVI void attn_store(AttnState& st, bf16* dst, bool active, int lane, float oscale = 1.f) {
    const int q = lane >> 4;
    float l = st.l; l += __shfl_xor(l, 16); l += __shfl_xor(l, 32);
    const float inv = l > 0.f ? oscale / l : 0.f;
    if (active) {
#pragma unroll
        for (int dt = 0; dt < 8; ++dt) { v2u w; w.x = pk2(st.o[dt][0] * inv, st.o[dt][1] * inv); w.y = pk2(st.o[dt][2] * inv, st.o[dt][3] * inv); *(v2u*)(dst + 16 * dt + 4 * q) = w; }
    }
}
template <int MODE>
DEVI void attn_run_linear2(AttnState& st0, AttnState& st1, const bf16x8 (&q0)[4], const bf16x8 (&q1)[4], const bf16* kbase, const bf16* vtbase, int kstart, int nsteps, int tq, int lane) {
    const int r = lane & 15;
    for (int s = 0; s < nsteps; ++s) {
        KVFrag A;
        kv_load(A, kbase, vtbase, kstart + 32 * s, r);
        attn_compute<MODE>(st0, q0, A, kstart + 32 * s, tq, lane);
        attn_compute<MODE>(st1, q1, A, kstart + 32 * s, tq, lane);
    }
}
DEVI void cmp_att_job2(Frame& F, int tile, int hp) {
    const int lane = F.lane, r = lane & 15, q = lane >> 4, t = tile * 16 + r, h = 2 * hp, g = h >> 2;
    AttnState st0, st1; attn_init(st0); attn_init(st1);
    bf16x8 q0[4], q1[4];
    const bf16* qp = (const bf16*)(F.ws + R_Q) + (size_t)t * DATT + (size_t)h * HD + 8 * q;
#pragma unroll
    for (int ks = 0; ks < 4; ++ks) { q0[ks] = ldg8(qp + 32 * ks); q1[ks] = ldg8(qp + HD + 32 * ks); }
    if (tile > 0) {
        const int nsteps = ((tile - 1) >> 5) + 1;
        const bf16* kb = (const bf16*)(F.ws + R_KC) + (size_t)g * 1024 * HD + lane * 8;
        const bf16* vb = (const bf16*)(F.ws + R_VCT) + (size_t)g * HD * 1024 + lane * 8;
        attn_run_linear2<0>(st0, st1, q0, q1, kb, vb, 0, nsteps, t, lane);
    }
    attn_store(st0, (bf16*)(F.ws + R_OC) + (size_t)t * DATT + (size_t)h * HD, true, lane);
    attn_store(st1, (bf16*)(F.ws + R_OC) + (size_t)t * DATT + (size_t)(h + 1) * HD, true, lane);
}
DEVI void win_att_job2(Frame& F, int tile, int hp) {
    const int lane = F.lane, r = lane & 15, q = lane >> 4, t0 = tile * 16, t = t0 + r, h = 2 * hp, g = h >> 2;
    AttnState st0, st1; attn_init(st0); attn_init(st1);
    bf16x8 q0[4], q1[4];
    const bf16* qp = (const bf16*)(F.ws + R_QR) + (size_t)t * DATT + (size_t)h * HD + 8 * q;
#pragma unroll
    for (int ks = 0; ks < 4; ++ks) { q0[ks] = ldg8(qp + 32 * ks); q1[ks] = ldg8(qp + HD + 32 * ks); }
    int k_lo = t0 - 511; k_lo = k_lo < 0 ? 0 : k_lo; k_lo &= ~31;
    const bf16* kb = (const bf16*)(F.ws + R_KWF) + (size_t)g * S * HD + lane * 8;
    const bf16* vb = (const bf16*)(F.ws + R_VWT) + (size_t)g * HD * S + lane * 8;
    attn_run_linear2<1>(st0, st1, q0, q1, kb, vb, k_lo, ((t0 + 15 - k_lo) >> 5) + 1, t, lane);
    attn_store(st0, (bf16*)(F.ws + R_OW) + (size_t)t * DATT + (size_t)h * HD, true, lane);
    attn_store(st1, (bf16*)(F.ws + R_OW) + (size_t)t * DATT + (size_t)(h + 1) * HD, true, lane);
}
DEVI void win_att_job8(Frame& F, int tile, int h) {
    const int lane = F.lane, r = lane & 15, q = lane >> 4, t0 = tile * 16, t = t0 + r, g = h >> 2;
    AttnState st; attn_init(st);
    const v8i qf = q_frag8((const bf16*)(F.ws + R_QR) + (size_t)t * DATT + (size_t)h * HD + 32 * q, true);
    const int lo = t0 - 511, blo = (lo < 0 ? 0 : lo) >> 6, nblk = (t0 >> 6) - blo + 1;
    v8i KA[4], KB[4]; const unsigned char* kb = (const unsigned char*)(F.ws + R_KW8) + (size_t)g * S * HD + lane * 16;
    attn128_k0(KA, KB, kb, blo, blo + (nblk > 1 ? 1 : 0));
    attn128_run<false, false>(st, qf, kb, (const unsigned char*)(F.ws + R_VW8) + (size_t)g * S * HD + lane * 16, nblk,
                [&](int i) { return blo + i; }, WinMask{t0, t}, q, KA, KB);
    attn_store(st, (bf16*)(F.ws + R_OW) + (size_t)t * DATT + (size_t)h * HD, true, lane);
}
DEVI void cmp_att_job(Frame& F, int tile, int h) {
    const int lane = F.lane, r = lane & 15, q = lane >> 4, t = tile * 16 + r, g = h >> 2;
    AttnState st; attn_init(st);
    bf16x8 qf[4];
    const bf16* qp = (const bf16*)(F.ws + R_Q) + (size_t)t * DATT + (size_t)h * HD + 8 * q;
#pragma unroll
    for (int ks = 0; ks < 4; ++ks) qf[ks] = ldg8(qp + 32 * ks);
    if (tile > 0) {
        const int nsteps = ((tile - 1) >> 5) + 1;
        const bf16* kb = (const bf16*)(F.ws + R_KC) + (size_t)g * 1024 * HD + lane * 8;
        const bf16* vb = (const bf16*)(F.ws + R_VCT) + (size_t)g * HD * 1024 + lane * 8;
        attn_run_linear<0>(st, qf, kb, vb, 0, nsteps, t, lane);
    }
    attn_store(st, (bf16*)(F.ws + R_OC) + (size_t)t * DATT + (size_t)h * HD, true, lane);
}
DEVI void win_att_job(Frame& F, int tile, int h) {
    const int lane = F.lane, r = lane & 15, q = lane >> 4, t0 = tile * 16, t = t0 + r, g = h >> 2;
    AttnState st; attn_init(st);
    bf16x8 qf[4];
    const bf16* qp = (const bf16*)(F.ws + R_QR) + (size_t)t * DATT + (size_t)h * HD + 8 * q;
#pragma unroll
    for (int ks = 0; ks < 4; ++ks) qf[ks] = ldg8(qp + 32 * ks);
    int k_lo = t0 - 511; k_lo = k_lo < 0 ? 0 : k_lo; k_lo &= ~31;
    const bf16* kb = (const bf16*)(F.ws + R_KWF) + (size_t)g * S * HD + lane * 8;
    const bf16* vb = (const bf16*)(F.ws + R_VWT) + (size_t)g * HD * S + lane * 8;
    attn_run_linear<1>(st, qf, kb, vb, k_lo, ((t0 + 15 - k_lo) >> 5) + 1, t, lane);
    attn_store(st, (bf16*)(F.ws + R_OW) + (size_t)t * DATT + (size_t)h * HD, true, lane);
}
DEVI f32x4 sel_imp_load(Frame& F, int t, int g) { return *(const f32x4*)((const float*)(F.ws + R_IMP) + ((size_t)t * 2 + g) * NSB + 4 * F.lane); }
DEVI void sel_att_job(Frame& F, int t, int g, const f32x4 iv, int variant = 0) {
    const int lane = F.lane, r = lane & 15, q = lane >> 4;
    v4u qraw[4];
    { const bf16* qp = (const bf16*)(F.ws + R_QR) + (size_t)t * DATT + (size_t)(4 * g + (r & 3)) * HD + 32 * q;
#pragma unroll
      for (int i = 0; i < 4; ++i) qraw[i] = *(const v4u*)(qp + 8 * i); }
    const int cur = t >> 6;
    v8i KA[4], KB[4]; const unsigned char* kb = (const unsigned char*)(F.ws + R_KS8) + (size_t)g * S * HD + lane * 16;
    attn128_k0(KA, KB, kb, 0, cur);
    const int nvis = (t - 31) >> 4, jlim = (t >= 31) ? ((nvis + 1) >> 2) : -1;
    unsigned ikey[4]; bool cand[4], sel[4];
    int nforced = 0, ncand = 0;
#pragma unroll
    for (int i = 0; i < 4; ++i) { const int j = 4 * lane + i; const float im = (j <= jlim) ? iv[i] : 0.f;
        const bool allowed = j <= cur, forced = allowed && ((j == 0) || (j == cur) || (j == cur - 1));
        ikey[i] = __float_as_uint(im); cand[i] = allowed && !forced; sel[i] = forced;
        nforced += __builtin_popcountll(__ballot(forced)); ncand += __builtin_popcountll(__ballot(cand[i])); }
    const int K = 16 - nforced;
    if (ncand <= K) {
#pragma unroll
        for (int i = 0; i < 4; ++i) sel[i] = sel[i] || cand[i];
    } else {
        unsigned thr = 0u;
        for (int bit = 30; bit >= 0; --bit) {
            const unsigned tr = thr | (1u << bit); int cnt = 0;
#pragma unroll
            for (int i = 0; i < 4; ++i) cnt += __builtin_popcountll(__ballot(cand[i] && ikey[i] >= tr));
            if (cnt >= K) { thr = tr; if (cnt == K) break; }
        }
        int cgt = 0; unsigned long long tm[4];
#pragma unroll
        for (int i = 0; i < 4; ++i) { const bool gt = cand[i] && ikey[i] > thr; sel[i] = sel[i] || gt; cgt += __builtin_popcountll(__ballot(gt)); tm[i] = __ballot(cand[i] && ikey[i] == thr); }
        for (int need = K - cgt; need > 0; --need) {
            int bestj = 1 << 30;
#pragma unroll
            for (int i = 0; i < 4; ++i) if (tm[i]) { const int j = 4 * (int)__builtin_ctzll(tm[i]) + i; bestj = j < bestj ? j : bestj; }
#pragma unroll
            for (int i = 0; i < 4; ++i) { if ((bestj & 3) == i) tm[i] &= tm[i] - 1ull; if (4 * lane + i == bestj) sel[i] = true; }
        }
    }
    int selv = 0, nsel = 1;
    if (cur >= 1) { selv = (lane == 1) ? cur : selv; nsel = 2; }
    if (cur >= 2) { selv = (lane == 2) ? cur - 1 : selv; nsel = 3; }
#pragma unroll
    for (int i = 0; i < 4; ++i) { const int jb = 4 * lane + i; unsigned long long m = __ballot(sel[i] && jb != 0 && jb != cur && jb != cur - 1);
        while (m) { const int bl = (int)__builtin_ctzll(m); m &= m - 1ull; selv = (lane == nsel) ? (4 * bl + i) : selv; ++nsel; } }
    if (variant == 4) nsel = 0;
#ifdef REP_PHASE
    if (variant == 1) selv = lane & 3;
    if (variant == 2) { selv = cur - lane; selv = selv < 0 ? 0 : selv; }
    if (variant == 4) { selv = lane & 3; nsel = 16; }
    if (variant == 3) nsel = 0;
#endif
    AttnState st; attn_init(st);
    v8i qf;
#pragma unroll
    for (int i = 0; i < 4; ++i) { const v4u w = qraw[i];
        qf[2 * i] = (r < 4) ? (int)pk4_fp8(bflo(w.x), bfhi(w.x), bflo(w.y), bfhi(w.y)) : 0; qf[2 * i + 1] = (r < 4) ? (int)pk4_fp8(bflo(w.z), bfhi(w.z), bflo(w.w), bfhi(w.w)) : 0; }
    attn128_run<false, true>(st, qf, kb, (const unsigned char*)(F.ws + R_VS8) + (size_t)g * S * HD + lane * 16, nsel,
                [&](int i) { return __builtin_amdgcn_readlane(selv, i); }, SelMask{cur, t}, q, KA, KB);
    attn_store(st, (bf16*)(F.ws + (variant ? R_ACT : R_OS)) + (size_t)t * DATT + (size_t)(4 * g + (r & 3)) * HD, r < 4, lane);
}

DEVI void mixnorm_job(Frame& F, const float* pMOG, int l, int t) {
    const int lane = F.lane;
    const float* mg = pMOG + (size_t)l * D;
    unsigned char* mixed = (unsigned char*)(F.ws + R_MIXED);
#pragma unroll
    for (int part = 0; part < 2; ++part) {
        const bf16* src = (const bf16*)(F.ws + (part ? R_SSMO : R_CONVO)) + (size_t)t * 512 + 8 * lane;
        const int gofs = part ? (DCONV + DATT) : 0;
        const v4u w = *(const v4u*)src; float x[8] = {bflo(w.x), bfhi(w.x), bflo(w.y), bfhi(w.y), bflo(w.z), bfhi(w.z), bflo(w.w), bfhi(w.w)};
        float s = 0.f;
#pragma unroll
        for (int c = 0; c < 8; ++c) s += x[c] * x[c];
        const float rr = 1.f / sqrtf(wave_sum(s) * (1.f / 512.f) + EPS);
        const f32x4 g0 = *(const f32x4*)(mg + gofs + 8 * lane), g1 = *(const f32x4*)(mg + gofs + 8 * lane + 4);
        v4u o; o.x = pk2(x[0] * rr * g0[0], x[1] * rr * g0[1]); o.y = pk2(x[2] * rr * g0[2], x[3] * rr * g0[3]); o.z = pk2(x[4] * rr * g1[0], x[5] * rr * g1[1]); o.w = pk2(x[6] * rr * g1[2], x[7] * rr * g1[3]);
        *(v4u*)(mixed + tix(S, t, 2 * (gofs + 8 * lane))) = o;
    }
    {
        const int h = lane >> 3; const float* gt = (const float*)(F.ws + R_GATES) + (size_t)t * 24 + 3 * h;
        const float gc = gt[0], gs = gt[1], gw = gt[2];
        const size_t off = (size_t)t * DATT + 16 * lane;
        const bf16* pc = (const bf16*)(F.ws + R_OC) + off; const bf16* ps = (const bf16*)(F.ws + R_OS) + off; const bf16* pw = (const bf16*)(F.ws + R_OW) + off;
        float x[16]; float s = 0.f;
#pragma unroll
        for (int hh = 0; hh < 2; ++hh) { const v4u a = *(const v4u*)(pc + 8 * hh), b = *(const v4u*)(ps + 8 * hh), c = *(const v4u*)(pw + 8 * hh);
            const unsigned aw[4] = {a.x, a.y, a.z, a.w}, bw[4] = {b.x, b.y, b.z, b.w}, cw[4] = {c.x, c.y, c.z, c.w};
#pragma unroll
            for (int i = 0; i < 4; ++i) { x[8 * hh + 2 * i] = gc * bflo(aw[i]) + gs * bflo(bw[i]) + gw * bflo(cw[i]); x[8 * hh + 2 * i + 1] = gc * bfhi(aw[i]) + gs * bfhi(bw[i]) + gw * bfhi(cw[i]); } }
#pragma unroll
        for (int c = 0; c < 16; ++c) s += x[c] * x[c];
        const float rr = 1.f / sqrtf(wave_sum(s) * (1.f / 1024.f) + EPS);
        const float* gp = mg + DCONV + 16 * lane;
        float gg[16];
#pragma unroll
        for (int c4 = 0; c4 < 4; ++c4) { const f32x4 v = *(const f32x4*)(gp + 4 * c4); gg[4 * c4] = v[0]; gg[4 * c4 + 1] = v[1]; gg[4 * c4 + 2] = v[2]; gg[4 * c4 + 3] = v[3]; }
        v4u o0, o1;
        o0.x = pk2(x[0] * rr * gg[0], x[1] * rr * gg[1]); o0.y = pk2(x[2] * rr * gg[2], x[3] * rr * gg[3]); o0.z = pk2(x[4] * rr * gg[4], x[5] * rr * gg[5]); o0.w = pk2(x[6] * rr * gg[6], x[7] * rr * gg[7]);
        o1.x = pk2(x[8] * rr * gg[8], x[9] * rr * gg[9]); o1.y = pk2(x[10] * rr * gg[10], x[11] * rr * gg[11]); o1.z = pk2(x[12] * rr * gg[12], x[13] * rr * gg[13]); o1.w = pk2(x[14] * rr * gg[14], x[15] * rr * gg[15]);
        *(v4u*)(mixed + tix(S, t, 2 * (DCONV + 16 * lane))) = o0; *(v4u*)(mixed + tix(S, t, 2 * (DCONV + 16 * lane + 8))) = o1;
    }
}

DEVI void norm_route_job(Frame& F, const float* g, const float* rw, int t, bool route) {
    const int lane = F.lane;
    const bf16* xrow = (const bf16*)(F.ws + WS_H) + (size_t)t * D;
    unsigned char* obase = (unsigned char*)(F.ws + WS_HN);
    f32x4 v[8]; float s = 0.f;
#pragma unroll
    for (int j = 0; j < 8; ++j) { v[j] = row_ld4<true>(xrow, 4 * lane + 256 * j); s += (v[j].x * v[j].x + v[j].y * v[j].y) + (v[j].z * v[j].z + v[j].w * v[j].w); }
    const float rr = 1.f / sqrtf(wave_sum(s) * (1.f / D) + EPS);
#pragma unroll
    for (int j = 0; j < 8; ++j) { const f32x4 gg = *(const f32x4*)(g + 4 * lane + 256 * j); v[j] = v[j] * rr * gg;
        *(unsigned*)((unsigned char*)(F.ws + R_HN8) + tix(S, t, 4 * lane + 256 * j)) = pk4_fp8(v[j].x, v[j].y, v[j].z, v[j].w); }
    if (!route) return;
    float lg[8];
#pragma unroll
    for (int e = 0; e < 8; ++e) lg[e] = 0.f;
#pragma unroll
    for (int j = 0; j < 8; ++j)
#pragma unroll
        for (int i = 0; i < 4; ++i) { const int k = 4 * lane + 256 * j + i; const f32x4 a = *(const f32x4*)(rw + (size_t)k * 8), b = *(const f32x4*)(rw + (size_t)k * 8 + 4); const float x = v[j][i];
            lg[0] += x * a[0]; lg[1] += x * a[1]; lg[2] += x * a[2]; lg[3] += x * a[3]; lg[4] += x * b[0]; lg[5] += x * b[1]; lg[6] += x * b[2]; lg[7] += x * b[3]; }
#pragma unroll
    for (int e = 0; e < 8; ++e) lg[e] = wave_sum(lg[e]);
    int e1 = 0; float v1 = lg[0];
#pragma unroll
    for (int e = 1; e < 8; ++e) if (lg[e] > v1) { v1 = lg[e]; e1 = e; }
    int e2 = -1; float v2 = -3.0e38f;
#pragma unroll
    for (int e = 0; e < 8; ++e) if (e != e1 && lg[e] > v2) { v2 = lg[e]; e2 = e; }
    const float p2 = __expf(v2 - v1), w1 = 1.f / (1.f + p2), w2 = p2 / (1.f + p2);
    if (lane < 2) {
        const int e = lane ? e2 : e1; const float w = lane ? w2 : w1;
        const unsigned slot = __hip_atomic_fetch_add((unsigned*)(F.ctl + CW_ECNT + 64 * e), 1u, RLX_AGENT);
        ((int*)(F.ws + WS_TOK + TOK_E))[2 * t + lane] = e; ((float*)(F.ws + WS_TOK + TOK_W))[2 * t + lane] = w; ((int*)(F.ws + WS_TOK + TOK_SLOT))[2 * t + lane] = (int)slot;
    }
}
DEVI void moe_prefix(Frame& F, int (&pe)[NE + 1]) {
    int acc = 0;
#pragma unroll
    for (int e = 0; e < NE; ++e) { pe[e] = acc; const unsigned c = __hip_atomic_load((unsigned*)(F.ctl + CW_ECNT + 64 * e), RLX_AGENT); acc += (int)((c + 255u) >> 8); }
    pe[NE] = acc;
}
DEVI void moe_gather_job(Frame& F, const int (&pe)[NE + 1], int job) {
    const int lane = F.lane, t = job >> 1;
    const int e = ((const int*)(F.ws + WS_TOK + TOK_E))[job], slot = ((const int*)(F.ws + WS_TOK + TOK_SLOT))[job];
    int p0 = 0;
#pragma unroll
    for (int k = 0; k < NE; ++k) p0 = (e == k) ? pe[k] : p0;
    const int row = p0 * 256 + slot;
    const unsigned char* src = (const unsigned char*)(F.ws + R_HN8); unsigned char* dst = (unsigned char*)(F.ws + M_ASORT);
#pragma unroll
    for (int i = 0; i < 4; ++i) { const int c8 = 8 * (lane + 64 * i); const v2u o = *(const v2u*)(src + tix(S, t, c8)); *(v2u*)(dst + tix(NPAD, row, c8)) = o; }
    if (lane == 0) { ((int*)(F.ws + WS_TOK + TOK_POS))[job] = row; ((float*)(F.ws + WS_TOK + TOK_RW))[row] = ((const float*)(F.ws + WS_TOK + TOK_W))[job]; }
}
DEVI void moe_combine_job(Frame& F, float* outp, const float* g, int t) {
    const int lane = F.lane;
    const bf16* xrow = (const bf16*)(F.ws + WS_H) + (size_t)t * D;
    const int r0 = ((const int*)(F.ws + WS_TOK + TOK_POS))[2 * t], r1 = ((const int*)(F.ws + WS_TOK + TOK_POS))[2 * t + 1];
    const bf16* y0 = (const bf16*)(F.ws + M_YS) + (size_t)r0 * D; const bf16* y1 = (const bf16*)(F.ws + M_YS) + (size_t)r1 * D;
    float* orow = outp + (size_t)t * D;
    f32x4 v[8]; float s = 0.f;
#pragma unroll
    for (int j = 0; j < 8; ++j) { const int c = 4 * lane + 256 * j; v[j] = row_ld4<true>(xrow, c);
        const v2u a = __builtin_nontemporal_load((const v2u*)(y0 + c)), b = __builtin_nontemporal_load((const v2u*)(y1 + c));
        v[j].x += bflo(a.x) + bflo(b.x); v[j].y += bfhi(a.x) + bfhi(b.x); v[j].z += bflo(a.y) + bflo(b.y); v[j].w += bfhi(a.y) + bfhi(b.y);
        s += (v[j].x * v[j].x + v[j].y * v[j].y) + (v[j].z * v[j].z + v[j].w * v[j].w); }
    const float rr = 1.f / sqrtf(wave_sum(s) * (1.f / D) + EPS);
#pragma unroll
    for (int j = 0; j < 8; ++j) { const int c = 4 * lane + 256 * j; const f32x4 gg = *(const f32x4*)(g + c); __builtin_nontemporal_store(v[j] * rr * gg, (f32x4*)(orow + c)); }
}

#ifndef REPV
#define REPV 0
#endif
#ifndef MK_N_LAUNCHES
#define MK_N_LAUNCHES 1
#endif
constexpr int N_PHASES = 25;

__global__ void __launch_bounds__(NTHR, 2) fwd_kernel(Args args) {
    extern __shared__ __attribute__((aligned(16))) unsigned char lds[];
    Frame F;
    F.lds = (LAS unsigned char*)lds;
    F.MISC = (volatile LAS unsigned*)(F.lds + MISC_OFF);
    F.tid = threadIdx.x; F.lane = F.tid & 63; F.wave = __builtin_amdgcn_readfirstlane(F.tid >> 6);
    F.G = gridDim.x; F.gw = blockIdx.x * NWAVES + F.wave; F.NGW = F.G * NWAVES;
    F.ws = args.ws; F.ctl = (gu32*)(args.ws + WS_CTL);
    if (F.tid < 38) ((const float**)(args.ws + CTL_TBL + (size_t)blockIdx.x * 512))[F.tid] = args.in[F.tid];
    unsigned char* ws = args.ws;
    for (int u = F.tid; u < (LDS_BYTES - LDSCTL_OFF) / 4; u += NTHR) ((LAS unsigned*)(F.lds + LDSCTL_OFF))[u] = 0u;
    __syncthreads();
    XcdBarrier bar = xcd_barrier_post((unsigned*)(F.ctl + CW_BAR) + args.li * XCD_BAR_WORDS, F.MISC + 8);
    const int lo = args.ph_lo, hi = args.ph_hi;
#define IN(k) (lo <= (k) && (k) < hi)
#ifdef PROBE_K
#define STAMP(i) do { if (blockIdx.x == 0 && threadIdx.x == 0) ((unsigned long long*)(args.ws + WS_CTL) + CW_DBG / 2)[(i)] = wall_clock64(); } while (0)
#else
#define STAMP(i) do { } while (0)
#endif
#define SEAM(k) do { if (IN(k) && IN((k) + 1)) xcd_barrier(bar); STAMP((k) + 1); } while (0)
    const int bx = blockIdx.x;
    STAMP(0);

#ifdef REP_PHASE
#define REPS(k) ((k) == REP_PHASE ? 1 + REP_N : 1)
#else
#define REPS(k) 1
#endif
#ifndef REPV
#define REPV 0
#endif
    for (int rep_ = 0; rep_ < REPS(0); ++rep_) if (IN(0)) { if (rep_) xcd_barrier(bar); F.ws = launder(args.ws); F.tid = vlaunder(threadIdx.x); F.lane = F.tid & 63; p0_prologue(F, rep_ ? REPV : 0); }
    SEAM(0);

#pragma unroll 1
    for (int l = 0; l < 2; ++l) {
        const int P = 1 + 12 * l;
#define PH(k) for (int rep_ = 0; rep_ < REPS(k); ++rep_) if (IN(k)) if ((rep_ == 0 || (xcd_barrier(bar), true)) && (F.ws = ws = launder(args.ws)) != nullptr && ((F.tid = vlaunder(threadIdx.x)), (F.lane = F.tid & 63), true))
        PH(P + 0) {
            pg8::Gemm g{(const bf16*)(ws + WS_HN), (const bf16*)(ws + R_WIN) + (size_t)l * 4096 * D, D, S, 4096};
            pg8::StaticOrder so; so.init(S, 4096, F.G, bx);
            if (rep_ && REPV == 1) { EpiBiasBf16 E2{(bf16*)(ws + R_ACT), 4096, F.in(IN_FNG)}; pg8::gemm_phase(F.lds + RING_OFF, g, so, E2); }
            else {
            EpiInProj E{(bf16*)(ws + R_CONVU), (bf16*)(ws + R_Q), (bf16*)(ws + R_KV), (bf16*)(ws + R_U)};
            pg8::gemm_phase(F.lds + RING_OFF, g, so, E); }
        }
        SEAM(P + 0);
        PH(P + 1) {
            if (!rep_ || REPV == 0 || REPV == 5)
            { pg8::Gemm g{(const bf16*)(ws + R_U), (const bf16*)(ws + R_TW) + (size_t)l * NGRP * 512 * 256, 256, 32768, 16384};
              Ssm1Order so{F.G, bx}; EpiSsm1 E{(float*)(ws + R_YINTRA), (float*)(ws + R_SC)};
              pg8::gemm_phase(F.lds + RING_OFF, g, so, E); }
            if (!rep_ || REPV == 0 || REPV == 1)
            for (int c = bx; c < 256; c += F.G) compress_job(F, l, c);
            const float* pGB = F.in(IN_GB); const int* pPOS = (const int*)F.in(IN_POS); const float* pDWW = F.in(IN_DWW); const float* pDWB = F.in(IN_DWB); const float* pLNG = F.in(IN_LNG); const float* pLNB = F.in(IN_LNB);
            for (int j = F.gw; j < 2048 + 4096 + 1024 + (rep_ ? 0 : S); j += F.NGW) {
                int r = j;
                if (r < 2048) { if (!rep_ || REPV == 0 || REPV == 2) vt_job(F, r); continue; } r -= 2048;
                if (r < 4096) { if (!rep_ || REPV == 0 || REPV == 3) dwconv_job(F, pDWW, pDWB, pLNG, pLNB, l, r); continue; } r -= 4096;
                if (r < 1024) { if (!rep_ || REPV == 0 || REPV == 4) gates_job(F, pGB, l, r); continue; } r -= 1024;
                rope_job(F, pPOS, r);
            }
        }
        SEAM(P + 1);
        PH(P + 2) {
            if (!rep_ || REPV == 0 || REPV == 1)
            { pg8::Gemm g{(const bf16*)(ws + R_CONVACT), (const bf16*)(ws + R_CPW) + (size_t)l * 512 * 512, 512, S, 512};
              pg8::StaticOrder so; so.init(S, 512, F.G, bx); EpiBiasBf16 E{(bf16*)(ws + R_CONVO), DCONV, F.in(IN_PWB) + l * DCONV};
              pg8::gemm_phase(F.lds + RING_OFF, g, so, E); }
            const bool scan_wave = (F.NGW >= 64) && (F.wave == 0) && (bx < 32);
            if (scan_wave) { if (!rep_ || REPV == 0 || REPV == 2) scan_job(F, l, bx); }
            else if (F.NGW < 64) { if (F.gw == 0) for (int gg = 0; gg < 32; ++gg) scan_job(F, l, gg); }
            if (F.NGW == 2048) {
                if (F.gw < 1024) { const int i = F.gw >> 1, g = F.gw & 1;
                    if (!rep_ || REPV == 0 || REPV == 3) { cmp_stats_job(F, g, 1023 - i); cmp_stats_job(F, g, i); } }
                else { const int e = F.gw - 1024;
                    if (!rep_ || REPV == 0 || REPV == 4)
                    for (int pp = 0; pp < 2; ++pp) { const int p = 2 * e + pp, i = p >> 2, hp = p & 3; cmp_att_job2(F, 1023 - i, hp); cmp_att_job2(F, i, hp); } }
                if (!scan_wave) { const int nsw = bx < 32 ? bx + 1 : 32;
                    if (!rep_ || REPV == 0 || REPV == 5)
                    for (int r = F.gw - nsw; r < 8192; r += 2016) win_att_job8(F, r >> 3, r & 7); }
            } else {
                for (int j = F.gw; j < 2048 + 4096 + 8192; j += F.NGW) {
                    if (j < 2048) cmp_stats_job(F, j & 1, 1023 - (j >> 1));
                    else if (j < 6144) cmp_att_job2(F, 1023 - ((j - 2048) >> 2), (j - 2048) & 3);
                    else win_att_job8(F, (j - 6144) >> 3, (j - 6144) & 7);
                }
            }
        }
        SEAM(P + 2);
        PH(P + 3) {
            gu32* cnt2 = F.ctl + CW_SSM2 + l * 4 * 64;
            { pg8::Gemm g{(const bf16*)(ws + R_HPREV), (const bf16*)(ws + R_WO2) + (size_t)l * NGRP * 256 * 256, 256, 32768, 8192};
              Ssm2Order so{F.G, bx}; EpiSsm2 E{(const float*)(ws + R_YINTRA), (const bf16*)(ws + R_U), F.in(IN_SD) + l * DSSM, (bf16*)(ws + R_YSSM), (bf16*)(ws + R_GY)};
              pg8::gemm_phase(F.lds + RING_OFF, g, so, E);
              if (bx < 128) { VM_WAIT(); __syncthreads();
                  if (F.tid == 0) { __builtin_amdgcn_fence(__ATOMIC_RELEASE, "agent"); asm volatile("s_waitcnt vmcnt(0)" ::: "memory");
                      for (int L = bx; L < 128; L += F.G) __hip_atomic_fetch_add(cnt2 + 64 * (L & 3), 1u, RLX_AGENT); } } }
            if (F.G == 256) {
                const int x = bx & 7, g = x & 1, qbase = (x >> 1) * (S / 4), w = (bx >> 3) * NWAVES + F.wave;
                f32x4 iv = sel_imp_load(F, qbase + w, g);
                for (int i = 0; i < S / 4 / 256; ++i) { const int inx = (i + 1 < S / 4 / 256) ? i + 1 : i; const f32x4 ivn = sel_imp_load(F, qbase + inx * 256 + w, g);
                    sel_att_job(F, qbase + i * 256 + w, g, iv, rep_ ? REPV : 0); iv = ivn; }
            } else
            for (int j = F.gw; j < 2 * S; j += F.NGW) sel_att_job(F, S - 1 - (j >> 1), j & 1, sel_imp_load(F, S - 1 - (j >> 1), j & 1));
            for (int L2 = F.G - 1 - bx; L2 < 128; L2 += F.G) {
                const int pm = L2 >> 1, pn = L2 & 1;
                if (F.tid == 0) { unsigned sp = 0;
                    while (__hip_atomic_load(cnt2 + 64 * (pm >> 4), RLX_AGENT) < 32u) { __builtin_amdgcn_s_sleep(2);
                        if (++sp > (1u << 22)) { __hip_atomic_store(F.ctl + CW_SSM2 + 8 * 64, 1u, RLX_AGENT); break; } }
                    __builtin_amdgcn_fence(__ATOMIC_ACQUIRE, "agent"); asm volatile("s_waitcnt vmcnt(0)" ::: "memory"); }
                __syncthreads();
                pg8::Gemm g{(const bf16*)(ws + R_YSSM), (const bf16*)(ws + R_GLU) + (size_t)l * 512 * 512, 512, S, 512};
                OneUnit so{pm, pn}; EpiGlu E{(const bf16*)(ws + R_GY), F.in(IN_GLB) + l * DSSM, (bf16*)(ws + R_SSMO)};
                pg8::gemm_phase(F.lds + RING_OFF, g, so, E);
            }
        }
        SEAM(P + 3);
        PH(P + 5) { const float* pMOG = F.in(IN_MOG); for (int t = F.gw; t < S; t += F.NGW) mixnorm_job(F, pMOG, l, t); }
        SEAM(P + 5);
        PH(P + 6) {
            pg8::Gemm g{(const bf16*)(ws + R_MIXED), (const bf16*)(ws + R_WOUT) + (size_t)l * D * D, D, S, D};
            pg8::StaticOrder so; so.init(S, D, F.G, bx); EpiResid E{l == 0 ? (const void*)F.in(IN_X) : (const void*)(ws + WS_H), l != 0, (bf16*)(ws + WS_H), 1.f};
            pg8::gemm_phase(F.lds + RING_OFF, g, so, E);
        }
        SEAM(P + 6);
        PH(P + 7) { const float* gn = F.in(IN_NFG) + (size_t)l * D; const float* prw = F.in(IN_RW); for (int t = F.gw; t < S; t += F.NGW) norm_route_job(F, gn, prw, t, l == 1); }
        SEAM(P + 7);
        if (l == 0) {
            PH(P + 8) {
                pg8::Gemm g{(const bf16*)(ws + R_HN8), (const bf16*)(ws + R_FGU), D / 2, S, 2 * DFF};
                pg8::StaticOrder so; so.init(S, 2 * DFF, F.G, bx); EpiSwiglu8 E{(unsigned char*)(ws + R_ACT), S, 2 * DFF / 256};
                pg8::gemm_phase<EpiSwiglu8, pg8::StaticOrder, true, true, true, 0, true>(F.lds + RING_OFF, g, so, E);
            }
            SEAM(P + 8);
            PH(P + 9) {
                pg8::Gemm g{(const bf16*)(ws + R_ACT), (const bf16*)(ws + R_FD), DFF / 2, S, D};
                pg8::StaticOrder so; so.init(S, D, F.G, bx); EpiResid E{(const void*)(ws + WS_H), true, (bf16*)(ws + WS_H), 1.f / (MOE_WSCALE * MOE_ASCALE)};
                pg8::gemm_phase<EpiResid, pg8::StaticOrder, true, true, true, 0, true>(F.lds + RING_OFF, g, so, E);
            }
            SEAM(P + 9);
            PH(P + 10) { const float* gn = F.in(IN_NMG) + D; for (int t = F.gw; t < S; t += F.NGW) rms_row_to_bf16<true>((const bf16*)(ws + WS_H) + (size_t)t * D, gn, (unsigned char*)(ws + WS_HN), t, F.lane); }
            SEAM(P + 10);
            SEAM(P + 11);
        } else {
            PH(P + 8) { int pe[NE + 1]; moe_prefix(F, pe); for (int j = F.gw; j < 2 * S; j += F.NGW) moe_gather_job(F, pe, j); }
            SEAM(P + 8);
            PH(P + 9) {
                MoeOrder mo; moe_prefix(F, mo.pe); mo.nct = 2 * DFFE / 256; mo.so.init(mo.pe[NE] * 256, 2 * DFFE, F.G, bx);
                pg8::Gemm g{(const bf16*)(ws + M_ASORT), (const bf16*)(ws + WS_MOE_GU), D / 2, NPAD, NE * 2 * DFFE};
                EpiSwiglu8 E{(unsigned char*)(ws + M_ACTS), NPAD, 2 * DFFE / 256};
#if defined(REP_PHASE) && REPV == 1
                if (rep_) { EpiSwiglu8 E2{(unsigned char*)(ws + M_ACTS + 238 * MiB), NPAD, 2 * DFFE / 256}; pg8::gemm_phase<EpiSwiglu8, MoeOrder, true, true, true, 1>(F.lds + RING_OFF, g, mo, E2); } else
#elif defined(REP_PHASE) && REPV == 2
                if (rep_) { EpiSwiglu8 E2{(unsigned char*)(ws + M_ACTS + 238 * MiB), NPAD, 2 * DFFE / 256}; pg8::gemm_phase<EpiSwiglu8, MoeOrder, true, true, true, 2>(F.lds + RING_OFF, g, mo, E2); } else
#endif
                pg8::gemm_phase<EpiSwiglu8, MoeOrder, true, true, true>(F.lds + RING_OFF, g, mo, E);
            }
            SEAM(P + 9);
            PH(P + 10) {
                MoeOrder mo; moe_prefix(F, mo.pe); mo.nct = D / 256; mo.so.init(mo.pe[NE] * 256, D, F.G, bx);
                const int units = mo.pe[NE] * (D / 256), full = (F.G == 256) ? units / 256 : (1 << 30), T = (F.G == 256) ? units - full * 256 : 0;
                mo.imax = full;
                pg8::Gemm g{(const bf16*)(ws + M_ACTS), (const bf16*)(ws + WS_MOE_D), DFFE / 2, NPAD, NE * D};
                const float oscale = 1.f / (MOE_WSCALE * MOE_ASCALE);
                EpiMoeDown E{(bf16*)(ws + M_YS), (const float*)(ws + WS_TOK + TOK_RW), oscale};
                pg8::gemm_phase<EpiMoeDown, MoeOrder, true, true, true>(F.lds + RING_OFF, g, mo, E);
                if (T > 0) {
                    const int ns = (T <= 36) ? 7 : 4, kt = (DFFE / 128) / ns;
                    if (bx < T * ns) {
                        const int u = bx / ns, sl = bx - u * ns;
                        Unit uu; mo.at((long)full * 256 + u, uu);
                        float* part = (float*)(ws + M_ASORT) + (size_t)(u * ns) * 65536;
                        pg8::Gemm gs{(const bf16*)((const unsigned char*)(ws + M_ACTS) + (size_t)sl * kt * NPAD * 128), (const bf16*)((const unsigned char*)(ws + WS_MOE_D) + (size_t)sl * kt * (NE * D) * 128), kt * 64, NPAD, NE * D};
                        OneUnit ou{uu.pm, uu.pn}; EpiMoePart EP{part + (size_t)sl * 65536};
                        pg8::gemm_phase<EpiMoePart, OneUnit, true, true, true>(F.lds + RING_OFF, gs, ou, EP);
                        VM_WAIT(); __syncthreads();
                        if (F.tid == 0) { __builtin_amdgcn_fence(__ATOMIC_RELEASE, "agent"); asm volatile("s_waitcnt vmcnt(0)" ::: "memory");
                            __hip_atomic_fetch_add(F.ctl + CW_TAIL + 64 * u, 1u, RLX_AGENT);
                            unsigned sp = 0;
                            while (__hip_atomic_load(F.ctl + CW_TAIL + 64 * u, RLX_AGENT) < (unsigned)ns) { __builtin_amdgcn_s_sleep(2);
                                if (++sp > (1u << 22)) { __hip_atomic_store(F.ctl + CW_SSM2 + 8 * 64, 1u, RLX_AGENT); break; } }
                            __builtin_amdgcn_fence(__ATOMIC_ACQUIRE, "agent"); asm volatile("s_waitcnt vmcnt(0)" ::: "memory"); }
                        __syncthreads();
                        {
                            const float* rwp = (const float*)(ws + WS_TOK + TOK_RW); bf16* O = (bf16*)(ws + M_YS);
                            const int per = (256 * 32 + ns - 1) / ns, i0 = sl * per, i1 = (i0 + per < 256 * 32) ? i0 + per : 256 * 32;
                            for (int it = i0 + F.tid; it < i1; it += NTHR) {
                                const int row = it >> 5, c8 = (it & 31) * 8; const float* p = part + (size_t)row * 256 + c8;
                                f32x4 va[7], vb[7];
#pragma unroll
                                for (int k = 0; k < 7; ++k) { const float* pk = p + (size_t)(k < ns ? k : 0) * 65536; va[k] = *(const f32x4*)pk; vb[k] = *(const f32x4*)(pk + 4); }
                                f32x4 a = va[0], b = vb[0];
#pragma unroll
                                for (int k = 1; k < 7; ++k) if (k < ns) { a = a + va[k]; b = b + vb[k]; }
                                const int grow = uu.pm * 256 + row; const float sc = rwp[grow] * oscale;
                                v4u w; w.x = pg8::cvt_pk_bf16(a[0] * sc, a[1] * sc); w.y = pg8::cvt_pk_bf16(a[2] * sc, a[3] * sc); w.z = pg8::cvt_pk_bf16(b[0] * sc, b[1] * sc); w.w = pg8::cvt_pk_bf16(b[2] * sc, b[3] * sc);
                                *(v4u*)(O + (size_t)grow * D + (uu.pn & 7) * 256 + c8) = w;
                            }
                        }
                    }
                }
            }
            SEAM(P + 10);
            PH(P + 11) { const float* pFNG = F.in(IN_FNG); for (int t = F.gw; t < S; t += F.NGW) moe_combine_job(F, args.out, pFNG, t); }
        }
    }
#ifdef PROBE_K
    xcd_barrier(bar); STAMP(25);
    xcd_barrier(bar);
    { const unsigned long long* T = (const unsigned long long*)(args.ws + WS_CTL) + CW_DBG / 2;
      const float d1 = (float)(T[PROBE_K + 1] - T[PROBE_K]) * 0.01f, d2 = (float)(T[PROBE_K + 2] - T[PROBE_K + 1]) * 0.01f;
      const float c1 = sqrtf(d1), c2 = 10.f * d2;
      for (size_t i = (size_t)blockIdx.x * NTHR + threadIdx.x; i < (size_t)S * D; i += (size_t)gridDim.x * NTHR) args.out[i] = (i == 0) ? c2 : c1; }
#endif
#undef IN
#undef PH
#undef REPS
#undef SEAM
}

extern "C" void kernel_launch(void* const* d_in, const int* in_sizes, int n_in, void* d_out, int out_size, void* d_ws, size_t ws_size, hipStream_t stream) {
    static int grid = 0;
    if (grid == 0) {
        if (n_in != 38 || out_size != S * D || ws_size < WS_END) { fprintf(stderr, "kernel_launch: unexpected problem shape (n_in %d, out %d, ws %zu < %zu)\n", n_in, out_size, ws_size, (size_t)WS_END); grid = -1; return; }
        int dev = 0, cus = 0, per_cu = 0;
        if (hipGetDevice(&dev) != hipSuccess || hipDeviceGetAttribute(&cus, hipDeviceAttributeMultiprocessorCount, dev) != hipSuccess) { grid = -1; return; }
        if (hipFuncSetAttribute((const void*)fwd_kernel, hipFuncAttributeMaxDynamicSharedMemorySize, LDS_BYTES) != hipSuccess) { fprintf(stderr, "kernel_launch: hipFuncSetAttribute failed\n"); grid = -1; return; }
        if (hipOccupancyMaxActiveBlocksPerMultiprocessor(&per_cu, (const void*)fwd_kernel, NTHR, LDS_BYTES) != hipSuccess || per_cu < 1)
            fprintf(stderr, "kernel_launch: note: occupancy query says %d\n", per_cu);
        (void)hipGetLastError();
        grid = cus;
    }
    if (grid < 0) return;
    if (hipMemsetAsync((char*)d_ws + WS_CTL, 0, CTL_ZERO_BYTES, stream) != hipSuccess) return;
    Args a{};
    for (int i = 0; i < 38; ++i) a.in[i] = (const float*)d_in[i];
    a.out = (float*)d_out; a.ws = (unsigned char*)d_ws; a.dbg = 0;
    constexpr int NL = MK_N_LAUNCHES;
    for (int li = 0; li < NL; ++li) {
        a.ph_lo = (NL == 1) ? 0 : li; a.ph_hi = (NL == 1) ? N_PHASES : li + 1; a.li = li;
        hipLaunchKernelGGL(fwd_kernel, dim3(grid), dim3(NTHR), LDS_BYTES, stream, a);
        const hipError_t le = hipPeekAtLastError();
        if (le != hipSuccess) { fprintf(stderr, "kernel_launch: launch %d failed: %s\n", li, hipGetErrorName(le)); break; }
    }
}
```

```cpp
#include <hip/hip_runtime.h>
#include <cstdio>
#include <cstdint>

namespace pg8 {
#define PG8_LAS __attribute__((address_space(3)))
typedef unsigned short bf16_t;
typedef short bf16x8 __attribute__((ext_vector_type(8)));
typedef float f32x4 __attribute__((ext_vector_type(4)));
typedef unsigned u32x4 __attribute__((ext_vector_type(4)));
typedef unsigned u32x2 __attribute__((ext_vector_type(2)));
constexpr int BM = 256, BK = 64, HALF = 128, HTB = HALF * BK * 2, STAGE_BYTES = 8 * HTB, NXCD = 8, WGM = 8;

__host__ __device__ __forceinline__ int lds_byte(int r, int c) { const int st = (r >> 4) * 2 + (c >> 5), rr = r & 15, cc = c & 31, ob = rr * 64 + cc * 2; return st * 1024 + (ob ^ (((ob >> 9) & 1) << 5)); }
__host__ __device__ __forceinline__ void stage_rc(int b, int& R, int& C) { const int st = b / 1024, sb = b % 1024, swz = sb ^ (((sb >> 9) & 1) << 5); R = (st >> 1) * 16 + swz / 64; C = (st & 1) * 32 + (swz % 64) / 2; }
__host__ __device__ __forceinline__ int g_swz(int r) { const int x = (r >> 1) & 7; return (((0x1320 >> (4 * (x >> 1))) & 3) << 1) | (x & 1); }
__host__ __device__ __forceinline__ int lds_off(int r, int c) { return (r >> 3) * 1024 + (r & 7) * 128 + ((c ^ g_swz(r & 15)) << 4); }
__host__ __device__ __forceinline__ void stage_rc2(int p16, int& R, int& CH) { const int s = p16 >> 6, L = p16 & 63; R = s * 8 + (L >> 3); CH = (L & 7) ^ g_swz(R & 15); }
__host__ __device__ __forceinline__ int perm32(int rho) { const int n = rho >> 4, i = rho & 15; return 8 * (i >> 2) + 4 * n + (i & 3); }

struct Unit { int pm, pn; };
struct Gemm { const bf16_t* A; const bf16_t* Bt; int K, nra, nrb; };

struct StaticOrder {
    int nM, nN, nwg, G, c;
    __host__ __device__ void init(int M, int N, int G_, int c_) { nM = M / BM; nN = N / BM; nwg = nM * nN; G = G_; c = c_; }
    __host__ __device__ bool next(int i, Unit& u) const { return at((long)i * G + c, u); }
    __host__ __device__ bool at(const long L, Unit& u) const {
        if (L >= nwg) return false;
        int wgid = (int)L; { const int q = nwg / NXCD, r = nwg % NXCD, xcd = wgid % NXCD, off = wgid / NXCD; wgid = (xcd < r ? xcd * (q + 1) : r * (q + 1) + (xcd - r) * q) + off; }
        const int nig = WGM * nN, gid = wgid / nig, fm = gid * WGM, gsz = (nM - fm) < WGM ? (nM - fm) : WGM;
        u.pm = fm + ((wgid % nig) % gsz); u.pn = (wgid % nig) / gsz; return true;
    }
};

__device__ __forceinline__ unsigned cvt_pk_bf16_asm(float lo, float hi) { unsigned r; asm volatile("v_cvt_pk_bf16_f32 %0, %1, %2" : "=v"(r) : "v"(lo), "v"(hi)); return r; }
typedef float f32x2_t __attribute__((ext_vector_type(2)));
typedef __bf16 hwbf16x2_t __attribute__((ext_vector_type(2)));
__device__ __forceinline__ unsigned cvt_pk_bf16(float lo, float hi) { const f32x2_t v = {lo, hi}; return __builtin_bit_cast(unsigned, __builtin_convertvector(v, hwbf16x2_t)); }

typedef int v8i_t __attribute__((ext_vector_type(8)));
typedef int v4i_t __attribute__((ext_vector_type(4)));
__device__ __forceinline__ v8i_t cat8(bf16x8 lo, bf16x8 hi) { const v4i_t a = __builtin_bit_cast(v4i_t, lo), b = __builtin_bit_cast(v4i_t, hi); return __builtin_shufflevector(a, b, 0, 1, 2, 3, 4, 5, 6, 7); }
template <class Epi, class Sched, bool ALIGN_EPI = true, bool SP2 = true, bool FP8 = false, int PROBE = 0, bool RECOMP = false>
__device__ __forceinline__ void gemm_phase(PG8_LAS unsigned char* lds, const Gemm g, const Sched& S, const Epi& E) {
    int tid_ = threadIdx.x; asm volatile("" : "+v"(tid_));
    const int tid = tid_, wid = __builtin_amdgcn_readfirstlane(tid >> 6), lane = tid & 63, wr = wid >> 2, wc = wid & 3, fr = lane & 15, fq = lane >> 4;
    const int K = g.K, nt = K / BK;
    unsigned voffA[2], voffB[2];
#pragma unroll
    for (int i = 0; i < 2; ++i) { int R, CH; stage_rc2(tid + i * 512, R, CH); const int Rb = Epi::PERM ? ((R & ~31) + perm32(R & 31)) : R;
        voffA[i] = (unsigned)(R * 128 + CH * 16); voffB[i] = (unsigned)(Rb * 128 + CH * 16); }
    const unsigned kstepA = (unsigned)g.nra * 128u, kstepB = (unsigned)g.nrb * 128u;
    const unsigned hstepA = HALF * 128u, hstepB = HALF * 128u;
    const unsigned tstepA = 2 * hstepA, tstepB = 2 * hstepB;
    const unsigned ldsw = (unsigned)wid * 1024u;
    const int aoffk0 = lds_off(wr * 64 + fr, FP8 ? 2 * fq : fq), aoffk1 = FP8 ? (aoffk0 ^ 16) : lds_off(wr * 64 + fr, fq + 4);
    const int boffk0 = lds_off(wc * 32 + fr, FP8 ? 2 * fq : fq), boffk1 = FP8 ? (boffk0 ^ 16) : lds_off(wc * 32 + fr, fq + 4);
#define PG8_SA(b, h) (((b) * 2 + (h)) * HTB)
#define PG8_SB(b, h) ((4 + (b) * 2 + (h)) * HTB)
#define PG8_STAGE(bufoff, goff, voff) do { const bool isB_ = (&(voff)[0] == &voffB[0]); \
        if constexpr (RECOMP) { int t2_ = tid; asm volatile("" : "+v"(t2_));     \
            _Pragma("unroll") for (int _i = 0; _i < 2; ++_i) { int R_, C_; stage_rc2(t2_ + _i * 512, R_, C_); const int Rr_ = (isB_ && Epi::PERM) ? ((R_ & ~31) + perm32(R_ & 31)) : R_; \
                __builtin_amdgcn_raw_ptr_buffer_load_lds(isB_ ? rsrcB : rsrcA, (PG8_LAS void*)(lds + (bufoff) + ldsw + _i * 8192), 16, Rr_ * 128 + C_ * 16, (int)(goff), 0, 0); } } \
        else { _Pragma("unroll") for (int _i = 0; _i < 2; ++_i) \
        __builtin_amdgcn_raw_ptr_buffer_load_lds(isB_ ? rsrcB : rsrcA, (PG8_LAS void*)(lds + (bufoff) + ldsw + _i * 8192), 16, (int)(voff)[_i], (int)(goff), 0, 0); } } while (0)
#define PG8_LDA(dst, b, h) do { if constexpr (PROBE == 2) break; _Pragma("unroll") for (int m = 0; m < 4; ++m) { if constexpr (FP8) dst##8[m] = cat8(*(const PG8_LAS bf16x8*)(lds + PG8_SA(b, h) + aoffk0 + m * 2048), *(const PG8_LAS bf16x8*)(lds + PG8_SA(b, h) + aoffk1 + m * 2048)); \
        else { dst[m][0] = *(const PG8_LAS bf16x8*)(lds + PG8_SA(b, h) + aoffk0 + m * 2048); dst[m][1] = *(const PG8_LAS bf16x8*)(lds + PG8_SA(b, h) + aoffk1 + m * 2048); } } } while (0)
#define PG8_LDB(dst, b, h) do { if constexpr (PROBE == 2) break; _Pragma("unroll") for (int n = 0; n < 2; ++n) { if constexpr (FP8) dst##8[n] = cat8(*(const PG8_LAS bf16x8*)(lds + PG8_SB(b, h) + boffk0 + n * 2048), *(const PG8_LAS bf16x8*)(lds + PG8_SB(b, h) + boffk1 + n * 2048)); \
        else { dst[n][0] = *(const PG8_LAS bf16x8*)(lds + PG8_SB(b, h) + boffk0 + n * 2048); dst[n][1] = *(const PG8_LAS bf16x8*)(lds + PG8_SB(b, h) + boffk1 + n * 2048); } } } while (0)
#define PG8_MMA(ai, bj, At, Bt) do { if constexpr (PROBE == 1) { _Pragma("unroll") for (int m = 0; m < 4; ++m) asm volatile("" :: "v"(At##8[m])); _Pragma("unroll") for (int n = 0; n < 2; ++n) asm volatile("" :: "v"(Bt##8[n])); break; } __builtin_amdgcn_s_setprio(1); _Pragma("unroll") for (int m = 0; m < 4; ++m) _Pragma("unroll") for (int n = 0; n < 2; ++n) { \
        if constexpr (FP8) acc[ai][bj][m][n] = __builtin_amdgcn_mfma_scale_f32_16x16x128_f8f6f4(Bt##8[n], At##8[m], acc[ai][bj][m][n], 0, 0, 0, 0x7F7F7F7F, 0, 0x7F7F7F7F); \
        else { _Pragma("unroll") for (int k = 0; k < 2; ++k) acc[ai][bj][m][n] = __builtin_amdgcn_mfma_f32_16x16x32_bf16(Bt[n][k], At[m][k], acc[ai][bj][m][n], 0, 0, 0); } } __builtin_amdgcn_s_setprio(0); } while (0)
#define PG8_WAIT_V(n) asm volatile("s_waitcnt vmcnt(" #n ")" ::: "memory")
#define PG8_WAIT_L(n) asm volatile("s_waitcnt lgkmcnt(" #n ")" ::: "memory")
#define PG8_BAR __builtin_amdgcn_s_barrier()
#define PG8_SCHED __builtin_amdgcn_sched_barrier(0)
    Unit cur, nxt; int ui = 0;
    if (!S.next(0, cur)) return;
    f32x4 acc[2][2][4][2];
#pragma unroll
    for (int a = 0; a < 2; ++a)
#pragma unroll
        for (int b = 0; b < 2; ++b)
#pragma unroll
            for (int m = 0; m < 4; ++m)
#pragma unroll
                for (int n = 0; n < 2; ++n) acc[a][b][m][n] = (f32x4){0.f, 0.f, 0.f, 0.f};
    bf16x8 At[4][2], B0[2][2], B1[2][2]; v8i_t At8[4], B08[2], B18[2];
    if constexpr (PROBE == 2) { _Pragma("unroll") for (int m = 0; m < 4; ++m) { At8[m] = (v8i_t){0x3a3b3c3d + tid, 0x38393a3b, 0x3c3d3e3f, 0x40414243, 0x34353637, 0x3b3c3d3e, 0x39383736, 0x3d3c3b3a}; asm volatile("" : "+v"(At8[m])); }
        _Pragma("unroll") for (int n = 0; n < 2; ++n) { B08[n] = At8[n]; B18[n] = At8[n + 2]; asm volatile("" : "+v"(B08[n]), "+v"(B18[n])); } }
    const __amdgpu_buffer_rsrc_t rsrcA = __builtin_amdgcn_make_buffer_rsrc((void*)g.A, 0, 0x7ffff000, 0x00020000), rsrcB = __builtin_amdgcn_make_buffer_rsrc((void*)g.Bt, 0, 0x7ffff000, 0x00020000);
    unsigned cA = (unsigned)cur.pm * (unsigned)tstepA, cB = (unsigned)cur.pn * (unsigned)tstepB;
    if constexpr (SP2) {
        PG8_STAGE(PG8_SB(0, 0), cB, voffB); PG8_STAGE(PG8_SB(0, 1), cB + hstepB, voffB); PG8_STAGE(PG8_SA(0, 0), cA, voffA); PG8_STAGE(PG8_SA(0, 1), cA + hstepA, voffA);
        if (wr == 1) PG8_BAR;
        PG8_WAIT_V(2); PG8_BAR;
        PG8_STAGE(PG8_SB(1, 0), cB + kstepB, voffB); PG8_STAGE(PG8_SA(1, 0), cA + kstepA, voffA); PG8_STAGE(PG8_SB(1, 1), cB + hstepB + kstepB, voffB);
        PG8_WAIT_V(6); PG8_BAR;
    } else {
        PG8_STAGE(PG8_SB(0, 0), cB, voffB); PG8_STAGE(PG8_SA(0, 0), cA, voffA); PG8_STAGE(PG8_SB(0, 1), cB + hstepB, voffB); PG8_STAGE(PG8_SA(0, 1), cA + hstepA, voffA);
        if (wr == 1) PG8_BAR;
        PG8_WAIT_V(4); PG8_BAR;
        PG8_STAGE(PG8_SB(1, 0), cB + kstepB, voffB); PG8_STAGE(PG8_SA(1, 0), cA + kstepA, voffA); PG8_STAGE(PG8_SB(1, 1), cB + hstepB + kstepB, voffB);
        PG8_WAIT_V(6); PG8_BAR;
    }
    for (;;) {
        const bool has_next = S.next(ui + 1, nxt);
        const unsigned nA = has_next ? (unsigned)nxt.pm * (unsigned)tstepA : cA, nB = has_next ? (unsigned)nxt.pn * (unsigned)tstepB : cB;
#pragma unroll 1
        for (int t = 0; t < nt; t += 2) {
            const bool last = (t == nt - 2);
            const unsigned a1 = cA + (unsigned)(t + 1) * kstepA;
            const unsigned a2 = last ? nA : cA + (unsigned)(t + 2) * kstepA, b2 = last ? nB : cB + (unsigned)(t + 2) * kstepB;
            const unsigned a3 = a2 + kstepA, b3 = b2 + kstepB;
            if constexpr (SP2) {
            PG8_LDB(B0, 0, 0); PG8_LDB(B1, 0, 1); PG8_SCHED; PG8_LDA(At, 0, 0); PG8_STAGE(PG8_SA(1, 1), a1 + hstepA, voffA);
            PG8_WAIT_V(8); PG8_WAIT_L(0); PG8_BAR; PG8_MMA(0, 0, At, B0); PG8_MMA(0, 1, At, B1); PG8_BAR; PG8_SCHED;
            PG8_LDA(At, 0, 1); PG8_STAGE(PG8_SB(0, 0), b2, voffB); PG8_STAGE(PG8_SB(0, 1), b2 + hstepB, voffB); PG8_STAGE(PG8_SA(0, 0), a2, voffA);
            PG8_WAIT_V(8); PG8_WAIT_L(0); PG8_BAR; PG8_MMA(1, 0, At, B0); PG8_MMA(1, 1, At, B1); PG8_BAR; PG8_SCHED;
            PG8_LDB(B0, 1, 0); PG8_LDB(B1, 1, 1); PG8_SCHED; PG8_LDA(At, 1, 0); PG8_STAGE(PG8_SA(0, 1), a2 + hstepA, voffA);
            PG8_WAIT_V(8); PG8_WAIT_L(0); PG8_BAR; PG8_MMA(0, 0, At, B0); PG8_MMA(0, 1, At, B1); PG8_BAR; PG8_SCHED;
            PG8_LDA(At, 1, 1); PG8_STAGE(PG8_SB(1, 0), b3, voffB); PG8_STAGE(PG8_SB(1, 1), b3 + hstepB, voffB); PG8_STAGE(PG8_SA(1, 0), a3, voffA);
            PG8_WAIT_V(8); PG8_WAIT_L(0); PG8_BAR; PG8_MMA(1, 0, At, B0); PG8_MMA(1, 1, At, B1); PG8_BAR; PG8_SCHED;
            } else {
            PG8_LDB(B0, 0, 0); PG8_SCHED; PG8_LDA(At, 0, 0); PG8_STAGE(PG8_SA(1, 1), a1 + hstepA, voffA);
            PG8_WAIT_L(8); PG8_BAR; PG8_WAIT_L(0); PG8_MMA(0, 0, At, B0); PG8_BAR; PG8_SCHED;
            PG8_LDB(B1, 0, 1); PG8_STAGE(PG8_SB(0, 0), b2, voffB);
            PG8_BAR; PG8_WAIT_L(0); PG8_MMA(0, 1, At, B1); PG8_BAR;
            PG8_LDA(At, 0, 1); PG8_STAGE(PG8_SA(0, 0), a2, voffA);
            PG8_BAR; PG8_WAIT_L(0); PG8_MMA(1, 0, At, B0); PG8_BAR; PG8_SCHED;
            PG8_STAGE(PG8_SB(0, 1), b2 + hstepB, voffB);
            PG8_WAIT_V(6); PG8_BAR; PG8_MMA(1, 1, At, B1); PG8_BAR;
            PG8_LDB(B0, 1, 0); PG8_SCHED; PG8_LDA(At, 1, 0); PG8_STAGE(PG8_SA(0, 1), a2 + hstepA, voffA);
            PG8_WAIT_L(8); PG8_BAR; PG8_WAIT_L(0); PG8_MMA(0, 0, At, B0); PG8_BAR; PG8_SCHED;
            PG8_LDB(B1, 1, 1); PG8_STAGE(PG8_SB(1, 0), b3, voffB);
            PG8_BAR; PG8_WAIT_L(0); PG8_MMA(0, 1, At, B1); PG8_BAR;
            PG8_LDA(At, 1, 1); PG8_STAGE(PG8_SA(1, 0), a3, voffA);
            PG8_BAR; PG8_WAIT_L(0); PG8_MMA(1, 0, At, B0); PG8_BAR; PG8_SCHED;
            PG8_STAGE(PG8_SB(1, 1), b3 + hstepB, voffB);
            PG8_WAIT_V(6); PG8_BAR; PG8_MMA(1, 1, At, B1); PG8_BAR;
            }
        }
        if constexpr (ALIGN_EPI) { if (wr == 0) PG8_BAR; }
        E(acc, cur, wr, wc, fr, fq);
        if (!has_next) break;
#pragma unroll
        for (int a = 0; a < 2; ++a)
#pragma unroll
            for (int b = 0; b < 2; ++b)
#pragma unroll
                for (int m = 0; m < 4; ++m)
#pragma unroll
                    for (int n = 0; n < 2; ++n) acc[a][b][m][n] = (f32x4){0.f, 0.f, 0.f, 0.f};
        cur = nxt; cA = nA; cB = nB; ++ui;
        if constexpr (ALIGN_EPI) { if (wr == 1) PG8_BAR; }
    }
    PG8_WAIT_V(0);
    if constexpr (!ALIGN_EPI) { if (wr == 0) PG8_BAR; }
    PG8_BAR;
#undef PG8_SA
#undef PG8_SB
#undef PG8_STAGE
#undef PG8_LDA
#undef PG8_LDB
#undef PG8_MMA
#undef PG8_WAIT_V
#undef PG8_WAIT_L
#undef PG8_BAR
#undef PG8_SCHED
}
}

constexpr int S = 16384, D = 2048, DIN = 4120, DCONV = 512, DATT = 1024, DSSM = 512;
constexpr int NH = 8, NKV = 2, HD = 128, NCMP = 1023, NSB = 256, CONVW = 31;
constexpr int DFF = 5632, NE = 8, DFFE = 7168, NGRP = 32, PST = 64;
constexpr int NPAD = 2 * S + NE * 256;
constexpr float EPS = 1e-5f;
constexpr int NWAVES = 8, NTHR = 512;

constexpr size_t MiB = 1u << 20;
constexpr size_t WS_CTL = 0, CTL_ZERO_BYTES = 1 * MiB;
constexpr size_t WS_H = 1 * MiB;
constexpr size_t WS_HN = WS_H + 128 * MiB;
constexpr size_t WS_MOE_GU = WS_HN + 64 * MiB;
constexpr size_t WS_MOE_D = WS_MOE_GU + 448 * MiB;
constexpr size_t WS_TOK = WS_MOE_D + 224 * MiB;
constexpr size_t WS_R = WS_TOK + 1 * MiB;
constexpr size_t R_WIN = WS_R;
constexpr size_t R_WOUT = R_WIN + 32 * MiB;
constexpr size_t R_WG = R_WOUT + 16 * MiB;
constexpr size_t R_CPW = R_WG + 1 * MiB;
constexpr size_t R_GLU = R_CPW + 1 * MiB;
constexpr size_t R_W1K = R_GLU + 1 * MiB;
constexpr size_t R_W1V = R_W1K + 2 * MiB;
constexpr size_t R_W2 = R_W1V + 2 * MiB;
constexpr size_t R_CB = R_W2 + 1 * MiB;
constexpr size_t R_TW = R_CB + 1 * MiB;
constexpr size_t R_WO2 = R_TW + 16 * MiB;
constexpr size_t R_FGU = R_WO2 + 8 * MiB;
constexpr size_t R_FD = R_FGU + 44 * MiB;
constexpr size_t R_CONVU = R_FD + 22 * MiB;
constexpr size_t R_Q = R_CONVU + 16 * MiB;
constexpr size_t R_QR = R_Q + 32 * MiB;
constexpr size_t R_KV = R_QR + 32 * MiB;
constexpr size_t R_VST = R_KV + 48 * MiB;
constexpr size_t R_VWT = R_VST + 8 * MiB;
constexpr size_t R_KC = R_VWT + 8 * MiB;
constexpr size_t R_VCT = R_KC + 1 * MiB;
constexpr size_t R_U = R_VCT + 1 * MiB;
constexpr size_t R_GATES = R_U + 16 * MiB;
constexpr size_t R_CONVACT = R_GATES + 2 * MiB;
constexpr size_t R_IMP = R_CONVACT + 16 * MiB;
constexpr size_t R_OC = R_IMP + 32 * MiB;
constexpr size_t R_OW = R_OC + 32 * MiB;
constexpr size_t R_OS = R_OW + 32 * MiB;
constexpr size_t R_CONVO = R_OS + 32 * MiB;
constexpr size_t R_SSMO = R_CONVO + 16 * MiB;
constexpr size_t R_YINTRA = R_SSMO + 16 * MiB;
constexpr size_t R_SC = R_YINTRA + 32 * MiB;
constexpr size_t R_HPREV = R_SC + 16 * MiB;
constexpr size_t R_YSSM = R_HPREV + 16 * MiB;
constexpr size_t R_GY = R_YSSM + 16 * MiB;
constexpr size_t R_MIXED = R_GY + 16 * MiB;
constexpr size_t R_ACT = R_MIXED + 64 * MiB;
constexpr size_t R_KSF = R_ACT + 176 * MiB;
constexpr size_t R_KWF = R_KSF + 8 * MiB;
constexpr size_t R_KS8 = R_KWF + 8 * MiB;
constexpr size_t R_VS8 = R_KS8 + 4 * MiB;
constexpr size_t R_HN8 = R_VS8 + 4 * MiB;
constexpr size_t R_END = R_HN8 + 32 * MiB;
constexpr size_t R_IMP2 = R_ACT;
constexpr size_t R_KW8 = R_KSF;
constexpr size_t R_VW8 = R_VST;
constexpr size_t M_ASORT = WS_R;
constexpr size_t M_ACTS = M_ASORT + 136 * MiB;
constexpr size_t M_YS = M_ACTS + 476 * MiB;
constexpr size_t M_END = M_YS + 136 * MiB;
constexpr size_t WS_END = R_END > M_END ? R_END : M_END;
static_assert((size_t)NPAD * D * 2 <= 136 * MiB && (size_t)NPAD * DFFE * 2 <= 476 * MiB, "moe buffers");
static_assert(WS_END <= 1792 * MiB, "workspace map must fit 4x the largest input tensor");
constexpr size_t TOK_E = 0;
constexpr size_t TOK_W = 128 * 1024;
constexpr size_t TOK_SLOT = 256 * 1024;
constexpr size_t TOK_POS = 384 * 1024;
constexpr size_t TOK_RW = 512 * 1024;
constexpr int CW_BAR = 4096;
constexpr int CW_ECNT = 131072;
constexpr int CW_DBG = 140000;
constexpr int CW_JOBQ = 137216;
constexpr int CW_TAIL = 133120;
constexpr int CW_SSM2 = 132096;

constexpr int RING_OFF = 0, RING_BYTES = 131072;
constexpr int LDSCTL_OFF = RING_BYTES, MISC_OFF = LDSCTL_OFF + 320;
constexpr int LDS_BYTES = 147456;

#define GAS __attribute__((address_space(1)))
#define LAS __attribute__((address_space(3)))
#define DEVI __device__ __forceinline__
typedef unsigned short bf16;
typedef unsigned v4u __attribute__((ext_vector_type(4)));
typedef unsigned v2u __attribute__((ext_vector_type(2)));
typedef float f32x4 __attribute__((ext_vector_type(4)));
typedef float f32x2 __attribute__((ext_vector_type(2)));
typedef short bf16x8 __attribute__((ext_vector_type(8)));
typedef short bf16x4 __attribute__((ext_vector_type(4)));
typedef GAS unsigned gu32;
#define RLX_AGENT __ATOMIC_RELAXED, __HIP_MEMORY_SCOPE_AGENT
#define LDS_WAIT() asm volatile("s_waitcnt lgkmcnt(0)" ::: "memory")
#define VM_WAIT() asm volatile("s_waitcnt vmcnt(0)" ::: "memory")
DEVI unsigned f2bf(float f) { unsigned u = __builtin_bit_cast(unsigned, f); return (u + 0x7fffu + ((u >> 16) & 1u)) >> 16; }
typedef __bf16 hwbf16x2 __attribute__((ext_vector_type(2)));
DEVI unsigned pk2(float lo, float hi) { const f32x2 v = {lo, hi}; return __builtin_bit_cast(unsigned, __builtin_convertvector(v, hwbf16x2)); }
DEVI float bf2f(unsigned b) { return __builtin_bit_cast(float, b << 16); }
DEVI float bflo(unsigned w) { return __builtin_bit_cast(float, w << 16); }
DEVI float bfhi(unsigned w) { return __builtin_bit_cast(float, w & 0xffff0000u); }
DEVI float sigmoidf_(float x) { return __builtin_amdgcn_rcpf(1.f + __expf(-x)); }
DEVI float siluf_(float x) { return x * __builtin_amdgcn_rcpf(1.f + __expf(-x)); }
DEVI float clamp448(float x) { return fminf(fmaxf(x, -448.f), 448.f); }
DEVI unsigned pk4_fp8(float a, float b, float c, float d) { int w = 0; w = __builtin_amdgcn_cvt_pk_fp8_f32(a, b, w, false); w = __builtin_amdgcn_cvt_pk_fp8_f32(c, d, w, true); return (unsigned)w; }
DEVI size_t tix(size_t NR, size_t row, unsigned kbyte) { return ((size_t)(kbyte >> 7) * NR + row) * 128 + (kbyte & 127u); }
DEVI float wave_sum(float v) {
#pragma unroll
    for (int o = 1; o < 64; o <<= 1) v += __shfl_xor(v, o);
    return v;
}

#define XB_TMO      128
#define XB_XCNT(j)  (256  + 64 * (j))
#define XB_XSUB(j)  (1280 + 64 * (j))
#define XB_XGEN(j)  (2304 + 64 * (j))
#define XB_TOP      3328
#define XB_TOPGEN   3392
#define XCD_BAR_WORDS 3456
#define XB_SPIN_CAP (1u << 20)

__device__ __forceinline__ unsigned xb_ld(unsigned* p)              { return __hip_atomic_load(p, __ATOMIC_RELAXED, __HIP_MEMORY_SCOPE_AGENT); }
__device__ __forceinline__ unsigned xb_add(unsigned* p, unsigned v) { return __hip_atomic_fetch_add(p, v, __ATOMIC_RELAXED, __HIP_MEMORY_SCOPE_AGENT); }
__device__ __forceinline__ unsigned xb_xcc_id() { return (unsigned)__builtin_amdgcn_s_getreg((3 << 11) | 20) & 0xFu; }
#define XB_SPIN(cond, bar) do { unsigned _sp = 0; while (cond) { __builtin_amdgcn_s_sleep(1); \
    if ((++_sp & 255u) == 0u) { if (xb_ld(&(bar)[XB_TMO])) break; if (_sp > XB_SPIN_CAP) { atomicAdd(&(bar)[XB_TMO], 1u); break; } } } } while (0)

struct XcdBarrier { unsigned* bar; unsigned x; volatile LAS unsigned* st; };

__device__ __forceinline__ XcdBarrier xcd_barrier_post(unsigned* bar, volatile LAS unsigned* st) {
    XcdBarrier b; b.bar = bar; b.x = xb_xcc_id(); b.st = st;
    if (threadIdx.x == 0) (void)xb_add(&bar[XB_XCNT(b.x)], 1u);
    return b;
}
__device__ __forceinline__ void xcd_barrier_complete(unsigned* bar, unsigned x, unsigned& nloc, unsigned& nx) {
    const unsigned G = gridDim.x * gridDim.y * gridDim.z;
    unsigned sum, cnt, mine, sp = 0u;
    for (;;) {
        sum = 0u; cnt = 0u; mine = 0u;
#pragma unroll
        for (unsigned j = 0; j < 16; ++j) { const unsigned c = xb_ld(&bar[XB_XCNT(j)]); sum += c; cnt += (c > 0u) ? 1u : 0u; mine = (j == x) ? c : mine; }
        if (sum == G) break;
        __builtin_amdgcn_s_sleep(1);
        if ((++sp & 255u) == 0u) { if (xb_ld(&bar[XB_TMO])) break; if (sp > XB_SPIN_CAP) { atomicAdd(&bar[XB_TMO], 1u); break; } }
    }
    nloc = mine > 0u ? mine : 1u; nx = cnt > 0u ? cnt : 1u;
}
__device__ __forceinline__ void xcd_barrier(const XcdBarrier& b) {
    asm volatile("s_waitcnt vmcnt(0)" ::: "memory");
    __syncthreads();
    if (threadIdx.x == 0) {
        unsigned* bar = b.bar;
        __builtin_amdgcn_s_waitcnt(0);
        unsigned nloc = b.st[0], nx = b.st[1];
        if (nloc == 0u) { xcd_barrier_complete(bar, b.x, nloc, nx); b.st[0] = nloc; b.st[1] = nx; }
        const unsigned old = xb_add(&bar[XB_XSUB(b.x)], 1u);
        const unsigned gen = old / nloc;
        if (old + 1u == (gen + 1u) * nloc) {
            __builtin_amdgcn_fence(__ATOMIC_RELEASE, "agent");
            asm volatile("s_waitcnt vmcnt(0)" ::: "memory");
            const unsigned og = xb_add(&bar[XB_TOP], 1u);
            const unsigned tg = og / nx;
            if (og + 1u == (tg + 1u) * nx) xb_add(&bar[XB_TOPGEN], 1u);
            else XB_SPIN(xb_ld(&bar[XB_TOPGEN]) == tg, bar);
            __builtin_amdgcn_fence(__ATOMIC_ACQUIRE, "agent");
            xb_add(&bar[XB_XGEN(b.x)], 1u);
            asm volatile("s_waitcnt vmcnt(0)" ::: "memory");
        } else {
            XB_SPIN(xb_ld(&bar[XB_XGEN(b.x)]) == gen, bar);
            __builtin_amdgcn_fence(__ATOMIC_ACQUIRE, "agent");
            asm volatile("s_waitcnt vmcnt(0)" ::: "memory");
        }
    }
    __syncthreads();
}

using pg8::Unit; using pg8::BM; using pg8::HALF;
typedef const f32x4 (&AccT)[2][2][4][2];

struct EpiInProj {
    static constexpr bool PERM = true;
    bf16 *convu, *q, *kv, *u;
    DEVI void operator()(AccT acc, const Unit& un, int wr, int wc, int fr, int fq) const {
        const int row0 = un.pm * BM + wr * 64 + fr, pn = un.pn, cw = wc * 32 + 8 * fq;
#pragma unroll
        for (int ai = 0; ai < 2; ++ai)
#pragma unroll
            for (int m = 0; m < 4; ++m) {
                const int row = row0 + ai * HALF + m * 16;
                if (pn < 4) {
                    float o[8];
#pragma unroll
                    for (int n = 0; n < 2; ++n)
#pragma unroll
                        for (int j = 0; j < 4; ++j) o[4 * n + j] = acc[ai][0][m][n][j] * sigmoidf_(acc[ai][1][m][n][j]);
                    v4u w; w.x = pg8::cvt_pk_bf16(o[0], o[1]); w.y = pg8::cvt_pk_bf16(o[2], o[3]); w.z = pg8::cvt_pk_bf16(o[4], o[5]); w.w = pg8::cvt_pk_bf16(o[6], o[7]);
                    *(v4u*)(convu + (size_t)row * DCONV + pn * 128 + cw) = w;
                } else {
#pragma unroll
                    for (int bj = 0; bj < 2; ++bj) {
                        const f32x4 v0 = acc[ai][bj][m][0], v1 = acc[ai][bj][m][1];
                        v4u w; w.x = pg8::cvt_pk_bf16(v0[0], v0[1]); w.y = pg8::cvt_pk_bf16(v0[2], v0[3]); w.z = pg8::cvt_pk_bf16(v1[0], v1[1]); w.w = pg8::cvt_pk_bf16(v1[2], v1[3]);
                        bf16* dst;
                        if (pn < 8) dst = q + (size_t)row * DATT + (pn - 4) * 256 + bj * 128 + cw;
                        else if (pn < 14) dst = kv + ((size_t)((pn - 8) * 2 + bj) * S + row) * HD + cw;
                        else { const int ch = (pn - 14) * 256 + bj * 128 + cw;
                            dst = (bf16*)((unsigned char*)u + tix(32768, (size_t)(ch >> 4) * 1024 + (row >> 4), 2 * ((row & 15) * 16 + (ch & 15)))); }
                        *(v4u*)dst = w;
                    }
                }
            }
    }
};
struct EpiSsm1 {
    static constexpr bool PERM = false;
    float *yintra, *sc;
    DEVI void operator()(AccT acc, const Unit& un, int wr, int wc, int fr, int fq) const {
        const int row0 = un.pm * BM + wr * 64 + fr, cw = wc * 32 + 4 * fq;
        if ((un.pn & 1) == 0) {
#pragma unroll
            for (int ai = 0; ai < 2; ++ai)
#pragma unroll
                for (int m = 0; m < 4; ++m) { float* p = yintra + (size_t)(row0 + ai * HALF + m * 16) * 256 + cw;
#pragma unroll
                    for (int bj = 0; bj < 2; ++bj)
#pragma unroll
                        for (int n = 0; n < 2; ++n) *(f32x4*)(p + bj * 128 + 16 * n) = acc[ai][bj][m][n]; }
        } else {
#pragma unroll
            for (int ai = 0; ai < 2; ++ai)
#pragma unroll
                for (int m = 0; m < 4; ++m) { float* p = sc + (size_t)(row0 + ai * HALF + m * 16) * 128 + cw;
#pragma unroll
                    for (int n = 0; n < 2; ++n) *(f32x4*)(p + 16 * n) = acc[ai][0][m][n]; }
        }
    }
};
struct EpiBiasBf16 {
    static constexpr bool PERM = true;
    bf16* O; int ldc; const float* bias;
    DEVI void operator()(AccT acc, const Unit& un, int wr, int wc, int fr, int fq) const {
        const int row0 = un.pm * BM + wr * 64 + fr, col0 = un.pn * BM + wc * 32 + 8 * fq;
#pragma unroll
        for (int ai = 0; ai < 2; ++ai)
#pragma unroll
            for (int m = 0; m < 4; ++m)
#pragma unroll
                for (int bj = 0; bj < 2; ++bj) {
                    const int col = col0 + bj * HALF;
                    const f32x4 b0 = *(const f32x4*)(bias + col), b1 = *(const f32x4*)(bias + col + 4);
                    const f32x4 v0 = acc[ai][bj][m][0] + b0, v1 = acc[ai][bj][m][1] + b1;
                    v4u w; w.x = pg8::cvt_pk_bf16(v0[0], v0[1]); w.y = pg8::cvt_pk_bf16(v0[2], v0[3]); w.z = pg8::cvt_pk_bf16(v1[0], v1[1]); w.w = pg8::cvt_pk_bf16(v1[2], v1[3]);
                    *(v4u*)(O + (size_t)(row0 + ai * HALF + m * 16) * ldc + col) = w;
                }
    }
};
DEVI float gelu_tanh(float y) { const float z = 0.7978845608028654f * (y + 0.044715f * y * y * y); const float e = __expf(2.f * z); const float th = 1.f - 2.f * __builtin_amdgcn_rcpf(e + 1.f); return 0.5f * y * (1.f + th); }
struct EpiSsm2 {
    static constexpr bool PERM = false;
    const float* yintra; const bf16* u; const float* dsk; bf16 *yssm, *gy;
    DEVI void operator()(AccT acc, const Unit& un, int wr, int wc, int fr, int fq) const {
        const int row0 = un.pm * BM + wr * 64 + fr, g = un.pn, cw = wc * 32 + 4 * fq;
#pragma unroll
        for (int ai = 0; ai < 2; ++ai)
#pragma unroll
            for (int m = 0; m < 4; ++m) {
                const int row = row0 + ai * HALF + m * 16, chunk = row & 1023;
#pragma unroll
                for (int bj = 0; bj < 2; ++bj)
#pragma unroll
                    for (int n = 0; n < 2; ++n) {
                        const int col = bj * 128 + cw + 16 * n, j = col >> 4, co = col & 15, t = chunk * 16 + j, ch = g * 16 + co;
                        const f32x4 yi = *(const f32x4*)(yintra + (size_t)row * 256 + col);
                        const v2u uu = *(const v2u*)((const unsigned char*)u + tix(32768, (size_t)g * 1024 + (t >> 4), 2 * ((t & 15) * 16 + co)));
                        const f32x4 dd = *(const f32x4*)(dsk + ch);
                        f32x4 y = acc[ai][bj][m][n] + yi;
                        y[0] += dd[0] * bflo(uu.x); y[1] += dd[1] * bfhi(uu.x); y[2] += dd[2] * bflo(uu.y); y[3] += dd[3] * bfhi(uu.y);
                        v2u w; w.x = pg8::cvt_pk_bf16(y[0], y[1]); w.y = pg8::cvt_pk_bf16(y[2], y[3]);
                        *(v2u*)((unsigned char*)yssm + tix(S, t, 2 * ch)) = w;
                        v2u w2; w2.x = pg8::cvt_pk_bf16(gelu_tanh(y[0]), gelu_tanh(y[1])); w2.y = pg8::cvt_pk_bf16(gelu_tanh(y[2]), gelu_tanh(y[3]));
                        *(v2u*)(gy + (size_t)t * DSSM + ch) = w2;
                    }
                asm volatile("" ::: "memory");
            }
    }
};
struct EpiGlu {
    static constexpr bool PERM = true;
    const bf16* gy; const float* bias; bf16* O;
    DEVI void operator()(AccT acc, const Unit& un, int wr, int wc, int fr, int fq) const {
        const int row0 = un.pm * BM + wr * 64 + fr, col0 = un.pn * BM + wc * 32 + 8 * fq;
#pragma unroll
        for (int ai = 0; ai < 2; ++ai)
#pragma unroll
            for (int m = 0; m < 4; ++m)
#pragma unroll
                for (int bj = 0; bj < 2; ++bj) {
                    const int col = col0 + bj * HALF; const size_t off = (size_t)(row0 + ai * HALF + m * 16) * DSSM + col;
                    const f32x4 b0 = *(const f32x4*)(bias + col), b1 = *(const f32x4*)(bias + col + 4);
                    const v4u g4 = *(const v4u*)(gy + off);
                    const f32x4 v0 = acc[ai][bj][m][0] + b0, v1 = acc[ai][bj][m][1] + b1;
                    v4u w;
                    w.x = pg8::cvt_pk_bf16(bflo(g4.x) * sigmoidf_(v0[0]), bfhi(g4.x) * sigmoidf_(v0[1]));
                    w.y = pg8::cvt_pk_bf16(bflo(g4.y) * sigmoidf_(v0[2]), bfhi(g4.y) * sigmoidf_(v0[3]));
                    w.z = pg8::cvt_pk_bf16(bflo(g4.z) * sigmoidf_(v1[0]), bfhi(g4.z) * sigmoidf_(v1[1]));
                    w.w = pg8::cvt_pk_bf16(bflo(g4.w) * sigmoidf_(v1[2]), bfhi(g4.w) * sigmoidf_(v1[3]));
                    *(v4u*)(O + off) = w;
                }
    }
};
struct EpiResid {
    static constexpr bool PERM = false;
    const void* base; bool b16; bf16* out; float scale;
    DEVI void operator()(AccT acc, const Unit& un, int wr, int wc, int fr, int fq) const {
        const int row0 = un.pm * BM + wr * 64 + fr, col0 = un.pn * BM + wc * 32 + 4 * fq;
#pragma unroll
        for (int ai = 0; ai < 2; ++ai) {
            f32x4 bs[4][2][2];
            if (b16) {
#pragma unroll
                for (int m = 0; m < 4; ++m) { const size_t off = (size_t)(row0 + ai * HALF + m * 16) * D + col0;
#pragma unroll
                    for (int bj = 0; bj < 2; ++bj)
#pragma unroll
                        for (int n = 0; n < 2; ++n) { const v2u w = *(const v2u*)((const bf16*)base + off + bj * HALF + n * 16); bs[m][bj][n] = (f32x4){bflo(w.x), bfhi(w.x), bflo(w.y), bfhi(w.y)}; } }
            } else {
#pragma unroll
                for (int m = 0; m < 4; ++m) { const size_t off = (size_t)(row0 + ai * HALF + m * 16) * D + col0;
#pragma unroll
                    for (int bj = 0; bj < 2; ++bj)
#pragma unroll
                        for (int n = 0; n < 2; ++n) bs[m][bj][n] = *(const f32x4*)((const float*)base + off + bj * HALF + n * 16); }
            }
#pragma unroll
            for (int m = 0; m < 4; ++m) { const size_t off = (size_t)(row0 + ai * HALF + m * 16) * D + col0;
#pragma unroll
                for (int bj = 0; bj < 2; ++bj)
#pragma unroll
                    for (int n = 0; n < 2; ++n) { const f32x4 r = bs[m][bj][n] + acc[ai][bj][m][n] * scale; v2u w; w.x = pk2(r[0], r[1]); w.y = pk2(r[2], r[3]); *(v2u*)(out + off + bj * HALF + n * 16) = w; } }
            asm volatile("" ::: "memory");
        }
    }
};
struct EpiSwiglu {
    static constexpr bool PERM = true;
    bf16* O; int ldc, nct;
    DEVI void operator()(AccT acc, const Unit& un, int wr, int wc, int fr, int fq) const {
        const int row0 = un.pm * BM + wr * 64 + fr, col0 = (un.pn % nct) * 128 + wc * 32 + 8 * fq;
#pragma unroll
        for (int ai = 0; ai < 2; ++ai)
#pragma unroll
            for (int m = 0; m < 4; ++m) {
                float o[8];
#pragma unroll
                for (int n = 0; n < 2; ++n)
#pragma unroll
                    for (int j = 0; j < 4; ++j) o[4 * n + j] = siluf_(acc[ai][0][m][n][j]) * acc[ai][1][m][n][j];
                v4u w; w.x = pg8::cvt_pk_bf16(o[0], o[1]); w.y = pg8::cvt_pk_bf16(o[2], o[3]); w.z = pg8::cvt_pk_bf16(o[4], o[5]); w.w = pg8::cvt_pk_bf16(o[6], o[7]);
                *(v4u*)(O + (size_t)(row0 + ai * HALF + m * 16) * ldc + col0) = w;
            }
    }
};
constexpr float MOE_WSCALE = 64.f, MOE_ASCALE = 4.f;
struct EpiSwiglu8 {
    static constexpr bool PERM = true;
    unsigned char* O; int nr, nct;
    DEVI void operator()(AccT acc, const Unit& un, int wr, int wc, int fr, int fq) const {
        const int row0 = un.pm * BM + wr * 64 + fr, col0 = (un.pn % nct) * 128 + wc * 32 + 8 * fq;
#pragma unroll
        for (int ai = 0; ai < 2; ++ai)
#pragma unroll
            for (int m = 0; m < 4; ++m) {
                float o[8];
#pragma unroll
                for (int n = 0; n < 2; ++n)
#pragma unroll
                    for (int j = 0; j < 4; ++j) o[4 * n + j] = clamp448(siluf_(acc[ai][0][m][n][j] * (1.f / MOE_WSCALE)) * acc[ai][1][m][n][j] * (MOE_ASCALE / MOE_WSCALE));
                v2u w; w.x = pk4_fp8(o[0], o[1], o[2], o[3]); w.y = pk4_fp8(o[4], o[5], o[6], o[7]);
                *(v2u*)(O + tix(nr, row0 + ai * HALF + m * 16, col0)) = w;
            }
    }
};
struct EpiMoeDown {
    static constexpr bool PERM = true;
    bf16* O; const float* rw; float scale;
    DEVI void operator()(AccT acc, const Unit& un, int wr, int wc, int fr, int fq) const {
        const int row0 = un.pm * BM + wr * 64 + fr, col0 = (un.pn & 7) * BM + wc * 32 + 8 * fq;
#pragma unroll
        for (int ai = 0; ai < 2; ++ai)
#pragma unroll
            for (int m = 0; m < 4; ++m) {
                const int row = row0 + ai * HALF + m * 16; const float s = rw[row] * scale;
#pragma unroll
                for (int bj = 0; bj < 2; ++bj) {
                    const f32x4 v0 = acc[ai][bj][m][0] * s, v1 = acc[ai][bj][m][1] * s;
                    v4u w; w.x = pg8::cvt_pk_bf16(v0[0], v0[1]); w.y = pg8::cvt_pk_bf16(v0[2], v0[3]); w.z = pg8::cvt_pk_bf16(v1[0], v1[1]); w.w = pg8::cvt_pk_bf16(v1[2], v1[3]);
                    *(v4u*)(O + (size_t)row * D + col0 + bj * HALF) = w;
                }
            }
    }
};

struct EpiMoePart {
    static constexpr bool PERM = true;
    float* P;
    DEVI void operator()(AccT acc, const Unit& un, int wr, int wc, int fr, int fq) const {
        const int row0 = wr * 64 + fr, col0 = wc * 32 + 8 * fq;
#pragma unroll
        for (int ai = 0; ai < 2; ++ai)
#pragma unroll
            for (int m = 0; m < 4; ++m) {
                float* pr = P + (size_t)(row0 + ai * HALF + m * 16) * 256 + col0;
#pragma unroll
                for (int bj = 0; bj < 2; ++bj) { *(f32x4*)(pr + bj * HALF) = acc[ai][bj][m][0]; *(f32x4*)(pr + bj * HALF + 4) = acc[ai][bj][m][1]; }
            }
    }
};

struct Ssm1Order { int G, c; DEVI bool next(int i, Unit& u) const { const int L = i * G + c; if (L >= 256) return false; u.pm = L >> 1; u.pn = (u.pm >> 2) * 2 + (L & 1); return true; } };
struct Ssm2Order { int G, c; DEVI bool next(int i, Unit& u) const { const int L = i * G + c; if (L >= 128) return false; u.pm = L; u.pn = L >> 2; return true; } };
struct OneUnit { int pm, pn; DEVI bool next(int i, Unit& u) const { if (i > 0) return false; u.pm = pm; u.pn = pn; return true; } };
struct MoeOrder {
    pg8::StaticOrder so; int nct; int pe[NE + 1]; int imax = 1 << 30;
    DEVI bool next(int i, Unit& u) const { return i < imax && at((long)i * so.G + so.c, u); }
    DEVI bool at(const long L, Unit& u) const {
        if (!so.at(L, u)) return false;
        int e = 0;
#pragma unroll
        for (int k = 1; k < NE; ++k) e += (u.pm >= pe[k]) ? 1 : 0;
        u.pn += e * nct; return true;
    }
};

struct Args { const float* in[38]; float* out; unsigned char* ws; int ph_lo, ph_hi, li, dbg; };
constexpr size_t CTL_TBL = 600000;
struct Frame {
    LAS unsigned char* lds; volatile LAS unsigned* MISC; gu32* ctl;
    int tid, lane, wave, G, gw, NGW;
    unsigned char* ws;
    DEVI const float* in(int i) const { const unsigned long long v = __hip_atomic_load((const unsigned long long*)(ws + CTL_TBL + (size_t)blockIdx.x * 512) + i, __ATOMIC_RELAXED, __HIP_MEMORY_SCOPE_WORKGROUP);
        return (const float*)(const GAS float*)(((unsigned long long)(unsigned)__builtin_amdgcn_readfirstlane((int)(v >> 32)) << 32) | (unsigned)__builtin_amdgcn_readfirstlane((int)v)); }
};
DEVI unsigned char* launder(unsigned char* p) { GAS unsigned char* g = (GAS unsigned char*)p; asm volatile("" : "+s"(g)); return (unsigned char*)g; }
DEVI int vlaunder(int v) { asm volatile("" : "+v"(v)); return v; }
enum { IN_X = 0, IN_POS, IN_NMG, IN_WIN, IN_DWW, IN_DWB, IN_LNG, IN_LNB, IN_PWW, IN_PWB, IN_GB, IN_PEK, IN_PEV, IN_W1K, IN_W2K, IN_W1V, IN_W2V,
       IN_LRE, IN_LIM, IN_LDT, IN_BRE, IN_BIM, IN_CRE, IN_CIM, IN_SD, IN_GLW, IN_GLB, IN_MOG, IN_WOUT, IN_NFG, IN_FG, IN_FU, IN_FD, IN_RW, IN_MG, IN_MU, IN_MD, IN_FNG };

DEVI void tr_item(const float* W, int ldw, int c0, int nvalid, int k0, bf16* dst, size_t ldd  , size_t nr  , int r0, LAS float* scr, int lane) {
    const int cg = (lane & 7) * 4;
#pragma unroll
    for (int i = 0; i < 8; ++i) {
        const int kk = 8 * i + (lane >> 3);
        const float* p = W + (size_t)(k0 + kk) * ldw + c0 + cg;
        f32x4 v;
        if (nvalid >= 32) { v = *(const f32x4*)p; }
        else { v[0] = cg + 0 < nvalid ? p[0] : 0.f; v[1] = cg + 1 < nvalid ? p[1] : 0.f; v[2] = cg + 2 < nvalid ? p[2] : 0.f; v[3] = cg + 3 < nvalid ? p[3] : 0.f; }
        scr[kk * 33 + cg + 0] = v[0]; scr[kk * 33 + cg + 1] = v[1]; scr[kk * 33 + cg + 2] = v[2]; scr[kk * 33 + cg + 3] = v[3];
    }
    LDS_WAIT(); asm volatile("" ::: "memory");
    const int c = lane & 7;
#pragma unroll
    for (int j = 0; j < 4; ++j) { const int n = (lane >> 3) + 8 * j; const LAS float* s = scr + (8 * c) * 33 + n;
        v4u o; o.x = pk2(s[0 * 33], s[1 * 33]); o.y = pk2(s[2 * 33], s[3 * 33]); o.z = pk2(s[4 * 33], s[5 * 33]); o.w = pk2(s[6 * 33], s[7 * 33]);
        if (nr) *(v4u*)((unsigned char*)dst + tix(nr, r0 + n, 2 * (k0 + 8 * c))) = o; else *(v4u*)(dst + (size_t)(r0 + n) * ldd + k0 + 8 * c) = o; }
    LDS_WAIT(); asm volatile("" ::: "memory");
}
DEVI void tr_item8(const float* W, int ldw, int c0, int k0, unsigned char* dst, size_t nr  , int r0, float scale, LAS float* scr, int lane) {
    const int cg = (lane & 7) * 4;
#pragma unroll
    for (int i = 0; i < 8; ++i) {
        const int kk = 8 * i + (lane >> 3);
        const f32x4 v = *(const f32x4*)(W + (size_t)(k0 + kk) * ldw + c0 + cg);
        scr[kk * 33 + cg + 0] = v[0]; scr[kk * 33 + cg + 1] = v[1]; scr[kk * 33 + cg + 2] = v[2]; scr[kk * 33 + cg + 3] = v[3];
    }
    LDS_WAIT(); asm volatile("" ::: "memory");
    const int c = lane & 7;
#pragma unroll
    for (int j = 0; j < 4; ++j) { const int n = (lane >> 3) + 8 * j; const LAS float* s = scr + (8 * c) * 33 + n;
        v2u o; o.x = pk4_fp8(s[0 * 33] * scale, s[1 * 33] * scale, s[2 * 33] * scale, s[3 * 33] * scale); o.y = pk4_fp8(s[4 * 33] * scale, s[5 * 33] * scale, s[6 * 33] * scale, s[7 * 33] * scale);
        *(v2u*)(dst + tix(nr, r0 + n, k0 + 8 * c)) = o; }
    LDS_WAIT(); asm volatile("" ::: "memory");
}
DEVI void tr_matrix_item(int item, const float* W, const float* W2, int K, int ldw, int Ndst, int kind, int nvalid_total, bf16* dst, LAS float* scr, int lane, bool tiled = true) {
    const int nblk = Ndst / 32, kb = item / nblk, nb = item % nblk, d0 = nb * 32;
    const float* src = W; int c0 = d0, nv = 32;
    if (kind == 1) { const int un = d0 >> 8, within = d0 & 255; src = (within >= 128) ? W2 : W; c0 = un * 128 + (within & 127); }
    else if (kind == 2) {
        const int un = d0 >> 8, within = d0 & 255;
        if (un < 4) c0 = (within >> 7) * 512 + un * 128 + (within & 127);
        else if (un < 14) c0 = d0;
        else c0 = 3608 + (d0 - 3584);
    }
    if (nvalid_total < Ndst) { nv = nvalid_total - d0; nv = nv < 0 ? 0 : (nv > 32 ? 32 : nv); }
    tr_item(src, ldw, c0, nv, kb * 64, dst, (size_t)K, tiled ? (size_t)Ndst : 0, d0, scr, lane);
}

template <bool B16>
DEVI f32x4 row_ld4(const void* xrow, int c) {
    if (B16) { const v2u w = *(const v2u*)((const bf16*)xrow + c); return (f32x4){bflo(w.x), bfhi(w.x), bflo(w.y), bfhi(w.y)}; }
    return *(const f32x4*)((const float*)xrow + c);
}
template <bool B16 = false>
DEVI void rms_row_to_bf16(const void* xrow, const float* g, unsigned char* obase  , int row, int lane) {
    f32x4 v[8]; float s = 0.f;
#pragma unroll
    for (int j = 0; j < 8; ++j) { v[j] = row_ld4<B16>(xrow, 4 * lane + 256 * j); s += (v[j].x * v[j].x + v[j].y * v[j].y) + (v[j].z * v[j].z + v[j].w * v[j].w); }
    const float r = 1.f / sqrtf(wave_sum(s) * (1.f / D) + EPS);
#pragma unroll
    for (int j = 0; j < 8; ++j) { const f32x4 gg = *(const f32x4*)(g + 4 * lane + 256 * j);
        v2u w; w.x = pk2(v[j].x * r * gg.x, v[j].y * r * gg.y); w.y = pk2(v[j].z * r * gg.z, v[j].w * r * gg.w);
        *(v2u*)(obase + tix(S, row, 2 * (4 * lane + 256 * j))) = w; }
}

DEVI void ssm_tables_job(Frame& F, int l, int g) {

    LAS float* apr = (LAS float*)F.lds;
    LAS float* api = apr + 18 * 64;
    LAS float* bbr = api + 18 * 64;
    LAS float* bbi = bbr + 1024;
    LAS float* ccr = bbi + 1024;
    LAS float* cci = ccr + 1024;
    LAS float* kt = cci + 1024;
    const int tid = F.tid;
    const size_t gp = (size_t)(l * NGRP + g) * PST;
    if (tid < 64) {
        const int p = tid;
        const float lr = fminf(F.in(IN_LRE)[gp + p], -1e-4f), li = F.in(IN_LIM)[gp + p], dt = expf(F.in(IN_LDT)[l * NGRP + g]);
        const float mag = expf(lr * dt), ar = mag * cosf(li * dt), ai = mag * sinf(li * dt);
        const float den = lr * lr + li * li, cr = ((ar - 1.f) * lr + ai * li) / den, ci = (ai * lr - (ar - 1.f) * li) / den;
        float pr = 1.f, pi = 0.f;
        for (int tau = 0; tau < 18; ++tau) { apr[tau * 64 + p] = pr; api[tau * 64 + p] = pi; const float nr = pr * ar - pi * ai, ni = pr * ai + pi * ar; pr = nr; pi = ni; }
        for (int c = 0; c < 16; ++c) { const float br = F.in(IN_BRE)[(gp + p) * 16 + c], bi = F.in(IN_BIM)[(gp + p) * 16 + c];
            bbr[p * 16 + c] = cr * br - ci * bi; bbi[p * 16 + c] = cr * bi + ci * br; }
        float* a16 = (float*)(F.ws + R_CB + 65536) + (gp + p) * 2;
        a16[0] = apr[16 * 64 + p]; a16[1] = api[16 * 64 + p];
    }
    for (int i = tid; i < 1024; i += NTHR) { const int co = i >> 6, p = i & 63; const size_t o = ((size_t)(l * NGRP + g) * 16 + co) * PST + p; ccr[i] = F.in(IN_CRE)[o]; cci[i] = F.in(IN_CIM)[o]; }
    __syncthreads();
    for (int i = tid; i < 4096; i += NTHR) {
        const int tau = i >> 8, co = (i >> 4) & 15, ci = i & 15; float s = 0.f;
        for (int p = 0; p < 64; ++p) {
            const float xr = apr[tau * 64 + p] * bbr[p * 16 + ci] - api[tau * 64 + p] * bbi[p * 16 + ci];
            const float xi = apr[tau * 64 + p] * bbi[p * 16 + ci] + api[tau * 64 + p] * bbr[p * 16 + ci];
            s += ccr[co * 64 + p] * xr - cci[co * 64 + p] * xi;
        }
        kt[i] = s;
    }
    __syncthreads();
    unsigned char* tw = (unsigned char*)(F.ws + R_TW) + (size_t)l * NGRP * 512 * 256 * 2;
    unsigned char* wo2 = (unsigned char*)(F.ws + R_WO2) + (size_t)l * NGRP * 256 * 256 * 2;
    for (int i2 = tid; i2 < 256 * 128; i2 += NTHR) {
        const int n = i2 >> 7, k = (i2 & 127) * 2, j = n >> 4, co = n & 15, ii = k >> 4, ci = k & 15;
        float v0 = 0.f, v1 = 0.f;
        if (ii <= j) { v0 = kt[(j - ii) * 256 + co * 16 + ci]; v1 = kt[(j - ii) * 256 + co * 16 + ci + 1]; }
        *(unsigned*)(tw + tix(16384, g * 512 + n, 2 * k)) = pk2(v0, v1);
    }
    for (int i2 = tid; i2 < 256 * 128; i2 += NTHR) {
        const int n = i2 >> 7, k = (i2 & 127) * 2, ii = k >> 4, ci = k & 15;
        float v0 = 0.f, v1 = 0.f;
        if (n < 128) { const int ri = n >> 6, p = n & 63; const float pr = apr[(15 - ii) * 64 + p], pi = api[(15 - ii) * 64 + p];
            const float b0r = bbr[p * 16 + ci], b0i = bbi[p * 16 + ci], b1r = bbr[p * 16 + ci + 1], b1i = bbi[p * 16 + ci + 1];
            if (ri == 0) { v0 = pr * b0r - pi * b0i; v1 = pr * b1r - pi * b1i; } else { v0 = pr * b0i + pi * b0r; v1 = pr * b1i + pi * b1r; } }
        *(unsigned*)(tw + tix(16384, g * 512 + 256 + n, 2 * k)) = pk2(v0, v1);
    }
    for (int i2 = tid; i2 < 256 * 128; i2 += NTHR) {
        const int n = i2 >> 7, k = (i2 & 127) * 2, j = n >> 4, co = n & 15;
        float v[2] = {0.f, 0.f};
#pragma unroll
        for (int e = 0; e < 2; ++e) { const int kk = k + e;
            if (kk < 128) { const int p = kk & 63; const float pr = apr[(j + 1) * 64 + p], pi = api[(j + 1) * 64 + p], cr = ccr[co * 64 + p], ci = cci[co * 64 + p];
                v[e] = (kk < 64) ? (cr * pr - ci * pi) : -(cr * pi + ci * pr); } }
        *(unsigned*)(wo2 + tix(8192, g * 256 + n, 2 * k)) = pk2(v[0], v[1]);
    }
    __syncthreads();
}
DEVI void cbias_job(Frame& F, int job) {
    LAS float* red = (LAS float*)F.lds;
    const int c = job & 15, kv = (job >> 4) & 1, l = job >> 5;
    const float* pe = F.in(kv ? IN_PEV : IN_PEK) + (size_t)l * 4096 + c * 256; const float* w1 = F.in(kv ? IN_W1V : IN_W1K) + (size_t)l * 4096 * 128 + (size_t)(c * 256) * 128;
    const int e = F.tid & 127, kq = F.tid >> 7; float s = 0.f;
#pragma unroll 16
    for (int k = kq * 64; k < kq * 64 + 64; ++k) s += pe[k] * w1[(size_t)k * 128 + e];
    red[F.tid] = s; __syncthreads();
    if (F.tid < 128) ((float*)(F.ws + R_CB))[(size_t)job * 128 + e] = (red[e] + red[128 + e]) + (red[256 + e] + red[384 + e]);
    __syncthreads();
}
DEVI void w1_tile_item(Frame& F, const float* pW1K, const float* pW1V, int item) {
    const int ks = item & 127, kv = (item >> 7) & 1, l = item >> 8, lane = F.lane, r = lane & 15, q = lane >> 4;
    const float* w1 = (kv ? pW1V : pW1K) + (size_t)l * 4096 * 128 + (size_t)(32 * ks + 8 * q) * 128 + r;
    bf16* dst = (bf16*)(F.ws + (kv ? R_W1V : R_W1K)) + (size_t)l * 128 * 4096 + ((size_t)ks * 8 * 64 + lane) * 8;
#pragma unroll
    for (int et = 0; et < 8; ++et) {
        float v[8];
#pragma unroll
        for (int j = 0; j < 8; ++j) v[j] = w1[(size_t)j * 128 + 16 * et];
        v4u o; o.x = pk2(v[0], v[1]); o.y = pk2(v[2], v[3]); o.z = pk2(v[4], v[5]); o.w = pk2(v[6], v[7]);
        *(v4u*)(dst + (size_t)et * 512) = o;
    }
}

struct Tile8 { const float* src; unsigned char* dst; int ldw; int nr, row0, k0; };
DEVI Tile8 moe_tile(Frame& F, const float* pMG, const float* pMU, const float* pMD, int r) {
    constexpr int I_MGU = 32 * (2 * DFFE / 32), I_MD = (DFFE / 64) * 64;
    const int e = r / (I_MGU + I_MD); r -= e * (I_MGU + I_MD);
    Tile8 t;
    if (r < I_MGU) { const int nblk = 2 * DFFE / 32, pq = r >> 1, kb = 2 * (pq / nblk) + (r & 1), nb = pq % nblk, d0 = nb * 32, un = d0 >> 8, within = d0 & 255;
        t.src = (within >= 128 ? pMU : pMG) + (size_t)e * D * DFFE + (size_t)(kb * 64) * DFFE + un * 128 + (within & 127); t.ldw = DFFE;
        t.dst = (unsigned char*)(F.ws + WS_MOE_GU); t.nr = NE * 2 * DFFE; t.row0 = e * 2 * DFFE + d0; t.k0 = kb * 64; }
    else { r -= I_MGU; const int nblk = D / 32, pq = r >> 1, kb = 2 * (pq / nblk) + (r & 1), nb = pq % nblk;
        t.src = pMD + (size_t)e * DFFE * D + (size_t)(kb * 64) * D + nb * 32; t.ldw = D;
        t.dst = (unsigned char*)(F.ws + WS_MOE_D); t.nr = NE * D; t.row0 = e * D + nb * 32; t.k0 = kb * 64; }
    return t;
}
DEVI Tile8 ffn_tile(Frame& F, const float* pFG, const float* pFU, const float* pFD, int r) {
    constexpr int I_FGU = 32 * (2 * DFF / 32);
    Tile8 t;
    if (r < I_FGU) { const int nblk = 2 * DFF / 32, pq = r >> 1, kb = 2 * (pq / nblk) + (r & 1), nb = pq % nblk, d0 = nb * 32, un = d0 >> 8, within = d0 & 255;
        t.src = (within >= 128 ? pFU : pFG) + (size_t)(kb * 64) * DFF + un * 128 + (within & 127); t.ldw = DFF;
        t.dst = (unsigned char*)(F.ws + R_FGU); t.nr = 2 * DFF; t.row0 = d0; t.k0 = kb * 64; }
    else { r -= I_FGU; const int nblk = D / 32, pq = r >> 1, kb = 2 * (pq / nblk) + (r & 1), nb = pq % nblk;
        t.src = pFD + (size_t)(kb * 64) * D + nb * 32; t.ldw = D;
        t.dst = (unsigned char*)(F.ws + R_FD); t.nr = D; t.row0 = nb * 32; t.k0 = kb * 64; }
    return t;
}
DEVI void tile8_load(const Tile8& t, f32x4 (&v)[8], int lane) {
#pragma unroll
    for (int i = 0; i < 8; ++i) v[i] = __builtin_nontemporal_load((const f32x4*)(t.src + (size_t)(8 * i + (lane >> 3)) * t.ldw + (lane & 7) * 4));
}
DEVI void tile8_store(const Tile8& t, const f32x4 (&v)[8], LAS float* scr, int lane) {
    const int cg = (lane & 7) * 4;
#pragma unroll
    for (int i = 0; i < 8; ++i) { const int kk = 8 * i + (lane >> 3); scr[kk * 33 + cg + 0] = v[i][0]; scr[kk * 33 + cg + 1] = v[i][1]; scr[kk * 33 + cg + 2] = v[i][2]; scr[kk * 33 + cg + 3] = v[i][3]; }
    LDS_WAIT(); asm volatile("" ::: "memory");
    const int c = lane & 7;
#pragma unroll
    for (int j = 0; j < 4; ++j) { const int n = (lane >> 3) + 8 * j; const LAS float* s = scr + (8 * c) * 33 + n;
        v2u o; o.x = pk4_fp8(s[0 * 33] * MOE_WSCALE, s[1 * 33] * MOE_WSCALE, s[2 * 33] * MOE_WSCALE, s[3 * 33] * MOE_WSCALE); o.y = pk4_fp8(s[4 * 33] * MOE_WSCALE, s[5 * 33] * MOE_WSCALE, s[6 * 33] * MOE_WSCALE, s[7 * 33] * MOE_WSCALE);
        *(v2u*)(t.dst + tix(t.nr, t.row0 + n, t.k0 + 8 * c)) = o; }
    LDS_WAIT(); asm volatile("" ::: "memory");
}

DEVI void p0_prologue(Frame& F, int variant = 0) {
     unsigned char* ws = F.ws;
    if (variant == 0) {
    for (int j = blockIdx.x; j < 128; j += F.G) { if (j < 64) ssm_tables_job(F, j >> 5, j & 31); else cbias_job(F, j - 64); }
    __syncthreads();
    }
    LAS float* scr = (LAS float*)(F.lds + RING_OFF + F.wave * 16384);
    if (variant == 0) {
    { const float* pX = F.in(IN_X); const float* pG = F.in(IN_NMG); for (int m = F.gw; m < S; m += F.NGW) rms_row_to_bf16(pX + (size_t)m * D, pG, (unsigned char*)(ws + WS_HN), m, F.lane); }
    constexpr int I_WIN = 32 * 128, I_WG = 32, I_WOUT = 32 * 64, I_SQ = 8 * 16, I_W1 = 64 * 4, I_W2 = 2 * 4;
    constexpr int I_LAYER = I_WIN + I_WG + I_WOUT + 2 * I_SQ + I_W1 + 2 * I_W2;
    constexpr int I_FGU = 32 * (2 * DFF / 32), I_FD = (DFF / 64) * 64, I_MGU = 32 * (2 * DFFE / 32), I_MD = (DFFE / 64) * 64;
    constexpr int NITEMS = 2 * I_LAYER;
    const float* pWIN = F.in(IN_WIN); const float* pWOUT = F.in(IN_WOUT); const float* pPWW = F.in(IN_PWW); const float* pGLW = F.in(IN_GLW); const float* pW2K = F.in(IN_W2K); const float* pW2V = F.in(IN_W2V);
    const float* pFG = F.in(IN_FG); const float* pFU = F.in(IN_FU); const float* pFD = F.in(IN_FD); const float* pW1K = F.in(IN_W1K); const float* pW1V = F.in(IN_W1V);
    for (int it = F.gw; it < NITEMS; it += F.NGW) {
        int r = it;
        if (r < 2 * I_LAYER) {
            const int l = r / I_LAYER; r -= l * I_LAYER;
            if (r < I_WIN) { tr_matrix_item(r, pWIN + (size_t)l * D * DIN, nullptr, D, DIN, 4096, 2, 4096, (bf16*)(ws + R_WIN) + (size_t)l * 4096 * D, scr, F.lane); continue; } r -= I_WIN;
            if (r < I_WG) {
#pragma unroll
                for (int h2 = 0; h2 < 2; ++h2) { const int ks = 2 * r + h2, rr = F.lane & 15, qq = F.lane >> 4;
#pragma unroll
                    for (int nt = 0; nt < 2; ++nt) { const int col = 16 * nt + rr; float v[8];
#pragma unroll
                        for (int j = 0; j < 8; ++j) v[j] = (col < 24) ? pWIN[(size_t)l * D * DIN + (size_t)(32 * ks + 8 * qq + j) * DIN + 3584 + col] : 0.f;
                        v4u o; o.x = pk2(v[0], v[1]); o.y = pk2(v[2], v[3]); o.z = pk2(v[4], v[5]); o.w = pk2(v[6], v[7]);
                        *(v4u*)((bf16*)(ws + R_WG) + (size_t)l * 32 * D + ((size_t)(ks * 2 + nt) * 64 + F.lane) * 8) = o; } }
                continue; } r -= I_WG;
            if (r < I_WOUT) { tr_matrix_item(r, pWOUT + (size_t)l * D * D, nullptr, D, D, D, 0, D, (bf16*)(ws + R_WOUT) + (size_t)l * D * D, scr, F.lane); continue; } r -= I_WOUT;
            if (r < I_SQ) { tr_matrix_item(r, pPWW + (size_t)l * 512 * 512, nullptr, 512, 512, 512, 0, 512, (bf16*)(ws + R_CPW) + (size_t)l * 512 * 512, scr, F.lane); continue; } r -= I_SQ;
            if (r < I_SQ) { tr_matrix_item(r, pGLW + (size_t)l * 512 * 512, nullptr, 512, 512, 512, 0, 512, (bf16*)(ws + R_GLU) + (size_t)l * 512 * 512, scr, F.lane); continue; } r -= I_SQ;
            if (r < I_W1) { w1_tile_item(F, pW1K, pW1V, l * 256 + r); continue; } r -= I_W1;
            if (r < I_W2) { tr_matrix_item(r, pW2K + (size_t)l * 128 * 128, nullptr, 128, 128, 128, 0, 128, (bf16*)(ws + R_W2) + (size_t)(l * 2 + 0) * 128 * 128, scr, F.lane, false); continue; } r -= I_W2;
            tr_matrix_item(r, pW2V + (size_t)l * 128 * 128, nullptr, 128, 128, 128, 0, 128, (bf16*)(ws + R_W2) + (size_t)(l * 2 + 1) * 128 * 128, scr, F.lane, false); continue;
        }
    }
    }
    constexpr int NMOE = NE * (32 * (2 * DFFE / 32) + (DFFE / 64) * 64), NFFN = 32 * (2 * DFF / 32) + (DFF / 64) * 64, NTOT = NMOE + NFFN;
    {
        const float* pMG = F.in(IN_MG); const float* pMU = F.in(IN_MU); const float* pMD = F.in(IN_MD);
        const float* pFG = F.in(IN_FG); const float* pFU = F.in(IN_FU); const float* pFD = F.in(IN_FD);
        const int NGW = F.NGW, NLATE = (F.G == 256) ? 512 : 0, RA = (F.G == 256) ? 84 : (1 << 20);
        auto item_of = [&](int k) -> int {
            const int q2 = k >> 1, RP = RA >> 1;
            int pr;
            if (q2 < RP) pr = q2 * NGW + F.gw;
            else { if (F.gw < NLATE) return -1; pr = RP * NGW + (q2 - RP) * (NGW - NLATE) + (F.gw - NLATE); }
            return pr < NTOT / 2 ? 2 * pr + (k & 1) : -1; };
        auto tile_of = [&](int it) -> Tile8 { return it < NMOE ? moe_tile(F, pMG, pMU, pMD, it) : ffn_tile(F, pFG, pFU, pFD, it - NMOE); };
        int it = item_of(0);
        if (it >= 0) {
            f32x4 va[8], vb[8];
            Tile8 t0 = tile_of(it); tile8_load(t0, va, F.lane);
            for (int k = 0; it >= 0; ++k) {
                const int itn = item_of(k + 1);
                const Tile8 t1 = tile_of(itn >= 0 ? itn : it); tile8_load(t1, vb, F.lane);
                if (variant == 1) { asm volatile("" :: "v"(va[0]), "v"(va[1]), "v"(va[2]), "v"(va[3]), "v"(va[4]), "v"(va[5]), "v"(va[6]), "v"(va[7])); } else tile8_store(t0, va, scr, F.lane);
                t0 = t1; it = itn;
#pragma unroll
                for (int i = 0; i < 8; ++i) va[i] = vb[i];
            }
        }
    }
}

#define MFMA16(a, b, c) __builtin_amdgcn_mfma_f32_16x16x32_bf16((a), (b), (c), 0, 0, 0)
DEVI bf16x8 ldg8(const bf16* p) { return *(const bf16x8*)p; }
DEVI bf16x8 zero8() { bf16x8 z = {0, 0, 0, 0, 0, 0, 0, 0}; return z; }
DEVI bf16x8 pack8(f32x4 a, f32x4 b) { v4u w; w.x = pg8::cvt_pk_bf16_asm(a[0], a[1]); w.y = pg8::cvt_pk_bf16_asm(a[2], a[3]); w.z = pg8::cvt_pk_bf16_asm(b[0], b[1]); w.w = pg8::cvt_pk_bf16_asm(b[2], b[3]); return __builtin_bit_cast(bf16x8, w); }

DEVI void gates_job(Frame& F, const float* pGB, int l, int job) {
    const int lane = F.lane, r = lane & 15, q = lane >> 4, t0 = job * 16;
    const unsigned char* hn = (const unsigned char*)(F.ws + WS_HN);
    const bf16* wg = (const bf16*)(F.ws + R_WG) + (size_t)l * 32 * D + lane * 8;
    f32x4 a0 = {0.f, 0.f, 0.f, 0.f}, a1 = a0;
#pragma unroll 16
    for (int ks = 0; ks < D / 32; ++ks) {
        const bf16x8 a = ldg8((const bf16*)(hn + tix(S, t0 + r, 64 * ks + 16 * q))), b0 = ldg8(wg + (size_t)(ks * 2) * 512), b1 = ldg8(wg + (size_t)(ks * 2 + 1) * 512);
        a0 = MFMA16(a, b0, a0); a1 = MFMA16(a, b1, a1);
    }
    const float* gb = pGB + l * 24; float* go = (float*)(F.ws + R_GATES);
#pragma unroll
    for (int j = 0; j < 4; ++j) { const int t = t0 + 4 * q + j;
        go[(size_t)t * 24 + r] = sigmoidf_(a0[j] + gb[r]);
        if (r < 8) go[(size_t)t * 24 + 16 + r] = sigmoidf_(a1[j] + gb[16 + r]); }
}

DEVI void rope_job(Frame& F, const int* pPOS, int t) {
    const int lane = F.lane;
    const float pos = (float)pPOS[t];
    float cs = 0.f, sn = 0.f;
    { const int i = lane & 15; const float inv = powf(500000.f, -(float)(2 * i) / 32.f); const float ang = pos * inv;
      double rv = (double)ang * 0.15915494309189533577; rv -= __builtin_floor(rv); const float fr = (float)rv;
      cs = __builtin_amdgcn_cosf(fr); sn = __builtin_amdgcn_sinf(fr); }
    float cv[16], sv[16];
#pragma unroll
    for (int i = 0; i < 16; ++i) { cv[i] = __shfl(cs, i); sv[i] = __shfl(sn, i); }
    const bf16* qrow = (const bf16*)(F.ws + R_Q) + (size_t)t * DATT + 16 * lane;
    v4u w0 = *(const v4u*)qrow, w1 = *(const v4u*)(qrow + 8);
    unsigned w[8] = {w0.x, w0.y, w0.z, w0.w, w1.x, w1.y, w1.z, w1.w};
    const int sub = lane & 7;
    float x[16], o[16];
#pragma unroll
    for (int i = 0; i < 8; ++i) { x[2 * i] = bflo(w[i]); x[2 * i + 1] = bfhi(w[i]); }
#pragma unroll
    for (int i = 0; i < 16; ++i) { const float other = __shfl_xor(x[i], 1);
        o[i] = (sub == 0) ? (x[i] * cv[i] - other * sv[i]) : ((sub == 1) ? (x[i] * cv[i] + other * sv[i]) : x[i]); }
    v4u o0, o1; o0.x = pk2(o[0], o[1]); o0.y = pk2(o[2], o[3]); o0.z = pk2(o[4], o[5]); o0.w = pk2(o[6], o[7]); o1.x = pk2(o[8], o[9]); o1.y = pk2(o[10], o[11]); o1.z = pk2(o[12], o[13]); o1.w = pk2(o[14], o[15]);
    bf16* qr = (bf16*)(F.ws + R_QR) + (size_t)t * DATT + 16 * lane;
    if (sub >= 2) { o0 = w0; o1 = w1; }
    *(v4u*)qr = o0; *(v4u*)(qr + 8) = o1;
    {
        const int tz = lane >> 5, g = (lane >> 4) & 1, c = lane & 15;
        const bf16* kp = (const bf16*)(F.ws + R_KV) + ((size_t)((tz ? 4 : 2) * 2 + g) * S + t) * HD + 8 * c;
        const v4u wv = *(const v4u*)kp;
        const unsigned ww[4] = {wv.x, wv.y, wv.z, wv.w}; unsigned ow[4];
        const int i0 = 8 * (c & 1);
#pragma unroll
        for (int i = 0; i < 4; ++i) {
            const unsigned pw = (unsigned)__shfl_xor((int)ww[i], 2);
            float a0 = bflo(ww[i]), a1 = bfhi(ww[i]); const float b0 = bflo(pw), b1 = bfhi(pw);
            float cc0 = 0.f, ss0 = 0.f, cc1 = 0.f, ss1 = 0.f;
#pragma unroll
            for (int k = 0; k < 16; ++k) { if (k == i0 + 2 * i) { cc0 = cv[k]; ss0 = sv[k]; } if (k == i0 + 2 * i + 1) { cc1 = cv[k]; ss1 = sv[k]; } }
            const float sg = (c < 2) ? -1.f : 1.f;
            const float r0 = a0 * cc0 + sg * b0 * ss0, r1 = a1 * cc1 + sg * b1 * ss1;
            ow[i] = (c < 4) ? pk2(r0, r1) : ww[i];
        }
        {
            v2u o8; o8.x = pk4_fp8(bflo(ow[0]), bfhi(ow[0]), bflo(ow[1]), bfhi(ow[1])); o8.y = pk4_fp8(bflo(ow[2]), bfhi(ow[2]), bflo(ow[3]), bfhi(ow[3]));
            *(v2u*)((unsigned char*)(F.ws + (tz ? R_KW8 : R_KS8)) + (size_t)g * S * HD + (size_t)((t >> 6) * 4 + ((t >> 4) & 3)) * 2048 + ((c & 3) >> 1) * 1024 + ((t & 15) + 16 * (c >> 2)) * 16 + (c & 1) * 8) = o8; }
    }
}

DEVI void dwconv_job(Frame& F, const float* pDWW, const float* pDWB, const float* pLNG, const float* pLNB, int l, int job) {
    const int lane = F.lane, c0 = 8 * lane, t0 = job * 4;
    const bf16* u = (const bf16*)(F.ws + R_CONVU);
    const float* dww = pDWW + (size_t)l * CONVW * DCONV + c0;
    float acc[4][8], wk[4][8];
#pragma unroll
    for (int i = 0; i < 4; ++i)
#pragma unroll
        for (int c = 0; c < 8; ++c) { acc[i][c] = 0.f; wk[i][c] = 0.f; }
#pragma unroll 2
    for (int kr = 0; kr < 34; ++kr) {
#pragma unroll
        for (int c = 0; c < 8; ++c) { wk[3][c] = wk[2][c]; wk[2][c] = wk[1][c]; wk[1][c] = wk[0][c]; }
        const int kk = kr <= 30 ? kr : 30; const float wm = kr <= 30 ? 1.f : 0.f;
        const f32x4 a = *(const f32x4*)(dww + (size_t)kk * DCONV), b = *(const f32x4*)(dww + (size_t)kk * DCONV + 4);
        wk[0][0] = a[0] * wm; wk[0][1] = a[1] * wm; wk[0][2] = a[2] * wm; wk[0][3] = a[3] * wm; wk[0][4] = b[0] * wm; wk[0][5] = b[1] * wm; wk[0][6] = b[2] * wm; wk[0][7] = b[3] * wm;
        const int r = t0 - 30 + kr; const int rc = r < 0 ? 0 : r; const float xm = r < 0 ? 0.f : 1.f;
        const v4u w = *(const v4u*)(u + (size_t)rc * DCONV + c0);
        const float x[8] = {bflo(w.x) * xm, bfhi(w.x) * xm, bflo(w.y) * xm, bfhi(w.y) * xm, bflo(w.z) * xm, bfhi(w.z) * xm, bflo(w.w) * xm, bfhi(w.w) * xm};
#pragma unroll
        for (int i = 0; i < 4; ++i)
#pragma unroll
            for (int c = 0; c < 8; ++c) acc[i][c] += x[c] * wk[i][c];
    }
    const float* dwb = pDWB + l * DCONV + c0; const float* lng = pLNG + l * DCONV + c0; const float* lnb = pLNB + l * DCONV + c0;
    float bb[8], gg[8], be[8];
#pragma unroll
    for (int c = 0; c < 8; ++c) { bb[c] = dwb[c]; gg[c] = lng[c]; be[c] = lnb[c]; }
    unsigned char* out = (unsigned char*)(F.ws + R_CONVACT);
#pragma unroll
    for (int i = 0; i < 4; ++i) {
        float s = 0.f;
#pragma unroll
        for (int c = 0; c < 8; ++c) { acc[i][c] += bb[c]; s += acc[i][c]; }
        const float mu = wave_sum(s) * (1.f / DCONV); float q = 0.f;
#pragma unroll
        for (int c = 0; c < 8; ++c) { const float d = acc[i][c] - mu; q += d * d; }
        const float rstd = 1.f / sqrtf(wave_sum(q) * (1.f / DCONV) + EPS);
        float y[8];
#pragma unroll
        for (int c = 0; c < 8; ++c) y[c] = siluf_((acc[i][c] - mu) * rstd * gg[c] + be[c]);
        v4u w; w.x = pk2(y[0], y[1]); w.y = pk2(y[2], y[3]); w.z = pk2(y[4], y[5]); w.w = pk2(y[6], y[7]);
        *(v4u*)(out + tix(S, t0 + i, 2 * c0)) = w;
    }
}

DEVI void vt_job(Frame& F, int job) {
    const int lane = F.lane;
    const int dh = job & 1, chunk = (job >> 1) & 255, g = (job >> 9) & 1, tz = job >> 10;
    LAS unsigned* scr = (LAS unsigned*)(F.lds + RING_OFF + F.wave * 16384);
    const bf16* v = (const bf16*)(F.ws + R_KV) + ((size_t)((tz ? 5 : 3) * 2 + g) * S + chunk * 64) * HD + dh * 64;
#pragma unroll
    for (int i = 0; i < 8; ++i) { const int row = 8 * i + (lane >> 3), cg = (lane & 7) * 4;
        const v4u w = *(const v4u*)(v + (size_t)row * HD + cg * 2);
        scr[row * 33 + cg + 0] = w.x; scr[row * 33 + cg + 1] = w.y; scr[row * 33 + cg + 2] = w.z; scr[row * 33 + cg + 3] = w.w; }
    LDS_WAIT(); asm volatile("" ::: "memory");
    const int r = lane & 15, q = lane >> 4;
    const LAS unsigned short* s16 = (const LAS unsigned short*)scr;
    {
        unsigned char* v8 = (unsigned char*)(F.ws + (tz ? R_VW8 : R_VS8)) + (size_t)g * S * HD + (size_t)chunk * 8192 + lane * 16;
#pragma unroll
        for (int dtl = 0; dtl < 4; ++dtl) { v4u o;
            unsigned wds[4];
#pragma unroll
            for (int T = 0; T < 4; ++T) { const int tk = 16 * T + 4 * q; wds[T] = pk4_fp8(bf2f(s16[(tk + 0) * 66 + 16 * dtl + r]), bf2f(s16[(tk + 1) * 66 + 16 * dtl + r]), bf2f(s16[(tk + 2) * 66 + 16 * dtl + r]), bf2f(s16[(tk + 3) * 66 + 16 * dtl + r])); }
            o.x = wds[0]; o.y = wds[1]; o.z = wds[2]; o.w = wds[3];
            *(v4u*)(v8 + (size_t)(dh * 4 + dtl) * 1024) = o; }
    }
    LDS_WAIT(); asm volatile("" ::: "memory");
}

DEVI void compress_job(Frame& F, int l, int job) {
    const int lane = F.lane, r = lane & 15, q = lane >> 4, w = F.wave;
    const int nt = job & 63, g = (job >> 6) & 1, kv = job >> 7;
    const int n0 = nt * 16; int nn = n0 + r; nn = nn > NCMP - 1 ? NCMP - 1 : nn;
    const bf16* raw = (const bf16*)(F.ws + R_KV) + ((size_t)(kv * 2 + g) * S) * HD + (size_t)nn * 2048 + 8 * q;
    const bf16* w1f = (const bf16*)(F.ws + (kv ? R_W1V : R_W1K)) + (size_t)l * 128 * 4096 + lane * 8;
    LAS f32x4* part = (LAS f32x4*)(F.lds + RING_OFF);
    LAS bf16* hidT = (LAS bf16*)(F.lds + RING_OFF + 65536);
    f32x4 hid[8];
#pragma unroll
    for (int e = 0; e < 8; ++e) hid[e] = (f32x4){0.f, 0.f, 0.f, 0.f};
#pragma unroll 4
    for (int k = 0; k < 16; ++k) {
        const int ks = 16 * w + k;
        const bf16x8 b = ldg8(raw + 32 * ks);
#pragma unroll
        for (int e = 0; e < 8; ++e) { const bf16x8 a = ldg8(w1f + ((size_t)ks * 8 + e) * 512); hid[e] = MFMA16(a, b, hid[e]); }
    }
#pragma unroll
    for (int e = 0; e < 8; ++e) part[(w * 8 + e) * 64 + lane] = hid[e];
    __syncthreads();
    {
        f32x4 sacc = part[(0 * 8 + w) * 64 + lane];
#pragma unroll
        for (int w2 = 1; w2 < 8; ++w2) sacc = sacc + part[(w2 * 8 + w) * 64 + lane];
        const float* cb = (const float*)(F.ws + R_CB) + (size_t)(l * 2 + kv) * 16 * 128 + 16 * w + 4 * q;
        f32x4 bv = *(const f32x4*)cb;
#pragma unroll
        for (int cc = 1; cc < 16; ++cc) bv = bv + *(const f32x4*)(cb + cc * 128);
        v2u pk; pk.x = pk2(siluf_(sacc[0] + bv[0]), siluf_(sacc[1] + bv[1])); pk.y = pk2(siluf_(sacc[2] + bv[2]), siluf_(sacc[3] + bv[3]));
        *(LAS v2u*)(hidT + r * 128 + 16 * w + 4 * q) = pk;
    }
    __syncthreads();
    const bf16* w2t = (const bf16*)(F.ws + R_W2) + (size_t)(l * 2 + kv) * 128 * 128 + (size_t)(16 * w + r) * 128 + 8 * q;
    f32x4 o = {0.f, 0.f, 0.f, 0.f};
#pragma unroll
    for (int s = 0; s < 4; ++s) {
        const bf16x8 a = ldg8(w2t + 32 * s);
        const bf16x8 b = *(const LAS bf16x8*)(hidT + r * 128 + 32 * s + 8 * q);
        o = MFMA16(a, b, o);
    }
    const int n = n0 + r, stp = n >> 5, kk = n & 31;
    if (kv == 0) { const int T = (kk >> 2) & 1, rr = ((kk >> 3) << 2) | (kk & 3);
        bf16* kc = (bf16*)(F.ws + R_KC) + (size_t)g * 1024 * HD;
        const int d0 = 16 * w + 4 * q, ks = d0 >> 5, qq = (d0 >> 3) & 3, j0 = d0 & 7;
        v2u wv; wv.x = pk2(o[0], o[1]); wv.y = pk2(o[2], o[3]);
        *(v2u*)(kc + ((((size_t)stp * 2 + T) * 4 + ks) * 64 + rr + 16 * qq) * 8 + j0) = wv; }
    else { const int qq = kk >> 3, jj = kk & 7;
        bf16* vct = (bf16*)(F.ws + R_VCT) + (size_t)g * 1024 * HD;
#pragma unroll
        for (int j = 0; j < 4; ++j) vct[(((size_t)stp * 8 + w) * 64 + (4 * q + j) + 16 * qq) * 8 + jj] = (bf16)f2bf(o[j]); }
    __syncthreads();
}

DEVI void scan_job(Frame& F, int l, int g) {
    const int p = F.lane;
    const float* a16 = (const float*)(F.ws + R_CB + 65536) + ((size_t)(l * NGRP + g) * PST + p) * 2;
    const float ar = a16[0], ai = a16[1];
    const float* sc = (const float*)(F.ws + R_SC) + (size_t)g * 1024 * 128;
    unsigned char* hp = (unsigned char*)(F.ws + R_HPREV);
    float hr = 0.f, hi = 0.f;
    for (int c0 = 0; c0 < 1024; c0 += 32) {
        float sr[32], si[32];
#pragma unroll
        for (int k = 0; k < 32; ++k) { sr[k] = sc[(size_t)(c0 + k) * 128 + p]; si[k] = sc[(size_t)(c0 + k) * 128 + 64 + p]; }
#pragma unroll
        for (int k = 0; k < 32; ++k) {
            const size_t rw_ = (size_t)g * 1024 + c0 + k;
            *(bf16*)(hp + tix(32768, rw_, 2 * p)) = (bf16)f2bf(hr); *(bf16*)(hp + tix(32768, rw_, 128 + 2 * p)) = (bf16)f2bf(hi); *(unsigned*)(hp + tix(32768, rw_, 256 + 4 * p)) = 0u;
            const float nr = ar * hr - ai * hi + sr[k], ni = ar * hi + ai * hr + si[k]; hr = nr; hi = ni;
        }
    }
}

constexpr float QK_SCALE = 0.08838834764831845f;
constexpr float C2 = 1.4426950408889634f * QK_SCALE;
constexpr float NEG_INF = -__builtin_inff();

DEVI int krow(int r, int T) { return 8 * (r >> 2) + 4 * T + (r & 3); }

DEVI void cmp_stats_job(Frame& F, int g, int tile) {
    const int lane = F.lane, r = lane & 15, q = lane >> 4, t0 = tile * 16, t = t0 + r;
    if (tile == 0) return;
    const int nmax = tile - 1;
    const int nsteps = (nmax >> 5) + 1;
    const bf16* qp = (const bf16*)(F.ws + R_Q) + (size_t)t * DATT + (size_t)(4 * g) * HD + 8 * q;
    bf16x8 qf[4][4];
#pragma unroll
    for (int h = 0; h < 4; ++h)
#pragma unroll
        for (int ks = 0; ks < 4; ++ks) qf[h][ks] = ldg8(qp + h * HD + 32 * ks);
    const bf16* kc = (const bf16*)(F.ws + R_KC) + (size_t)g * 1024 * HD + lane * 8;
    const int nvis = (t - 31) >> 4;
    float m[4], lsum[4];
#pragma unroll
    for (int h = 0; h < 4; ++h) { m[h] = -1e30f; lsum[h] = 0.f; }
    for (int pass = 0; pass < 2; ++pass) {
        float inv_l[4];
        if (pass == 1) {
#pragma unroll
            for (int h = 0; h < 4; ++h) {
                float mm = m[h], ll = lsum[h];
#pragma unroll
                for (int o = 16; o < 64; o <<= 1) { const float om = __shfl_xor(mm, o), ol = __shfl_xor(ll, o); const float nm = fmaxf(mm, om);
                    ll = ll * __builtin_amdgcn_exp2f(mm - nm) + ol * __builtin_amdgcn_exp2f(om - nm); mm = nm; }
                m[h] = mm; inv_l[h] = ll > 0.f ? 1.f / ll : 0.f;
            }
        }
        float carry = 0.f;
        auto kload = [&](bf16x8 (&kf)[2][4], int st) { const size_t sc_ = (st < nsteps) ? st : nsteps - 1;
#pragma unroll
            for (int T = 0; T < 2; ++T)
#pragma unroll
                for (int ks = 0; ks < 4; ++ks) kf[T][ks] = ldg8(kc + ((sc_ * 2 + T) * 4 + ks) * 512); };
        auto step = [&](const bf16x8 (&kf)[2][4], const int st) {
            const int key0 = st * 32;
            f32x4 imp0 = {0.f, 0.f, 0.f, 0.f}, imp1 = imp0;
#pragma unroll
            for (int h = 0; h < 4; ++h) {
                f32x4 s0 = {0.f, 0.f, 0.f, 0.f}, s1 = s0;
#pragma unroll
                for (int ks = 0; ks < 4; ++ks) { s0 = MFMA16(kf[0][ks], qf[h][ks], s0); s1 = MFMA16(kf[1][ks], qf[h][ks], s1); }
#pragma unroll
                for (int j = 0; j < 4; ++j) { s0[j] = (key0 + 8 * q + j <= nvis) ? s0[j] * C2 : NEG_INF; s1[j] = (key0 + 8 * q + 4 + j <= nvis) ? s1[j] * C2 : NEG_INF; }
                if (pass == 0) {
                    float mx = fmaxf(fmaxf(fmaxf(s0[0], s0[1]), fmaxf(s0[2], s0[3])), fmaxf(fmaxf(s1[0], s1[1]), fmaxf(s1[2], s1[3])));
                    const float nm = fmaxf(m[h], mx); float ps = 0.f;
#pragma unroll
                    for (int j = 0; j < 4; ++j) ps += __builtin_amdgcn_exp2f(s0[j] - nm) + __builtin_amdgcn_exp2f(s1[j] - nm);
                    lsum[h] = lsum[h] * __builtin_amdgcn_exp2f(m[h] - nm) + ps; m[h] = nm;
                } else {
#pragma unroll
                    for (int j = 0; j < 4; ++j) { imp0[j] += __builtin_amdgcn_exp2f(s0[j] - m[h]) * inv_l[h]; imp1[j] += __builtin_amdgcn_exp2f(s1[j] - m[h]) * inv_l[h]; }
                }
            }
            if (pass == 1) {
                const float prev_lane = __shfl_up(imp1[3], 16);
                const float pm1 = (q == 0) ? carry : prev_lane;
                const float b0 = pm1 + (imp0[0] + imp0[1]) + (imp0[2] + imp0[3]);
                const float b1 = imp0[3] + (imp1[0] + imp1[1]) + (imp1[2] + imp1[3]);
                carry = __shfl(imp1[3], 48 + r);
                float* dst = (float*)(F.ws + R_IMP) + ((size_t)t * 2 + g) * NSB + (key0 >> 2) + 2 * q;
                f32x2 w = {b0, b1}; *(f32x2*)dst = w;
            }
                };
        bf16x8 kA[2][4], kB[2][4];
        kload(kA, 0);
        for (int st = 0; st < nsteps; st += 2) {
            kload(kB, st + 1);
            step(kA, st);
            kload(kA, st + 2);
            if (st + 1 < nsteps) step(kB, st + 1);
        }
        if (pass == 1 && q == 0 && 8 * nsteps < NSB) ((float*)(F.ws + R_IMP))[((size_t)t * 2 + g) * NSB + 8 * nsteps] = carry;
    }
}

struct AttnState { f32x4 o[8]; float m, l; };
struct KVFrag { bf16x8 k[2][4]; bf16x8 v[8]; };
DEVI void kv_load(KVFrag& f, const bf16* kbase  , const bf16* vtbase  , int key0, int r) {
    const size_t st = (size_t)(key0 >> 5);
#pragma unroll
    for (int T = 0; T < 2; ++T)
#pragma unroll
        for (int ks = 0; ks < 4; ++ks) f.k[T][ks] = ldg8(kbase + ((st * 2 + T) * 4 + ks) * 512);
#pragma unroll
    for (int dt = 0; dt < 8; ++dt) f.v[dt] = ldg8(vtbase + (st * 8 + dt) * 512);
}
template <int MODE>
DEVI void attn_compute(AttnState& st, const bf16x8 (&qf)[4], const KVFrag& f, int key0, int tq, int lane) {
    const int q = lane >> 4;
    f32x4 s0 = {0.f, 0.f, 0.f, 0.f}, s1 = s0;
#pragma unroll
    for (int ks = 0; ks < 4; ++ks) { s0 = MFMA16(f.k[0][ks], qf[ks], s0); s1 = MFMA16(f.k[1][ks], qf[ks], s1); }
#pragma unroll
    for (int j = 0; j < 4; ++j) {
        const int ka = key0 + 8 * q + j, kb = ka + 4; bool va, vb;
        if (MODE == 0) { va = 16 * ka + 31 <= tq; vb = 16 * kb + 31 <= tq; }
        else if (MODE == 1) { va = (unsigned)(tq - ka) < 512u; vb = (unsigned)(tq - kb) < 512u; }
        else { va = ka <= tq; vb = kb <= tq; }
        s0[j] = va ? s0[j] * C2 : NEG_INF; s1[j] = vb ? s1[j] * C2 : NEG_INF;
    }
    float mx = fmaxf(fmaxf(fmaxf(s0[0], s0[1]), fmaxf(s0[2], s0[3])), fmaxf(fmaxf(s1[0], s1[1]), fmaxf(s1[2], s1[3])));
    mx = fmaxf(mx, __shfl_xor(mx, 16)); mx = fmaxf(mx, __shfl_xor(mx, 32));
    const float nm = fmaxf(st.m, mx), alpha = __builtin_amdgcn_exp2f(st.m - nm);
    st.m = nm;
    float ps = 0.f;
#pragma unroll
    for (int j = 0; j < 4; ++j) { s0[j] = __builtin_amdgcn_exp2f(s0[j] - nm); s1[j] = __builtin_amdgcn_exp2f(s1[j] - nm); ps += s0[j] + s1[j]; }
    st.l = st.l * alpha + ps;
    if (!__all(alpha == 1.f)) {
#pragma unroll
        for (int dt = 0; dt < 8; ++dt) st.o[dt] = st.o[dt] * alpha;
    }
    const bf16x8 pf = pack8(s0, s1);
#pragma unroll
    for (int dt = 0; dt < 8; ++dt) st.o[dt] = MFMA16(f.v[dt], pf, st.o[dt]);
}
template <int MODE>
DEVI void attn_run_linear(AttnState& st, const bf16x8 (&qf)[4], const bf16* kbase, const bf16* vtbase, int kstart, int nsteps, int tq, int lane) {
    const int r = lane & 15;
    KVFrag A, B;
    kv_load(A, kbase, vtbase, kstart, r);
    for (int s = 0; s < nsteps; s += 2) {
        const int s1 = (s + 1 < nsteps) ? s + 1 : nsteps - 1, s2 = (s + 2 < nsteps) ? s + 2 : nsteps - 1;
        kv_load(B, kbase, vtbase, kstart + 32 * s1, r);
        attn_compute<MODE>(st, qf, A, kstart + 32 * s, tq, lane);
        kv_load(A, kbase, vtbase, kstart + 32 * s2, r);
        if (s + 1 < nsteps) attn_compute<MODE>(st, qf, B, kstart + 32 * s1, tq, lane);
    }
}
typedef long i64_t;
#define MFMA16F8(a, b, c) __builtin_amdgcn_mfma_f32_16x16x32_fp8_fp8((a), (b), (c), 0, 0, 0)
struct KVFrag8 { i64_t k[2][4]; i64_t v[8]; };
DEVI void kv_load8(KVFrag8& f, const unsigned char* kbase  , const unsigned char* vtbase  , int key0) {
    const size_t st = (size_t)(key0 >> 5);
#pragma unroll
    for (int T = 0; T < 2; ++T)
#pragma unroll
        for (int ks = 0; ks < 4; ++ks) f.k[T][ks] = *(const i64_t*)(kbase + ((st * 2 + T) * 4 + ks) * 512);
#pragma unroll
    for (int dt = 0; dt < 8; ++dt) f.v[dt] = *(const i64_t*)(vtbase + (st * 8 + dt) * 512);
}
template <bool MASK>
DEVI void attn_compute8(AttnState& st, const i64_t (&qf)[4], const KVFrag8& f, int key0, int tq, int lane) {
    const int q = lane >> 4;
    f32x4 s0 = {0.f, 0.f, 0.f, 0.f}, s1 = s0;
#pragma unroll
    for (int ks = 0; ks < 4; ++ks) { s0 = MFMA16F8(f.k[0][ks], qf[ks], s0); s1 = MFMA16F8(f.k[1][ks], qf[ks], s1); }
    if (MASK) {
#pragma unroll
        for (int j = 0; j < 4; ++j) { const int ka = key0 + 8 * q + j, kb = ka + 4; s0[j] = (ka <= tq) ? s0[j] : NEG_INF; s1[j] = (kb <= tq) ? s1[j] : NEG_INF; }
    }
    float mx = fmaxf(fmaxf(fmaxf(s0[0], s0[1]), fmaxf(s0[2], s0[3])), fmaxf(fmaxf(s1[0], s1[1]), fmaxf(s1[2], s1[3])));
    mx = fmaxf(mx, __shfl_xor(mx, 16)); mx = fmaxf(mx, __shfl_xor(mx, 32));
    const float nm = fmaxf(st.m, mx * C2), alpha = __builtin_amdgcn_exp2f(st.m - nm), bias = 8.f - nm;
    st.m = nm;
    float ps = 0.f;
#pragma unroll
    for (int j = 0; j < 4; ++j) { s0[j] = __builtin_amdgcn_exp2f(__builtin_fmaf(s0[j], C2, bias)); s1[j] = __builtin_amdgcn_exp2f(__builtin_fmaf(s1[j], C2, bias)); ps += s0[j] + s1[j]; }
    st.l = st.l * alpha + ps;
    if (!__all(alpha == 1.f)) {
#pragma unroll
        for (int dt = 0; dt < 8; ++dt) st.o[dt] = st.o[dt] * alpha;
    }
    const i64_t pf = (i64_t)(((unsigned long long)pk4_fp8(s1[0], s1[1], s1[2], s1[3]) << 32) | pk4_fp8(s0[0], s0[1], s0[2], s0[3]));
#pragma unroll
    for (int dt = 0; dt < 8; ++dt) st.o[dt] = MFMA16F8(f.v[dt], pf, st.o[dt]);
}
typedef int v8i __attribute__((ext_vector_type(8)));
#define MFMA128(a, b, c) __builtin_amdgcn_mfma_scale_f32_16x16x128_f8f6f4((a), (b), (c), 0, 0, 0, 0x7F7F7F7F, 0, 0x7F7F7F7F)
DEVI v8i ld32(const unsigned char* p) { const v4u a = *(const v4u*)p, b = *(const v4u*)(p + 1024);
    v8i r; r[0] = a.x; r[1] = a.y; r[2] = a.z; r[3] = a.w; r[4] = b.x; r[5] = b.y; r[6] = b.z; r[7] = b.w; return r; }
DEVI void attn_init(AttnState& st) {
#pragma unroll
    for (int dt = 0; dt < 8; ++dt) st.o[dt] = (f32x4){0.f, 0.f, 0.f, 0.f};
    st.m = -1e30f; st.l = 0.f;
}
template <int CTRL, int BANK> DEVI float dpp_merge(float old, float src) { return __builtin_bit_cast(float, __builtin_amdgcn_update_dpp(__builtin_bit_cast(int, old), __builtin_bit_cast(int, src), CTRL, 0xf, BANK, false)); }
template <int CTRL> DEVI int dpp_mov(int src) { return __builtin_amdgcn_update_dpp(0, src, CTRL, 0xf, 0xf, true); }
template <int CTRL> DEVI float dpp_movf(float src) { return __builtin_bit_cast(float, __builtin_amdgcn_update_dpp(0, __builtin_bit_cast(int, src), CTRL, 0xf, 0xf, true)); }
template <bool LATE_K, bool C4, class BlkFn, class MaskFn>
DEVI void attn128_run(AttnState& st, const v8i qf, const unsigned char* kb, const unsigned char* vb, int nblk, BlkFn blk, MaskFn M, int q, v8i (&KA)[4], v8i (&KB)[4]) {
    const int nst = (nblk + 1) >> 1;
    for (int ss = 0; ss < nst; ++ss) {
        const int bA = blk(2 * ss);
        const bool hasB = (2 * ss + 1 < nblk);
        const int bB = blk(hasB ? 2 * ss + 1 : 2 * ss);
        v8i vf[8];
#pragma unroll
        for (int dt = 0; dt < 8; ++dt) { const v4u a = *(const v4u*)(vb + (size_t)bA * 8192 + dt * 1024), b = *(const v4u*)(vb + (size_t)bB * 8192 + dt * 1024);
            vf[dt][0] = a.x; vf[dt][1] = a.y; vf[dt][2] = a.z; vf[dt][3] = a.w; vf[dt][4] = b.x; vf[dt][5] = b.y; vf[dt][6] = b.z; vf[dt][7] = b.w; }
        f32x4 sa[4], sb[4];
#pragma unroll
        for (int T = 0; T < 4; ++T) { const f32x4 z = {0.f, 0.f, 0.f, 0.f}; sa[T] = MFMA128(KA[T], qf, z); sb[T] = MFMA128(KB[T], qf, z); }
        if (M.need(bA)) {
#pragma unroll
            for (int T = 0; T < 4; ++T)
#pragma unroll
                for (int j = 0; j < 4; ++j) sa[T][j] = M.vis(64 * bA + 16 * T + 4 * q + j) ? sa[T][j] : NEG_INF; }
        if (!hasB || M.need(bB)) {
#pragma unroll
            for (int T = 0; T < 4; ++T)
#pragma unroll
                for (int j = 0; j < 4; ++j) sb[T][j] = (hasB && M.vis(64 * bB + 16 * T + 4 * q + j)) ? sb[T][j] : NEG_INF; }
        v8i pf;
        if (C4) {
            f32x4 ca, cb;
#pragma unroll
            for (int j = 0; j < 4; ++j) {
                float x = sa[0][j]; x = dpp_merge<0x114, 0x2>(x, sa[1][j]); x = dpp_merge<0x118, 0x4>(x, sa[2][j]); x = dpp_merge<0x11C, 0x8>(x, sa[3][j]); ca[j] = x;
                float y = sb[0][j]; y = dpp_merge<0x114, 0x2>(y, sb[1][j]); y = dpp_merge<0x118, 0x4>(y, sb[2][j]); y = dpp_merge<0x11C, 0x8>(y, sb[3][j]); cb[j] = y; }
            float mx = fmaxf(fmaxf(fmaxf(ca[0], ca[1]), fmaxf(ca[2], ca[3])), fmaxf(fmaxf(cb[0], cb[1]), fmaxf(cb[2], cb[3])));
            mx = fmaxf(mx, dpp_movf<0x124>(mx)); mx = fmaxf(mx, dpp_movf<0x128>(mx));
            mx = fmaxf(mx, __shfl_xor(mx, 16)); mx = fmaxf(mx, __shfl_xor(mx, 32));
            const float nm = fmaxf(st.m, mx * C2), alpha = __builtin_amdgcn_exp2f(st.m - nm), bias = 8.f - nm;
            st.m = nm;
            float ps = 0.f;
#pragma unroll
            for (int j = 0; j < 4; ++j) { ca[j] = __builtin_amdgcn_exp2f(__builtin_fmaf(ca[j], C2, bias)); cb[j] = __builtin_amdgcn_exp2f(__builtin_fmaf(cb[j], C2, bias)); ps += ca[j] + cb[j]; }
            st.l = st.l * alpha + ps;
            if (!__all(alpha == 1.f)) {
#pragma unroll
                for (int dt = 0; dt < 8; ++dt) st.o[dt] = st.o[dt] * alpha;
            }
            const int wa = (int)pk4_fp8(ca[0], ca[1], ca[2], ca[3]), wb = (int)pk4_fp8(cb[0], cb[1], cb[2], cb[3]);
            pf[0] = wa; pf[1] = dpp_mov<0x104>(wa); pf[2] = dpp_mov<0x108>(wa); pf[3] = dpp_mov<0x10C>(wa);
            pf[4] = wb; pf[5] = dpp_mov<0x104>(wb); pf[6] = dpp_mov<0x108>(wb); pf[7] = dpp_mov<0x10C>(wb);
        } else {
        float mx = NEG_INF;
#pragma unroll
            for (int T = 0; T < 4; ++T) { mx = fmaxf(mx, fmaxf(fmaxf(sa[T][0], sa[T][1]), fmaxf(sa[T][2], sa[T][3]))); mx = fmaxf(mx, fmaxf(fmaxf(sb[T][0], sb[T][1]), fmaxf(sb[T][2], sb[T][3]))); }
            mx = fmaxf(mx, __shfl_xor(mx, 16)); mx = fmaxf(mx, __shfl_xor(mx, 32));
            const float nm = fmaxf(st.m, mx * C2), alpha = __builtin_amdgcn_exp2f(st.m - nm), bias = 8.f - nm;
            st.m = nm;
            float ps = 0.f;
#pragma unroll
            for (int T = 0; T < 4; ++T)
#pragma unroll
                for (int j = 0; j < 4; ++j) { sa[T][j] = __builtin_amdgcn_exp2f(__builtin_fmaf(sa[T][j], C2, bias)); sb[T][j] = __builtin_amdgcn_exp2f(__builtin_fmaf(sb[T][j], C2, bias)); ps += sa[T][j] + sb[T][j]; }
            st.l = st.l * alpha + ps;
            if (!__all(alpha == 1.f)) {
#pragma unroll
                for (int dt = 0; dt < 8; ++dt) st.o[dt] = st.o[dt] * alpha;
            }
#pragma unroll
            for (int T = 0; T < 4; ++T) { pf[T] = (int)pk4_fp8(sa[T][0], sa[T][1], sa[T][2], sa[T][3]); pf[4 + T] = (int)pk4_fp8(sb[T][0], sb[T][1], sb[T][2], sb[T][3]); }
        }
        if (!LATE_K)
        { const int n0 = (2 * ss + 2 < nblk) ? 2 * ss + 2 : 2 * ss, n1 = (2 * ss + 3 < nblk) ? 2 * ss + 3 : n0;
          const int c0_ = blk(n0), c1_ = blk(n1);
#pragma unroll
          for (int T = 0; T < 4; ++T) { KA[T] = ld32(kb + (size_t)c0_ * 8192 + T * 2048); KB[T] = ld32(kb + (size_t)c1_ * 8192 + T * 2048); } }
#pragma unroll
        for (int dt = 0; dt < 8; ++dt) st.o[dt] = MFMA128(vf[dt], pf, st.o[dt]);
        if (LATE_K)
        { const int n0 = (2 * ss + 2 < nblk) ? 2 * ss + 2 : 2 * ss, n1 = (2 * ss + 3 < nblk) ? 2 * ss + 3 : n0;
          const int c0_ = blk(n0), c1_ = blk(n1);
#pragma unroll
          for (int T = 0; T < 4; ++T) { KA[T] = ld32(kb + (size_t)c0_ * 8192 + T * 2048); KB[T] = ld32(kb + (size_t)c1_ * 8192 + T * 2048); } }
    }
    if (C4) { st.l += dpp_movf<0x124>(st.l); st.l += dpp_movf<0x128>(st.l); }
}
DEVI void attn128_k0(v8i (&KA)[4], v8i (&KB)[4], const unsigned char* kb, int b0_, int b1_) {
#pragma unroll
    for (int T = 0; T < 4; ++T) { KA[T] = ld32(kb + (size_t)b0_ * 8192 + T * 2048); KB[T] = ld32(kb + (size_t)b1_ * 8192 + T * 2048); }
}
struct SelMask { int cur, t; DEVI bool need(int b) const { return b == cur; } DEVI bool vis(int key) const { return key <= t; } };
struct WinMask { int t0, tq; DEVI bool need(int b) const { return !(64 * b + 63 <= t0 && 64 * b >= t0 - 496); } DEVI bool vis(int key) const { return (unsigned)(tq - key) < 512u; } };
DEVI v8i q_frag8(const bf16* qp, bool on) {
    v8i qf;
#pragma unroll
    for (int i = 0; i < 4; ++i) { const v4u w = *(const v4u*)(qp + 8 * i);
        qf[2 * i] = on ? (int)pk4_fp8(bflo(w.x), bfhi(w.x), bflo(w.y), bfhi(w.y)) : 0; qf[2 * i + 1] = on ? (int)pk4_fp8(bflo(w.z), bfhi(w.z), bflo(w.w), bfhi(w.w)) : 0; }
    return qf;
}
DEVI void attn_store(AttnState& st, bf16* dst, bool active, int lane, float oscale = 1.f) {
    const int q = lane >> 4;
    float l = st.l; l += __shfl_xor(l, 16); l += __shfl_xor(l, 32);
    const float inv = l > 0.f ? oscale / l : 0.f;
    if (active) {
#pragma unroll
        for (int dt = 0; dt < 8; ++dt) { v2u w; w.x = pk2(st.o[dt][0] * inv, st.o[dt][1] * inv); w.y = pk2(st.o[dt][2] * inv, st.o[dt][3] * inv); *(v2u*)(dst + 16 * dt + 4 * q) = w; }
    }
}
template <int MODE>
DEVI void attn_run_linear2(AttnState& st0, AttnState& st1, const bf16x8 (&q0)[4], const bf16x8 (&q1)[4], const bf16* kbase, const bf16* vtbase, int kstart, int nsteps, int tq, int lane) {
    const int r = lane & 15;
    for (int s = 0; s < nsteps; ++s) {
        KVFrag A;
        kv_load(A, kbase, vtbase, kstart + 32 * s, r);
        attn_compute<MODE>(st0, q0, A, kstart + 32 * s, tq, lane);
        attn_compute<MODE>(st1, q1, A, kstart + 32 * s, tq, lane);
    }
}
DEVI void cmp_att_job2(Frame& F, int tile, int hp) {
    const int lane = F.lane, r = lane & 15, q = lane >> 4, t = tile * 16 + r, h = 2 * hp, g = h >> 2;
    AttnState st0, st1; attn_init(st0); attn_init(st1);
    bf16x8 q0[4], q1[4];
    const bf16* qp = (const bf16*)(F.ws + R_Q) + (size_t)t * DATT + (size_t)h * HD + 8 * q;
#pragma unroll
    for (int ks = 0; ks < 4; ++ks) { q0[ks] = ldg8(qp + 32 * ks); q1[ks] = ldg8(qp + HD + 32 * ks); }
    if (tile > 0) {
        const int nsteps = ((tile - 1) >> 5) + 1;
        const bf16* kb = (const bf16*)(F.ws + R_KC) + (size_t)g * 1024 * HD + lane * 8;
        const bf16* vb = (const bf16*)(F.ws + R_VCT) + (size_t)g * HD * 1024 + lane * 8;
        attn_run_linear2<0>(st0, st1, q0, q1, kb, vb, 0, nsteps, t, lane);
    }
    attn_store(st0, (bf16*)(F.ws + R_OC) + (size_t)t * DATT + (size_t)h * HD, true, lane);
    attn_store(st1, (bf16*)(F.ws + R_OC) + (size_t)t * DATT + (size_t)(h + 1) * HD, true, lane);
}
DEVI void win_att_job2(Frame& F, int tile, int hp) {
    const int lane = F.lane, r = lane & 15, q = lane >> 4, t0 = tile * 16, t = t0 + r, h = 2 * hp, g = h >> 2;
    AttnState st0, st1; attn_init(st0); attn_init(st1);
    bf16x8 q0[4], q1[4];
    const bf16* qp = (const bf16*)(F.ws + R_QR) + (size_t)t * DATT + (size_t)h * HD + 8 * q;
#pragma unroll
    for (int ks = 0; ks < 4; ++ks) { q0[ks] = ldg8(qp + 32 * ks); q1[ks] = ldg8(qp + HD + 32 * ks); }
    int k_lo = t0 - 511; k_lo = k_lo < 0 ? 0 : k_lo; k_lo &= ~31;
    const bf16* kb = (const bf16*)(F.ws + R_KWF) + (size_t)g * S * HD + lane * 8;
    const bf16* vb = (const bf16*)(F.ws + R_VWT) + (size_t)g * HD * S + lane * 8;
    attn_run_linear2<1>(st0, st1, q0, q1, kb, vb, k_lo, ((t0 + 15 - k_lo) >> 5) + 1, t, lane);
    attn_store(st0, (bf16*)(F.ws + R_OW) + (size_t)t * DATT + (size_t)h * HD, true, lane);
    attn_store(st1, (bf16*)(F.ws + R_OW) + (size_t)t * DATT + (size_t)(h + 1) * HD, true, lane);
}
DEVI void win_att_job8(Frame& F, int tile, int h) {
    const int lane = F.lane, r = lane & 15, q = lane >> 4, t0 = tile * 16, t = t0 + r, g = h >> 2;
    AttnState st; attn_init(st);
    const v8i qf = q_frag8((const bf16*)(F.ws + R_QR) + (size_t)t * DATT + (size_t)h * HD + 32 * q, true);
    const int lo = t0 - 511, blo = (lo < 0 ? 0 : lo) >> 6, nblk = (t0 >> 6) - blo + 1;
    v8i KA[4], KB[4]; const unsigned char* kb = (const unsigned char*)(F.ws + R_KW8) + (size_t)g * S * HD + lane * 16;
    attn128_k0(KA, KB, kb, blo, blo + (nblk > 1 ? 1 : 0));
    attn128_run<false, false>(st, qf, kb, (const unsigned char*)(F.ws + R_VW8) + (size_t)g * S * HD + lane * 16, nblk,
                [&](int i) { return blo + i; }, WinMask{t0, t}, q, KA, KB);
    attn_store(st, (bf16*)(F.ws + R_OW) + (size_t)t * DATT + (size_t)h * HD, true, lane);
}
DEVI void cmp_att_job(Frame& F, int tile, int h) {
    const int lane = F.lane, r = lane & 15, q = lane >> 4, t = tile * 16 + r, g = h >> 2;
    AttnState st; attn_init(st);
    bf16x8 qf[4];
    const bf16* qp = (const bf16*)(F.ws + R_Q) + (size_t)t * DATT + (size_t)h * HD + 8 * q;
#pragma unroll
    for (int ks = 0; ks < 4; ++ks) qf[ks] = ldg8(qp + 32 * ks);
    if (tile > 0) {
        const int nsteps = ((tile - 1) >> 5) + 1;
        const bf16* kb = (const bf16*)(F.ws + R_KC) + (size_t)g * 1024 * HD + lane * 8;
        const bf16* vb = (const bf16*)(F.ws + R_VCT) + (size_t)g * HD * 1024 + lane * 8;
        attn_run_linear<0>(st, qf, kb, vb, 0, nsteps, t, lane);
    }
    attn_store(st, (bf16*)(F.ws + R_OC) + (size_t)t * DATT + (size_t)h * HD, true, lane);
}
DEVI void win_att_job(Frame& F, int tile, int h) {
    const int lane = F.lane, r = lane & 15, q = lane >> 4, t0 = tile * 16, t = t0 + r, g = h >> 2;
    AttnState st; attn_init(st);
    bf16x8 qf[4];
    const bf16* qp = (const bf16*)(F.ws + R_QR) + (size_t)t * DATT + (size_t)h * HD + 8 * q;
#pragma unroll
    for (int ks = 0; ks < 4; ++ks) qf[ks] = ldg8(qp + 32 * ks);
    int k_lo = t0 - 511; k_lo = k_lo < 0 ? 0 : k_lo; k_lo &= ~31;
    const bf16* kb = (const bf16*)(F.ws + R_KWF) + (size_t)g * S * HD + lane * 8;
    const bf16* vb = (const bf16*)(F.ws + R_VWT) + (size_t)g * HD * S + lane * 8;
    attn_run_linear<1>(st, qf, kb, vb, k_lo, ((t0 + 15 - k_lo) >> 5) + 1, t, lane);
    attn_store(st, (bf16*)(F.ws + R_OW) + (size_t)t * DATT + (size_t)h * HD, true, lane);
}
DEVI f32x4 sel_imp_load(Frame& F, int t, int g) { return *(const f32x4*)((const float*)(F.ws + R_IMP) + ((size_t)t * 2 + g) * NSB + 4 * F.lane); }
DEVI void sel_att_job(Frame& F, int t, int g, const f32x4 iv, int variant = 0) {
    const int lane = F.lane, r = lane & 15, q = lane >> 4;
    v4u qraw[4];
    { const bf16* qp = (const bf16*)(F.ws + R_QR) + (size_t)t * DATT + (size_t)(4 * g + (r & 3)) * HD + 32 * q;
#pragma unroll
      for (int i = 0; i < 4; ++i) qraw[i] = *(const v4u*)(qp + 8 * i); }
    const int cur = t >> 6;
    v8i KA[4], KB[4]; const unsigned char* kb = (const unsigned char*)(F.ws + R_KS8) + (size_t)g * S * HD + lane * 16;
    attn128_k0(KA, KB, kb, 0, cur);
    const int nvis = (t - 31) >> 4, jlim = (t >= 31) ? ((nvis + 1) >> 2) : -1;
    unsigned ikey[4]; bool cand[4], sel[4];
    int nforced = 0, ncand = 0;
#pragma unroll
    for (int i = 0; i < 4; ++i) { const int j = 4 * lane + i; const float im = (j <= jlim) ? iv[i] : 0.f;
        const bool allowed = j <= cur, forced = allowed && ((j == 0) || (j == cur) || (j == cur - 1));
        ikey[i] = __float_as_uint(im); cand[i] = allowed && !forced; sel[i] = forced;
        nforced += __builtin_popcountll(__ballot(forced)); ncand += __builtin_popcountll(__ballot(cand[i])); }
    const int K = 16 - nforced;
    if (ncand <= K) {
#pragma unroll
        for (int i = 0; i < 4; ++i) sel[i] = sel[i] || cand[i];
    } else {
        unsigned thr = 0u;
        for (int bit = 30; bit >= 0; --bit) {
            const unsigned tr = thr | (1u << bit); int cnt = 0;
#pragma unroll
            for (int i = 0; i < 4; ++i) cnt += __builtin_popcountll(__ballot(cand[i] && ikey[i] >= tr));
            if (cnt >= K) { thr = tr; if (cnt == K) break; }
        }
        int cgt = 0; unsigned long long tm[4];
#pragma unroll
        for (int i = 0; i < 4; ++i) { const bool gt = cand[i] && ikey[i] > thr; sel[i] = sel[i] || gt; cgt += __builtin_popcountll(__ballot(gt)); tm[i] = __ballot(cand[i] && ikey[i] == thr); }
        for (int need = K - cgt; need > 0; --need) {
            int bestj = 1 << 30;
#pragma unroll
            for (int i = 0; i < 4; ++i) if (tm[i]) { const int j = 4 * (int)__builtin_ctzll(tm[i]) + i; bestj = j < bestj ? j : bestj; }
#pragma unroll
            for (int i = 0; i < 4; ++i) { if ((bestj & 3) == i) tm[i] &= tm[i] - 1ull; if (4 * lane + i == bestj) sel[i] = true; }
        }
    }
    int selv = 0, nsel = 1;
    if (cur >= 1) { selv = (lane == 1) ? cur : selv; nsel = 2; }
    if (cur >= 2) { selv = (lane == 2) ? cur - 1 : selv; nsel = 3; }
#pragma unroll
    for (int i = 0; i < 4; ++i) { const int jb = 4 * lane + i; unsigned long long m = __ballot(sel[i] && jb != 0 && jb != cur && jb != cur - 1);
        while (m) { const int bl = (int)__builtin_ctzll(m); m &= m - 1ull; selv = (lane == nsel) ? (4 * bl + i) : selv; ++nsel; } }
    if (variant == 4) nsel = 0;
#ifdef REP_PHASE
    if (variant == 1) selv = lane & 3;
    if (variant == 2) { selv = cur - lane; selv = selv < 0 ? 0 : selv; }
    if (variant == 4) { selv = lane & 3; nsel = 16; }
    if (variant == 3) nsel = 0;
#endif
    AttnState st; attn_init(st);
    v8i qf;
#pragma unroll
    for (int i = 0; i < 4; ++i) { const v4u w = qraw[i];
        qf[2 * i] = (r < 4) ? (int)pk4_fp8(bflo(w.x), bfhi(w.x), bflo(w.y), bfhi(w.y)) : 0; qf[2 * i + 1] = (r < 4) ? (int)pk4_fp8(bflo(w.z), bfhi(w.z), bflo(w.w), bfhi(w.w)) : 0; }
    attn128_run<false, true>(st, qf, kb, (const unsigned char*)(F.ws + R_VS8) + (size_t)g * S * HD + lane * 16, nsel,
                [&](int i) { return __builtin_amdgcn_readlane(selv, i); }, SelMask{cur, t}, q, KA, KB);
    attn_store(st, (bf16*)(F.ws + (variant ? R_ACT : R_OS)) + (size_t)t * DATT + (size_t)(4 * g + (r & 3)) * HD, r < 4, lane);
}

DEVI void mixnorm_job(Frame& F, const float* pMOG, int l, int t) {
    const int lane = F.lane;
    const float* mg = pMOG + (size_t)l * D;
    unsigned char* mixed = (unsigned char*)(F.ws + R_MIXED);
#pragma unroll
    for (int part = 0; part < 2; ++part) {
        const bf16* src = (const bf16*)(F.ws + (part ? R_SSMO : R_CONVO)) + (size_t)t * 512 + 8 * lane;
        const int gofs = part ? (DCONV + DATT) : 0;
        const v4u w = *(const v4u*)src; float x[8] = {bflo(w.x), bfhi(w.x), bflo(w.y), bfhi(w.y), bflo(w.z), bfhi(w.z), bflo(w.w), bfhi(w.w)};
        float s = 0.f;
#pragma unroll
        for (int c = 0; c < 8; ++c) s += x[c] * x[c];
        const float rr = 1.f / sqrtf(wave_sum(s) * (1.f / 512.f) + EPS);
        const f32x4 g0 = *(const f32x4*)(mg + gofs + 8 * lane), g1 = *(const f32x4*)(mg + gofs + 8 * lane + 4);
        v4u o; o.x = pk2(x[0] * rr * g0[0], x[1] * rr * g0[1]); o.y = pk2(x[2] * rr * g0[2], x[3] * rr * g0[3]); o.z = pk2(x[4] * rr * g1[0], x[5] * rr * g1[1]); o.w = pk2(x[6] * rr * g1[2], x[7] * rr * g1[3]);
        *(v4u*)(mixed + tix(S, t, 2 * (gofs + 8 * lane))) = o;
    }
    {
        const int h = lane >> 3; const float* gt = (const float*)(F.ws + R_GATES) + (size_t)t * 24 + 3 * h;
        const float gc = gt[0], gs = gt[1], gw = gt[2];
        const size_t off = (size_t)t * DATT + 16 * lane;
        const bf16* pc = (const bf16*)(F.ws + R_OC) + off; const bf16* ps = (const bf16*)(F.ws + R_OS) + off; const bf16* pw = (const bf16*)(F.ws + R_OW) + off;
        float x[16]; float s = 0.f;
#pragma unroll
        for (int hh = 0; hh < 2; ++hh) { const v4u a = *(const v4u*)(pc + 8 * hh), b = *(const v4u*)(ps + 8 * hh), c = *(const v4u*)(pw + 8 * hh);
            const unsigned aw[4] = {a.x, a.y, a.z, a.w}, bw[4] = {b.x, b.y, b.z, b.w}, cw[4] = {c.x, c.y, c.z, c.w};
#pragma unroll
            for (int i = 0; i < 4; ++i) { x[8 * hh + 2 * i] = gc * bflo(aw[i]) + gs * bflo(bw[i]) + gw * bflo(cw[i]); x[8 * hh + 2 * i + 1] = gc * bfhi(aw[i]) + gs * bfhi(bw[i]) + gw * bfhi(cw[i]); } }
#pragma unroll
        for (int c = 0; c < 16; ++c) s += x[c] * x[c];
        const float rr = 1.f / sqrtf(wave_sum(s) * (1.f / 1024.f) + EPS);
        const float* gp = mg + DCONV + 16 * lane;
        float gg[16];
#pragma unroll
        for (int c4 = 0; c4 < 4; ++c4) { const f32x4 v = *(const f32x4*)(gp + 4 * c4); gg[4 * c4] = v[0]; gg[4 * c4 + 1] = v[1]; gg[4 * c4 + 2] = v[2]; gg[4 * c4 + 3] = v[3]; }
        v4u o0, o1;
        o0.x = pk2(x[0] * rr * gg[0], x[1] * rr * gg[1]); o0.y = pk2(x[2] * rr * gg[2], x[3] * rr * gg[3]); o0.z = pk2(x[4] * rr * gg[4], x[5] * rr * gg[5]); o0.w = pk2(x[6] * rr * gg[6], x[7] * rr * gg[7]);
        o1.x = pk2(x[8] * rr * gg[8], x[9] * rr * gg[9]); o1.y = pk2(x[10] * rr * gg[10], x[11] * rr * gg[11]); o1.z = pk2(x[12] * rr * gg[12], x[13] * rr * gg[13]); o1.w = pk2(x[14] * rr * gg[14], x[15] * rr * gg[15]);
        *(v4u*)(mixed + tix(S, t, 2 * (DCONV + 16 * lane))) = o0; *(v4u*)(mixed + tix(S, t, 2 * (DCONV + 16 * lane + 8))) = o1;
    }
}

DEVI void norm_route_job(Frame& F, const float* g, const float* rw, int t, bool route) {
    const int lane = F.lane;
    const bf16* xrow = (const bf16*)(F.ws + WS_H) + (size_t)t * D;
    unsigned char* obase = (unsigned char*)(F.ws + WS_HN);
    f32x4 v[8]; float s = 0.f;
#pragma unroll
    for (int j = 0; j < 8; ++j) { v[j] = row_ld4<true>(xrow, 4 * lane + 256 * j); s += (v[j].x * v[j].x + v[j].y * v[j].y) + (v[j].z * v[j].z + v[j].w * v[j].w); }
    const float rr = 1.f / sqrtf(wave_sum(s) * (1.f / D) + EPS);
#pragma unroll
    for (int j = 0; j < 8; ++j) { const f32x4 gg = *(const f32x4*)(g + 4 * lane + 256 * j); v[j] = v[j] * rr * gg;
        *(unsigned*)((unsigned char*)(F.ws + R_HN8) + tix(S, t, 4 * lane + 256 * j)) = pk4_fp8(v[j].x, v[j].y, v[j].z, v[j].w); }
    if (!route) return;
    float lg[8];
#pragma unroll
    for (int e = 0; e < 8; ++e) lg[e] = 0.f;
#pragma unroll
    for (int j = 0; j < 8; ++j)
#pragma unroll
        for (int i = 0; i < 4; ++i) { const int k = 4 * lane + 256 * j + i; const f32x4 a = *(const f32x4*)(rw + (size_t)k * 8), b = *(const f32x4*)(rw + (size_t)k * 8 + 4); const float x = v[j][i];
            lg[0] += x * a[0]; lg[1] += x * a[1]; lg[2] += x * a[2]; lg[3] += x * a[3]; lg[4] += x * b[0]; lg[5] += x * b[1]; lg[6] += x * b[2]; lg[7] += x * b[3]; }
#pragma unroll
    for (int e = 0; e < 8; ++e) lg[e] = wave_sum(lg[e]);
    int e1 = 0; float v1 = lg[0];
#pragma unroll
    for (int e = 1; e < 8; ++e) if (lg[e] > v1) { v1 = lg[e]; e1 = e; }
    int e2 = -1; float v2 = -3.0e38f;
#pragma unroll
    for (int e = 0; e < 8; ++e) if (e != e1 && lg[e] > v2) { v2 = lg[e]; e2 = e; }
    const float p2 = __expf(v2 - v1), w1 = 1.f / (1.f + p2), w2 = p2 / (1.f + p2);
    if (lane < 2) {
        const int e = lane ? e2 : e1; const float w = lane ? w2 : w1;
        const unsigned slot = __hip_atomic_fetch_add((unsigned*)(F.ctl + CW_ECNT + 64 * e), 1u, RLX_AGENT);
        ((int*)(F.ws + WS_TOK + TOK_E))[2 * t + lane] = e; ((float*)(F.ws + WS_TOK + TOK_W))[2 * t + lane] = w; ((int*)(F.ws + WS_TOK + TOK_SLOT))[2 * t + lane] = (int)slot;
    }
}
DEVI void moe_prefix(Frame& F, int (&pe)[NE + 1]) {
    int acc = 0;
#pragma unroll
    for (int e = 0; e < NE; ++e) { pe[e] = acc; const unsigned c = __hip_atomic_load((unsigned*)(F.ctl + CW_ECNT + 64 * e), RLX_AGENT); acc += (int)((c + 255u) >> 8); }
    pe[NE] = acc;
}
DEVI void moe_gather_job(Frame& F, const int (&pe)[NE + 1], int job) {
    const int lane = F.lane, t = job >> 1;
    const int e = ((const int*)(F.ws + WS_TOK + TOK_E))[job], slot = ((const int*)(F.ws + WS_TOK + TOK_SLOT))[job];
    int p0 = 0;
#pragma unroll
    for (int k = 0; k < NE; ++k) p0 = (e == k) ? pe[k] : p0;
    const int row = p0 * 256 + slot;
    const unsigned char* src = (const unsigned char*)(F.ws + R_HN8); unsigned char* dst = (unsigned char*)(F.ws + M_ASORT);
#pragma unroll
    for (int i = 0; i < 4; ++i) { const int c8 = 8 * (lane + 64 * i); const v2u o = *(const v2u*)(src + tix(S, t, c8)); *(v2u*)(dst + tix(NPAD, row, c8)) = o; }
    if (lane == 0) { ((int*)(F.ws + WS_TOK + TOK_POS))[job] = row; ((float*)(F.ws + WS_TOK + TOK_RW))[row] = ((const float*)(F.ws + WS_TOK + TOK_W))[job]; }
}
DEVI void moe_combine_job(Frame& F, float* outp, const float* g, int t) {
    const int lane = F.lane;
    const bf16* xrow = (const bf16*)(F.ws + WS_H) + (size_t)t * D;
    const int r0 = ((const int*)(F.ws + WS_TOK + TOK_POS))[2 * t], r1 = ((const int*)(F.ws + WS_TOK + TOK_POS))[2 * t + 1];
    const bf16* y0 = (const bf16*)(F.ws + M_YS) + (size_t)r0 * D; const bf16* y1 = (const bf16*)(F.ws + M_YS) + (size_t)r1 * D;
    float* orow = outp + (size_t)t * D;
    f32x4 v[8]; float s = 0.f;
#pragma unroll
    for (int j = 0; j < 8; ++j) { const int c = 4 * lane + 256 * j; v[j] = row_ld4<true>(xrow, c);
        const v2u a = __builtin_nontemporal_load((const v2u*)(y0 + c)), b = __builtin_nontemporal_load((const v2u*)(y1 + c));
        v[j].x += bflo(a.x) + bflo(b.x); v[j].y += bfhi(a.x) + bfhi(b.x); v[j].z += bflo(a.y) + bflo(b.y); v[j].w += bfhi(a.y) + bfhi(b.y);
        s += (v[j].x * v[j].x + v[j].y * v[j].y) + (v[j].z * v[j].z + v[j].w * v[j].w); }
    const float rr = 1.f / sqrtf(wave_sum(s) * (1.f / D) + EPS);
#pragma unroll
    for (int j = 0; j < 8; ++j) { const int c = 4 * lane + 256 * j; const f32x4 gg = *(const f32x4*)(g + c); __builtin_nontemporal_store(v[j] * rr * gg, (f32x4*)(orow + c)); }
}

#ifndef REPV
#define REPV 0
#endif
#ifndef MK_N_LAUNCHES
#define MK_N_LAUNCHES 1
#endif
constexpr int N_PHASES = 25;

__global__ void __launch_bounds__(NTHR, 2) fwd_kernel(Args args) {
    extern __shared__ __attribute__((aligned(16))) unsigned char lds[];
    Frame F;
    F.lds = (LAS unsigned char*)lds;
    F.MISC = (volatile LAS unsigned*)(F.lds + MISC_OFF);
    F.tid = threadIdx.x; F.lane = F.tid & 63; F.wave = __builtin_amdgcn_readfirstlane(F.tid >> 6);
    F.G = gridDim.x; F.gw = blockIdx.x * NWAVES + F.wave; F.NGW = F.G * NWAVES;
    F.ws = args.ws; F.ctl = (gu32*)(args.ws + WS_CTL);
    if (F.tid < 38) ((const float**)(args.ws + CTL_TBL + (size_t)blockIdx.x * 512))[F.tid] = args.in[F.tid];
    unsigned char* ws = args.ws;
    for (int u = F.tid; u < (LDS_BYTES - LDSCTL_OFF) / 4; u += NTHR) ((LAS unsigned*)(F.lds + LDSCTL_OFF))[u] = 0u;
    __syncthreads();
    XcdBarrier bar = xcd_barrier_post((unsigned*)(F.ctl + CW_BAR) + args.li * XCD_BAR_WORDS, F.MISC + 8);
    const int lo = args.ph_lo, hi = args.ph_hi;
#define IN(k) (lo <= (k) && (k) < hi)
#ifdef PROBE_K
#define STAMP(i) do { if (blockIdx.x == 0 && threadIdx.x == 0) ((unsigned long long*)(args.ws + WS_CTL) + CW_DBG / 2)[(i)] = wall_clock64(); } while (0)
#else
#define STAMP(i) do { } while (0)
#endif
#define SEAM(k) do { if (IN(k) && IN((k) + 1)) xcd_barrier(bar); STAMP((k) + 1); } while (0)
    const int bx = blockIdx.x;
    STAMP(0);

#ifdef REP_PHASE
#define REPS(k) ((k) == REP_PHASE ? 1 + REP_N : 1)
#else
#define REPS(k) 1
#endif
#ifndef REPV
#define REPV 0
#endif
    for (int rep_ = 0; rep_ < REPS(0); ++rep_) if (IN(0)) { if (rep_) xcd_barrier(bar); F.ws = launder(args.ws); F.tid = vlaunder(threadIdx.x); F.lane = F.tid & 63; p0_prologue(F, rep_ ? REPV : 0); }
    SEAM(0);

#pragma unroll 1
    for (int l = 0; l < 2; ++l) {
        const int P = 1 + 12 * l;
#define PH(k) for (int rep_ = 0; rep_ < REPS(k); ++rep_) if (IN(k)) if ((rep_ == 0 || (xcd_barrier(bar), true)) && (F.ws = ws = launder(args.ws)) != nullptr && ((F.tid = vlaunder(threadIdx.x)), (F.lane = F.tid & 63), true))
        PH(P + 0) {
            pg8::Gemm g{(const bf16*)(ws + WS_HN), (const bf16*)(ws + R_WIN) + (size_t)l * 4096 * D, D, S, 4096};
            pg8::StaticOrder so; so.init(S, 4096, F.G, bx);
            if (rep_ && REPV == 1) { EpiBiasBf16 E2{(bf16*)(ws + R_ACT), 4096, F.in(IN_FNG)}; pg8::gemm_phase(F.lds + RING_OFF, g, so, E2); }
            else {
            EpiInProj E{(bf16*)(ws + R_CONVU), (bf16*)(ws + R_Q), (bf16*)(ws + R_KV), (bf16*)(ws + R_U)};
            pg8::gemm_phase(F.lds + RING_OFF, g, so, E); }
        }
        SEAM(P + 0);
        PH(P + 1) {
            if (!rep_ || REPV == 0 || REPV == 5)
            { pg8::Gemm g{(const bf16*)(ws + R_U), (const bf16*)(ws + R_TW) + (size_t)l * NGRP * 512 * 256, 256, 32768, 16384};
              Ssm1Order so{F.G, bx}; EpiSsm1 E{(float*)(ws + R_YINTRA), (float*)(ws + R_SC)};
              pg8::gemm_phase(F.lds + RING_OFF, g, so, E); }
            if (!rep_ || REPV == 0 || REPV == 1)
            for (int c = bx; c < 256; c += F.G) compress_job(F, l, c);
            const float* pGB = F.in(IN_GB); const int* pPOS = (const int*)F.in(IN_POS); const float* pDWW = F.in(IN_DWW); const float* pDWB = F.in(IN_DWB); const float* pLNG = F.in(IN_LNG); const float* pLNB = F.in(IN_LNB);
            if (F.NGW == 2048) {
                for (int j = F.gw; j < 2048 + 4096; j += F.NGW) {
                    if (j < 2048) { if (!rep_ || REPV == 0 || REPV == 2) vt_job(F, j); }
                    else { if (!rep_ || REPV == 0 || REPV == 3) dwconv_job(F, pDWW, pDWB, pLNG, pLNB, l, j - 2048); } }
                if (F.gw < 1024) { if (!rep_ || REPV == 0 || REPV == 4) gates_job(F, pGB, l, F.gw);
                    if (!rep_) for (int i = 0; i < 4; ++i) rope_job(F, pPOS, F.gw + 1024 * i); }
                else { if (!rep_) for (int i = 0; i < 12; ++i) rope_job(F, pPOS, 4096 + (F.gw - 1024) + 1024 * i); }
            } else
            for (int j = F.gw; j < 2048 + 4096 + 1024 + (rep_ ? 0 : S); j += F.NGW) {
                int r = j;
                if (r < 2048) { if (!rep_ || REPV == 0 || REPV == 2) vt_job(F, r); continue; } r -= 2048;
                if (r < 4096) { if (!rep_ || REPV == 0 || REPV == 3) dwconv_job(F, pDWW, pDWB, pLNG, pLNB, l, r); continue; } r -= 4096;
                if (r < 1024) { if (!rep_ || REPV == 0 || REPV == 4) gates_job(F, pGB, l, r); continue; } r -= 1024;
                rope_job(F, pPOS, r);
            }
        }
        SEAM(P + 1);
        PH(P + 2) {
            if (!rep_ || REPV == 0 || REPV == 1)
            { pg8::Gemm g{(const bf16*)(ws + R_CONVACT), (const bf16*)(ws + R_CPW) + (size_t)l * 512 * 512, 512, S, 512};
              pg8::StaticOrder so; so.init(S, 512, F.G, bx); EpiBiasBf16 E{(bf16*)(ws + R_CONVO), DCONV, F.in(IN_PWB) + l * DCONV};
              pg8::gemm_phase(F.lds + RING_OFF, g, so, E); }
            const bool scan_wave = (F.NGW >= 64) && (F.wave == 0) && (bx < 32);
            if (scan_wave) { if (!rep_ || REPV == 0 || REPV == 2) scan_job(F, l, bx); }
            else if (F.NGW < 64) { if (F.gw == 0) for (int gg = 0; gg < 32; ++gg) scan_job(F, l, gg); }
            if (F.NGW == 2048) {
                if (F.gw < 1024) { const int i = F.gw >> 1, g = F.gw & 1;
                    if (!rep_ || REPV == 0 || REPV == 3) { cmp_stats_job(F, g, 1023 - i); cmp_stats_job(F, g, i); } }
                else { const int e = F.gw - 1024;
                    if (!rep_ || REPV == 0 || REPV == 4)
                    for (int pp = 0; pp < 2; ++pp) { const int p = 2 * e + pp, i = p >> 2, hp = p & 3; cmp_att_job2(F, 1023 - i, hp); cmp_att_job2(F, i, hp); } }
                if (!scan_wave) { const int nsw = bx < 32 ? bx + 1 : 32;
                    if (!rep_ || REPV == 0 || REPV == 5)
                    for (int r = F.gw - nsw; r < 8192; r += 2016) win_att_job8(F, r >> 3, r & 7); }
            } else {
                for (int j = F.gw; j < 2048 + 4096 + 8192; j += F.NGW) {
                    if (j < 2048) cmp_stats_job(F, j & 1, 1023 - (j >> 1));
                    else if (j < 6144) cmp_att_job2(F, 1023 - ((j - 2048) >> 2), (j - 2048) & 3);
                    else win_att_job8(F, (j - 6144) >> 3, (j - 6144) & 7);
                }
            }
        }
        SEAM(P + 2);
        PH(P + 3) {
            gu32* cnt2 = F.ctl + CW_SSM2 + l * 4 * 64;
            { pg8::Gemm g{(const bf16*)(ws + R_HPREV), (const bf16*)(ws + R_WO2) + (size_t)l * NGRP * 256 * 256, 256, 32768, 8192};
              Ssm2Order so{F.G, bx}; EpiSsm2 E{(const float*)(ws + R_YINTRA), (const bf16*)(ws + R_U), F.in(IN_SD) + l * DSSM, (bf16*)(ws + R_YSSM), (bf16*)(ws + R_GY)};
              pg8::gemm_phase(F.lds + RING_OFF, g, so, E);
              if (bx < 128) { VM_WAIT(); __syncthreads();
                  if (F.tid == 0) { __builtin_amdgcn_fence(__ATOMIC_RELEASE, "agent"); asm volatile("s_waitcnt vmcnt(0)" ::: "memory");
                      for (int L = bx; L < 128; L += F.G) __hip_atomic_fetch_add(cnt2 + 64 * (L & 3), 1u, RLX_AGENT); } } }
            if (F.G == 256) {
                const int x = bx & 7, g = x & 1, qi = x >> 1, w = (bx >> 3) * NWAVES + F.wave;
                const int qbase = (qi == 0) ? 0 : 4456 + (qi - 1) * 3976, qend = (qi == 3) ? S : 4456 + qi * 3976;
                f32x4 iv = sel_imp_load(F, qbase + w, g);
                for (int t = qbase + w; t < qend; t += 256) { const int tn = (t + 256 < qend) ? t + 256 : t; const f32x4 ivn = sel_imp_load(F, tn, g);
                    sel_att_job(F, t, g, iv, rep_ ? REPV : 0); iv = ivn; }
            } else
            for (int j = F.gw; j < 2 * S; j += F.NGW) sel_att_job(F, S - 1 - (j >> 1), j & 1, sel_imp_load(F, S - 1 - (j >> 1), j & 1));
            for (int L2 = F.G - 1 - bx; L2 < 128; L2 += F.G) {
                const int pm = L2 >> 1, pn = L2 & 1;
                if (F.tid == 0) { unsigned sp = 0;
                    while (__hip_atomic_load(cnt2 + 64 * (pm >> 4), RLX_AGENT) < 32u) { __builtin_amdgcn_s_sleep(2);
                        if (++sp > (1u << 22)) { __hip_atomic_store(F.ctl + CW_SSM2 + 8 * 64, 1u, RLX_AGENT); break; } }
                    __builtin_amdgcn_fence(__ATOMIC_ACQUIRE, "agent"); asm volatile("s_waitcnt vmcnt(0)" ::: "memory"); }
                __syncthreads();
                pg8::Gemm g{(const bf16*)(ws + R_YSSM), (const bf16*)(ws + R_GLU) + (size_t)l * 512 * 512, 512, S, 512};
                OneUnit so{pm, pn}; EpiGlu E{(const bf16*)(ws + R_GY), F.in(IN_GLB) + l * DSSM, (bf16*)(ws + R_SSMO)};
                pg8::gemm_phase(F.lds + RING_OFF, g, so, E);
            }
        }
        SEAM(P + 3);
        PH(P + 5) { const float* pMOG = F.in(IN_MOG); for (int t = F.gw; t < S; t += F.NGW) mixnorm_job(F, pMOG, l, t); }
        SEAM(P + 5);
        PH(P + 6) {
            pg8::Gemm g{(const bf16*)(ws + R_MIXED), (const bf16*)(ws + R_WOUT) + (size_t)l * D * D, D, S, D};
            pg8::StaticOrder so; so.init(S, D, F.G, bx); EpiResid E{l == 0 ? (const void*)F.in(IN_X) : (const void*)(ws + WS_H), l != 0, (bf16*)(ws + WS_H), 1.f};
            pg8::gemm_phase(F.lds + RING_OFF, g, so, E);
        }
        SEAM(P + 6);
        PH(P + 7) { const float* gn = F.in(IN_NFG) + (size_t)l * D; const float* prw = F.in(IN_RW); for (int t = F.gw; t < S; t += F.NGW) norm_route_job(F, gn, prw, t, l == 1); }
        SEAM(P + 7);
        if (l == 0) {
            PH(P + 8) {
                pg8::Gemm g{(const bf16*)(ws + R_HN8), (const bf16*)(ws + R_FGU), D / 2, S, 2 * DFF};
                pg8::StaticOrder so; so.init(S, 2 * DFF, F.G, bx); EpiSwiglu8 E{(unsigned char*)(ws + R_ACT), S, 2 * DFF / 256};
                pg8::gemm_phase<EpiSwiglu8, pg8::StaticOrder, true, true, true, 0, true>(F.lds + RING_OFF, g, so, E);
            }
            SEAM(P + 8);
            PH(P + 9) {
                pg8::Gemm g{(const bf16*)(ws + R_ACT), (const bf16*)(ws + R_FD), DFF / 2, S, D};
                pg8::StaticOrder so; so.init(S, D, F.G, bx); EpiResid E{(const void*)(ws + WS_H), true, (bf16*)(ws + WS_H), 1.f / (MOE_WSCALE * MOE_ASCALE)};
                pg8::gemm_phase<EpiResid, pg8::StaticOrder, true, true, true, 0, true>(F.lds + RING_OFF, g, so, E);
            }
            SEAM(P + 9);
            PH(P + 10) { const float* gn = F.in(IN_NMG) + D; for (int t = F.gw; t < S; t += F.NGW) rms_row_to_bf16<true>((const bf16*)(ws + WS_H) + (size_t)t * D, gn, (unsigned char*)(ws + WS_HN), t, F.lane); }
            SEAM(P + 10);
            SEAM(P + 11);
        } else {
            PH(P + 8) { int pe[NE + 1]; moe_prefix(F, pe); for (int j = F.gw; j < 2 * S; j += F.NGW) moe_gather_job(F, pe, j); }
            SEAM(P + 8);
            PH(P + 9) {
                MoeOrder mo; moe_prefix(F, mo.pe); mo.nct = 2 * DFFE / 256; mo.so.init(mo.pe[NE] * 256, 2 * DFFE, F.G, bx);
                pg8::Gemm g{(const bf16*)(ws + M_ASORT), (const bf16*)(ws + WS_MOE_GU), D / 2, NPAD, NE * 2 * DFFE};
                EpiSwiglu8 E{(unsigned char*)(ws + M_ACTS), NPAD, 2 * DFFE / 256};
#if defined(REP_PHASE) && REPV == 1
                if (rep_) { EpiSwiglu8 E2{(unsigned char*)(ws + M_ACTS + 238 * MiB), NPAD, 2 * DFFE / 256}; pg8::gemm_phase<EpiSwiglu8, MoeOrder, true, true, true, 1>(F.lds + RING_OFF, g, mo, E2); } else
#elif defined(REP_PHASE) && REPV == 2
                if (rep_) { EpiSwiglu8 E2{(unsigned char*)(ws + M_ACTS + 238 * MiB), NPAD, 2 * DFFE / 256}; pg8::gemm_phase<EpiSwiglu8, MoeOrder, true, true, true, 2>(F.lds + RING_OFF, g, mo, E2); } else
#endif
                pg8::gemm_phase<EpiSwiglu8, MoeOrder, true, true, true>(F.lds + RING_OFF, g, mo, E);
            }
            SEAM(P + 9);
            PH(P + 10) {
                MoeOrder mo; moe_prefix(F, mo.pe); mo.nct = D / 256; mo.so.init(mo.pe[NE] * 256, D, F.G, bx);
                const int units = mo.pe[NE] * (D / 256), full = (F.G == 256) ? units / 256 : (1 << 30), T = (F.G == 256) ? units - full * 256 : 0;
                mo.imax = full;
                pg8::Gemm g{(const bf16*)(ws + M_ACTS), (const bf16*)(ws + WS_MOE_D), DFFE / 2, NPAD, NE * D};
                const float oscale = 1.f / (MOE_WSCALE * MOE_ASCALE);
                EpiMoeDown E{(bf16*)(ws + M_YS), (const float*)(ws + WS_TOK + TOK_RW), oscale};
                pg8::gemm_phase<EpiMoeDown, MoeOrder, true, true, true>(F.lds + RING_OFF, g, mo, E);
                if (T > 0) {
                    const int ns = (T <= 36) ? 7 : 4, kt = (DFFE / 128) / ns;
                    if (bx < T * ns) {
                        const int u = bx / ns, sl = bx - u * ns;
                        Unit uu; mo.at((long)full * 256 + u, uu);
                        float* part = (float*)(ws + M_ASORT) + (size_t)(u * ns) * 65536;
                        pg8::Gemm gs{(const bf16*)((const unsigned char*)(ws + M_ACTS) + (size_t)sl * kt * NPAD * 128), (const bf16*)((const unsigned char*)(ws + WS_MOE_D) + (size_t)sl * kt * (NE * D) * 128), kt * 64, NPAD, NE * D};
                        OneUnit ou{uu.pm, uu.pn}; EpiMoePart EP{part + (size_t)sl * 65536};
                        pg8::gemm_phase<EpiMoePart, OneUnit, true, true, true>(F.lds + RING_OFF, gs, ou, EP);
                        VM_WAIT(); __syncthreads();
                        if (F.tid == 0) { __builtin_amdgcn_fence(__ATOMIC_RELEASE, "agent"); asm volatile("s_waitcnt vmcnt(0)" ::: "memory");
                            __hip_atomic_fetch_add(F.ctl + CW_TAIL + 64 * u, 1u, RLX_AGENT);
                            unsigned sp = 0;
                            while (__hip_atomic_load(F.ctl + CW_TAIL + 64 * u, RLX_AGENT) < (unsigned)ns) { __builtin_amdgcn_s_sleep(2);
                                if (++sp > (1u << 22)) { __hip_atomic_store(F.ctl + CW_SSM2 + 8 * 64, 1u, RLX_AGENT); break; } }
                            __builtin_amdgcn_fence(__ATOMIC_ACQUIRE, "agent"); asm volatile("s_waitcnt vmcnt(0)" ::: "memory"); }
                        __syncthreads();
                        {
                            const float* rwp = (const float*)(ws + WS_TOK + TOK_RW); bf16* O = (bf16*)(ws + M_YS);
                            const int per = (256 * 32 + ns - 1) / ns, i0 = sl * per, i1 = (i0 + per < 256 * 32) ? i0 + per : 256 * 32;
                            for (int it = i0 + F.tid; it < i1; it += NTHR) {
                                const int row = it >> 5, c8 = (it & 31) * 8; const float* p = part + (size_t)row * 256 + c8;
                                f32x4 va[7], vb[7];
#pragma unroll
                                for (int k = 0; k < 7; ++k) { const float* pk = p + (size_t)(k < ns ? k : 0) * 65536; va[k] = *(const f32x4*)pk; vb[k] = *(const f32x4*)(pk + 4); }
                                f32x4 a = va[0], b = vb[0];
#pragma unroll
                                for (int k = 1; k < 7; ++k) if (k < ns) { a = a + va[k]; b = b + vb[k]; }
                                const int grow = uu.pm * 256 + row; const float sc = rwp[grow] * oscale;
                                v4u w; w.x = pg8::cvt_pk_bf16(a[0] * sc, a[1] * sc); w.y = pg8::cvt_pk_bf16(a[2] * sc, a[3] * sc); w.z = pg8::cvt_pk_bf16(b[0] * sc, b[1] * sc); w.w = pg8::cvt_pk_bf16(b[2] * sc, b[3] * sc);
                                *(v4u*)(O + (size_t)grow * D + (uu.pn & 7) * 256 + c8) = w;
                            }
                        }
                    }
                }
            }
            SEAM(P + 10);
            PH(P + 11) { const float* pFNG = F.in(IN_FNG); for (int t = F.gw; t < S; t += F.NGW) moe_combine_job(F, args.out, pFNG, t); }
        }
    }
#ifdef PROBE_K
    xcd_barrier(bar); STAMP(25);
    xcd_barrier(bar);
    { const unsigned long long* T = (const unsigned long long*)(args.ws + WS_CTL) + CW_DBG / 2;
      const float d1 = (float)(T[PROBE_K + 1] - T[PROBE_K]) * 0.01f, d2 = (float)(T[PROBE_K + 2] - T[PROBE_K + 1]) * 0.01f;
      const float c1 = sqrtf(d1), c2 = 10.f * d2;
      for (size_t i = (size_t)blockIdx.x * NTHR + threadIdx.x; i < (size_t)S * D; i += (size_t)gridDim.x * NTHR) args.out[i] = (i == 0) ? c2 : c1; }
#endif
#undef IN
#undef PH
#undef REPS
#undef SEAM
}

extern "C" void kernel_launch(void* const* d_in, const int* in_sizes, int n_in, void* d_out, int out_size, void* d_ws, size_t ws_size, hipStream_t stream) {
    static int grid = 0;
    if (grid == 0) {
        if (n_in != 38 || out_size != S * D || ws_size < WS_END) { fprintf(stderr, "kernel_launch: unexpected problem shape (n_in %d, out %d, ws %zu < %zu)\n", n_in, out_size, ws_size, (size_t)WS_END); grid = -1; return; }
        int dev = 0, cus = 0, per_cu = 0;
        if (hipGetDevice(&dev) != hipSuccess || hipDeviceGetAttribute(&cus, hipDeviceAttributeMultiprocessorCount, dev) != hipSuccess) { grid = -1; return; }
        if (hipFuncSetAttribute((const void*)fwd_kernel, hipFuncAttributeMaxDynamicSharedMemorySize, LDS_BYTES) != hipSuccess) { fprintf(stderr, "kernel_launch: hipFuncSetAttribute failed\n"); grid = -1; return; }
        if (hipOccupancyMaxActiveBlocksPerMultiprocessor(&per_cu, (const void*)fwd_kernel, NTHR, LDS_BYTES) != hipSuccess || per_cu < 1)
            fprintf(stderr, "kernel_launch: note: occupancy query says %d\n", per_cu);
        (void)hipGetLastError();
        grid = cus;
    }
    if (grid < 0) return;
    if (hipMemsetAsync((char*)d_ws + WS_CTL, 0, CTL_ZERO_BYTES, stream) != hipSuccess) return;
    Args a{};
    for (int i = 0; i < 38; ++i) a.in[i] = (const float*)d_in[i];
    a.out = (float*)d_out; a.ws = (unsigned char*)d_ws; a.dbg = 0;
    constexpr int NL = MK_N_LAUNCHES;
    for (int li = 0; li < NL; ++li) {
        a.ph_lo = (NL == 1) ? 0 : li; a.ph_hi = (NL == 1) ? N_PHASES : li + 1; a.li = li;
        hipLaunchKernelGGL(fwd_kernel, dim3(grid), dim3(NTHR), LDS_BYTES, stream, a);
        const hipError_t le = hipPeekAtLastError();
        if (le != hipSuccess) { fprintf(stderr, "kernel_launch: launch %d failed: %s\n", li, hipGetErrorName(le)); break; }
    }
}
```
